# Optimizing an MI355X kernel written in HIP

```python
import math
import jax, jax.numpy as jnp
from jax import lax
import numpy as np

D_MODEL = 1024
BATCH = 8
SEQ = 4096
DEPTH = 2

CHUNK = 64
N_EVEN = (DEPTH + 1) // 2
N_ODD = DEPTH // 2
A_WIDTH = D_MODEL // 2
A_KEY = 128
A_HEADS = A_WIDTH // A_KEY
A_VAL = A_WIDTH // A_HEADS
B_WIDTH = D_MODEL // 2
B_HEAD = 64
B_HEADS = B_WIDTH // B_HEAD
B_DECAY_LORA = 32
B_AAA_LORA = 32
B_GATE_LORA = 96
B_SHIFT_COLS = 3 * B_WIDTH + B_DECAY_LORA + B_AAA_LORA + B_GATE_LORA
EVEN_IN = 4 * A_WIDTH + B_SHIFT_COLS
C_WIDTH = D_MODEL // 4
C_GROUP = 16
C_GROUPS = C_WIDTH // C_GROUP
C_STATE = 64
D_WIDTH = D_MODEL - C_WIDTH
D_HEADS = 4
D_HEAD = D_WIDTH // D_HEADS
D_CONV = 4
ODD_IN = C_WIDTH + 4 * D_WIDTH + 2 * D_HEADS
FFN_HIDDEN = ((8 * D_MODEL // 3 + 255) // 256) * 256

RMS_EPS = 1e-6
GN_EPS = 64e-5
M_INIT = -1e30
F32 = jnp.float32

kernel_name = "hybrid_hgrn2_rwkv7_s5_mlstm_trunk"


def rms_norm(x, g):
    xf = x.astype(F32)
    y = xf * lax.rsqrt(jnp.mean(xf * xf, axis=-1, keepdims=True) + RMS_EPS)
    return (y * g.astype(F32)).astype(x.dtype)


def head_rms_norm(y, g, n_heads):
    bn, s, w = y.shape
    yh = y.reshape(bn, s, n_heads, w // n_heads)
    yh = yh * lax.rsqrt(jnp.mean(yh * yh, axis=-1, keepdims=True) + RMS_EPS)
    return yh.reshape(bn, s, w) * g.astype(F32)


def split_cols(u, sizes):
    return jnp.split(u, np.cumsum(sizes)[:-1].tolist(), axis=-1)


def token_shift(u):
    return jnp.pad(u, ((0, 0), (1, 0), (0, 0)))[:, :-1]


def causal_depthwise_conv(u, w):
    k, c = w.shape
    return lax.conv_general_dilated(
        u, w[:, None, :].astype(u.dtype), window_strides=(1,), padding=[(k - 1, 0)],
        dimension_numbers=("NWC", "WIO", "NWC"), feature_group_count=c)


def to_chunks(t):
    bn, s, h, d = t.shape
    return t.reshape(bn, s // CHUNK, CHUNK, h, d).transpose(1, 0, 3, 2, 4)


def from_chunks(t):
    nc, bn, h, l, d = t.shape
    return t.transpose(1, 0, 3, 2, 4).reshape(bn, nc * l, h, d)


def gate_chunks(t):
    bn, s, h = t.shape
    return t.reshape(bn, s // CHUNK, CHUNK, h).transpose(1, 0, 3, 2)


def hgrn2_mix(q, f_pre, i, g, lb, gain):
    bn, s, _ = q.shape
    q = jax.nn.silu(q.astype(F32))
    lb = lb.astype(F32)
    f = lb + (1.0 - lb) * jax.nn.sigmoid(f_pre.astype(F32))
    logf = jnp.log(f)
    k = 1.0 - f
    heads = lambda t: to_chunks(t.reshape(bn, s, A_HEADS, -1))
    mask = jnp.tril(jnp.ones((CHUNK, CHUNK), dtype=bool))[:, :, None]

    def chunk_step(state, inp):
        qc, kc, lfc, vc = inp
        b = jnp.cumsum(lfc, axis=2)
        diff = b[:, :, :, None, :] - b[:, :, None, :, :]
        decay = jnp.exp(jnp.where(mask, diff, -jnp.inf))
        att = jnp.einsum("bhtk,bhsk,bhtsk->bhts", qc, kc, decay)
        o = (jnp.einsum("bhtk,bhkv->bhtv", qc * jnp.exp(b), state)
             + jnp.einsum("bhts,bhsv->bhtv", att, vc))
        b_last = b[:, :, -1:, :]
        state = (jnp.exp(b_last[:, :, 0, :])[..., None] * state
                 + jnp.einsum("bhsk,bhsv->bhkv", kc * jnp.exp(b_last - b), vc))
        return state, o

    state0 = jnp.zeros((bn, A_HEADS, A_KEY, A_VAL), F32)
    _, o = lax.scan(chunk_step, state0,
                    (heads(q), heads(k), heads(logf), heads(i.astype(F32))))
    o = from_chunks(o).reshape(bn, s, A_WIDTH)
    return head_rms_norm(o, gain, A_HEADS) * jax.nn.silu(g.astype(F32))


def rwkv7_mix(u, mu, w0, w2, a0, a2, g2, k_k, k_a, r_k, ln_w, ln_b):
    bn, s, _ = u.shape
    u = u.astype(F32)
    u = u + (token_shift(u) - u) * mu.astype(F32)
    r, k, v, wd, ad, gd = split_cols(
        u, (B_WIDTH, B_WIDTH, B_WIDTH, B_DECAY_LORA, B_AAA_LORA, B_GATE_LORA))
    w_log = -jax.nn.softplus(-(w0 + jnp.tanh(wd) @ w2)) - 0.5
    decay = jnp.exp(-jnp.exp(w_log))
    a = jax.nn.sigmoid(a0 + ad @ a2)
    g = jax.nn.sigmoid(gd) @ g2
    heads = lambda t: t.reshape(bn, s, B_HEADS, B_HEAD)
    kk = heads(k * k_k)
    kk = kk / jnp.maximum(jnp.sqrt(jnp.sum(kk * kk, axis=-1, keepdims=True)), 1e-12)
    k = heads(k * (1.0 + (a - 1.0) * k_a))
    r, v, decay, a = heads(r), heads(v), heads(decay), heads(a)

    def step(state, inp):
        r_t, w_t, k_t, v_t, a_t, b_t = inp
        sa = jnp.einsum("bhvk,bhk->bhv", state, a_t)
        state = (state * w_t[:, :, None, :] + sa[..., None] * b_t[:, :, None, :]
                 + v_t[..., None] * k_t[:, :, None, :])
        return state, jnp.einsum("bhvk,bhk->bhv", state, r_t)

    tm = lambda t: t.transpose(1, 0, 2, 3)
    state0 = jnp.zeros((bn, B_HEADS, B_HEAD, B_HEAD), F32)
    _, y = lax.scan(step, state0,
                    (tm(r), tm(decay), tm(k), tm(v), tm(-kk), tm(kk * a)))
    y = y.transpose(1, 0, 2, 3)
    mean = jnp.mean(y, axis=-1, keepdims=True)
    var = jnp.mean(jnp.square(y - mean), axis=-1, keepdims=True)
    y = ((y - mean) * lax.rsqrt(var + GN_EPS) * ln_w.astype(F32).reshape(B_HEADS, B_HEAD)
         + ln_b.astype(F32).reshape(B_HEADS, B_HEAD))
    y = y + jnp.sum(r * k * r_k.astype(F32).reshape(B_HEADS, B_HEAD), axis=-1, keepdims=True) * v
    return y.reshape(bn, s, B_WIDTH) * g


def _complex_affine_combine(e1, e2):
    a1r, a1i, b1r, b1i = e1
    a2r, a2i, b2r, b2i = e2
    return (a2r * a1r - a2i * a1i,
            a2r * a1i + a2i * a1r,
            a2r * b1r - a2i * b1i + b2r,
            a2r * b1i + a2i * b1r + b2i)


def s5_mix(u, lam_re, lam_im, log_step, b_re, b_im, c_re, c_im, d_skip, glu_w, glu_b):
    bn, s, _ = u.shape
    u = u.astype(F32)
    lam_re, lam_im = lam_re.astype(F32), lam_im.astype(F32)
    step = jnp.exp(log_step.astype(F32))[:, None]
    mag = jnp.exp(lam_re * step)
    lb_re, lb_im = mag * jnp.cos(lam_im * step), mag * jnp.sin(lam_im * step)
    den = lam_re * lam_re + lam_im * lam_im
    nr, ni = lb_re - 1.0, lb_im
    coef_re = (nr * lam_re + ni * lam_im) / den
    coef_im = (ni * lam_re - nr * lam_im) / den
    b_re, b_im = b_re.astype(F32), b_im.astype(F32)
    bb_re = coef_re[..., None] * b_re - coef_im[..., None] * b_im
    bb_im = coef_re[..., None] * b_im + coef_im[..., None] * b_re
    ug = u.reshape(bn, s, C_GROUPS, C_GROUP)
    xr = jnp.einsum("bsgh,gph->sbgp", ug, bb_re)
    xi = jnp.einsum("bsgh,gph->sbgp", ug, bb_im)
    a_re = jnp.broadcast_to(lb_re, (s, 1, C_GROUPS, C_STATE))
    a_im = jnp.broadcast_to(lb_im, (s, 1, C_GROUPS, C_STATE))
    _, _, hr, hi = lax.associative_scan(_complex_affine_combine, (a_re, a_im, xr, xi), axis=0)
    y = (jnp.einsum("sbgp,ghp->bsgh", hr, c_re.astype(F32))
         - jnp.einsum("sbgp,ghp->bsgh", hi, c_im.astype(F32)))
    y = y.reshape(bn, s, C_WIDTH) + d_skip.astype(F32) * u
    z = jax.nn.gelu(y)
    return z * jax.nn.sigmoid(z @ glu_w.astype(F32) + glu_b.astype(F32))


def mlstm_mix(q, k, v, o, i_pre, f_pre, conv_q, conv_k, gain):
    bn, s, _ = q.shape
    q = jax.nn.silu(causal_depthwise_conv(q.astype(F32), conv_q.astype(F32)))
    k = jax.nn.silu(causal_depthwise_conv(k.astype(F32), conv_k.astype(F32))) / math.sqrt(D_HEAD)
    heads = lambda t: to_chunks(t.reshape(bn, s, D_HEADS, D_HEAD))
    log_f = jax.nn.log_sigmoid(f_pre.astype(F32))
    log_i = i_pre.astype(F32)
    mask = jnp.tril(jnp.ones((CHUNK, CHUNK), dtype=bool))

    def chunk_step(carry, inp):
        c_st, n_st, m_st = carry
        qc, kc, vc, lfc, ic = inp
        b = jnp.cumsum(lfc, axis=-1)
        dmat = jnp.where(mask, b[..., :, None] - b[..., None, :] + ic[..., None, :], -jnp.inf)
        e_inter = b + m_st[..., None]
        m_t = jnp.maximum(e_inter, jnp.max(dmat, axis=-1))
        w_intra = jnp.exp(dmat - m_t[..., None])
        s_inter = jnp.exp(e_inter - m_t)
        qk = jnp.einsum("bhtd,bhsd->bhts", qc, kc) * w_intra
        num = (s_inter[..., None] * jnp.einsum("bhtd,bhdv->bhtv", qc, c_st)
               + jnp.einsum("bhts,bhsv->bhtv", qk, vc))
        den = s_inter * jnp.einsum("bhtd,bhd->bht", qc, n_st) + jnp.sum(qk, axis=-1)
        h = num / jnp.maximum(jnp.abs(den), jnp.exp(-m_t))[..., None]
        m_new = m_t[..., -1]
        w_last = jnp.exp(b[..., -1:] - b + ic - m_new[..., None])
        d_prev = jnp.exp(b[..., -1] + m_st - m_new)
        c_new = d_prev[..., None, None] * c_st + jnp.einsum("bhs,bhsd,bhsv->bhdv", w_last, kc, vc)
        n_new = d_prev[..., None] * n_st + jnp.einsum("bhs,bhsd->bhd", w_last, kc)
        return (c_new, n_new, m_new), h

    carry0 = (jnp.zeros((bn, D_HEADS, D_HEAD, D_HEAD), F32),
              jnp.zeros((bn, D_HEADS, D_HEAD), F32),
              jnp.full((bn, D_HEADS), M_INIT, F32))
    _, h = lax.scan(chunk_step, carry0,
                    (heads(q), heads(k), heads(v.astype(F32)), gate_chunks(log_f), gate_chunks(log_i)))
    h = from_chunks(h).reshape(bn, s, D_WIDTH)
    return head_rms_norm(h, gain, D_HEADS) * jax.nn.sigmoid(o.astype(F32))


def swiglu(h, w_gate, w_up, w_down):
    return (jax.nn.silu(h @ w_gate) * (h @ w_up)) @ w_down


def setup_inputs(seed: int = 0) -> dict:
    key = jax.random.key(seed)
    ks = iter(jax.random.split(key, 64))
    nrm = lambda shape, scale: jax.random.normal(next(ks), shape, F32) * scale
    d = D_MODEL
    lam_im0 = jnp.float32(np.pi) * jnp.arange(C_STATE, dtype=F32)
    return {
        "x": nrm((BATCH, SEQ, d), 1.0),
        "norm_mix": 1.0 + nrm((DEPTH, d), 0.02),
        "norm_ffn": 1.0 + nrm((DEPTH, d), 0.02),
        "norm_final": 1.0 + nrm((d,), 0.02),
        "w_in_even": nrm((N_EVEN, d, EVEN_IN), d ** -0.5),
        "w_out_even": nrm((N_EVEN, A_WIDTH + B_WIDTH, d), (A_WIDTH + B_WIDTH) ** -0.5),
        "lb_table": nrm((DEPTH + 1, A_WIDTH), 0.1),
        "a_norm": 1.0 + nrm((N_EVEN, A_WIDTH), 0.02),
        "b_mu": jax.random.uniform(next(ks), (N_EVEN, B_SHIFT_COLS), F32),
        "b_w0": jnp.linspace(-6.0, -1.0, B_WIDTH, dtype=F32) + nrm((N_EVEN, B_WIDTH), 0.1),
        "b_w2": nrm((N_EVEN, B_DECAY_LORA, B_WIDTH), 0.1 * B_DECAY_LORA ** -0.5),
        "b_a0": nrm((N_EVEN, B_WIDTH), 0.1),
        "b_a2": nrm((N_EVEN, B_AAA_LORA, B_WIDTH), 0.3 * B_AAA_LORA ** -0.5),
        "b_g2": nrm((N_EVEN, B_GATE_LORA, B_WIDTH), B_GATE_LORA ** -0.5),
        "b_kk": 0.85 + nrm((N_EVEN, B_WIDTH), 0.02),
        "b_ka": 1.0 + nrm((N_EVEN, B_WIDTH), 0.02),
        "b_rk": nrm((N_EVEN, B_WIDTH), 0.1),
        "b_ln_w": 1.0 + nrm((N_EVEN, B_WIDTH), 0.02),
        "b_ln_b": nrm((N_EVEN, B_WIDTH), 0.02),
        "w_in_odd": nrm((N_ODD, d, ODD_IN), d ** -0.5),
        "w_out_odd": nrm((N_ODD, C_WIDTH + D_WIDTH, d), (C_WIDTH + D_WIDTH) ** -0.5),
        "c_lam_re": -0.5 + nrm((N_ODD, C_GROUPS, C_STATE), 0.01),
        "c_lam_im": lam_im0 + nrm((N_ODD, C_GROUPS, C_STATE), 0.01),
        "c_log_step": jax.random.uniform(next(ks), (N_ODD, C_GROUPS), F32,
                                         minval=math.log(1e-3), maxval=math.log(1e-1)),
        "c_b_re": nrm((N_ODD, C_GROUPS, C_STATE, C_GROUP), (2 * C_GROUP) ** -0.5),
        "c_b_im": nrm((N_ODD, C_GROUPS, C_STATE, C_GROUP), (2 * C_GROUP) ** -0.5),
        "c_c_re": nrm((N_ODD, C_GROUPS, C_GROUP, C_STATE), C_STATE ** -0.5),
        "c_c_im": nrm((N_ODD, C_GROUPS, C_GROUP, C_STATE), C_STATE ** -0.5),
        "c_d": nrm((N_ODD, C_WIDTH), 1.0),
        "c_glu_w": nrm((N_ODD, C_WIDTH, C_WIDTH), C_WIDTH ** -0.5),
        "c_glu_b": nrm((N_ODD, C_WIDTH), 0.02),
        "d_conv_q": nrm((N_ODD, D_CONV, D_WIDTH), D_CONV ** -0.5),
        "d_conv_k": nrm((N_ODD, D_CONV, D_WIDTH), D_CONV ** -0.5),
        "d_i_bias": nrm((N_ODD, D_HEADS), 0.1),
        "d_f_bias": jnp.linspace(3.0, 6.0, D_HEADS, dtype=F32) + nrm((N_ODD, D_HEADS), 0.1),
        "d_norm": 1.0 + nrm((N_ODD, D_WIDTH), 0.02),
        "ffn_gate": nrm((DEPTH, d, FFN_HIDDEN), d ** -0.5),
        "ffn_up": nrm((DEPTH, d, FFN_HIDDEN), d ** -0.5),
        "ffn_down": nrm((DEPTH, FFN_HIDDEN, d), FFN_HIDDEN ** -0.5),
    }


def reference(x, norm_mix, norm_ffn, norm_final, w_in_even, w_out_even, lb_table, a_norm,
              b_mu, b_w0, b_w2, b_a0, b_a2, b_g2, b_kk, b_ka, b_rk, b_ln_w, b_ln_b,
              w_in_odd, w_out_odd, c_lam_re, c_lam_im, c_log_step, c_b_re, c_b_im,
              c_c_re, c_c_im, c_d, c_glu_w, c_glu_b, d_conv_q, d_conv_k, d_i_bias,
              d_f_bias, d_norm, ffn_gate, ffn_up, ffn_down):
    lower_bounds = jnp.cumsum(jax.nn.softmax(lb_table.astype(F32), axis=0), axis=0)
    for l in range(DEPTH):
        h = rms_norm(x, norm_mix[l])
        if l % 2 == 0:
            e = l // 2
            u = h @ w_in_even[e]
            aq, af, ai, ag, ub = split_cols(u, (A_WIDTH, A_WIDTH, A_WIDTH, A_WIDTH, B_SHIFT_COLS))
            ya = hgrn2_mix(aq, af, ai, ag, lower_bounds[l], a_norm[e])
            yb = rwkv7_mix(ub, b_mu[e], b_w0[e], b_w2[e], b_a0[e], b_a2[e], b_g2[e],
                           b_kk[e], b_ka[e], b_rk[e], b_ln_w[e], b_ln_b[e])
            y = jnp.concatenate([ya, yb], axis=-1).astype(x.dtype) @ w_out_even[e]
        else:
            o_ = l // 2
            u = h @ w_in_odd[o_]
            uc, dq, dk, dv, do, di, df = split_cols(
                u, (C_WIDTH, D_WIDTH, D_WIDTH, D_WIDTH, D_WIDTH, D_HEADS, D_HEADS))
            yc = s5_mix(uc, c_lam_re[o_], c_lam_im[o_], c_log_step[o_], c_b_re[o_], c_b_im[o_],
                        c_c_re[o_], c_c_im[o_], c_d[o_], c_glu_w[o_], c_glu_b[o_])
            yd = mlstm_mix(dq, dk, dv, do, di + d_i_bias[o_], df + d_f_bias[o_],
                           d_conv_q[o_], d_conv_k[o_], d_norm[o_])
            y = jnp.concatenate([yc, yd], axis=-1).astype(x.dtype) @ w_out_odd[o_]
        x = x + y
        h = rms_norm(x, norm_ffn[l])
        x = x + swiglu(h, ffn_gate[l], ffn_up[l], ffn_down[l])
    return rms_norm(x, norm_final)
```

```cpp
#include <hip/hip_runtime.h>
#include <cstdio>
#include <cstdint>
#include <cmath>

namespace {
constexpr int SEQ = 4096, BATCH = 8, DM = 1024;
constexpr int EVEN_IN = 3744, ODD_IN = 3336, FFN = 2816;
constexpr int NSUB = 2;
constexpr int MSUB = NSUB * SEQ;

__device__ __forceinline__ float sigmoidf_(float x) { return 1.f / (1.f + __expf(-x)); }
__device__ __forceinline__ float siluf_(float x) { return x * sigmoidf_(x); }
__device__ __forceinline__ float softplusf_(float x) { return fmaxf(x, 0.f) + log1pf(__expf(-fabsf(x))); }
__device__ __forceinline__ float wave_sum(float v) {
#pragma unroll
    for (int o = 1; o < 64; o <<= 1) v += __shfl_xor(v, o);
    return v;
}

__global__ void __launch_bounds__(256) k_rmsnorm(const float* x, const float* g, float* out, int M) {
    const int lane = threadIdx.x & 63, row = blockIdx.x * 4 + (threadIdx.x >> 6);
    if (row >= M) return;
    const float4* xr = (const float4*)(x + (size_t)row * DM) + lane;
    float4 v[4]; float s = 0.f;
#pragma unroll
    for (int j = 0; j < 4; ++j) { v[j] = xr[64 * j]; s += v[j].x * v[j].x + v[j].y * v[j].y + v[j].z * v[j].z + v[j].w * v[j].w; }
    s = wave_sum(s);
    const float rs = 1.0f / sqrtf(s * (1.f / DM) + 1e-6f);
    float4* o = (float4*)(out + (size_t)row * DM) + lane;
    const float4* gg = (const float4*)g + lane;
#pragma unroll
    for (int j = 0; j < 4; ++j) { const float4 w = gg[64 * j]; float4 r; r.x = v[j].x * rs * w.x; r.y = v[j].y * rs * w.y; r.z = v[j].z * rs * w.z; r.w = v[j].w * rs * w.w; o[64 * j] = r; }
}

template <int MODE>
__global__ void __launch_bounds__(256) k_gemm(const float* A, int lda, const float* W, int ldw, float* C, int ldc, const float* R, int ldr, int M, int N, int K) {
    __shared__ float As[16][68];
    __shared__ float Ws[16][68];
    const int bm = blockIdx.y * 64, bn = blockIdx.x * 64, tid = threadIdx.x, tx = tid & 15, ty = tid >> 4;
    float acc[4][4];
#pragma unroll
    for (int i = 0; i < 4; ++i)
#pragma unroll
        for (int j = 0; j < 4; ++j) acc[i][j] = 0.f;
    for (int k0 = 0; k0 < K; k0 += 16) {
        { const int r = tid >> 2, kk = (tid & 3) * 4; const float4 v = *(const float4*)(A + (size_t)(bm + r) * lda + k0 + kk);
          As[kk + 0][r] = v.x; As[kk + 1][r] = v.y; As[kk + 2][r] = v.z; As[kk + 3][r] = v.w; }
        { const int kk = tid >> 4, n = (tid & 15) * 4; float4 v = make_float4(0.f, 0.f, 0.f, 0.f);
          if (bn + n < N) v = *(const float4*)(W + (size_t)(k0 + kk) * ldw + bn + n);
          Ws[kk][n + 0] = v.x; Ws[kk][n + 1] = v.y; Ws[kk][n + 2] = v.z; Ws[kk][n + 3] = v.w; }
        __syncthreads();
#pragma unroll
        for (int kk = 0; kk < 16; ++kk) {
            float a[4], b[4];
#pragma unroll
            for (int i = 0; i < 4; ++i) a[i] = As[kk][ty * 4 + i];
#pragma unroll
            for (int j = 0; j < 4; ++j) b[j] = Ws[kk][tx * 4 + j];
#pragma unroll
            for (int i = 0; i < 4; ++i)
#pragma unroll
                for (int j = 0; j < 4; ++j) acc[i][j] = fmaf(a[i], b[j], acc[i][j]);
        }
        __syncthreads();
    }
    const int col = bn + tx * 4;
    if (col < N) {
#pragma unroll
        for (int i = 0; i < 4; ++i) {
            const int row = bm + ty * 4 + i;
            float4 o = make_float4(acc[i][0], acc[i][1], acc[i][2], acc[i][3]);
            float4* cp = (float4*)(C + (size_t)row * ldc + col);
            if (MODE == 1) { const float4 r = *(const float4*)(R + (size_t)row * ldr + col); o.x += r.x; o.y += r.y; o.z += r.z; o.w += r.w; }
            if (MODE == 2) { const float4 c = *cp; o.x *= siluf_(c.x); o.y *= siluf_(c.y); o.z *= siluf_(c.z); o.w *= siluf_(c.w); }
            *cp = o;
        }
    }
}

__global__ void __launch_bounds__(256) k_hgrn2(const float* u, const float* lb_table, float* o_raw) {
    constexpr int T = 16;
    __shared__ float sq[T][128], sf[T][128], sk[T][128], sv[T][64];
    const int blk = blockIdx.x, vh = blk & 1, h = (blk >> 1) & 3, b = blk >> 3;
    const int tid = threadIdx.x, lane = tid & 63, wave = tid >> 6, kp = lane >> 4, v16 = lane & 15, vloc = wave * 16 + v16;
    float S[32];
#pragma unroll
    for (int j = 0; j < 32; ++j) S[j] = 0.f;
    for (int t0 = 0; t0 < SEQ; t0 += T) {
        __syncthreads();
        for (int e = tid; e < T * 128; e += 256) {
            const int tt = e >> 7, k = e & 127; const size_t row = (size_t)(b * SEQ + t0 + tt) * EVEN_IN; const int c = h * 128 + k;
            const float l0 = lb_table[c], l1 = lb_table[512 + c], l2 = lb_table[1024 + c];
            const float mx = fmaxf(l0, fmaxf(l1, l2)); const float e0 = expf(l0 - mx), e1 = expf(l1 - mx), e2 = expf(l2 - mx);
            const float lb = e0 / (e0 + e1 + e2);
            const float f = lb + (1.f - lb) * sigmoidf_(u[row + 512 + c]);
            sq[tt][k] = siluf_(u[row + c]); sf[tt][k] = f; sk[tt][k] = 1.f - f;
        }
        for (int e = tid; e < T * 64; e += 256) { const int tt = e >> 6, v = e & 63; sv[tt][v] = u[(size_t)(b * SEQ + t0 + tt) * EVEN_IN + 1024 + h * 128 + vh * 64 + v]; }
        __syncthreads();
        for (int tt = 0; tt < T; ++tt) {
            const float vv = sv[tt][vloc]; float o = 0.f;
#pragma unroll
            for (int j = 0; j < 32; ++j) { const int k = kp * 32 + j; S[j] = fmaf(sf[tt][k], S[j], sk[tt][k] * vv); o = fmaf(sq[tt][k], S[j], o); }
            o += __shfl_xor(o, 16); o += __shfl_xor(o, 32);
            if (kp == 0) o_raw[(size_t)(b * SEQ + t0 + tt) * 512 + h * 128 + vh * 64 + vloc] = o;
        }
    }
}

__global__ void __launch_bounds__(512) k_rwkv_prep(const float* u, const float* mu, const float* w0, const float* w2, const float* a0, const float* a2, const float* g2,
                                                   const float* k_k, const float* k_a, float* R, float* Wd, float* Kp, float* V, float* An, float* Bv, float* G) {
    __shared__ float sl[160];
    const int m = blockIdx.x, t = m % SEQ, c = threadIdx.x;
    const float* ur = u + (size_t)m * EVEN_IN + 2048; const float* up = ur - EVEN_IN;
    auto lerp = [&](int col) { const float cur = ur[col]; const float prev = (t > 0) ? up[col] : 0.f; return cur + (prev - cur) * mu[col]; };
    if (c < 160) { const float v = lerp(1536 + c); sl[c] = (c < 32) ? tanhf(v) : (c < 64 ? v : sigmoidf_(v)); }
    __syncthreads();
    const float r = lerp(c), k = lerp(512 + c), v = lerp(1024 + c);
    float wl = w0[c], al = a0[c], g = 0.f;
    for (int j = 0; j < 32; ++j) { wl = fmaf(sl[j], w2[j * 512 + c], wl); al = fmaf(sl[32 + j], a2[j * 512 + c], al); }
    for (int j = 0; j < 96; ++j) g = fmaf(sl[64 + j], g2[j * 512 + c], g);
    const float wlog = -softplusf_(-wl) - 0.5f;
    const float dec = expf(-expf(wlog));
    const float a = sigmoidf_(al);
    const float kkv = k * k_k[c];
    const float ss = wave_sum(kkv * kkv);
    const float kk = kkv / fmaxf(sqrtf(ss), 1e-12f);
    const size_t o = (size_t)m * 512 + c;
    R[o] = r; Wd[o] = dec; Kp[o] = k * (1.f + (a - 1.f) * k_a[c]); V[o] = v; An[o] = -kk; Bv[o] = kk * a; G[o] = g;
}

__global__ void __launch_bounds__(256) k_rwkv_rec(const float* R, const float* Wd, const float* Kp, const float* V, const float* An, const float* Bv, float* Y) {
    const int lane = threadIdx.x & 63, gw = blockIdx.x * 4 + (threadIdx.x >> 6);
    const int vrow = gw & 63, h = (gw >> 6) & 7, b = gw >> 9;
    float S = 0.f;
    const size_t base = (size_t)b * SEQ * 512 + h * 64;
    constexpr int U = 8;
    for (int t0 = 0; t0 < SEQ; t0 += U) {
        float r[U], w[U], k[U], a[U], bb[U], vv[U];
#pragma unroll
        for (int i = 0; i < U; ++i) { const size_t o = base + (size_t)(t0 + i) * 512; r[i] = R[o + lane]; w[i] = Wd[o + lane]; k[i] = Kp[o + lane]; a[i] = An[o + lane]; bb[i] = Bv[o + lane]; vv[i] = V[o + vrow]; }
#pragma unroll
        for (int i = 0; i < U; ++i) {
            const float sa = wave_sum(S * a[i]);
            S = S * w[i] + sa * bb[i] + vv[i] * k[i];
            const float y = wave_sum(S * r[i]);
            if (lane == 0) Y[base + (size_t)(t0 + i) * 512 + vrow] = y;
        }
    }
}

__global__ void __launch_bounds__(512) k_post_even(const float* u, const float* o_raw, const float* a_norm, const float* Y, const float* R, const float* Kp, const float* V, const float* G,
                                                   const float* r_k, const float* ln_w, const float* ln_b, float* ycat) {
    __shared__ float red[8];
    const int m = blockIdx.x, c = threadIdx.x, wave = c >> 6;
    const float o = o_raw[(size_t)m * 512 + c];
    const float ss = wave_sum(o * o);
    if ((c & 63) == 0) red[wave] = ss;
    __syncthreads();
    const float tot = red[(wave & ~1)] + red[(wave | 1)];
    const float ag = u[(size_t)m * EVEN_IN + 1536 + c];
    ycat[(size_t)m * DM + c] = o * (1.0f / sqrtf(tot * (1.f / 128.f) + 1e-6f)) * a_norm[c] * siluf_(ag);
    const size_t i = (size_t)m * 512 + c;
    const float y = Y[i];
    const float mean = wave_sum(y) * (1.f / 64.f);
    const float d = y - mean;
    const float var = wave_sum(d * d) * (1.f / 64.f);
    float yn = d * (1.0f / sqrtf(var + 64e-5f)) * ln_w[c] + ln_b[c];
    const float bonus = wave_sum(R[i] * Kp[i] * r_k[c]);
    yn += bonus * V[i];
    ycat[(size_t)m * DM + 512 + c] = yn * G[i];
}

__global__ void k_s5_prep(const float* lam_re, const float* lam_im, const float* log_step, const float* b_re, const float* b_im, float* lbr, float* lbi, float* bbr, float* bbi) {
    const int gp = blockIdx.x * blockDim.x + threadIdx.x;
    if (gp >= 16 * 64) return;
    const int g = gp >> 6;
    const float step = expf(log_step[g]);
    const float lr = lam_re[gp], li = lam_im[gp];
    const float mag = expf(lr * step);
    const float br = mag * cosf(li * step), bi = mag * sinf(li * step);
    lbr[gp] = br; lbi[gp] = bi;
    const float den = lr * lr + li * li; const float nr = br - 1.f, ni = bi;
    const float cr = (nr * lr + ni * li) / den, ci = (ni * lr - nr * li) / den;
    for (int h = 0; h < 16; ++h) { const float xr = b_re[gp * 16 + h], xi = b_im[gp * 16 + h]; bbr[gp * 16 + h] = cr * xr - ci * xi; bbi[gp * 16 + h] = cr * xi + ci * xr; }
}

__global__ void __launch_bounds__(64) k_s5_rec(const float* u, const float* lbr, const float* lbi, const float* bbr, const float* bbi, const float* c_re, const float* c_im, float* y_raw) {
    const int lane = threadIdx.x, g = blockIdx.x & 15, b = blockIdx.x >> 4;
    const int gp = g * 64 + lane;
    const float ar = lbr[gp], ai = lbi[gp];
    float br[16], bi[16], cr[16], ci[16];
#pragma unroll
    for (int h = 0; h < 16; ++h) { br[h] = bbr[gp * 16 + h]; bi[h] = bbi[gp * 16 + h]; cr[h] = c_re[(g * 16 + h) * 64 + lane]; ci[h] = c_im[(g * 16 + h) * 64 + lane]; }
    float hr = 0.f, hi = 0.f;
    for (int t = 0; t < SEQ; ++t) {
        const float* ur = u + (size_t)(b * SEQ + t) * ODD_IN + g * 16;
        float xr = 0.f, xi = 0.f;
#pragma unroll
        for (int h = 0; h < 16; ++h) { const float uv = ur[h]; xr = fmaf(br[h], uv, xr); xi = fmaf(bi[h], uv, xi); }
        const float nr = ar * hr - ai * hi + xr, ni = ar * hi + ai * hr + xi;
        hr = nr; hi = ni;
        float mine = 0.f;
#pragma unroll
        for (int h = 0; h < 16; ++h) { const float s = wave_sum(cr[h] * hr - ci[h] * hi); if (lane == h) mine = s; }
        if (lane < 16) y_raw[(size_t)(b * SEQ + t) * 256 + g * 16 + lane] = mine;
    }
}

__global__ void __launch_bounds__(256) k_s5_post(const float* u, const float* y_raw, const float* d_skip, const float* glu_w, const float* glu_b, float* ycat) {
    __shared__ float z[256];
    const int m = blockIdx.x, c = threadIdx.x;
    const float y = y_raw[(size_t)m * 256 + c] + d_skip[c] * u[(size_t)m * ODD_IN + c];
    const float zz = 0.5f * y * (1.f + tanhf(0.7978845608028654f * (y + 0.044715f * y * y * y)));
    z[c] = zz;
    __syncthreads();
    float acc = glu_b[c];
    for (int j = 0; j < 256; ++j) acc = fmaf(z[j], glu_w[j * 256 + c], acc);
    ycat[(size_t)m * DM + c] = zz * sigmoidf_(acc);
}

__global__ void __launch_bounds__(768) k_mlstm_prep(const float* u, const float* conv_q, const float* conv_k, const float* i_bias, const float* f_bias, float* Q, float* K, float* FG, float* IG) {
    const int m = blockIdx.x, t = m % SEQ, c = threadIdx.x;
    float aq = 0.f, ak = 0.f;
#pragma unroll
    for (int j = 0; j < 4; ++j) { const int tt = t - 3 + j; if (tt >= 0) { const float* ur = u + (size_t)(m - 3 + j) * ODD_IN; aq = fmaf(conv_q[j * 768 + c], ur[256 + c], aq); ak = fmaf(conv_k[j * 768 + c], ur[1024 + c], ak); } }
    Q[(size_t)m * 768 + c] = siluf_(aq);
    K[(size_t)m * 768 + c] = siluf_(ak) * 0.07216878364870322f;
    if (c < 4) { const float* ur = u + (size_t)m * ODD_IN; IG[(size_t)m * 4 + c] = expf(ur[3328 + c] + i_bias[c]); FG[(size_t)m * 4 + c] = sigmoidf_(ur[3332 + c] + f_bias[c]); }
}

__global__ void __launch_bounds__(768) k_mlstm_rec(const float* u, const float* Q, const float* K, const float* FG, const float* IG, float* h_raw) {
    constexpr int T = 8;
    __shared__ float sq[T][192], sk[T][192], sv[T][192], sf[T], si[T];
    const int h = blockIdx.x & 3, b = blockIdx.x >> 2;
    const int tid = threadIdx.x, lane = tid & 63, wave = tid >> 6, dp = lane >> 4, v = wave * 16 + (lane & 15);
    float C[48], n[48];
#pragma unroll
    for (int j = 0; j < 48; ++j) { C[j] = 0.f; n[j] = 0.f; }
    for (int t0 = 0; t0 < SEQ; t0 += T) {
        __syncthreads();
        for (int e = tid; e < T * 192; e += 768) { const int tt = e / 192, d = e % 192; const size_t m = (size_t)(b * SEQ + t0 + tt);
            sq[tt][d] = Q[m * 768 + h * 192 + d]; sk[tt][d] = K[m * 768 + h * 192 + d]; sv[tt][d] = u[m * ODD_IN + 1792 + h * 192 + d]; }
        if (tid < T) { const size_t m = (size_t)(b * SEQ + t0 + tid); sf[tid] = FG[m * 4 + h]; si[tid] = IG[m * 4 + h]; }
        __syncthreads();
        for (int tt = 0; tt < T; ++tt) {
            const float f = sf[tt], ig = si[tt], vv = sv[tt][v]; float num = 0.f, den = 0.f;
#pragma unroll
            for (int j = 0; j < 48; ++j) { const int d = dp * 48 + j; const float ik = ig * sk[tt][d], q = sq[tt][d];
                C[j] = fmaf(f, C[j], ik * vv); n[j] = fmaf(f, n[j], ik); num = fmaf(q, C[j], num); den = fmaf(q, n[j], den); }
            num += __shfl_xor(num, 16); num += __shfl_xor(num, 32); den += __shfl_xor(den, 16); den += __shfl_xor(den, 32);
            if (dp == 0) h_raw[(size_t)(b * SEQ + t0 + tt) * 768 + h * 192 + v] = num / fmaxf(fabsf(den), 1.0f);
        }
    }
}

__global__ void __launch_bounds__(768) k_mlstm_post(const float* u, const float* h_raw, const float* gain, float* ycat) {
    __shared__ float red[12];
    const int m = blockIdx.x, c = threadIdx.x, wave = c >> 6, head = c / 192;
    const float hv = h_raw[(size_t)m * 768 + c];
    const float ss = wave_sum(hv * hv);
    if ((c & 63) == 0) red[wave] = ss;
    __syncthreads();
    const float tot = red[head * 3] + red[head * 3 + 1] + red[head * 3 + 2];
    const float o = u[(size_t)m * ODD_IN + 2560 + c];
    ycat[(size_t)m * DM + 256 + c] = hv * (1.0f / sqrtf(tot * (1.f / 192.f) + 1e-6f)) * gain[c] * sigmoidf_(o);
}

template <int MODE>
void gemm(hipStream_t st, const float* A, int lda, const float* W, int ldw, float* C, int ldc, const float* R, int ldr, int M, int N, int K) {
    dim3 grid((N + 63) / 64, M / 64);
    hipLaunchKernelGGL(k_gemm<MODE>, grid, dim3(256), 0, st, A, lda, W, ldw, C, ldc, R, ldr, M, N, K);
}
}

extern "C" void kernel_launch(void* const* d_in, const int* in_sizes, int n_in, void* d_out, int out_size, void* d_ws, size_t ws_size, hipStream_t stream) {
    auto P = [&](int i) { return (const float*)d_in[i]; };
    const float* x_in = P(0);
    float* out = (float*)d_out;
    char* ws = (char*)d_ws;
    size_t off = 0;
    auto carve = [&](size_t nfloats) { float* p = (float*)(ws + off); off += ((nfloats * 4 + 255) / 256) * 256; return p; };
    float* U = carve((size_t)MSUB * EVEN_IN);
    float* HN = carve((size_t)MSUB * DM);
    float* YC = carve((size_t)MSUB * DM);
    float* T0 = carve((size_t)MSUB * 768);
    float* T1 = carve((size_t)MSUB * 768);
    float* T2 = carve((size_t)MSUB * 768);
    float* T3 = carve((size_t)MSUB * 512);
    float* T4 = carve((size_t)MSUB * 512);
    float* T5 = carve((size_t)MSUB * 512);
    float* T6 = carve((size_t)MSUB * 512);
    float* T7 = carve((size_t)MSUB * 512);
    float* T8 = carve((size_t)MSUB * 512);
    float* FG = carve((size_t)MSUB * 4);
    float* IG = carve((size_t)MSUB * 4);
    float* LBR = carve(1024); float* LBI = carve(1024); float* BBR = carve(16384); float* BBI = carve(16384);
    if (off > ws_size) { fprintf(stderr, "workspace too small: need %zu have %zu\n", off, ws_size); return; }

    hipLaunchKernelGGL(k_s5_prep, dim3(4), dim3(256), 0, stream, P(21), P(22), P(23), P(24), P(25), LBR, LBI, BBR, BBI);

    for (int sb = 0; sb < BATCH / NSUB; ++sb) {
        const size_t tok0 = (size_t)sb * MSUB;
        const float* xs = x_in + tok0 * DM;
        float* os = out + tok0 * DM;
        hipLaunchKernelGGL(k_rmsnorm, dim3(MSUB / 4), dim3(256), 0, stream, xs, P(1), HN, MSUB);
        gemm<0>(stream, HN, DM, P(4), EVEN_IN, U, EVEN_IN, nullptr, 0, MSUB, EVEN_IN, DM);
        hipLaunchKernelGGL(k_hgrn2, dim3(NSUB * 8), dim3(256), 0, stream, U, P(6), T0);
        hipLaunchKernelGGL(k_rwkv_prep, dim3(MSUB), dim3(512), 0, stream, U, P(8), P(9), P(10), P(11), P(12), P(13), P(14), P(15), T2, T3, T4, T5, T6, T7, T8);
        hipLaunchKernelGGL(k_rwkv_rec, dim3(NSUB * 8 * 64 / 4), dim3(256), 0, stream, T2, T3, T4, T5, T6, T7, T1);
        hipLaunchKernelGGL(k_post_even, dim3(MSUB), dim3(512), 0, stream, U, T0, P(7), T1, T2, T4, T5, T8, P(16), P(17), P(18), YC);
        gemm<1>(stream, YC, DM, P(5), DM, os, DM, xs, DM, MSUB, DM, DM);
        hipLaunchKernelGGL(k_rmsnorm, dim3(MSUB / 4), dim3(256), 0, stream, os, P(2), HN, MSUB);
        gemm<0>(stream, HN, DM, P(36), FFN, U, FFN, nullptr, 0, MSUB, FFN, DM);
        gemm<2>(stream, HN, DM, P(37), FFN, U, FFN, nullptr, 0, MSUB, FFN, DM);
        gemm<1>(stream, U, FFN, P(38), DM, os, DM, os, DM, MSUB, DM, FFN);
        hipLaunchKernelGGL(k_rmsnorm, dim3(MSUB / 4), dim3(256), 0, stream, os, P(1) + DM, HN, MSUB);
        gemm<0>(stream, HN, DM, P(19), ODD_IN, U, ODD_IN, nullptr, 0, MSUB, ODD_IN, DM);
        hipLaunchKernelGGL(k_s5_rec, dim3(NSUB * 16), dim3(64), 0, stream, U, LBR, LBI, BBR, BBI, P(26), P(27), T3);
        hipLaunchKernelGGL(k_s5_post, dim3(MSUB), dim3(256), 0, stream, U, T3, P(28), P(29), P(30), YC);
        hipLaunchKernelGGL(k_mlstm_prep, dim3(MSUB), dim3(768), 0, stream, U, P(31), P(32), P(33), P(34), T1, T2, FG, IG);
        hipLaunchKernelGGL(k_mlstm_rec, dim3(NSUB * 4), dim3(768), 0, stream, U, T1, T2, FG, IG, T0);
        hipLaunchKernelGGL(k_mlstm_post, dim3(MSUB), dim3(768), 0, stream, U, T0, P(35), YC);
        gemm<1>(stream, YC, DM, P(20), DM, os, DM, os, DM, MSUB, DM, DM);
        hipLaunchKernelGGL(k_rmsnorm, dim3(MSUB / 4), dim3(256), 0, stream, os, P(2) + DM, HN, MSUB);
        gemm<0>(stream, HN, DM, P(36) + (size_t)DM * FFN, FFN, U, FFN, nullptr, 0, MSUB, FFN, DM);
        gemm<2>(stream, HN, DM, P(37) + (size_t)DM * FFN, FFN, U, FFN, nullptr, 0, MSUB, FFN, DM);
        gemm<1>(stream, U, FFN, P(38) + (size_t)FFN * DM, DM, os, DM, os, DM, MSUB, DM, FFN);
        hipLaunchKernelGGL(k_rmsnorm, dim3(MSUB / 4), dim3(256), 0, stream, os, P(3), os, MSUB);
    }
}
```

```cpp
#include <hip/hip_runtime.h>
#include <hip/hip_cooperative_groups.h>
#include <cstdio>
#include <cstdint>
#include <cmath>
namespace cg = cooperative_groups;

#define LAS __attribute__((address_space(3)))
typedef unsigned short bf16_t;
typedef short bf16x8 __attribute__((ext_vector_type(8)));
typedef float f32x4 __attribute__((ext_vector_type(4)));
typedef unsigned u32x4 __attribute__((ext_vector_type(4)));
typedef unsigned u32x2 __attribute__((ext_vector_type(2)));

constexpr int SEQ = 4096, BATCH = 8, DM = 1024, M = BATCH * SEQ;
constexpr int EVEN_IN = 3744, LDU0 = 3840, ODD_IN = 3336, LDU1 = 3584, FFN = 2816;
constexpr float RMS_EPS = 1e-6f;

constexpr size_t MiB = 1u << 20;
constexpr size_t WS_CTL = 0, CTL_BYTES = 1 * MiB;
constexpr size_t CTL_SS1 = 128 * 1024, CTL_SS2 = 256 * 1024, CTL_SS3 = 384 * 1024, CTL_SS0 = 512 * 1024;
constexpr size_t CTL_LB = 640 * 1024, CTL_LBR = 644 * 1024, CTL_LBI = 648 * 1024, CTL_BBR = 656 * 1024, CTL_BBI = 720 * 1024;
constexpr size_t WS_IN0 = 1 * MiB, WS_OUT0 = WS_IN0 + (size_t)LDU0 * DM * 2, WS_GU0 = WS_OUT0 + 2 * MiB, WS_D0 = WS_GU0 + 11 * MiB;
constexpr size_t WS_IN1 = WS_D0 + (size_t)DM * FFN * 2, WS_OUT1 = WS_IN1 + (size_t)LDU1 * DM * 2, WS_GU1 = WS_OUT1 + 2 * MiB, WS_D1 = WS_GU1 + 11 * MiB;
constexpr size_t WS_XB = 53 * MiB, WS_YC = 117 * MiB, WS_U = 181 * MiB, WS_MS = 421 * MiB, WS_END = 512 * MiB;
static_assert(WS_D1 + (size_t)DM * FFN * 2 <= WS_XB, "weights fit");
static_assert(WS_U + (size_t)M * LDU0 * 2 <= WS_MS, "U fits");

__device__ __forceinline__ float bf2f(bf16_t h) { return __uint_as_float(((unsigned)h) << 16); }
__device__ __forceinline__ float bflo(unsigned w) { return __uint_as_float(w << 16); }
__device__ __forceinline__ float bfhi(unsigned w) { return __uint_as_float(w & 0xffff0000u); }
__device__ __forceinline__ unsigned pk2(float lo, float hi) { unsigned r; asm volatile("v_cvt_pk_bf16_f32 %0, %1, %2" : "=v"(r) : "v"(lo), "v"(hi)); return r; }
__device__ __forceinline__ bf16_t f2bf(float f) { return (bf16_t)(pk2(f, 0.f) & 0xffffu); }
__device__ __forceinline__ float sigmoidf_(float x) { return 1.f / (1.f + __expf(-x)); }
__device__ __forceinline__ float siluf_(float x) { return x * sigmoidf_(x); }
__device__ __forceinline__ float softplusf_(float x) { return fmaxf(x, 0.f) + log1pf(__expf(-fabsf(x))); }
__device__ __forceinline__ float wave_sum(float v) {
#pragma unroll
    for (int o = 1; o < 64; o <<= 1) v += __shfl_xor(v, o);
    return v;
}
__device__ __forceinline__ float half_sum(float v) {
#pragma unroll
    for (int o = 1; o < 32; o <<= 1) v += __shfl_xor(v, o);
    return v;
}

namespace pg8 {
constexpr int BM = 256, BK = 64, HALF = 128, HTB = HALF * BK * 2, STAGE_BYTES = 8 * HTB, NXCD = 8, WGM = 8;
__device__ __forceinline__ int lds_byte(int r, int c) { const int st = (r >> 4) * 2 + (c >> 5), rr = r & 15, cc = c & 31, ob = rr * 64 + cc * 2; return st * 1024 + (ob ^ (((ob >> 9) & 1) << 5)); }
__device__ __forceinline__ void stage_rc(int b, int& R, int& C) { const int st = b / 1024, sb = b % 1024, swz = sb ^ (((sb >> 9) & 1) << 5); R = (st >> 1) * 16 + swz / 64; C = (st & 1) * 32 + (swz % 64) / 2; }
__device__ __forceinline__ int perm32(int rho) { const int n = rho >> 4, i = rho & 15; return 8 * (i >> 2) + 4 * n + (i & 3); }
struct Unit { int pm, pn; };
struct Gemm { const bf16_t* A; const bf16_t* Bt; int lda, ldb, M, N, K; };
struct StaticOrder {
    int nM, nN, nwg, G, c;
    __device__ void init(int M_, int N_, int G_, int c_) { nM = M_ / BM; nN = N_ / BM; nwg = nM * nN; G = G_; c = c_; }
    __device__ bool next(int i, Unit& u) const {
        const long L = (long)i * G + c; if (L >= nwg) return false;
        int wgid = (int)L; { const int q = nwg / NXCD, r = nwg % NXCD, xcd = wgid % NXCD, off = wgid / NXCD; wgid = (xcd < r ? xcd * (q + 1) : r * (q + 1) + (xcd - r) * q) + off; }
        const int nig = WGM * nN, gid = wgid / nig, fm = gid * WGM, gsz = (nM - fm) < WGM ? (nM - fm) : WGM;
        u.pm = fm + ((wgid % nig) % gsz); u.pn = (wgid % nig) / gsz; return true;
    }
};

struct EpiScaleBf16 {
    static constexpr bool PERM = true;
    bf16_t* O; int ldc; const float* ss;
    __device__ __forceinline__ void operator()(const f32x4 (&acc)[2][2][4][2], const Unit& u, int wr, int wc, int fr, int fq) const {
        const int row0 = u.pm * BM + wr * 64 + fr, col0 = u.pn * BM + wc * 32 + 8 * fq;
#pragma unroll
        for (int ai = 0; ai < 2; ++ai)
#pragma unroll
            for (int m = 0; m < 4; ++m) { const int row = row0 + ai * HALF + m * 16; const float rs = 1.0f / sqrtf(ss[row] * (1.f / DM) + RMS_EPS);
                bf16_t* rowp = O + (size_t)row * ldc + col0;
#pragma unroll
                for (int bj = 0; bj < 2; ++bj) { const f32x4 v0 = acc[ai][bj][m][0] * rs, v1 = acc[ai][bj][m][1] * rs;
                    u32x4 w; w.x = pk2(v0[0], v0[1]); w.y = pk2(v0[2], v0[3]); w.z = pk2(v1[0], v1[1]); w.w = pk2(v1[2], v1[3]);
                    *(u32x4*)(rowp + bj * HALF) = w; } }
    }
};
struct EpiSwiGlu {
    static constexpr bool PERM = true;
    bf16_t* O; int ldc; const float* ss;
    __device__ __forceinline__ void operator()(const f32x4 (&acc)[2][2][4][2], const Unit& u, int wr, int wc, int fr, int fq) const {
        const int row0 = u.pm * BM + wr * 64 + fr, col0 = u.pn * HALF + wc * 32 + 8 * fq;
#pragma unroll
        for (int ai = 0; ai < 2; ++ai)
#pragma unroll
            for (int m = 0; m < 4; ++m) { const int row = row0 + ai * HALF + m * 16; const float rs = 1.0f / sqrtf(ss[row] * (1.f / DM) + RMS_EPS);
                f32x4 h[2];
#pragma unroll
                for (int n = 0; n < 2; ++n) { const f32x4 g = acc[ai][0][m][n] * rs, up = acc[ai][1][m][n] * rs;
#pragma unroll
                    for (int e = 0; e < 4; ++e) h[n][e] = siluf_(g[e]) * up[e]; }
                u32x4 w; w.x = pk2(h[0][0], h[0][1]); w.y = pk2(h[0][2], h[0][3]); w.z = pk2(h[1][0], h[1][1]); w.w = pk2(h[1][2], h[1][3]);
                *(u32x4*)(O + (size_t)row * ldc + col0) = w; }
    }
};
template <bool WITH_SS> struct EpiResidual {
    static constexpr bool PERM = false;
    const float* base; float* out; bf16_t* xb; float* ss;
    __device__ __forceinline__ void operator()(const f32x4 (&acc)[2][2][4][2], const Unit& u, int wr, int wc, int fr, int fq) const {
        const int row0 = u.pm * BM + wr * 64 + fr, col0 = u.pn * BM + wc * 32 + 4 * fq;
#pragma unroll
        for (int ai = 0; ai < 2; ++ai)
#pragma unroll
            for (int m = 0; m < 4; ++m) { const int row = row0 + ai * HALF + m * 16; const size_t off = (size_t)row * DM + col0; float s = 0.f;
#pragma unroll
                for (int bj = 0; bj < 2; ++bj)
#pragma unroll
                    for (int n = 0; n < 2; ++n) { const size_t o = off + bj * HALF + n * 16; const f32x4 r = *(const f32x4*)(base + o); const f32x4 v = r + acc[ai][bj][m][n];
                        *(f32x4*)(out + o) = v; u32x2 w; w.x = pk2(v[0], v[1]); w.y = pk2(v[2], v[3]); *(u32x2*)(xb + o) = w;
                        s += (v[0] * v[0] + v[1] * v[1]) + (v[2] * v[2] + v[3] * v[3]); }
                if (WITH_SS) { s += __shfl_xor(s, 16); s += __shfl_xor(s, 32); if (fq == 0) atomicAdd(ss + row, s); } }
    }
};

template <class Epi, class Sched, bool ALIGN_EPI, bool SP2>
__device__ __forceinline__ void gemm_phase(LAS unsigned char* lds, const Gemm g, const Sched& S, const Epi& E) {
    const int tid = threadIdx.x, wid = __builtin_amdgcn_readfirstlane(tid >> 6), lane = tid & 63, wr = wid >> 2, wc = wid & 3, fr = lane & 15, fq = lane >> 4;
    const int K = g.K, nt = K / BK;
    unsigned voffA[2], voffB[2];
#pragma unroll
    for (int i = 0; i < 2; ++i) { int R, C; stage_rc(tid * 16 + i * 8192, R, C); const int Rb = Epi::PERM ? ((R & ~31) + perm32(R & 31)) : R;
        voffA[i] = (unsigned)(R * g.lda + C) * 2u; voffB[i] = (unsigned)(Rb * g.ldb + C) * 2u; }
    const size_t kstep = (size_t)(BK * 2);
    const size_t hstepA = (size_t)HALF * g.lda * 2, hstepB = (size_t)HALF * g.ldb * 2;
    const size_t tstepA = 2 * hstepA, tstepB = 2 * hstepB;
    const unsigned ldsw = (unsigned)wid * 1024u;
    const int aoff = lds_byte(wr * 64 + fr, fq * 8), boff = lds_byte(wc * 32 + fr, fq * 8);
#define PG8_SA(b, h) (((b) * 2 + (h)) * HTB)
#define PG8_SB(b, h) ((4 + (b) * 2 + (h)) * HTB)
#define PG8_STAGE(bufoff, gbase, voff) do { _Pragma("unroll") for (int _i = 0; _i < 2; ++_i) \
        __builtin_amdgcn_global_load_lds((const unsigned*)((const char*)(gbase) + (voff)[_i]), (LAS unsigned*)(lds + (bufoff) + ldsw + _i * 8192), 16, 0, 0); } while (0)
#define PG8_LDA(dst, b, h) do { _Pragma("unroll") for (int m = 0; m < 4; ++m) _Pragma("unroll") for (int k = 0; k < 2; ++k) dst[m][k] = *(const LAS bf16x8*)(lds + PG8_SA(b, h) + aoff + m * 2048 + k * 1024); } while (0)
#define PG8_LDB(dst, b, h) do { _Pragma("unroll") for (int n = 0; n < 2; ++n) _Pragma("unroll") for (int k = 0; k < 2; ++k) dst[n][k] = *(const LAS bf16x8*)(lds + PG8_SB(b, h) + boff + n * 2048 + k * 1024); } while (0)
#define PG8_MMA(ai, bj, At, Bt) do { __builtin_amdgcn_s_setprio(1); _Pragma("unroll") for (int m = 0; m < 4; ++m) _Pragma("unroll") for (int n = 0; n < 2; ++n) _Pragma("unroll") for (int k = 0; k < 2; ++k) \
        acc[ai][bj][m][n] = __builtin_amdgcn_mfma_f32_16x16x32_bf16(Bt[n][k], At[m][k], acc[ai][bj][m][n], 0, 0, 0); __builtin_amdgcn_s_setprio(0); } while (0)
#define PG8_WAIT_V(n) asm volatile("s_waitcnt vmcnt(" #n ")" ::: "memory")
#define PG8_WAIT_L(n) asm volatile("s_waitcnt lgkmcnt(" #n ")" ::: "memory")
#define PG8_BAR __builtin_amdgcn_s_barrier()
#define PG8_SCHED __builtin_amdgcn_sched_barrier(0)
    Unit cur, nxt; int ui = 0;
    if (!S.next(0, cur)) return;
    f32x4 acc[2][2][4][2];
#pragma unroll
    for (int a = 0; a < 2; ++a)
#pragma unroll
        for (int b = 0; b < 2; ++b)
#pragma unroll
            for (int m = 0; m < 4; ++m)
#pragma unroll
                for (int n = 0; n < 2; ++n) acc[a][b][m][n] = (f32x4){0.f, 0.f, 0.f, 0.f};
    bf16x8 At[4][2], B0[2][2], B1[2][2];
    const char* cA = (const char*)g.A + (size_t)cur.pm * tstepA; const char* cB = (const char*)g.Bt + (size_t)cur.pn * tstepB;
    if constexpr (SP2) {
        PG8_STAGE(PG8_SB(0, 0), cB, voffB); PG8_STAGE(PG8_SB(0, 1), cB + hstepB, voffB); PG8_STAGE(PG8_SA(0, 0), cA, voffA); PG8_STAGE(PG8_SA(0, 1), cA + hstepA, voffA);
        if (wr == 1) PG8_BAR;
        PG8_WAIT_V(2); PG8_BAR;
        PG8_STAGE(PG8_SB(1, 0), cB + kstep, voffB); PG8_STAGE(PG8_SA(1, 0), cA + kstep, voffA); PG8_STAGE(PG8_SB(1, 1), cB + hstepB + kstep, voffB);
        PG8_WAIT_V(6); PG8_BAR;
    } else {
        PG8_STAGE(PG8_SB(0, 0), cB, voffB); PG8_STAGE(PG8_SA(0, 0), cA, voffA); PG8_STAGE(PG8_SB(0, 1), cB + hstepB, voffB); PG8_STAGE(PG8_SA(0, 1), cA + hstepA, voffA);
        if (wr == 1) PG8_BAR;
        PG8_WAIT_V(4); PG8_BAR;
        PG8_STAGE(PG8_SB(1, 0), cB + kstep, voffB); PG8_STAGE(PG8_SA(1, 0), cA + kstep, voffA); PG8_STAGE(PG8_SB(1, 1), cB + hstepB + kstep, voffB);
        PG8_WAIT_V(6); PG8_BAR;
    }
    for (;;) {
        const bool has_next = S.next(ui + 1, nxt);
        const char* nA = has_next ? (const char*)g.A + (size_t)nxt.pm * tstepA : cA; const char* nB = has_next ? (const char*)g.Bt + (size_t)nxt.pn * tstepB : cB;
        for (int t = 0; t < nt; t += 2) {
            const bool last = (t == nt - 2);
            const char* a1 = cA + (size_t)(t + 1) * kstep;
            const char* a2 = last ? nA : cA + (size_t)(t + 2) * kstep; const char* b2 = last ? nB : cB + (size_t)(t + 2) * kstep;
            const char* a3 = a2 + kstep; const char* b3 = b2 + kstep;
            if constexpr (SP2) {
            PG8_LDB(B0, 0, 0); PG8_LDB(B1, 0, 1); PG8_SCHED; PG8_LDA(At, 0, 0); PG8_STAGE(PG8_SA(1, 1), a1 + hstepA, voffA);
            PG8_WAIT_V(8); PG8_WAIT_L(0); PG8_BAR; PG8_MMA(0, 0, At, B0); PG8_MMA(0, 1, At, B1); PG8_BAR; PG8_SCHED;
            PG8_LDA(At, 0, 1); PG8_STAGE(PG8_SB(0, 0), b2, voffB); PG8_STAGE(PG8_SB(0, 1), b2 + hstepB, voffB); PG8_STAGE(PG8_SA(0, 0), a2, voffA);
            PG8_WAIT_V(8); PG8_WAIT_L(0); PG8_BAR; PG8_MMA(1, 0, At, B0); PG8_MMA(1, 1, At, B1); PG8_BAR; PG8_SCHED;
            PG8_LDB(B0, 1, 0); PG8_LDB(B1, 1, 1); PG8_SCHED; PG8_LDA(At, 1, 0); PG8_STAGE(PG8_SA(0, 1), a2 + hstepA, voffA);
            PG8_WAIT_V(8); PG8_WAIT_L(0); PG8_BAR; PG8_MMA(0, 0, At, B0); PG8_MMA(0, 1, At, B1); PG8_BAR; PG8_SCHED;
            PG8_LDA(At, 1, 1); PG8_STAGE(PG8_SB(1, 0), b3, voffB); PG8_STAGE(PG8_SB(1, 1), b3 + hstepB, voffB); PG8_STAGE(PG8_SA(1, 0), a3, voffA);
            PG8_WAIT_V(8); PG8_WAIT_L(0); PG8_BAR; PG8_MMA(1, 0, At, B0); PG8_MMA(1, 1, At, B1); PG8_BAR; PG8_SCHED;
            } else {
            PG8_LDB(B0, 0, 0); PG8_SCHED; PG8_LDA(At, 0, 0); PG8_STAGE(PG8_SA(1, 1), a1 + hstepA, voffA);
            PG8_WAIT_L(8); PG8_BAR; PG8_WAIT_L(0); PG8_MMA(0, 0, At, B0); PG8_BAR; PG8_SCHED;
            PG8_LDB(B1, 0, 1); PG8_STAGE(PG8_SB(0, 0), b2, voffB);
            PG8_BAR; PG8_WAIT_L(0); PG8_MMA(0, 1, At, B1); PG8_BAR;
            PG8_LDA(At, 0, 1); PG8_STAGE(PG8_SA(0, 0), a2, voffA);
            PG8_BAR; PG8_WAIT_L(0); PG8_MMA(1, 0, At, B0); PG8_BAR; PG8_SCHED;
            PG8_STAGE(PG8_SB(0, 1), b2 + hstepB, voffB);
            PG8_WAIT_V(6); PG8_BAR; PG8_MMA(1, 1, At, B1); PG8_BAR;
            PG8_LDB(B0, 1, 0); PG8_SCHED; PG8_LDA(At, 1, 0); PG8_STAGE(PG8_SA(0, 1), a2 + hstepA, voffA);
            PG8_WAIT_L(8); PG8_BAR; PG8_WAIT_L(0); PG8_MMA(0, 0, At, B0); PG8_BAR; PG8_SCHED;
            PG8_LDB(B1, 1, 1); PG8_STAGE(PG8_SB(1, 0), b3, voffB);
            PG8_BAR; PG8_WAIT_L(0); PG8_MMA(0, 1, At, B1); PG8_BAR;
            PG8_LDA(At, 1, 1); PG8_STAGE(PG8_SA(1, 0), a3, voffA);
            PG8_BAR; PG8_WAIT_L(0); PG8_MMA(1, 0, At, B0); PG8_BAR; PG8_SCHED;
            PG8_STAGE(PG8_SB(1, 1), b3 + hstepB, voffB);
            PG8_WAIT_V(6); PG8_BAR; PG8_MMA(1, 1, At, B1); PG8_BAR;
            }
        }
        if constexpr (ALIGN_EPI) { if (wr == 0) PG8_BAR; }
        E(acc, cur, wr, wc, fr, fq);
        if (!has_next) break;
#pragma unroll
        for (int a = 0; a < 2; ++a)
#pragma unroll
            for (int b = 0; b < 2; ++b)
#pragma unroll
                for (int m = 0; m < 4; ++m)
#pragma unroll
                    for (int n = 0; n < 2; ++n) acc[a][b][m][n] = (f32x4){0.f, 0.f, 0.f, 0.f};
        cur = nxt; cA = nA; cB = nB; ++ui;
        if constexpr (ALIGN_EPI) { if (wr == 1) PG8_BAR; }
    }
    PG8_WAIT_V(0);
    if constexpr (!ALIGN_EPI) { if (wr == 0) PG8_BAR; }
    PG8_BAR;
#undef PG8_SA
#undef PG8_SB
#undef PG8_STAGE
#undef PG8_LDA
#undef PG8_LDB
#undef PG8_MMA
#undef PG8_WAIT_V
#undef PG8_WAIT_L
#undef PG8_BAR
#undef PG8_SCHED
}
}

constexpr int LDS_BYTES = 147456;
struct Params { const float* in[39]; float* out; unsigned char* ws; };

__device__ __forceinline__ void tr_tile(const float* W, int N, const float* gain, bf16_t* Bt, int ldb, int mode, int k0, int n0, LAS float* t, int tid) {
#pragma unroll
    for (int i = 0; i < 8; ++i) { const int kk = (tid >> 6) + 8 * i, n = tid & 63; float v = (n0 + n < N) ? W[(size_t)(k0 + kk) * N + n0 + n] : 0.f; if (gain) v *= gain[k0 + kk]; t[kk * 65 + n] = v; }
    __syncthreads();
    { const int n = tid >> 3, kc = (tid & 7) * 8; const int j = n0 + n; const int drow = mode == 0 ? j : ((j >> 7) * 256 + (j & 127) + (mode == 2 ? 128 : 0));
      u32x4 w; w.x = pk2(t[(kc + 0) * 65 + n], t[(kc + 1) * 65 + n]); w.y = pk2(t[(kc + 2) * 65 + n], t[(kc + 3) * 65 + n]); w.z = pk2(t[(kc + 4) * 65 + n], t[(kc + 5) * 65 + n]); w.w = pk2(t[(kc + 6) * 65 + n], t[(kc + 7) * 65 + n]);
      *(u32x4*)(Bt + (size_t)drow * ldb + k0 + kc) = w; }
    __syncthreads();
}

__global__ void __launch_bounds__(512, 2) mega(Params p) {
    extern __shared__ __attribute__((aligned(16))) unsigned char lds_raw[];
    LAS unsigned char* lds = (LAS unsigned char*)lds_raw;
    cg::grid_group grid = cg::this_grid();
    const int tid = threadIdx.x, lane = tid & 63, wave = tid >> 6, G = gridDim.x, bid = blockIdx.x;
    unsigned char* ws = p.ws;
    float* SS0 = (float*)(ws + CTL_SS0); float* SS1 = (float*)(ws + CTL_SS1); float* SS2 = (float*)(ws + CTL_SS2); float* SS3 = (float*)(ws + CTL_SS3);
    float* LBT = (float*)(ws + CTL_LB); float* LBR = (float*)(ws + CTL_LBR); float* LBI = (float*)(ws + CTL_LBI); float* BBR = (float*)(ws + CTL_BBR); float* BBI = (float*)(ws + CTL_BBI);
    bf16_t* XB = (bf16_t*)(ws + WS_XB); bf16_t* YC = (bf16_t*)(ws + WS_YC); bf16_t* U = (bf16_t*)(ws + WS_U);
    float* xout = p.out;

    {
        LAS float* tt = (LAS float*)lds;
        constexpr int T_IN0 = 16 * 60, T_SQ = 16 * 16, T_GU = 16 * 44, T_DN = 44 * 16, T_IN1 = 16 * 56;
        constexpr int NT = T_IN0 + T_SQ + 2 * T_GU + T_DN + T_IN1 + T_SQ + 2 * T_GU + T_DN;
        for (int it = bid; it < NT; it += G) {
            int r = it; const float* W; const float* gain; bf16_t* dst; int N, nNt, ldb, mode;
            if (r < T_IN0) { W = p.in[4]; gain = p.in[1]; dst = (bf16_t*)(ws + WS_IN0); N = EVEN_IN; nNt = 60; ldb = DM; mode = 0; }
            else if ((r -= T_IN0) < T_SQ) { W = p.in[5]; gain = nullptr; dst = (bf16_t*)(ws + WS_OUT0); N = DM; nNt = 16; ldb = DM; mode = 0; }
            else if ((r -= T_SQ) < T_GU) { W = p.in[36]; gain = p.in[2]; dst = (bf16_t*)(ws + WS_GU0); N = FFN; nNt = 44; ldb = DM; mode = 1; }
            else if ((r -= T_GU) < T_GU) { W = p.in[37]; gain = p.in[2]; dst = (bf16_t*)(ws + WS_GU0); N = FFN; nNt = 44; ldb = DM; mode = 2; }
            else if ((r -= T_GU) < T_DN) { W = p.in[38]; gain = nullptr; dst = (bf16_t*)(ws + WS_D0); N = DM; nNt = 16; ldb = FFN; mode = 0; }
            else if ((r -= T_DN) < T_IN1) { W = p.in[19]; gain = p.in[1] + DM; dst = (bf16_t*)(ws + WS_IN1); N = ODD_IN; nNt = 56; ldb = DM; mode = 0; }
            else if ((r -= T_IN1) < T_SQ) { W = p.in[20]; gain = nullptr; dst = (bf16_t*)(ws + WS_OUT1); N = DM; nNt = 16; ldb = DM; mode = 0; }
            else if ((r -= T_SQ) < T_GU) { W = p.in[36] + (size_t)DM * FFN; gain = p.in[2] + DM; dst = (bf16_t*)(ws + WS_GU1); N = FFN; nNt = 44; ldb = DM; mode = 1; }
            else if ((r -= T_GU) < T_GU) { W = p.in[37] + (size_t)DM * FFN; gain = p.in[2] + DM; dst = (bf16_t*)(ws + WS_GU1); N = FFN; nNt = 44; ldb = DM; mode = 2; }
            else { r -= T_GU; W = p.in[38] + (size_t)FFN * DM; gain = nullptr; dst = (bf16_t*)(ws + WS_D1); N = DM; nNt = 16; ldb = FFN; mode = 0; }
            const int kb = r / nNt, nb = r % nNt;
            tr_tile(W, N, gain, dst, ldb, mode, kb * 64, nb * 64, tt, tid);
        }
        const float* x = p.in[0];
        for (int row = bid * 8 + wave; row < M; row += G * 8) {
            const f32x4* xr = (const f32x4*)(x + (size_t)row * DM) + lane; f32x4 v[4]; float s = 0.f;
#pragma unroll
            for (int j = 0; j < 4; ++j) { v[j] = xr[64 * j]; s += (v[j][0] * v[j][0] + v[j][1] * v[j][1]) + (v[j][2] * v[j][2] + v[j][3] * v[j][3]); }
            s = wave_sum(s); if (lane == 0) SS0[row] = s;
            u32x2* o = (u32x2*)(XB + (size_t)row * DM) + lane;
#pragma unroll
            for (int j = 0; j < 4; ++j) { u32x2 w; w.x = pk2(v[j][0], v[j][1]); w.y = pk2(v[j][2], v[j][3]); o[64 * j] = w; }
        }
        if (bid == 0) {
            { const float* lt = p.in[6]; const float l0 = lt[tid], l1 = lt[512 + tid], l2 = lt[1024 + tid]; const float mx = fmaxf(l0, fmaxf(l1, l2));
              const float e0 = expf(l0 - mx), e1 = expf(l1 - mx), e2 = expf(l2 - mx); LBT[tid] = e0 / (e0 + e1 + e2); }
            for (int gp = tid; gp < 1024; gp += 512) {
                const int g = gp >> 6; const float step = expf(p.in[23][g]); const float lr = p.in[21][gp], li = p.in[22][gp];
                const float mag = expf(lr * step); const float br = mag * cosf(li * step), bi = mag * sinf(li * step);
                LBR[gp] = br; LBI[gp] = bi;
                const float den = lr * lr + li * li, nr = br - 1.f, ni = bi; const float cr = (nr * lr + ni * li) / den, ci = (ni * lr - nr * li) / den;
                for (int h = 0; h < 16; ++h) { const float xr2 = p.in[24][gp * 16 + h], xi2 = p.in[25][gp * 16 + h]; BBR[gp * 16 + h] = cr * xr2 - ci * xi2; BBI[gp * 16 + h] = cr * xi2 + ci * xr2; }
            }
        }
    }
    grid.sync();

    { pg8::Gemm g{XB, (const bf16_t*)(ws + WS_IN0), DM, DM, M, LDU0, DM}; pg8::StaticOrder S; S.init(M, LDU0, G, bid);
      pg8::EpiScaleBf16 E{U, LDU0, SS0}; pg8::gemm_phase<pg8::EpiScaleBf16, pg8::StaticOrder, true, true>(lds, g, S, E); }
    grid.sync();

    bf16_t* Rr = (bf16_t*)xout; bf16_t* Kp = Rr + (size_t)M * 512; bf16_t* Vv = Kp + (size_t)M * 512; bf16_t* An = Vv + (size_t)M * 512;
    bf16_t* Bv = XB; bf16_t* Dd = XB + (size_t)M * 512;
    bf16_t* Gg = (bf16_t*)(ws + WS_MS); bf16_t* Yr = Gg + (size_t)M * 512;

    {
        const int c = tid;
        float w2r[32], a2r[32], g2r[96];
#pragma unroll
        for (int j = 0; j < 32; ++j) { w2r[j] = p.in[10][j * 512 + c]; a2r[j] = p.in[12][j * 512 + c]; }
#pragma unroll
        for (int j = 0; j < 96; ++j) g2r[j] = p.in[13][j * 512 + c];
        const float* mu = p.in[8];
        const float mu_r = mu[c], mu_k = mu[512 + c], mu_v = mu[1024 + c], mu_l = (c < 160) ? mu[1536 + c] : 0.f;
        const float w0c = p.in[9][c], a0c = p.in[11][c], kkc = p.in[14][c], kac = p.in[15][c];
        const float one_m_lb = 1.f - LBT[c];
        LAS float* sl = (LAS float*)lds;
        int it = 0;
        for (int m = bid; m < M; m += G, ++it) {
            bf16_t* ur = U + (size_t)m * LDU0; const bf16_t* up = ur - LDU0; const bool hp = (m & (SEQ - 1)) != 0;
            LAS float* s = sl + (it & 1) * 160;
            if (c < 160) { const float cur = bf2f(ur[3584 + c]); const float prev = hp ? bf2f(up[3584 + c]) : 0.f; const float v = cur + (prev - cur) * mu_l;
                s[c] = (c < 32) ? tanhf(v) : (c < 64 ? v : sigmoidf_(v)); }
            { const float aq = bf2f(ur[c]), af = bf2f(ur[512 + c]); ur[c] = f2bf(siluf_(aq)); ur[512 + c] = f2bf(one_m_lb * sigmoidf_(-af)); }
            float r, k, v;
            { const float c0 = bf2f(ur[2048 + c]), c1 = bf2f(ur[2560 + c]), c2 = bf2f(ur[3072 + c]);
              const float p0 = hp ? bf2f(up[2048 + c]) : 0.f, p1 = hp ? bf2f(up[2560 + c]) : 0.f, p2 = hp ? bf2f(up[3072 + c]) : 0.f;
              r = c0 + (p0 - c0) * mu_r; k = c1 + (p1 - c1) * mu_k; v = c2 + (p2 - c2) * mu_v; }
            __syncthreads();
            float wl = w0c, al = a0c, g = 0.f;
#pragma unroll
            for (int j = 0; j < 32; ++j) { wl = fmaf(s[j], w2r[j], wl); al = fmaf(s[32 + j], a2r[j], al); }
#pragma unroll
            for (int j = 0; j < 96; ++j) g = fmaf(s[64 + j], g2r[j], g);
            const float wlog = -softplusf_(-wl) - 0.5f;
            const float dd = -expm1f(-__expf(wlog));
            const float a = sigmoidf_(al);
            const float kkv = k * kkc; const float ssq = wave_sum(kkv * kkv); const float kk = kkv / fmaxf(sqrtf(ssq), 1e-12f);
            const size_t o = (size_t)m * 512 + c;
            Rr[o] = f2bf(r); Dd[o] = f2bf(dd); Kp[o] = f2bf(k * (1.f + (a - 1.f) * kac)); Vv[o] = f2bf(v); An[o] = f2bf(-kk); Bv[o] = f2bf(kk * a); Gg[o] = f2bf(g);
        }
    }
    grid.sync();

    for (int item = bid; item < 256; item += G) {
        const int q = item & 3, h = (item >> 2) & 7, b = item >> 5;
        const int vrow = q * 16 + wave * 2 + (lane >> 5), kp2 = lane & 31;
        const size_t base = (size_t)b * SEQ * 512 + h * 64;
        const unsigned* R32 = (const unsigned*)(Rr + base) + kp2; const unsigned* K32 = (const unsigned*)(Kp + base) + kp2; const unsigned* A32 = (const unsigned*)(An + base) + kp2;
        const unsigned* B32 = (const unsigned*)(Bv + base) + kp2; const unsigned* D32 = (const unsigned*)(Dd + base) + kp2; const bf16_t* V16 = Vv + base + vrow; bf16_t* Y16 = Yr + base + vrow;
        float S0 = 0.f, S1 = 0.f;
        constexpr int UN = 8;
        unsigned nr[UN], nk[UN], na[UN], nb[UN], nd[UN]; bf16_t nv[UN];
#pragma unroll
        for (int i = 0; i < UN; ++i) { const size_t o = (size_t)i * 256; nr[i] = R32[o]; nk[i] = K32[o]; na[i] = A32[o]; nb[i] = B32[o]; nd[i] = D32[o]; nv[i] = V16[(size_t)i * 512]; }
        for (int t0 = 0; t0 < SEQ; t0 += UN) {
            unsigned cr[UN], ck[UN], ca[UN], cb[UN], cd[UN]; bf16_t cv[UN];
#pragma unroll
            for (int i = 0; i < UN; ++i) { cr[i] = nr[i]; ck[i] = nk[i]; ca[i] = na[i]; cb[i] = nb[i]; cd[i] = nd[i]; cv[i] = nv[i]; }
            if (t0 + UN < SEQ) {
#pragma unroll
                for (int i = 0; i < UN; ++i) { const size_t o = (size_t)(t0 + UN + i) * 256; nr[i] = R32[o]; nk[i] = K32[o]; na[i] = A32[o]; nb[i] = B32[o]; nd[i] = D32[o]; nv[i] = V16[(size_t)(t0 + UN + i) * 512]; }
            }
#pragma unroll
            for (int i = 0; i < UN; ++i) {
                const float vv = bf2f(cv[i]);
                const float sa = half_sum(S0 * bflo(ca[i]) + S1 * bfhi(ca[i]));
                S0 = (S0 - S0 * bflo(cd[i])) + sa * bflo(cb[i]) + vv * bflo(ck[i]);
                S1 = (S1 - S1 * bfhi(cd[i])) + sa * bfhi(cb[i]) + vv * bfhi(ck[i]);
                const float y = half_sum(S0 * bflo(cr[i]) + S1 * bfhi(cr[i]));
                if (kp2 == 0) Y16[(size_t)(t0 + i) * 512] = f2bf(y);
            }
        }
    }
    for (int item = bid; item < 256; item += G) {
        const int vs = item & 7, h = (item >> 3) & 3, b = item >> 5;
        const int v = vs * 16 + wave * 2 + (lane >> 5), kg = lane & 31;
        bf16_t* ub = U + (size_t)b * SEQ * LDU0;
        const u32x2* Q2 = (const u32x2*)(ub + h * 128 + kg * 4); const u32x2* K2 = (const u32x2*)(ub + 512 + h * 128 + kg * 4); bf16_t* V16 = ub + 1024 + h * 128 + v;
        constexpr size_t RS2 = LDU0 / 4;
        float S[4] = {0.f, 0.f, 0.f, 0.f};
        constexpr int UN = 8;
        u32x2 nq[UN], nk[UN]; bf16_t nv[UN];
#pragma unroll
        for (int i = 0; i < UN; ++i) { nq[i] = Q2[(size_t)i * RS2]; nk[i] = K2[(size_t)i * RS2]; nv[i] = V16[(size_t)i * LDU0]; }
        for (int t0 = 0; t0 < SEQ; t0 += UN) {
            u32x2 cq[UN], ck[UN]; bf16_t cv[UN];
#pragma unroll
            for (int i = 0; i < UN; ++i) { cq[i] = nq[i]; ck[i] = nk[i]; cv[i] = nv[i]; }
            if (t0 + UN < SEQ) {
#pragma unroll
                for (int i = 0; i < UN; ++i) { nq[i] = Q2[(size_t)(t0 + UN + i) * RS2]; nk[i] = K2[(size_t)(t0 + UN + i) * RS2]; nv[i] = V16[(size_t)(t0 + UN + i) * LDU0]; }
            }
#pragma unroll
            for (int i = 0; i < UN; ++i) {
                const float vv = bf2f(cv[i]);
                const float k0 = bflo(ck[i].x), k1 = bfhi(ck[i].x), k2 = bflo(ck[i].y), k3 = bfhi(ck[i].y);
                S[0] = fmaf(1.f - k0, S[0], k0 * vv); S[1] = fmaf(1.f - k1, S[1], k1 * vv); S[2] = fmaf(1.f - k2, S[2], k2 * vv); S[3] = fmaf(1.f - k3, S[3], k3 * vv);
                float o = bflo(cq[i].x) * S[0] + bfhi(cq[i].x) * S[1] + bflo(cq[i].y) * S[2] + bfhi(cq[i].y) * S[3];
                o = half_sum(o);
                if (kg == 0) V16[(size_t)(t0 + i) * LDU0] = f2bf(o);
            }
        }
    }
    grid.sync();

    {
        LAS float* red = (LAS float*)lds;
        const int c = tid;
        const float anorm = p.in[7][c], rk = p.in[16][c], lnw = p.in[17][c], lnb = p.in[18][c];
        int it = 0;
        for (int m = bid; m < M; m += G, ++it) {
            const bf16_t* ur = U + (size_t)m * LDU0; LAS float* rd = red + (it & 1) * 8;
            const float o = bf2f(ur[1024 + c]); const float ss = wave_sum(o * o);
            if (lane == 0) rd[wave] = ss;
            const size_t i = (size_t)m * 512 + c;
            const float y = bf2f(Yr[i]); const float mean = wave_sum(y) * (1.f / 64.f); const float d = y - mean; const float var = wave_sum(d * d) * (1.f / 64.f);
            float yn = d * (1.0f / sqrtf(var + 64e-5f)) * lnw + lnb;
            const float vv = bf2f(Vv[i]);
            const float bonus = wave_sum(bf2f(Rr[i]) * bf2f(Kp[i]) * rk);
            yn = (yn + bonus * vv) * bf2f(Gg[i]);
            YC[(size_t)m * DM + 512 + c] = f2bf(yn);
            __syncthreads();
            const float tot = rd[wave & ~1] + rd[wave | 1];
            YC[(size_t)m * DM + c] = f2bf(o * (1.0f / sqrtf(tot * (1.f / 128.f) + RMS_EPS)) * anorm * siluf_(bf2f(ur[1536 + c])));
        }
    }
    grid.sync();

    { pg8::Gemm g{YC, (const bf16_t*)(ws + WS_OUT0), DM, DM, M, DM, DM}; pg8::StaticOrder S; S.init(M, DM, G, bid);
      pg8::EpiResidual<true> E{p.in[0], xout, XB, SS1}; pg8::gemm_phase<pg8::EpiResidual<true>, pg8::StaticOrder, true, true>(lds, g, S, E); }
    grid.sync();
    bf16_t* HID = U;
    { pg8::Gemm g{XB, (const bf16_t*)(ws + WS_GU0), DM, DM, M, 2 * FFN, DM}; pg8::StaticOrder S; S.init(M, 2 * FFN, G, bid);
      pg8::EpiSwiGlu E{HID, FFN, SS1}; pg8::gemm_phase<pg8::EpiSwiGlu, pg8::StaticOrder, true, true>(lds, g, S, E); }
    grid.sync();
    { pg8::Gemm g{HID, (const bf16_t*)(ws + WS_D0), FFN, FFN, M, DM, FFN}; pg8::StaticOrder S; S.init(M, DM, G, bid);
      pg8::EpiResidual<true> E{xout, xout, XB, SS2}; pg8::gemm_phase<pg8::EpiResidual<true>, pg8::StaticOrder, true, true>(lds, g, S, E); }
    grid.sync();
    { pg8::Gemm g{XB, (const bf16_t*)(ws + WS_IN1), DM, DM, M, LDU1, DM}; pg8::StaticOrder S; S.init(M, LDU1, G, bid);
      pg8::EpiScaleBf16 E{U, LDU1, SS2}; pg8::gemm_phase<pg8::EpiScaleBf16, pg8::StaticOrder, true, true>(lds, g, S, E); }
    grid.sync();

    bf16_t* Qc = XB; bf16_t* Kc = (bf16_t*)(ws + WS_MS); float* FGt = (float*)(ws + WS_MS + 48 * MiB); float* IGt = (float*)(ws + WS_MS + 49 * MiB);
    {
        const float* cq = p.in[31]; const float* ck = p.in[32];
        for (int m = bid; m < M; m += G) {
            const int t = m & (SEQ - 1);
            for (int c = tid; c < 768; c += 512) {
                float aq = 0.f, ak = 0.f;
#pragma unroll
                for (int j = 0; j < 4; ++j) { if (t - 3 + j >= 0) { const bf16_t* ur = U + (size_t)(m - 3 + j) * LDU1; aq = fmaf(cq[j * 768 + c], bf2f(ur[256 + c]), aq); ak = fmaf(ck[j * 768 + c], bf2f(ur[1024 + c]), ak); } }
                Qc[(size_t)m * 768 + c] = f2bf(siluf_(aq)); Kc[(size_t)m * 768 + c] = f2bf(siluf_(ak) * 0.07216878364870322f);
            }
            if (tid < 4) { const bf16_t* ur = U + (size_t)m * LDU1; IGt[(size_t)m * 4 + tid] = __expf(bf2f(ur[3328 + tid]) + p.in[33][tid]); FGt[(size_t)m * 4 + tid] = sigmoidf_(bf2f(ur[3332 + tid]) + p.in[34][tid]); }
        }
    }
    grid.sync();

    if (bid < 192) {
        constexpr int T = 8;
        LAS float* sq = (LAS float*)lds; LAS float* sk = sq + T * 192; LAS float* sv = sk + T * 192; LAS float* sf = sv + T * 32; LAS float* si = sf + T;
        const int vs = bid % 6, h = (bid / 6) & 3, b = bid / 24;
        const int v = tid >> 4, dg = tid & 15;
        float C[12], n[12];
#pragma unroll
        for (int j = 0; j < 12; ++j) { C[j] = 0.f; n[j] = 0.f; }
        for (int t0 = 0; t0 < SEQ; t0 += T) {
            __syncthreads();
            for (int e = tid; e < T * 192; e += 512) { const int tt = e / 192, d = e % 192; const size_t mm = (size_t)(b * SEQ + t0 + tt); sq[e] = bf2f(Qc[mm * 768 + h * 192 + d]); sk[e] = bf2f(Kc[mm * 768 + h * 192 + d]); }
            if (tid < T * 32) { const int tt = tid >> 5, vv = tid & 31; sv[tid] = bf2f(U[(size_t)(b * SEQ + t0 + tt) * LDU1 + 1792 + h * 192 + vs * 32 + vv]); }
            if (tid < T) { const size_t mm = (size_t)(b * SEQ + t0 + tid); sf[tid] = FGt[mm * 4 + h]; si[tid] = IGt[mm * 4 + h]; }
            __syncthreads();
            for (int tt = 0; tt < T; ++tt) {
                const float f = sf[tt], ig = si[tt], vv = sv[tt * 32 + v]; float num = 0.f, den = 0.f;
#pragma unroll
                for (int j = 0; j < 12; ++j) { const int d = dg * 12 + j; const float ik = ig * sk[tt * 192 + d], qq = sq[tt * 192 + d];
                    C[j] = fmaf(f, C[j], ik * vv); n[j] = fmaf(f, n[j], ik); num = fmaf(qq, C[j], num); den = fmaf(qq, n[j], den); }
#pragma unroll
                for (int o = 1; o < 16; o <<= 1) { num += __shfl_xor(num, o); den += __shfl_xor(den, o); }
                if (dg == 0) U[(size_t)(b * SEQ + t0 + tt) * LDU1 + 1792 + h * 192 + vs * 32 + v] = f2bf(num / fmaxf(fabsf(den), 1.0f));
            }
        }
    } else if (wave < 2) {
        const int chain = (bid - 192) * 2 + wave, g = chain & 15, b = chain >> 4;
        LAS float* hx = (LAS float*)(lds + wave * 1024);
        const int gp = g * 64 + lane;
        const float ar = LBR[gp], ai = LBI[gp];
        float br[16], bi[16];
#pragma unroll
        for (int hh = 0; hh < 16; ++hh) { br[hh] = BBR[gp * 16 + hh]; bi[hh] = BBI[gp * 16 + hh]; }
        const int ho = lane & 15, pq = lane >> 4;
        float cr[16], ci[16];
#pragma unroll
        for (int j = 0; j < 16; ++j) { cr[j] = p.in[26][(g * 16 + ho) * 64 + pq * 16 + j]; ci[j] = p.in[27][(g * 16 + ho) * 64 + pq * 16 + j]; }
        const float dsk = p.in[28][g * 16 + ho];
        float hr = 0.f, hi = 0.f;
        bf16_t* ub = U + (size_t)b * SEQ * LDU1 + g * 16;
        for (int t = 0; t < SEQ; ++t) {
            bf16_t* ur = ub + (size_t)t * LDU1;
            const u32x4 ua = *(const u32x4*)ur, ubv = *(const u32x4*)(ur + 8);
            float uu[16];
            uu[0] = bflo(ua.x); uu[1] = bfhi(ua.x); uu[2] = bflo(ua.y); uu[3] = bfhi(ua.y); uu[4] = bflo(ua.z); uu[5] = bfhi(ua.z); uu[6] = bflo(ua.w); uu[7] = bfhi(ua.w);
            uu[8] = bflo(ubv.x); uu[9] = bfhi(ubv.x); uu[10] = bflo(ubv.y); uu[11] = bfhi(ubv.y); uu[12] = bflo(ubv.z); uu[13] = bfhi(ubv.z); uu[14] = bflo(ubv.w); uu[15] = bfhi(ubv.w);
            float xr = 0.f, xi = 0.f;
#pragma unroll
            for (int hh = 0; hh < 16; ++hh) { xr = fmaf(br[hh], uu[hh], xr); xi = fmaf(bi[hh], uu[hh], xi); }
            const float nr2 = ar * hr - ai * hi + xr, ni2 = ar * hi + ai * hr + xi; hr = nr2; hi = ni2;
            hx[lane] = hr; hx[64 + lane] = hi;
            asm volatile("s_waitcnt lgkmcnt(0)" ::: "memory");
            float y = 0.f;
#pragma unroll
            for (int j = 0; j < 16; ++j) y += cr[j] * hx[pq * 16 + j] - ci[j] * hx[64 + pq * 16 + j];
            y += __shfl_xor(y, 16); y += __shfl_xor(y, 32);
            float uo = uu[0];
#pragma unroll
            for (int j = 1; j < 16; ++j) uo = (ho == j) ? uu[j] : uo;
            y += dsk * uo;
            const float z = 0.5f * y * (1.f + tanhf(0.7978845608028654f * (y + 0.044715f * y * y * y)));
            asm volatile("s_waitcnt lgkmcnt(0)" ::: "memory");
            if (lane < 16) ur[lane] = f2bf(z);
        }
    }
    grid.sync();

    {
        LAS float* z = (LAS float*)lds;
        LAS float* red = z + 16 * 256;
        const float* gw = p.in[29];
        for (int m0 = bid * 16; m0 < M; m0 += G * 16) {
            __syncthreads();
            for (int e = tid; e < 16 * 256; e += 512) { const int tk = e >> 8, c = e & 255; z[e] = bf2f(U[(size_t)(m0 + tk) * LDU1 + c]); }
            __syncthreads();
            { const int c = tid & 255, hf = tid >> 8; float acc[8];
#pragma unroll
              for (int i = 0; i < 8; ++i) acc[i] = p.in[30][c];
              for (int j = 0; j < 256; ++j) { const float w = gw[j * 256 + c];
#pragma unroll
                  for (int i = 0; i < 8; ++i) acc[i] = fmaf(z[(hf * 8 + i) * 256 + j], w, acc[i]); }
#pragma unroll
              for (int i = 0; i < 8; ++i) { const int tk = hf * 8 + i; YC[(size_t)(m0 + tk) * DM + c] = f2bf(z[tk * 256 + c] * sigmoidf_(acc[i])); } }
            for (int tk = 0; tk < 16; ++tk) {
                const size_t mm = (size_t)(m0 + tk); const bf16_t* ur = U + mm * LDU1;
                float hv[2];
#pragma unroll
                for (int i = 0; i < 2; ++i) { const int c = tid + 512 * i; hv[i] = (c < 768) ? bf2f(ur[1792 + c]) : 0.f; const float ss = wave_sum(hv[i] * hv[i]); if (lane == 0 && c < 768) red[c >> 6] = ss; }
                __syncthreads();
#pragma unroll
                for (int i = 0; i < 2; ++i) { const int c = tid + 512 * i; if (c < 768) { const int hd = c / 192; const float tot = red[hd * 3] + red[hd * 3 + 1] + red[hd * 3 + 2];
                    YC[mm * DM + 256 + c] = f2bf(hv[i] * (1.0f / sqrtf(tot * (1.f / 192.f) + RMS_EPS)) * p.in[35][c] * sigmoidf_(bf2f(ur[2560 + c]))); } }
                __syncthreads();
            }
        }
    }
    grid.sync();

    { pg8::Gemm g{YC, (const bf16_t*)(ws + WS_OUT1), DM, DM, M, DM, DM}; pg8::StaticOrder S; S.init(M, DM, G, bid);
      pg8::EpiResidual<true> E{xout, xout, XB, SS3}; pg8::gemm_phase<pg8::EpiResidual<true>, pg8::StaticOrder, true, true>(lds, g, S, E); }
    grid.sync();
    { pg8::Gemm g{XB, (const bf16_t*)(ws + WS_GU1), DM, DM, M, 2 * FFN, DM}; pg8::StaticOrder S; S.init(M, 2 * FFN, G, bid);
      pg8::EpiSwiGlu E{HID, FFN, SS3}; pg8::gemm_phase<pg8::EpiSwiGlu, pg8::StaticOrder, true, true>(lds, g, S, E); }
    grid.sync();
    { pg8::Gemm g{HID, (const bf16_t*)(ws + WS_D1), FFN, FFN, M, DM, FFN}; pg8::StaticOrder S; S.init(M, DM, G, bid);
      pg8::EpiResidual<false> E{xout, xout, XB, nullptr}; pg8::gemm_phase<pg8::EpiResidual<false>, pg8::StaticOrder, true, true>(lds, g, S, E); }
    grid.sync();

    {
        const f32x4* gg = (const f32x4*)p.in[3] + lane;
        for (int row = bid * 8 + wave; row < M; row += G * 8) {
            f32x4* xr = (f32x4*)(xout + (size_t)row * DM) + lane; f32x4 v[4]; float s = 0.f;
#pragma unroll
            for (int j = 0; j < 4; ++j) { v[j] = xr[64 * j]; s += (v[j][0] * v[j][0] + v[j][1] * v[j][1]) + (v[j][2] * v[j][2] + v[j][3] * v[j][3]); }
            s = wave_sum(s); const float rs = 1.0f / sqrtf(s * (1.f / DM) + RMS_EPS);
#pragma unroll
            for (int j = 0; j < 4; ++j) xr[64 * j] = v[j] * rs * gg[64 * j];
        }
    }
}

extern "C" void kernel_launch(void* const* d_in, const int* in_sizes, int n_in, void* d_out, int out_size, void* d_ws, size_t ws_size, hipStream_t stream) {
    static int ready = 0;
    if (!ready) {
        if (n_in != 39 || out_size != M * DM || ws_size < WS_END) { fprintf(stderr, "kernel_launch: unexpected problem shape (n_in %d out %d ws %zu)\n", n_in, out_size, ws_size); ready = -1; return; }
        if (hipFuncSetAttribute((const void*)mega, hipFuncAttributeMaxDynamicSharedMemorySize, LDS_BYTES) != hipSuccess) { fprintf(stderr, "kernel_launch: hipFuncSetAttribute failed\n"); ready = -1; return; }
        int per_cu = 0; (void)hipOccupancyMaxActiveBlocksPerMultiprocessor(&per_cu, (const void*)mega, 512, LDS_BYTES);
        if (per_cu < 1) fprintf(stderr, "kernel_launch: occupancy query says %d blocks per CU\n", per_cu);
        (void)hipGetLastError();
        ready = 1;
    }
    if (ready < 0) return;
    (void)hipMemsetAsync((char*)d_ws + WS_CTL, 0, CTL_BYTES, stream);
    Params p{};
    for (int i = 0; i < 39; ++i) p.in[i] = (const float*)d_in[i];
    p.out = (float*)d_out; p.ws = (unsigned char*)d_ws;
    void* args[] = {&p};
    hipError_t e = hipLaunchCooperativeKernel((const void*)mega, dim3(256), dim3(512), args, LDS_BYTES, stream);
    if (e != hipSuccess) fprintf(stderr, "kernel_launch: cooperative launch failed: %s\n", hipGetErrorString(e));
}
```

```cpp
#include <hip/hip_runtime.h>
#include <hip/hip_cooperative_groups.h>
#include <cstdio>
#include <cstdint>
#include <cmath>
namespace cg = cooperative_groups;

#define LAS __attribute__((address_space(3)))
typedef unsigned short bf16_t;
typedef short bf16x8 __attribute__((ext_vector_type(8)));
typedef short s16x4 __attribute__((ext_vector_type(4)));
typedef float f32x4 __attribute__((ext_vector_type(4)));
typedef unsigned u32x4 __attribute__((ext_vector_type(4)));
typedef unsigned u32x2 __attribute__((ext_vector_type(2)));

constexpr int SEQ = 4096, BATCH = 8, DM = 1024, M = BATCH * SEQ;
constexpr int EVEN_IN = 3744, LDU0 = 3840, ODD_IN = 3336, NP1 = 3584, LDU1 = 3712, FFN = 2816;
constexpr float RMS_EPS = 1e-6f;

constexpr size_t MiB = 1u << 20;
constexpr size_t WS_CTL = 0, CTL_BYTES = 1 * MiB;
constexpr size_t CTL_SS1 = 128 * 1024, CTL_SS2 = 256 * 1024, CTL_SS3 = 384 * 1024, CTL_SS0 = 512 * 1024;
constexpr size_t CTL_TS = 800 * 1024;
constexpr size_t CTL_LB = 640 * 1024, CTL_LBR = 644 * 1024, CTL_LBI = 648 * 1024, CTL_BBR = 656 * 1024, CTL_BBI = 720 * 1024;
constexpr size_t WS_IN0 = 1 * MiB, WS_OUT0 = WS_IN0 + (size_t)LDU0 * DM * 2, WS_GU0 = WS_OUT0 + 2 * MiB, WS_D0 = WS_GU0 + 11 * MiB;
constexpr size_t WS_IN1 = WS_D0 + (size_t)DM * FFN * 2, WS_OUT1 = WS_IN1 + (size_t)NP1 * DM * 2, WS_GU1 = WS_OUT1 + 2 * MiB, WS_D1 = WS_GU1 + 11 * MiB;
constexpr size_t WS_GLU = WS_D1 + (size_t)DM * FFN * 2;
constexpr size_t WS_LORA = WS_GLU + 256 * 256 * 2;
constexpr size_t WS_XB = 53 * MiB, WS_YC = 117 * MiB, WS_U = 181 * MiB, WS_MS = 421 * MiB, WS_END = 512 * MiB;
constexpr size_t WS_SSQ = WS_MS + 70 * MiB;
static_assert(WS_LORA + 512 * 160 * 2 <= WS_XB, "weights fit");
static_assert(WS_U + (size_t)M * LDU0 * 2 <= WS_MS, "U fits");

__device__ __forceinline__ float bf2f(bf16_t h) { return __uint_as_float(((unsigned)h) << 16); }
__device__ __forceinline__ float bflo(unsigned w) { return __uint_as_float(w << 16); }
__device__ __forceinline__ unsigned long long ss_fix(float s) { return (unsigned long long)(s * 1048576.0f); }
__device__ __forceinline__ float ss_flt(unsigned long long q) { return ((float)(unsigned)(q >> 32) * 4294967296.0f + (float)(unsigned)q) * (1.0f / 1048576.0f); }
__device__ __forceinline__ float bfhi(unsigned w) { return __uint_as_float(w & 0xffff0000u); }
typedef __bf16 bf16x2_t __attribute__((ext_vector_type(2)));
typedef float f32x2c_t __attribute__((ext_vector_type(2)));
__device__ __forceinline__ unsigned pk2(float lo, float hi) { const bf16x2_t v = __builtin_convertvector((f32x2c_t){lo, hi}, bf16x2_t); return __builtin_bit_cast(unsigned, v); }
__device__ __forceinline__ bf16_t f2bf(float f) { const __bf16 b = (__bf16)f; return __builtin_bit_cast(bf16_t, b); }
__device__ __forceinline__ float sigmoidf_(float x) { return __builtin_amdgcn_rcpf(1.f + __expf(-x)); }
__device__ __forceinline__ float rsqrtf_(float x) { return __builtin_amdgcn_rsqf(x); }
__device__ __forceinline__ float siluf_(float x) { return x * sigmoidf_(x); }
__device__ __forceinline__ float softplusf_(float x) { return fmaxf(x, 0.f) + __logf(1.f + __expf(-fabsf(x))); }
__device__ __forceinline__ float tanhf_(float x) { const float e = __expf(-2.f * fabsf(x)); const float t = (1.f - e) * __builtin_amdgcn_rcpf(1.f + e); return x < 0.f ? -t : t; }
template <int CTRL> __device__ __forceinline__ float dpp_mov(float x) { return __int_as_float(__builtin_amdgcn_update_dpp(0, __float_as_int(x), CTRL, 0xf, 0xf, true)); }
__device__ __forceinline__ float row_sum16(float v) { v += dpp_mov<0xB1>(v); v += dpp_mov<0x4E>(v); v += dpp_mov<0x141>(v); v += dpp_mov<0x140>(v); return v; }
__device__ __forceinline__ float xrow16(float v) { const auto r = __builtin_amdgcn_permlane16_swap(__float_as_uint(v), __float_as_uint(v), false, false); return __uint_as_float(r[0]) + __uint_as_float(r[1]); }
__device__ __forceinline__ float xrow32(float v) { const auto r = __builtin_amdgcn_permlane32_swap(__float_as_uint(v), __float_as_uint(v), false, false); return __uint_as_float(r[0]) + __uint_as_float(r[1]); }
__device__ __forceinline__ float half_sum(float v) { return xrow16(row_sum16(v)); }
__device__ __forceinline__ float wave_sum(float v) { return xrow32(half_sum(v)); }

typedef float f32x2 __attribute__((ext_vector_type(2)));
__device__ __forceinline__ void half_reduce8(const float (&p)[8], int lane, float& o0, float& o1) {
    const bool b0 = (lane & 1) != 0, b1 = (lane & 2) != 0;
    float r[4];
#pragma unroll
    for (int i = 0; i < 4; ++i) { const float keep = b0 ? p[2 * i + 1] : p[2 * i], send = b0 ? p[2 * i] : p[2 * i + 1]; r[i] = keep + dpp_mov<0xB1>(send); }
    float q0, q1;
    { const float keep = b1 ? r[1] : r[0], send = b1 ? r[0] : r[1]; q0 = keep + dpp_mov<0x4E>(send); }
    { const float keep = b1 ? r[3] : r[2], send = b1 ? r[2] : r[3]; q1 = keep + dpp_mov<0x4E>(send); }
    q0 += dpp_mov<0x124>(q0); q0 += dpp_mov<0x128>(q0);
    q1 += dpp_mov<0x124>(q1); q1 += dpp_mov<0x128>(q1);
    o0 = xrow16(q0); o1 = xrow16(q1);
}

#define LBAR() do { asm volatile("s_waitcnt lgkmcnt(0)" ::: "memory"); __builtin_amdgcn_s_barrier(); asm volatile("" ::: "memory"); } while (0)
namespace pg8 {
constexpr int BM = 256, BK = 64, HALF = 128, HTB = HALF * BK * 2, STAGE_BYTES = 8 * HTB, NXCD = 8, WGM = 8;
__device__ __forceinline__ int lds_byte(int r, int c) { const int st = (r >> 4) * 2 + (c >> 5), rr = r & 15, cc = c & 31, ob = rr * 64 + cc * 2; return st * 1024 + (ob ^ (((ob >> 9) & 1) << 5)); }
__device__ __forceinline__ void stage_rc(int b, int& R, int& C) { const int st = b / 1024, sb = b % 1024, swz = sb ^ (((sb >> 9) & 1) << 5); R = (st >> 1) * 16 + swz / 64; C = (st & 1) * 32 + (swz % 64) / 2; }
__device__ __forceinline__ int perm32(int rho) { const int n = rho >> 4, i = rho & 15; return 8 * (i >> 2) + 4 * n + (i & 3); }
struct Unit { int pm, pn; };
struct Gemm { const bf16_t* A; const bf16_t* Bt; int lda, ldb, M, N, K; };
struct StaticOrder {
    int nM, nN, nwg, G, c;
    __device__ void init(int M_, int N_, int G_, int c_) { nM = M_ / BM; nN = N_ / BM; nwg = nM * nN; G = G_; c = c_; }
    __device__ bool next(int i, Unit& u) const {
        const long L = (long)i * G + c; if (L >= nwg) return false;
        int wgid = (int)L; { const int q = nwg / NXCD, r = nwg % NXCD, xcd = wgid % NXCD, off = wgid / NXCD; wgid = (xcd < r ? xcd * (q + 1) : r * (q + 1) + (xcd - r) * q) + off; }
        const int nig = WGM * nN, gid = wgid / nig, fm = gid * WGM, gsz = (nM - fm) < WGM ? (nM - fm) : WGM;
        u.pm = fm + ((wgid % nig) % gsz); u.pn = (wgid % nig) / gsz; return true;
    }
};

struct EpiScaleBf16 {
    static constexpr bool PERM = true;
    bf16_t* O; int ldc; const unsigned long long* ss;
    __device__ __forceinline__ void operator()(const f32x4 (&acc)[2][2][4][2], const Unit& u, int wr, int wc, int fr, int fq) const {
        const int row0 = u.pm * BM + wr * 64 + fr, col0 = u.pn * BM + wc * 32 + 8 * fq;
#pragma unroll
        for (int ai = 0; ai < 2; ++ai)
#pragma unroll
            for (int m = 0; m < 4; ++m) { const int row = row0 + ai * HALF + m * 16; const float rs = rsqrtf_(ss_flt(ss[row]) * (1.f / DM) + RMS_EPS);
                bf16_t* rowp = O + (size_t)row * ldc + col0;
#pragma unroll
                for (int bj = 0; bj < 2; ++bj) { const f32x4 v0 = acc[ai][bj][m][0] * rs, v1 = acc[ai][bj][m][1] * rs;
                    u32x4 w; w.x = pk2(v0[0], v0[1]); w.y = pk2(v0[2], v0[3]); w.z = pk2(v1[0], v1[1]); w.w = pk2(v1[2], v1[3]);
                    *(u32x4*)(rowp + bj * HALF) = w; } }
    }
};
struct EpiSwiGlu {
    static constexpr bool PERM = true;
    bf16_t* O; int ldc; const unsigned long long* ss;
    __device__ __forceinline__ void operator()(const f32x4 (&acc)[2][2][4][2], const Unit& u, int wr, int wc, int fr, int fq) const {
        const int row0 = u.pm * BM + wr * 64 + fr, col0 = u.pn * HALF + wc * 32 + 8 * fq;
#pragma unroll
        for (int ai = 0; ai < 2; ++ai)
#pragma unroll
            for (int m = 0; m < 4; ++m) { const int row = row0 + ai * HALF + m * 16; const float rs = rsqrtf_(ss_flt(ss[row]) * (1.f / DM) + RMS_EPS);
                f32x4 h[2];
#pragma unroll
                for (int n = 0; n < 2; ++n) { const f32x4 g = acc[ai][0][m][n] * rs, up = acc[ai][1][m][n] * rs;
#pragma unroll
                    for (int e = 0; e < 4; ++e) h[n][e] = siluf_(g[e]) * up[e]; }
                u32x4 w; w.x = pk2(h[0][0], h[0][1]); w.y = pk2(h[0][2], h[0][3]); w.z = pk2(h[1][0], h[1][1]); w.w = pk2(h[1][2], h[1][3]);
                *(u32x4*)(O + (size_t)row * ldc + col0) = w; }
    }
};
template <bool BASE_F32, bool WITH_SS> struct EpiResidual {
    static constexpr bool PERM = true;
    const float* base32; const bf16_t* base16; bf16_t* xb; unsigned long long* ss;
    __device__ __forceinline__ void operator()(const f32x4 (&acc)[2][2][4][2], const Unit& u, int wr, int wc, int fr, int fq) const {
        const int row0 = u.pm * BM + wr * 64 + fr, col0 = u.pn * BM + wc * 32 + 8 * fq;
#pragma unroll
        for (int ai = 0; ai < 2; ++ai)
#pragma unroll
            for (int m = 0; m < 4; ++m) { const int row = row0 + ai * HALF + m * 16; const size_t off = (size_t)row * DM + col0; float s = 0.f;
#pragma unroll
                for (int bj = 0; bj < 2; ++bj) { const size_t o = off + bj * HALF; f32x4 r0, r1;
                    if (BASE_F32) { r0 = *(const f32x4*)(base32 + o); r1 = *(const f32x4*)(base32 + o + 4); }
                    else { const u32x4 rb = *(const u32x4*)(base16 + o); r0 = (f32x4){bflo(rb.x), bfhi(rb.x), bflo(rb.y), bfhi(rb.y)}; r1 = (f32x4){bflo(rb.z), bfhi(rb.z), bflo(rb.w), bfhi(rb.w)}; }
                    const f32x4 v0 = r0 + acc[ai][bj][m][0], v1 = r1 + acc[ai][bj][m][1];
                    u32x4 w; w.x = pk2(v0[0], v0[1]); w.y = pk2(v0[2], v0[3]); w.z = pk2(v1[0], v1[1]); w.w = pk2(v1[2], v1[3]); *(u32x4*)(xb + o) = w;
                    s += ((v0[0] * v0[0] + v0[1] * v0[1]) + (v0[2] * v0[2] + v0[3] * v0[3])) + ((v1[0] * v1[0] + v1[1] * v1[1]) + (v1[2] * v1[2] + v1[3] * v1[3])); }
                if (WITH_SS) { s = xrow32(xrow16(s)); if (fq == 0) atomicAdd(ss + row, ss_fix(s)); } }
    }
};

template <class Epi, class Sched, bool ALIGN_EPI, bool SP2>
__device__ __forceinline__ void gemm_phase(LAS unsigned char* lds, const Gemm g, const Sched& S, const Epi& E) {
    int tid_ = threadIdx.x; asm volatile("" : "+v"(tid_));
    const int tid = tid_, wid = __builtin_amdgcn_readfirstlane(tid >> 6), lane = tid & 63, wr = wid >> 2, wc = wid & 3, fr = lane & 15, fq = lane >> 4;
    const int K = g.K, nt = K / BK;
    unsigned voffA[2], voffB[2];
#pragma unroll
    for (int i = 0; i < 2; ++i) { int R, C; stage_rc(tid * 16 + i * 8192, R, C); const int Rb = Epi::PERM ? ((R & ~31) + perm32(R & 31)) : R;
        voffA[i] = (unsigned)(R * g.lda + C) * 2u; voffB[i] = (unsigned)(Rb * g.ldb + C) * 2u; }
    const size_t kstep = (size_t)(BK * 2);
    const size_t hstepA = (size_t)HALF * g.lda * 2, hstepB = (size_t)HALF * g.ldb * 2;
    const size_t tstepA = 2 * hstepA, tstepB = 2 * hstepB;
    const unsigned ldsw = (unsigned)wid * 1024u;
    const int aoff = lds_byte(wr * 64 + fr, fq * 8), boff = lds_byte(wc * 32 + fr, fq * 8);
#define PG8_SA(b, h) (((b) * 2 + (h)) * HTB)
#define PG8_SB(b, h) ((4 + (b) * 2 + (h)) * HTB)
#define PG8_STAGE(bufoff, gbase, voff) do { _Pragma("unroll") for (int _i = 0; _i < 2; ++_i) \
        __builtin_amdgcn_global_load_lds((const unsigned*)((const char*)(gbase) + (voff)[_i]), (LAS unsigned*)(lds + (bufoff) + ldsw + _i * 8192), 16, 0, 0); } while (0)
#define PG8_LDA(dst, b, h) do { _Pragma("unroll") for (int m = 0; m < 4; ++m) _Pragma("unroll") for (int k = 0; k < 2; ++k) dst[m][k] = *(const LAS bf16x8*)(lds + PG8_SA(b, h) + aoff + m * 2048 + k * 1024); } while (0)
#define PG8_LDB(dst, b, h) do { _Pragma("unroll") for (int n = 0; n < 2; ++n) _Pragma("unroll") for (int k = 0; k < 2; ++k) dst[n][k] = *(const LAS bf16x8*)(lds + PG8_SB(b, h) + boff + n * 2048 + k * 1024); } while (0)
#define PG8_MMA(ai, bj, At, Bt) do { __builtin_amdgcn_s_setprio(1); _Pragma("unroll") for (int m = 0; m < 4; ++m) _Pragma("unroll") for (int n = 0; n < 2; ++n) _Pragma("unroll") for (int k = 0; k < 2; ++k) \
        acc[ai][bj][m][n] = __builtin_amdgcn_mfma_f32_16x16x32_bf16(Bt[n][k], At[m][k], acc[ai][bj][m][n], 0, 0, 0); __builtin_amdgcn_s_setprio(0); } while (0)
#define PG8_WAIT_V(n) asm volatile("s_waitcnt vmcnt(" #n ")" ::: "memory")
#define PG8_WAIT_L(n) asm volatile("s_waitcnt lgkmcnt(" #n ")" ::: "memory")
#define PG8_BAR __builtin_amdgcn_s_barrier()
#define PG8_SCHED __builtin_amdgcn_sched_barrier(0)
    Unit cur, nxt; int ui = 0;
    if (!S.next(0, cur)) return;
    f32x4 acc[2][2][4][2];
#pragma unroll
    for (int a = 0; a < 2; ++a)
#pragma unroll
        for (int b = 0; b < 2; ++b)
#pragma unroll
            for (int m = 0; m < 4; ++m)
#pragma unroll
                for (int n = 0; n < 2; ++n) acc[a][b][m][n] = (f32x4){0.f, 0.f, 0.f, 0.f};
    bf16x8 At[4][2], B0[2][2], B1[2][2];
    const char* cA = (const char*)g.A + (size_t)cur.pm * tstepA; const char* cB = (const char*)g.Bt + (size_t)cur.pn * tstepB;
    if constexpr (SP2) {
        PG8_STAGE(PG8_SB(0, 0), cB, voffB); PG8_STAGE(PG8_SB(0, 1), cB + hstepB, voffB); PG8_STAGE(PG8_SA(0, 0), cA, voffA); PG8_STAGE(PG8_SA(0, 1), cA + hstepA, voffA);
        if (wr == 1) PG8_BAR;
        PG8_WAIT_V(2); PG8_BAR;
        PG8_STAGE(PG8_SB(1, 0), cB + kstep, voffB); PG8_STAGE(PG8_SA(1, 0), cA + kstep, voffA); PG8_STAGE(PG8_SB(1, 1), cB + hstepB + kstep, voffB);
        PG8_WAIT_V(6); PG8_BAR;
    } else {
        PG8_STAGE(PG8_SB(0, 0), cB, voffB); PG8_STAGE(PG8_SA(0, 0), cA, voffA); PG8_STAGE(PG8_SB(0, 1), cB + hstepB, voffB); PG8_STAGE(PG8_SA(0, 1), cA + hstepA, voffA);
        if (wr == 1) PG8_BAR;
        PG8_WAIT_V(4); PG8_BAR;
        PG8_STAGE(PG8_SB(1, 0), cB + kstep, voffB); PG8_STAGE(PG8_SA(1, 0), cA + kstep, voffA); PG8_STAGE(PG8_SB(1, 1), cB + hstepB + kstep, voffB);
        PG8_WAIT_V(6); PG8_BAR;
    }
    for (;;) {
        const bool has_next = S.next(ui + 1, nxt);
        const char* nA = has_next ? (const char*)g.A + (size_t)nxt.pm * tstepA : cA; const char* nB = has_next ? (const char*)g.Bt + (size_t)nxt.pn * tstepB : cB;
        for (int t = 0; t < nt; t += 2) {
            const bool last = (t == nt - 2);
            const char* a1 = cA + (size_t)(t + 1) * kstep;
            const char* a2 = last ? nA : cA + (size_t)(t + 2) * kstep; const char* b2 = last ? nB : cB + (size_t)(t + 2) * kstep;
            const char* a3 = a2 + kstep; const char* b3 = b2 + kstep;
            if constexpr (SP2) {
            PG8_LDB(B0, 0, 0); PG8_LDB(B1, 0, 1); PG8_SCHED; PG8_LDA(At, 0, 0); PG8_STAGE(PG8_SA(1, 1), a1 + hstepA, voffA);
            PG8_WAIT_V(8); PG8_WAIT_L(0); PG8_BAR; PG8_MMA(0, 0, At, B0); PG8_MMA(0, 1, At, B1); PG8_BAR; PG8_SCHED;
            PG8_LDA(At, 0, 1); PG8_STAGE(PG8_SB(0, 0), b2, voffB); PG8_STAGE(PG8_SB(0, 1), b2 + hstepB, voffB); PG8_STAGE(PG8_SA(0, 0), a2, voffA);
            PG8_WAIT_V(8); PG8_WAIT_L(0); PG8_BAR; PG8_MMA(1, 0, At, B0); PG8_MMA(1, 1, At, B1); PG8_BAR; PG8_SCHED;
            PG8_LDB(B0, 1, 0); PG8_LDB(B1, 1, 1); PG8_SCHED; PG8_LDA(At, 1, 0); PG8_STAGE(PG8_SA(0, 1), a2 + hstepA, voffA);
            PG8_WAIT_V(8); PG8_WAIT_L(0); PG8_BAR; PG8_MMA(0, 0, At, B0); PG8_MMA(0, 1, At, B1); PG8_BAR; PG8_SCHED;
            PG8_LDA(At, 1, 1); PG8_STAGE(PG8_SB(1, 0), b3, voffB); PG8_STAGE(PG8_SB(1, 1), b3 + hstepB, voffB); PG8_STAGE(PG8_SA(1, 0), a3, voffA);
            PG8_WAIT_V(8); PG8_WAIT_L(0); PG8_BAR; PG8_MMA(1, 0, At, B0); PG8_MMA(1, 1, At, B1); PG8_BAR; PG8_SCHED;
            } else {
            PG8_LDB(B0, 0, 0); PG8_SCHED; PG8_LDA(At, 0, 0); PG8_STAGE(PG8_SA(1, 1), a1 + hstepA, voffA);
            PG8_WAIT_L(8); PG8_BAR; PG8_WAIT_L(0); PG8_MMA(0, 0, At, B0); PG8_BAR; PG8_SCHED;
            PG8_LDB(B1, 0, 1); PG8_STAGE(PG8_SB(0, 0), b2, voffB);
            PG8_BAR; PG8_WAIT_L(0); PG8_MMA(0, 1, At, B1); PG8_BAR;
            PG8_LDA(At, 0, 1); PG8_STAGE(PG8_SA(0, 0), a2, voffA);
            PG8_BAR; PG8_WAIT_L(0); PG8_MMA(1, 0, At, B0); PG8_BAR; PG8_SCHED;
            PG8_STAGE(PG8_SB(0, 1), b2 + hstepB, voffB);
            PG8_WAIT_V(6); PG8_BAR; PG8_MMA(1, 1, At, B1); PG8_BAR;
            PG8_LDB(B0, 1, 0); PG8_SCHED; PG8_LDA(At, 1, 0); PG8_STAGE(PG8_SA(0, 1), a2 + hstepA, voffA);
            PG8_WAIT_L(8); PG8_BAR; PG8_WAIT_L(0); PG8_MMA(0, 0, At, B0); PG8_BAR; PG8_SCHED;
            PG8_LDB(B1, 1, 1); PG8_STAGE(PG8_SB(1, 0), b3, voffB);
            PG8_BAR; PG8_WAIT_L(0); PG8_MMA(0, 1, At, B1); PG8_BAR;
            PG8_LDA(At, 1, 1); PG8_STAGE(PG8_SA(1, 0), a3, voffA);
            PG8_BAR; PG8_WAIT_L(0); PG8_MMA(1, 0, At, B0); PG8_BAR; PG8_SCHED;
            PG8_STAGE(PG8_SB(1, 1), b3 + hstepB, voffB);
            PG8_WAIT_V(6); PG8_BAR; PG8_MMA(1, 1, At, B1); PG8_BAR;
            }
        }
        if constexpr (ALIGN_EPI) { if (wr == 0) PG8_BAR; }
        E(acc, cur, wr, wc, fr, fq);
        if (!has_next) break;
#pragma unroll
        for (int a = 0; a < 2; ++a)
#pragma unroll
            for (int b = 0; b < 2; ++b)
#pragma unroll
                for (int m = 0; m < 4; ++m)
#pragma unroll
                    for (int n = 0; n < 2; ++n) acc[a][b][m][n] = (f32x4){0.f, 0.f, 0.f, 0.f};
        cur = nxt; cA = nA; cB = nB; ++ui;
        if constexpr (ALIGN_EPI) { if (wr == 1) PG8_BAR; }
    }
    PG8_WAIT_V(0);
    if constexpr (!ALIGN_EPI) { if (wr == 0) PG8_BAR; }
    PG8_BAR;
#undef PG8_SA
#undef PG8_SB
#undef PG8_STAGE
#undef PG8_LDA
#undef PG8_LDB
#undef PG8_MMA
#undef PG8_WAIT_V
#undef PG8_WAIT_L
#undef PG8_BAR
#undef PG8_SCHED
}
}

#define XB_TMO      128
#define XB_XCNT(j)  (256  + 64 * (j))
#define XB_XSUB(j)  (1280 + 64 * (j))
#define XB_XGEN(j)  (2304 + 64 * (j))
#define XB_TOP      3328
#define XB_TOPGEN   3392
#define XCD_BAR_WORDS 3456
#define XB_SPIN_CAP (1u << 18)
__device__ __forceinline__ unsigned xb_ld(unsigned* p)              { return __hip_atomic_load(p, __ATOMIC_RELAXED, __HIP_MEMORY_SCOPE_AGENT); }
__device__ __forceinline__ unsigned xb_add(unsigned* p, unsigned v) { return __hip_atomic_fetch_add(p, v, __ATOMIC_RELAXED, __HIP_MEMORY_SCOPE_AGENT); }
__device__ __forceinline__ unsigned xb_xcc_id() { return (unsigned)__builtin_amdgcn_s_getreg((3 << 11) | 20) & 0xFu; }
#define XB_SPIN(cond, bar) do { unsigned _sp = 0; while (cond) { __builtin_amdgcn_s_sleep(1); \
    if ((++_sp & 255u) == 0u) { if (xb_ld(&(bar)[XB_TMO])) break; if (_sp > XB_SPIN_CAP) { atomicAdd(&(bar)[XB_TMO], 1u); break; } } } } while (0)
struct XcdBarrier { unsigned* bar; unsigned x; volatile LAS unsigned* st; };
__device__ __forceinline__ XcdBarrier xcd_barrier_post(unsigned* bar, volatile LAS unsigned* st) {
    XcdBarrier b; b.bar = bar; b.x = xb_xcc_id(); b.st = st;
    if (threadIdx.x == 0) (void)xb_add(&bar[XB_XCNT(b.x)], 1u);
    return b;
}
__device__ __forceinline__ void xcd_barrier_complete(unsigned* bar, unsigned x, unsigned& nloc, unsigned& nx) {
    const unsigned G = gridDim.x * gridDim.y * gridDim.z;
    unsigned sum, cnt, mine, sp = 0u;
    for (;;) {
        sum = 0u; cnt = 0u; mine = 0u;
#pragma unroll
        for (unsigned j = 0; j < 16; ++j) { const unsigned c = xb_ld(&bar[XB_XCNT(j)]); sum += c; cnt += (c > 0u) ? 1u : 0u; mine = (j == x) ? c : mine; }
        if (sum == G) break;
        __builtin_amdgcn_s_sleep(1);
        if ((++sp & 255u) == 0u) { if (xb_ld(&bar[XB_TMO])) break; if (sp > XB_SPIN_CAP) { atomicAdd(&bar[XB_TMO], 1u); break; } }
    }
    nloc = mine > 0u ? mine : 1u; nx = cnt > 0u ? cnt : 1u;
}
__device__ __forceinline__ void xcd_barrier(const XcdBarrier& b, const int tid0) {
    asm volatile("s_waitcnt vmcnt(0)" ::: "memory");
    __syncthreads();
    if (tid0 == 0) {
        unsigned* bar = b.bar;
        __builtin_amdgcn_s_waitcnt(0);
        unsigned nloc = b.st[0], nx = b.st[1];
        if (nloc == 0u) { xcd_barrier_complete(bar, b.x, nloc, nx); b.st[0] = nloc; b.st[1] = nx; }
        const unsigned old = xb_add(&bar[XB_XSUB(b.x)], 1u);
        const unsigned gen = old / nloc;
        if (old + 1u == (gen + 1u) * nloc) {
            __builtin_amdgcn_fence(__ATOMIC_RELEASE, "agent");
            asm volatile("s_waitcnt vmcnt(0)" ::: "memory");
            const unsigned og = xb_add(&bar[XB_TOP], 1u);
            const unsigned tg = og / nx;
            if (og + 1u == (tg + 1u) * nx) xb_add(&bar[XB_TOPGEN], 1u);
            else XB_SPIN(xb_ld(&bar[XB_TOPGEN]) == tg, bar);
            __builtin_amdgcn_fence(__ATOMIC_ACQUIRE, "agent");
            xb_add(&bar[XB_XGEN(b.x)], 1u);
            asm volatile("s_waitcnt vmcnt(0)" ::: "memory");
        } else {
            XB_SPIN(xb_ld(&bar[XB_XGEN(b.x)]) == gen, bar);
            __builtin_amdgcn_fence(__ATOMIC_ACQUIRE, "agent");
            asm volatile("s_waitcnt vmcnt(0)" ::: "memory");
        }
    }
    __syncthreads();
}

constexpr int LDS_BYTES = 147456;
struct Params { const float* in[39]; float* out; unsigned char* ws; };

struct TrTile { const float* W; const float* gain; bf16_t* dst; int N, Npad, ldb, mode, k0, n0; };
__device__ __forceinline__ void tr_load(const TrTile& t, int tid, f32x4 (&v)[8], float (&gv)[8]) {
    const float* gp = t.gain ? t.gain : t.W;
#pragma unroll
    for (int i = 0; i < 8; ++i) { const int pp = tid + 512 * i, kk = pp >> 6, n = t.n0 + (pp & 63) * 4; const bool inb = n + 3 < t.N;
        v[i] = *(const f32x4*)(t.W + (size_t)(t.k0 + kk) * t.N + (inb ? n : 0)); gv[i] = gp[t.k0 + kk]; }
}
__device__ __forceinline__ void tr_to_lds(const TrTile& t, int tid, const f32x4 (&v)[8], const float (&gv)[8], LAS unsigned char* l) {
#pragma unroll
    for (int i = 0; i < 8; ++i) { const int pp = tid + 512 * i, kk = pp >> 6, n4 = (pp & 63) * 4; const bool inb = t.n0 + n4 + 3 < t.N;
        const float g = t.gain ? gv[i] : 1.f; const f32x4 x = inb ? v[i] * g : (f32x4){0.f, 0.f, 0.f, 0.f};
        u32x2 w; w.x = pk2(x[0], x[1]); w.y = pk2(x[2], x[3]); *(LAS u32x2*)(l + kk * 528 + n4 * 2) = w; }
}
__device__ __forceinline__ void tr_store(const TrTile& t, int tid, const LAS unsigned char* l) {
#pragma unroll
    for (int i = 0; i < 4; ++i) { const int pp = tid + 512 * i, n = pp >> 3, c = pp & 7; const int jn = t.n0 + n;
        if (jn < t.Npad) { const LAS bf16_t* s = (const LAS bf16_t*)(l + (8 * c) * 528) + n;
            const int drow = t.mode == 0 ? jn : ((jn >> 7) * 256 + (jn & 127) + (t.mode == 2 ? 128 : 0));
            u32x4 o; o.x = (unsigned)s[0] | ((unsigned)s[264] << 16); o.y = (unsigned)s[2 * 264] | ((unsigned)s[3 * 264] << 16); o.z = (unsigned)s[4 * 264] | ((unsigned)s[5 * 264] << 16); o.w = (unsigned)s[6 * 264] | ((unsigned)s[7 * 264] << 16);
            *(u32x4*)(t.dst + (size_t)drow * t.ldb + t.k0 + 8 * c) = o; } }
}

__global__ void __launch_bounds__(512, 2) mega(Params p) {
    extern __shared__ __attribute__((aligned(16))) unsigned char lds_raw[];
    LAS unsigned char* lds = (LAS unsigned char*)lds_raw;
    cg::grid_group grid = cg::this_grid();
    const int G = gridDim.x, bid = blockIdx.x;
#define PHASE_IDS int tid_o = threadIdx.x; asm volatile("" : "+v"(tid_o)); const int tid = tid_o, lane = tid & 63, wave = tid >> 6; (void)lane; (void)wave;
#define SS0 ((unsigned long long*)(p.ws + WS_SSQ))
#define SS1 (SS0 + M)
#define SS2 (SS0 + 2 * M)
#define SS3 (SS0 + 3 * M)
#define LBT ((float*)(p.ws + CTL_LB))
#define LBR ((float*)(p.ws + CTL_LBR))
#define LBI ((float*)(p.ws + CTL_LBI))
#define BBR ((float*)(p.ws + CTL_BBR))
#define BBI ((float*)(p.ws + CTL_BBI))
#define XB ((bf16_t*)(p.ws + WS_XB))
#define YC ((bf16_t*)(p.ws + WS_YC))
#define U ((bf16_t*)(p.ws + WS_U))
    { volatile LAS unsigned* st0 = (volatile LAS unsigned*)(lds + LDS_BYTES - 64); if (threadIdx.x < 16) st0[threadIdx.x] = 0u; }
    __syncthreads();
    (void)xcd_barrier_post((unsigned*)(p.ws + WS_CTL), (volatile LAS unsigned*)(lds + LDS_BYTES - 64));
#ifndef PROBE
#define PROBE 0
#endif
#ifndef PROBE_MASK
#define PROBE_MASK 0
#endif
#define STAMP(k) do { if (PROBE && bid == 0 && threadIdx.x == 0) ((unsigned long long*)(p.ws + CTL_TS))[k] = __builtin_amdgcn_s_memrealtime(); } while (0)
#define STAMP2(k, blk) do { if (PROBE && bid == (blk) && threadIdx.x == 0) ((unsigned long long*)(p.ws + CTL_TS))[k] = __builtin_amdgcn_s_memrealtime(); } while (0)
    STAMP(0);
#define GSYNC() do { XcdBarrier xb_; xb_.bar = (unsigned*)(p.ws + WS_CTL); xb_.x = xb_xcc_id(); xb_.st = (volatile LAS unsigned*)(lds + LDS_BYTES - 64); xcd_barrier(xb_, (int)threadIdx.x); } while (0)

    {
        PHASE_IDS
        constexpr int T_IN0 = 16 * 15, T_SQ = 16 * 4, T_GU = 16 * 11, T_DN = 44 * 4, T_IN1 = 16 * 14, T_GL = 4 * 1;
        constexpr int NT = T_IN0 + T_SQ + 2 * T_GU + T_DN + T_IN1 + T_SQ + 2 * T_GU + T_DN + T_GL;
#define P0_DECODE(T_, it_) { int r = (it_); const float* W; const float* gain; bf16_t* dst; int N, Npad, nNt, ldb, mode; \
            if (r < T_IN0) { W = p.in[4]; gain = p.in[1]; dst = (bf16_t*)(p.ws + WS_IN0); N = EVEN_IN; Npad = LDU0; nNt = 15; ldb = DM; mode = 0; } \
            else if ((r -= T_IN0) < T_SQ) { W = p.in[5]; gain = nullptr; dst = (bf16_t*)(p.ws + WS_OUT0); N = DM; Npad = DM; nNt = 4; ldb = DM; mode = 0; } \
            else if ((r -= T_SQ) < T_GU) { W = p.in[36]; gain = p.in[2]; dst = (bf16_t*)(p.ws + WS_GU0); N = FFN; Npad = FFN; nNt = 11; ldb = DM; mode = 1; } \
            else if ((r -= T_GU) < T_GU) { W = p.in[37]; gain = p.in[2]; dst = (bf16_t*)(p.ws + WS_GU0); N = FFN; Npad = FFN; nNt = 11; ldb = DM; mode = 2; } \
            else if ((r -= T_GU) < T_DN) { W = p.in[38]; gain = nullptr; dst = (bf16_t*)(p.ws + WS_D0); N = DM; Npad = DM; nNt = 4; ldb = FFN; mode = 0; } \
            else if ((r -= T_DN) < T_IN1) { W = p.in[19]; gain = p.in[1] + DM; dst = (bf16_t*)(p.ws + WS_IN1); N = ODD_IN; Npad = NP1; nNt = 14; ldb = DM; mode = 0; } \
            else if ((r -= T_IN1) < T_SQ) { W = p.in[20]; gain = nullptr; dst = (bf16_t*)(p.ws + WS_OUT1); N = DM; Npad = DM; nNt = 4; ldb = DM; mode = 0; } \
            else if ((r -= T_SQ) < T_GU) { W = p.in[36] + (size_t)DM * FFN; gain = p.in[2] + DM; dst = (bf16_t*)(p.ws + WS_GU1); N = FFN; Npad = FFN; nNt = 11; ldb = DM; mode = 1; } \
            else if ((r -= T_GU) < T_GU) { W = p.in[37] + (size_t)DM * FFN; gain = p.in[2] + DM; dst = (bf16_t*)(p.ws + WS_GU1); N = FFN; Npad = FFN; nNt = 11; ldb = DM; mode = 2; } \
            else if ((r -= T_GU) < T_DN) { W = p.in[38] + (size_t)FFN * DM; gain = nullptr; dst = (bf16_t*)(p.ws + WS_D1); N = DM; Npad = DM; nNt = 4; ldb = FFN; mode = 0; } \
            else { r -= T_DN; W = p.in[29]; gain = nullptr; dst = (bf16_t*)(p.ws + WS_GLU); N = 256; Npad = 256; nNt = 1; ldb = 256; mode = 0; } \
            T_.W = W; T_.gain = gain; T_.dst = dst; T_.N = N; T_.Npad = Npad; T_.ldb = ldb; T_.mode = mode; T_.k0 = (r / nNt) * 64; T_.n0 = (r % nNt) * 256; }
        if (bid < NT) {
            TrTile cur, nxt; f32x4 tv[8]; float tg[8];
            P0_DECODE(cur, bid); tr_load(cur, tid, tv, tg);
            for (int it = bid; it < NT; it += G) {
                const int itn = (it + G < NT) ? it + G : it; P0_DECODE(nxt, itn);
                __syncthreads();
                tr_to_lds(cur, tid, tv, tg, lds);
                tr_load(nxt, tid, tv, tg);
                __syncthreads();
                tr_store(cur, tid, lds);
                cur = nxt;
            }
        }
#undef P0_DECODE
        const float* x = p.in[0];
        for (int row = bid * 8 + wave; row < M; row += G * 16) {
            const int row2 = row + G * 8; const bool has2 = row2 < M;
            const f32x4* xr = (const f32x4*)(x + (size_t)row * DM) + lane; const f32x4* xr2 = (const f32x4*)(x + (size_t)(has2 ? row2 : row) * DM) + lane; f32x4 v[4], v2[4]; float s = 0.f, s2 = 0.f;
#pragma unroll
            for (int j = 0; j < 4; ++j) { v[j] = xr[64 * j]; v2[j] = xr2[64 * j]; }
#pragma unroll
            for (int j = 0; j < 4; ++j) { s += (v[j][0] * v[j][0] + v[j][1] * v[j][1]) + (v[j][2] * v[j][2] + v[j][3] * v[j][3]); s2 += (v2[j][0] * v2[j][0] + v2[j][1] * v2[j][1]) + (v2[j][2] * v2[j][2] + v2[j][3] * v2[j][3]); }
            s = wave_sum(s); s2 = wave_sum(s2); if (lane == 0) { SS0[row] = ss_fix(s); if (has2) SS0[row2] = ss_fix(s2); }
            u32x2* o = (u32x2*)(XB + (size_t)row * DM) + lane; u32x2* o2 = (u32x2*)(XB + (size_t)row2 * DM) + lane;
#pragma unroll
            for (int j = 0; j < 4; ++j) { u32x2 w; w.x = pk2(v[j][0], v[j][1]); w.y = pk2(v[j][2], v[j][3]); o[64 * j] = w; if (has2) { u32x2 w2; w2.x = pk2(v2[j][0], v2[j][1]); w2.y = pk2(v2[j][2], v2[j][3]); o2[64 * j] = w2; } }
        }
        for (int i = bid * 512 + tid; i < 3 * M; i += G * 512) SS1[i] = 0ull;
        for (int i = bid * 512 + tid; i < 512 * 160; i += G * 512) { const int c = i / 160, k = i % 160;
            const float v = (k < 32) ? p.in[10][k * 512 + c] : (k < 64) ? p.in[12][(k - 32) * 512 + c] : p.in[13][(k - 64) * 512 + c]; ((bf16_t*)(p.ws + WS_LORA))[i] = f2bf(v); }
        { const int gt = bid * 512 + tid;
          if (gt < 512) { const float* lt = p.in[6]; const float l0 = lt[gt], l1 = lt[512 + gt], l2 = lt[1024 + gt]; const float mx = fmaxf(l0, fmaxf(l1, l2));
              const float e0 = expf(l0 - mx), e1 = expf(l1 - mx), e2 = expf(l2 - mx); LBT[gt] = e0 / (e0 + e1 + e2); }
          const int i = gt - 512;
          if (i >= 0 && i < 16384) { const int gp = i >> 4, h = i & 15, g = gp >> 6; const float step = expf(p.in[23][g]); const float lr = p.in[21][gp], li = p.in[22][gp];
              const float mag = expf(lr * step); const float br = mag * cosf(li * step), bi = mag * sinf(li * step);
              if (h == 0) { LBR[gp] = br; LBI[gp] = bi; }
              const float den = lr * lr + li * li, nr = br - 1.f, ni = bi; const float cr = (nr * lr + ni * li) / den, ci = (ni * lr - nr * li) / den;
              const float xr2 = p.in[24][gp * 16 + h], xi2 = p.in[25][gp * 16 + h]; BBR[gp * 16 + h] = cr * xr2 - ci * xi2; BBI[gp * 16 + h] = cr * xi2 + ci * xr2; } }
    }
    grid.sync();
    STAMP(1);

    { pg8::Gemm g{XB, (const bf16_t*)(p.ws + WS_IN0), DM, DM, M, LDU0, DM}; pg8::StaticOrder S; S.init(M, LDU0, G, bid);
      pg8::EpiScaleBf16 E{U, LDU0, SS0}; pg8::gemm_phase<pg8::EpiScaleBf16, pg8::StaticOrder, true, true>(lds, g, S, E); }
    GSYNC();
    STAMP(2);

#define Rt ((bf16_t*)p.out)
#define At (Rt + (size_t)M * 512)
#define Bh (Rt + (size_t)M * 1024)
#define Kh (Rt + (size_t)M * 1536)
#define Vv XB
#define BVG (XB + (size_t)M * 512)
#define Gg ((bf16_t*)(p.ws + WS_MS))
#define GLc ((float*)(p.ws + WS_MS + 32 * MiB))
#define HEM ((float*)(p.ws + WS_MS + 64 * MiB))
#define HEL ((float*)(p.ws + WS_MS + 65 * MiB))
#define HELM ((float*)(p.ws + WS_MS + 66 * MiB))

    {
        PHASE_IDS
        const int hd = __builtin_amdgcn_readfirstlane(tid >> 6), fr = lane & 15, fq = lane >> 4;
        constexpr int SLS = 336;
        const bf16_t* LT = (const bf16_t*)(p.ws + WS_LORA);
        float mu_r[4], mu_k[4], mu_v[4], w0c[4], a0c[4], kkc[4], kac[4], rkc[4];
#pragma unroll
        for (int nt = 0; nt < 4; ++nt) { const int c = hd * 64 + 4 * fr + nt; mu_r[nt] = p.in[8][c]; mu_k[nt] = p.in[8][512 + c]; mu_v[nt] = p.in[8][1024 + c];
            w0c[nt] = p.in[9][c]; a0c[nt] = p.in[11][c]; kkc[nt] = p.in[14][c]; kac[nt] = p.in[15][c]; rkc[nt] = p.in[16][c]; }
        bf16_t sa_c[5], sa_p[5];
        const unsigned char* zsrc = p.ws + WS_CTL + 128 * 1024;
#define P2_FETCH(cidx_, RAWn_) { const int m0_ = (cidx_) * 16; const bool sq_ = (m0_ & (SEQ - 1)) == 0; \
            _Pragma("unroll") for (int i_ = 0; i_ < 5; ++i_) { const int id_ = tid + 512 * i_, t_ = id_ / 160, j_ = id_ % 160; const bf16_t* ur_ = U + (size_t)(m0_ + t_) * LDU0 + 3584 + j_; sa_c[i_] = ur_[0]; sa_p[i_] = ur_[-LDU0]; } \
            _Pragma("unroll") for (int i_ = 0; i_ < 7; ++i_) { const int q_ = hd + 8 * i_; if (q_ < 51) { const int row_ = q_ / 3, th_ = q_ % 3; \
                const unsigned char* g_ = (row_ == 0 && sq_) ? zsrc + th_ * 1024 + lane * 16 : (const unsigned char*)(U + ((size_t)m0_ + row_) * LDU0 - LDU0 + 2048 + th_ * 512 + lane * 8); \
                __builtin_amdgcn_global_load_lds((const unsigned*)g_, (LAS unsigned*)((RAWn_) + row_ * 3088 + th_ * 1024), 16, 0, 0); } } }
        P2_FETCH(bid, lds + 12288);
        int it = 0;
        for (int cidx = bid; cidx < M / 16; cidx += G, ++it) {
            const int m0 = cidx * 16; const bool seq0 = (m0 & (SEQ - 1)) == 0;
            LAS unsigned char* SL = lds + (it & 1) * (16 * SLS);
            LAS unsigned char* RAW = lds + 12288 + (it & 1) * 52496;
            bf16x8 ltf[4][5];
#pragma unroll
            for (int nt = 0; nt < 4; ++nt) { const bf16_t* lr = LT + (size_t)(hd * 64 + 4 * fr + nt) * 160 + 8 * fq;
#pragma unroll
                for (int q = 0; q < 5; ++q) ltf[nt][q] = *(const bf16x8*)(lr + 32 * q); }
#pragma unroll
            for (int i = 0; i < 5; ++i) { const int id = tid + 512 * i, t = id / 160, j = id % 160;
                const float cur = bf2f(sa_c[i]); const float prev = (t == 0 && seq0) ? 0.f : bf2f(sa_p[i]); const float v = cur + (prev - cur) * p.in[8][1536 + j];
                *(LAS bf16_t*)(SL + t * SLS + j * 2) = f2bf((j < 32) ? tanhf_(v) : (j < 64 ? v : sigmoidf_(v))); }
            asm volatile("s_waitcnt vmcnt(0)" ::: "memory");
            __syncthreads();
            f32x4 dw[4], da[4], dg[4];
            { bf16x8 sf[5];
#pragma unroll
              for (int kk = 0; kk < 5; ++kk) sf[kk] = *(const LAS bf16x8*)(SL + fr * SLS + (kk * 32 + 8 * fq) * 2);
              const f32x4 z4 = {0.f, 0.f, 0.f, 0.f};
#pragma unroll
              for (int nt = 0; nt < 4; ++nt) { const bf16x8 wf = ltf[nt][0], af = ltf[nt][1], g0 = ltf[nt][2], g1 = ltf[nt][3], g2 = ltf[nt][4];
                  dw[nt] = __builtin_amdgcn_mfma_f32_16x16x32_bf16(sf[0], wf, z4, 0, 0, 0); da[nt] = __builtin_amdgcn_mfma_f32_16x16x32_bf16(sf[1], af, z4, 0, 0, 0);
                  f32x4 g = __builtin_amdgcn_mfma_f32_16x16x32_bf16(sf[2], g0, z4, 0, 0, 0); g = __builtin_amdgcn_mfma_f32_16x16x32_bf16(sf[3], g1, g, 0, 0, 0); dg[nt] = __builtin_amdgcn_mfma_f32_16x16x32_bf16(sf[4], g2, g, 0, 0, 0); } }
            { const int cn = (cidx + G < M / 16) ? cidx + G : cidx; P2_FETCH(cn, lds + 12288 + ((it + 1) & 1) * 52496); }
            float as_[4][4], wd_[4][4];
            float ssq[4] = {0.f, 0.f, 0.f, 0.f}, bon[4] = {0.f, 0.f, 0.f, 0.f};
#pragma unroll
            for (int nt = 0; nt < 4; ++nt)
#pragma unroll
                for (int r = 0; r < 4; ++r) { const LAS bf16_t* rw = (const LAS bf16_t*)(RAW + (4 * fq + r) * 3088) + hd * 64 + 4 * fr + nt;
                    const float c0 = bf2f(rw[1544]), c1 = bf2f(rw[1544 + 512]);
                    const float p0 = bf2f(rw[0]), p1 = bf2f(rw[512]);
                    const float rv = c0 + (p0 - c0) * mu_r[nt], kv = c1 + (p1 - c1) * mu_k[nt];
                    const float wlog = -softplusf_(-(w0c[nt] + dw[nt][r])) - 0.5f;
                    wd_[nt][r] = __expf(-__expf(wlog));
                    const float a = sigmoidf_(a0c[nt] + da[nt][r]); as_[nt][r] = a;
                    const float kkv = kv * kkc[nt]; ssq[r] = fmaf(kkv, kkv, ssq[r]);
                    bon[r] = fmaf(rv * kv * (1.f + (a - 1.f) * kac[nt]), rkc[nt], bon[r]); }
#pragma unroll
            for (int r = 0; r < 4; ++r) { ssq[r] = 1.0f / fmaxf(sqrtf(row_sum16(ssq[r])), 1e-12f); bon[r] = row_sum16(bon[r]); }
            float gam[4][5];
#pragma unroll
            for (int nt = 0; nt < 4; ++nt) {
                const float q1 = wd_[nt][0], q2 = q1 * wd_[nt][1], q3 = q2 * wd_[nt][2], q4 = q3 * wd_[nt][3];
                const float t0 = __shfl(q4, fr), t1 = __shfl(q4, fr + 16), t2 = __shfl(q4, fr + 32);
                const float pre = (fq == 0) ? 1.f : (fq == 1) ? t0 : (fq == 2) ? t0 * t1 : t0 * t1 * t2;
                gam[nt][0] = pre; gam[nt][1] = pre * q1; gam[nt][2] = pre * q2; gam[nt][3] = pre * q3; gam[nt][4] = pre * q4; }
#pragma unroll
            for (int r = 0; r < 4; ++r) { const size_t o = (size_t)(m0 + 4 * fq + r) * 512 + hd * 64 + 4 * fr; const LAS bf16_t* rw = (const LAS bf16_t*)(RAW + (4 * fq + r) * 3088) + hd * 64 + 4 * fr;
                float oa[4], orr[4], ob[4], okk[4], ov[4], og[4], obv[4];
#pragma unroll
                for (int nt = 0; nt < 4; ++nt) {
                    const float c0 = bf2f(rw[1544 + nt]), c1 = bf2f(rw[1544 + 512 + nt]), c2 = bf2f(rw[1544 + 1024 + nt]);
                    const float p0 = bf2f(rw[nt]), p1 = bf2f(rw[512 + nt]), p2 = bf2f(rw[1024 + nt]);
                    const float rv = c0 + (p0 - c0) * mu_r[nt], kv = c1 + (p1 - c1) * mu_k[nt], vv = c2 + (p2 - c2) * mu_v[nt];
                    const float a = as_[nt][r], kk = kv * kkc[nt] * ssq[r], kp = kv * (1.f + (a - 1.f) * kac[nt]), ig = __builtin_amdgcn_rcpf(gam[nt][r + 1]), g = dg[nt][r];
                    oa[nt] = -kk * gam[nt][r]; orr[nt] = rv * gam[nt][r + 1]; ob[nt] = kk * a * ig; okk[nt] = kp * ig; ov[nt] = vv; og[nt] = g; obv[nt] = bon[r] * vv * g; }
                u32x2 w;
                w.x = pk2(oa[0], oa[1]); w.y = pk2(oa[2], oa[3]); *(u32x2*)(At + o) = w;
                w.x = pk2(orr[0], orr[1]); w.y = pk2(orr[2], orr[3]); *(u32x2*)(Rt + o) = w;
                w.x = pk2(ob[0], ob[1]); w.y = pk2(ob[2], ob[3]); *(u32x2*)(Bh + o) = w;
                w.x = pk2(okk[0], okk[1]); w.y = pk2(okk[2], okk[3]); *(u32x2*)(Kh + o) = w;
                w.x = pk2(ov[0], ov[1]); w.y = pk2(ov[2], ov[3]); *(u32x2*)(Vv + o) = w;
                w.x = pk2(og[0], og[1]); w.y = pk2(og[2], og[3]); *(u32x2*)(Gg + o) = w;
                w.x = pk2(obv[0], obv[1]); w.y = pk2(obv[2], obv[3]); *(u32x2*)(BVG + o) = w; }
            if (fq == 3) *(f32x4*)(GLc + (size_t)cidx * 512 + hd * 64 + 4 * fr) = (f32x4){gam[0][4], gam[1][4], gam[2][4], gam[3][4]};
        }
#undef P2_FETCH
        STAMP2(20, 0);
#define HP_ROW(it_) (U + ((size_t)((it_) >> 6) * 64 + lane) * LDU0 + (((it_) >> 4) & 3) * 128 + ((it_) & 15) * 8)
#define HP_LB(it_) (LBT + (((it_) >> 4) & 3) * 128 + ((it_) & 15) * 8)
        u32x4 wq_n, wf_n; f32x4 lb_n0, lb_n1;
        { const bf16_t* r0 = HP_ROW(bid * 8 + wave); wq_n = *(const u32x4*)r0; wf_n = *(const u32x4*)(r0 + 512); const float* l0 = HP_LB(bid * 8 + wave); lb_n0 = *(const f32x4*)l0; lb_n1 = *(const f32x4*)(l0 + 4); }
        for (int it = bid * 8 + wave; it < (M / 64) * 64; it += G * 8) {
            const int ch = it >> 6, hh = (it >> 4) & 3, cg = it & 15; const int c0 = hh * 128 + cg * 8;
            bf16_t* r = HP_ROW(it);
            const u32x4 wq = wq_n, wf = wf_n; const float lbv[8] = {lb_n0[0], lb_n0[1], lb_n0[2], lb_n0[3], lb_n1[0], lb_n1[1], lb_n1[2], lb_n1[3]};
            { const int itn = (it + G * 8 < (M / 64) * 64) ? it + G * 8 : it; const bf16_t* rn = HP_ROW(itn); wq_n = *(const u32x4*)rn; wf_n = *(const u32x4*)(rn + 512); const float* ln = HP_LB(itn); lb_n0 = *(const f32x4*)ln; lb_n1 = *(const f32x4*)(ln + 4); }
            const unsigned wqa[4] = {wq.x, wq.y, wq.z, wq.w}, wfa[4] = {wf.x, wf.y, wf.z, wf.w};
            unsigned oq[4], ok[4];
#pragma unroll
            for (int j = 0; j < 8; ++j) { const float aq = (j & 1) ? bfhi(wqa[j >> 1]) : bflo(wqa[j >> 1]), af = (j & 1) ? bfhi(wfa[j >> 1]) : bflo(wfa[j >> 1]);
                const float kv = (1.f - lbv[j]) * sigmoidf_(-af);
                float bs = __logf(1.f - kv);
                bs += __int_as_float(__builtin_amdgcn_update_dpp(0, __float_as_int(bs), 0x111, 0xf, 0xf, true)); bs += __int_as_float(__builtin_amdgcn_update_dpp(0, __float_as_int(bs), 0x112, 0xf, 0xf, true));
                bs += __int_as_float(__builtin_amdgcn_update_dpp(0, __float_as_int(bs), 0x114, 0xf, 0xf, true)); bs += __int_as_float(__builtin_amdgcn_update_dpp(0, __float_as_int(bs), 0x118, 0xf, 0xf, true));
                bs += __int_as_float(__builtin_amdgcn_update_dpp(0, __float_as_int(bs), 0x142, 0xa, 0xf, false)); bs += __int_as_float(__builtin_amdgcn_update_dpp(0, __float_as_int(bs), 0x143, 0xc, 0xf, false));
                const float bm = __int_as_float(__builtin_amdgcn_readlane(__float_as_int(bs), 31)), bL = __int_as_float(__builtin_amdgcn_readlane(__float_as_int(bs), 63));
                const float qt = siluf_(aq) * __expf(bs - bm), kt = kv * __expf(bm - bs);
                if (j & 1) { oq[j >> 1] = pk2(__uint_as_float(oq[j >> 1]), qt); ok[j >> 1] = pk2(__uint_as_float(ok[j >> 1]), kt); } else { oq[j >> 1] = __float_as_uint(qt); ok[j >> 1] = __float_as_uint(kt); }
                if (lane == 0) { const size_t vo = (size_t)ch * 512 + c0 + j; HEM[vo] = __expf(bm); HEL[vo] = __expf(bL); HELM[vo] = __expf(bL - bm); } }
            u32x4 w; w.x = oq[0]; w.y = oq[1]; w.z = oq[2]; w.w = oq[3]; *(u32x4*)r = w;
            w.x = ok[0]; w.y = ok[1]; w.z = ok[2]; w.w = ok[3]; *(u32x4*)(r + 512) = w;
        }
#undef HP_ROW
#undef HP_LB
    }
    GSYNC();
    STAMP(3);

    for (int item = bid; item < 256; item += G) {
        PHASE_IDS
        const int w = __builtin_amdgcn_readfirstlane(tid >> 6), fr = lane & 15, fq = lane >> 4;
        const int vt = item & 3, h = (item >> 2) & 7, b = item >> 5;
        constexpr int BUF = 20992, oRt = 0, oAt = 2304, oBh = 4608, oKh = 6912, oBT = 9216, oKT = 14336, oVT = 19456, oGL = 20736;
        constexpr int oMS = 4 * BUF, MSET = 3840, oAf = oMS + 3 * MSET, oTT = oAf + 2 * 1024, oWT = oTT + 2 * 1280, oUT = oWT + 1280, oST = oUT + 1280, LTOT = oST + 2304;
        constexpr int NCH = SEQ / 16;
        LAS unsigned char* L = lds;
        __syncthreads();
        for (int i = tid; i < LTOT / 4; i += 512) ((LAS unsigned*)L)[i] = 0u;
        __syncthreads();
        const size_t tok0 = (size_t)b * SEQ; const size_t colb = (size_t)h * 64;
#define RC_F144(B_, off_, kk_) (*(const LAS bf16x8*)((B_) + (off_) + fr * 144 + ((kk_) * 32 + 8 * fq) * 2))
#define RC_F80(base_, row0_) (*(const LAS bf16x8*)((base_) + ((row0_) + fr) * 80 + (8 * fq) * 2))
        if (w >= 3) {
            const int lt = tid - 192;
            const bf16_t* arr[4] = {Rt, At, Bh, Kh};
            const int q0 = lt, q1 = lt + 320;
            const int kind1 = (q1 < 512) ? 0 : (q1 < 544) ? 1 : (q1 < 560) ? 2 : 3;
            const char* gp0 = (const char*)(arr[q0 >> 7] + (tok0 + ((q0 >> 3) & 15)) * 512 + colb + (q0 & 7) * 8);
            const char* gp1 = kind1 == 0 ? (const char*)(arr[(q1 >> 7) & 3] + (tok0 + ((q1 >> 3) & 15)) * 512 + colb + (q1 & 7) * 8)
                            : kind1 == 1 ? (const char*)(Vv + (tok0 + ((q1 - 512) >> 1)) * 512 + colb + vt * 16 + ((q1 - 512) & 1) * 8)
                            : kind1 == 2 ? (const char*)(GLc + ((size_t)b * NCH) * 512 + colb + (q1 - 544) * 4) : gp0;
            const size_t st1 = (kind1 == 2) ? (size_t)512 * 4 : (size_t)16 * 512 * 2;
            u32x4 d0[2], d1[2], d2[2], d3[2];
#define RP_H(w_, j_) ((bf16_t)(((j_) & 1) ? ((w_) >> 16) : ((w_) & 0xffffu)))
#define RP_FETCH(D_, c_) { const size_t cc_ = (size_t)((c_) < NCH ? (c_) : NCH - 1); D_[0] = *(const u32x4*)(gp0 + cc_ * (size_t)(16 * 512 * 2)); D_[1] = *(const u32x4*)(gp1 + cc_ * st1); }
#define RP_TILE(B_, q_, D_) { const int tl_ = (q_) >> 7, t_ = ((q_) >> 3) & 15, k_ = ((q_) & 7) * 8; const unsigned w4_[4] = {D_.x, D_.y, D_.z, D_.w}; *(LAS u32x4*)((B_) + tl_ * 2304 + t_ * 144 + k_ * 2) = D_; \
                if (tl_ >= 2) { LAS bf16_t* x_ = (LAS bf16_t*)((B_) + (tl_ == 2 ? oBT : oKT) + k_ * 80 + t_ * 2); const int g_ = (q_) & 7; \
                    _Pragma("unroll") for (int j_ = 0; j_ < 8; ++j_) { const int jj_ = (j_ + g_) & 7; const unsigned ww_ = (jj_ >> 1) == 0 ? w4_[0] : (jj_ >> 1) == 1 ? w4_[1] : (jj_ >> 1) == 2 ? w4_[2] : w4_[3]; x_[jj_ * 40] = (bf16_t)(ww_ >> ((jj_ & 1) * 16)); } } }
#define RP_STORE(D_, buf_) { LAS unsigned char* B_ = L + (buf_) * BUF; RP_TILE(B_, q0, D_[0]); \
                if (kind1 == 0) { RP_TILE(B_, q1, D_[1]); } \
                else if (kind1 == 1) { const int vq_ = q1 - 512; const unsigned w4_[4] = {D_[1].x, D_[1].y, D_[1].z, D_[1].w}; LAS bf16_t* x_ = (LAS bf16_t*)(B_ + oVT + ((vq_ & 1) * 8) * 80 + (vq_ >> 1) * 2); _Pragma("unroll") for (int j_ = 0; j_ < 8; ++j_) x_[j_ * 40] = RP_H(w4_[j_ >> 1], j_); } \
                else if (kind1 == 2) *(LAS u32x4*)(B_ + oGL + (q1 - 544) * 16) = D_[1]; }
            RP_FETCH(d0, 0); RP_STORE(d0, 0); RP_FETCH(d0, 1); RP_STORE(d0, 1); RP_FETCH(d0, 2); RP_STORE(d0, 2);
            RP_FETCH(d3, 3); RP_FETCH(d0, 4); RP_FETCH(d1, 5); RP_FETCH(d2, 6);
            LBAR(); LBAR(); LBAR();
            for (int i = 0; i < NCH; i += 4) {
                if (i + 3 < NCH) RP_STORE(d3, (i + 3) & 3);
                RP_FETCH(d3, i + 7);
                LBAR();
                if (i + 4 < NCH) RP_STORE(d0, (i + 4) & 3);
                RP_FETCH(d0, i + 8);
                LBAR();
                if (i + 5 < NCH) RP_STORE(d1, (i + 5) & 3);
                RP_FETCH(d1, i + 9);
                LBAR();
                if (i + 6 < NCH) RP_STORE(d2, (i + 6) & 3);
                RP_FETCH(d2, i + 10);
                LBAR();
            }
#undef RP_TILE
#undef RP_FETCH
#undef RP_H
#undef RP_STORE
        } else if (w == 1) {
            auto amats = [&](int cc) {
                const LAS unsigned char* B_ = L + (cc & 3) * BUF; LAS unsigned char* Ms = L + oMS + (cc % 3) * MSET; LAS unsigned char* Af = L + oAf + (cc & 1) * 1024;
                const bf16x8 a0 = RC_F144(B_, oAt, 0), a1 = RC_F144(B_, oAt, 1), r0 = RC_F144(B_, oRt, 0), r1 = RC_F144(B_, oRt, 1), b0 = RC_F144(B_, oBh, 0), b1 = RC_F144(B_, oBh, 1), k0 = RC_F144(B_, oKh, 0), k1 = RC_F144(B_, oKh, 1);
                const f32x4 z4 = {0.f, 0.f, 0.f, 0.f};
                f32x4 dab = __builtin_amdgcn_mfma_f32_16x16x32_bf16(a0, b0, z4, 0, 0, 0); dab = __builtin_amdgcn_mfma_f32_16x16x32_bf16(a1, b1, dab, 0, 0, 0);
                f32x4 dak = __builtin_amdgcn_mfma_f32_16x16x32_bf16(a0, k0, z4, 0, 0, 0); dak = __builtin_amdgcn_mfma_f32_16x16x32_bf16(a1, k1, dak, 0, 0, 0);
                f32x4 drb = __builtin_amdgcn_mfma_f32_16x16x32_bf16(r0, b0, z4, 0, 0, 0); drb = __builtin_amdgcn_mfma_f32_16x16x32_bf16(r1, b1, drb, 0, 0, 0);
                f32x4 drk = __builtin_amdgcn_mfma_f32_16x16x32_bf16(r0, k0, z4, 0, 0, 0); drk = __builtin_amdgcn_mfma_f32_16x16x32_bf16(r1, k1, drk, 0, 0, 0);
#pragma unroll
                for (int r = 0; r < 4; ++r) { const int t = 4 * fq + r; const bool st = fr < t, le = fr <= t;
                    *(LAS float*)(Af + t * 64 + fr * 4) = st ? dab[r] : 0.f;
                    *(LAS bf16_t*)(Ms + t * 80 + fr * 2) = f2bf(st ? dak[r] : 0.f);
                    *(LAS bf16_t*)(Ms + 1280 + t * 80 + fr * 2) = f2bf(le ? drb[r] : 0.f);
                    *(LAS bf16_t*)(Ms + 2560 + t * 80 + fr * 2) = f2bf(le ? drk[r] : 0.f); } };
            LBAR();
            amats(0);
            LBAR();
            amats(1);
            LBAR();
            for (int i = 0; i < NCH; ++i) { if (i + 2 < NCH) amats(i + 2); LBAR(); }
        } else if (w == 2) {
            auto tinv = [&](int cc) {
                const LAS unsigned char* Af = L + oAf + (cc & 1) * 1024; LAS unsigned char* Tt = L + oTT + (cc & 1) * 1280;
                f32x4 am[16][4];
#pragma unroll
                for (int t = 1; t < 16; ++t)
#pragma unroll
                    for (int sq = 0; sq < 4; ++sq) if (4 * sq < t) am[t][sq] = *(const LAS f32x4*)(Af + t * 64 + sq * 16);
                asm volatile("s_waitcnt lgkmcnt(0)" ::: "memory");
                float x[16];
#pragma unroll
                for (int t = 0; t < 16; ++t) {
                    float acc0 = (t == fr) ? 1.f : 0.f, acc1 = 0.f;
#pragma unroll
                    for (int sq = 0; sq < 4; ++sq) { if (4 * sq < t) {
#pragma unroll
                        for (int e = 0; e < 4; ++e) { const int s = 4 * sq + e; if (s < t) { if (s & 1) acc1 = fmaf(am[t][sq][e], x[s], acc1); else acc0 = fmaf(am[t][sq][e], x[s], acc0); } } } }
                    x[t] = acc0 + acc1; }
                if (fq == 0) {
#pragma unroll
                    for (int t = 0; t < 16; ++t) *(LAS bf16_t*)(Tt + t * 80 + fr * 2) = f2bf(x[t]); } };
            LBAR(); LBAR();
            tinv(0);
            LBAR();
            for (int i = 0; i < NCH; ++i) { if (i + 1 < NCH) tinv(i + 1); LBAR(); }
        } else {
            f32x4 Sacc[4];
#pragma unroll
            for (int kt = 0; kt < 4; ++kt) Sacc[kt] = (f32x4){0.f, 0.f, 0.f, 0.f};
            bf16_t* yg = Vv + tok0 * 512 + colb + vt * 16 + fr;
            LBAR(); LBAR(); LBAR();
            for (int i = 0; i < NCH; ++i) {
                const LAS unsigned char* B_ = L + (i & 3) * BUF; const LAS unsigned char* Ms = L + oMS + (i % 3) * MSET; const LAS unsigned char* Tt = L + oTT + (i & 1) * 1280;
                const bf16x8 a0 = RC_F144(B_, oAt, 0), a1 = RC_F144(B_, oAt, 1), r0 = RC_F144(B_, oRt, 0), r1 = RC_F144(B_, oRt, 1);
                const bf16x8 s0 = *(const LAS bf16x8*)(L + oST + fr * 144 + (8 * fq) * 2), s1 = *(const LAS bf16x8*)(L + oST + fr * 144 + (32 + 8 * fq) * 2);
                const bf16x8 vtf = RC_F80(B_ + oVT, 0), makf = RC_F80(Ms, 0), mrbf = RC_F80(Ms + 1280, 0), mrkf = RC_F80(Ms + 2560, 0), ttf = RC_F80(Tt, 0);
                bf16x8 btf[4], ktf[4]; f32x4 glv[4];
#pragma unroll
                for (int kt = 0; kt < 4; ++kt) { btf[kt] = RC_F80(B_ + oBT, kt * 16); ktf[kt] = RC_F80(B_ + oKT, kt * 16); glv[kt] = *(const LAS f32x4*)(B_ + oGL + (kt * 16 + 4 * fq) * 4); }
                asm volatile("s_waitcnt lgkmcnt(0)" ::: "memory");
                const f32x4 z4 = {0.f, 0.f, 0.f, 0.f};
                f32x4 dw = __builtin_amdgcn_mfma_f32_16x16x32_bf16(a0, s0, z4, 0, 0, 0); dw = __builtin_amdgcn_mfma_f32_16x16x32_bf16(a1, s1, dw, 0, 0, 0);
                dw = __builtin_amdgcn_mfma_f32_16x16x32_bf16(makf, vtf, dw, 0, 0, 0);
                f32x4 dy = __builtin_amdgcn_mfma_f32_16x16x32_bf16(r0, s0, z4, 0, 0, 0); dy = __builtin_amdgcn_mfma_f32_16x16x32_bf16(r1, s1, dy, 0, 0, 0);
                dy = __builtin_amdgcn_mfma_f32_16x16x32_bf16(mrkf, vtf, dy, 0, 0, 0);
                { u32x2 ww; ww.x = pk2(dw[0], dw[1]); ww.y = pk2(dw[2], dw[3]); *(LAS u32x2*)(L + oWT + fr * 80 + (4 * fq) * 2) = ww; }
                f32x4 sk[4];
#pragma unroll
                for (int kt = 0; kt < 4; ++kt) sk[kt] = __builtin_amdgcn_mfma_f32_16x16x32_bf16(ktf[kt], vtf, Sacc[kt], 0, 0, 0);
                f32x4 du = __builtin_amdgcn_mfma_f32_16x16x32_bf16(ttf, RC_F80(L + oWT, 0), z4, 0, 0, 0);
                { u32x2 uw; uw.x = pk2(du[0], du[1]); uw.y = pk2(du[2], du[3]); *(LAS u32x2*)(L + oUT + fr * 80 + (4 * fq) * 2) = uw; }
                const bf16x8 utf = RC_F80(L + oUT, 0);
                dy = __builtin_amdgcn_mfma_f32_16x16x32_bf16(mrbf, utf, dy, 0, 0, 0);
#pragma unroll
                for (int kt = 0; kt < 4; ++kt) {
                    f32x4 sa = __builtin_amdgcn_mfma_f32_16x16x32_bf16(btf[kt], utf, sk[kt], 0, 0, 0);
                    sa = sa * glv[kt]; Sacc[kt] = sa;
                    u32x2 sw; sw.x = pk2(sa[0], sa[1]); sw.y = pk2(sa[2], sa[3]); *(LAS u32x2*)(L + oST + fr * 144 + (kt * 16 + 4 * fq) * 2) = sw; }
                { bf16_t* yo = yg + (size_t)(i * 16 + 4 * fq) * 512; yo[0] = f2bf(dy[0]); yo[512] = f2bf(dy[1]); yo[1024] = f2bf(dy[2]); yo[1536] = f2bf(dy[3]); }
                LBAR();
            }
        }
#undef RC_F144
#undef RC_F80
    }
    STAMP(17);
    for (int item = bid; item < 256; item += G) {
        PHASE_IDS
        const int w = __builtin_amdgcn_readfirstlane(tid >> 6), fr = lane & 15, fq = lane >> 4;
        const int vs = item & 7, h = (item >> 3) & 3, b = item >> 5;
        constexpr int QS = 272, TS = 144;
        constexpr int oQ = 0, oK = 17408, oKT = 34816, oVT = 53248, oP = 55552, oCT = 64768, oV = 69120;
        LAS unsigned char* L = lds;
        const size_t tok0 = (size_t)b * SEQ;
        int prow[2], pc8[2];
#pragma unroll
        for (int i = 0; i < 2; ++i) { const int pp = tid + 512 * i; prow[i] = pp >> 4; pc8[i] = (pp & 15) * 8; }
        const int vrow = tid & 63, vpart = (tid >> 6) & 1;
        u32x4 qa[2], ka[2], va = {0u, 0u, 0u, 0u}; float vem = 0.f, vel = 0.f, velm = 0.f;
#define HM_FETCH(c_) { const size_t tb_ = tok0 + (size_t)(c_) * 64; _Pragma("unroll") for (int i_ = 0; i_ < 2; ++i_) { const bf16_t* r_ = U + (tb_ + prow[i_]) * LDU0 + h * 128 + pc8[i_]; qa[i_] = *(const u32x4*)r_; ka[i_] = *(const u32x4*)(r_ + 512); } \
            { va = *(const u32x4*)(U + (tb_ + vrow) * LDU0 + 1024 + h * 128 + vs * 16 + vpart * 8); const size_t vo_ = ((size_t)b * (SEQ / 64) + (c_)) * 512 + h * 128 + (tid & 127); vem = HEM[vo_]; vel = HEL[vo_]; velm = HELM[vo_]; } }
#define HM_H(w_, j_) ((bf16_t)(((j_) & 1) ? ((w_) >> 16) : ((w_) & 0xffffu)))
#define HM_STORE() { _Pragma("unroll") for (int i_ = 0; i_ < 2; ++i_) { *(LAS u32x4*)(L + oQ + prow[i_] * QS + pc8[i_] * 2) = qa[i_]; *(LAS u32x4*)(L + oK + prow[i_] * QS + pc8[i_] * 2) = ka[i_]; } \
            if (tid < 128) { LAS bf16_t* vt_ = (LAS bf16_t*)(L + oVT + (vpart * 8) * TS + vrow * 2); const unsigned vw4_[4] = {va.x, va.y, va.z, va.w}; \
                _Pragma("unroll") for (int j_ = 0; j_ < 8; ++j_) vt_[j_ * (TS / 2)] = HM_H(vw4_[j_ >> 1], j_); \
                ((LAS float*)(L + oV))[tid] = vem; ((LAS float*)(L + oV))[128 + tid] = vel; ((LAS float*)(L + oV))[256 + tid] = velm; } }
#define HM_FRAG(off_, row_, stride_, kk_) (*(const LAS bf16x8*)(L + (off_) + ((row_) + fr) * (stride_) + ((kk_) * 32 + 8 * fq) * 2))
        __syncthreads();
        for (int i = tid; i < 4352 / 4; i += 512) ((LAS unsigned*)(L + oCT))[i] = 0u;
        HM_FETCH(0); HM_STORE();
        LBAR();
        f32x4 Cacc = {0.f, 0.f, 0.f, 0.f};
        const LAS float* vEL = (const LAS float*)(L + oV) + 128; const LAS float* vELM = vEL + 128;
        for (int c = 0; c < SEQ / 64; ++c) {
            HM_FETCH((c + 1 < SEQ / 64) ? c + 1 : c);
#pragma unroll
            for (int i = 0; i < 2; ++i) { const int pp = tid + 512 * i, d = pp & 127, s8 = (pp >> 7) * 8; const LAS bf16_t* kc = (const LAS bf16_t*)(L + oK + s8 * QS) + d;
                u32x4 tw; tw.x = (unsigned)kc[0] | ((unsigned)kc[QS / 2] << 16); tw.y = (unsigned)kc[2 * (QS / 2)] | ((unsigned)kc[3 * (QS / 2)] << 16);
                tw.z = (unsigned)kc[4 * (QS / 2)] | ((unsigned)kc[5 * (QS / 2)] << 16); tw.w = (unsigned)kc[6 * (QS / 2)] | ((unsigned)kc[7 * (QS / 2)] << 16);
                *(LAS u32x4*)(L + oKT + d * TS + s8 * 2) = tw; }
            { const int sb = w >> 1, tb0 = (w & 1) * 2;
              f32x4 a0 = {0.f, 0.f, 0.f, 0.f}, a1 = {0.f, 0.f, 0.f, 0.f};
#pragma unroll
              for (int kk = 0; kk < 4; ++kk) { const bf16x8 kf = HM_FRAG(oK, sb * 16, QS, kk);
                  a0 = __builtin_amdgcn_mfma_f32_16x16x32_bf16(kf, HM_FRAG(oQ, tb0 * 16, QS, kk), a0, 0, 0, 0);
                  a1 = __builtin_amdgcn_mfma_f32_16x16x32_bf16(kf, HM_FRAG(oQ, tb0 * 16 + 16, QS, kk), a1, 0, 0, 0); }
              const int s0 = sb * 16 + 4 * fq;
#pragma unroll
              for (int j = 0; j < 2; ++j) { const int t = (tb0 + j) * 16 + fr; const f32x4 a = j ? a1 : a0;
                  u32x2 pw; pw.x = pk2((s0 <= t) ? a[0] : 0.f, (s0 + 1 <= t) ? a[1] : 0.f); pw.y = pk2((s0 + 2 <= t) ? a[2] : 0.f, (s0 + 3 <= t) ? a[3] : 0.f);
                  *(LAS u32x2*)(L + oP + t * TS + s0 * 2) = pw; } }
            LBAR();
            if (w < 4) { f32x4 d = {0.f, 0.f, 0.f, 0.f};
#pragma unroll
                for (int kk = 0; kk < 2; ++kk) d = __builtin_amdgcn_mfma_f32_16x16x32_bf16(HM_FRAG(oP, w * 16, TS, kk), HM_FRAG(oVT, 0, TS, kk), d, 0, 0, 0);
#pragma unroll
                for (int kk = 0; kk < 4; ++kk) d = __builtin_amdgcn_mfma_f32_16x16x32_bf16(HM_FRAG(oQ, w * 16, QS, kk), HM_FRAG(oCT, 0, QS, kk), d, 0, 0, 0);
                bf16_t* op = U + (tok0 + (size_t)c * 64 + w * 16 + 4 * fq) * LDU0 + 1024 + h * 128 + vs * 16 + fr;
                op[0] = f2bf(d[0]); op[LDU0] = f2bf(d[1]); op[2 * LDU0] = f2bf(d[2]); op[3 * LDU0] = f2bf(d[3]); }
            { f32x4 tmp = {0.f, 0.f, 0.f, 0.f};
#pragma unroll
              for (int kk = 0; kk < 2; ++kk) tmp = __builtin_amdgcn_mfma_f32_16x16x32_bf16(HM_FRAG(oKT, w * 16, TS, kk), HM_FRAG(oVT, 0, TS, kk), tmp, 0, 0, 0);
              const int k0 = w * 16 + 4 * fq;
#pragma unroll
              for (int r = 0; r < 4; ++r) Cacc[r] = Cacc[r] * vEL[k0 + r] + tmp[r] * vELM[k0 + r]; }
            LBAR();
            if (c + 1 < SEQ / 64) HM_STORE();
            LBAR();
            { const int k0 = w * 16 + 4 * fq; const LAS float* vEM = (const LAS float*)(L + oV);
              u32x2 cw; cw.x = pk2(Cacc[0] * vEM[k0], Cacc[1] * vEM[k0 + 1]); cw.y = pk2(Cacc[2] * vEM[k0 + 2], Cacc[3] * vEM[k0 + 3]);
              *(LAS u32x2*)(L + oCT + fr * QS + k0 * 2) = cw; }
            LBAR();
        }
#undef HM_FETCH
#undef HM_STORE
#undef HM_FRAG
#undef HM_H
    }
    GSYNC();
    STAMP(4);

    {
        PHASE_IDS
        const int gw = bid * 8 + wave, NWH = G * 4;
        const int c8 = lane * 8;
        if ((gw & 1) == 0) {
            const f32x4 an0 = *(const f32x4*)(p.in[7] + c8), an1 = *(const f32x4*)(p.in[7] + c8 + 4);
            for (int m0 = gw >> 1; m0 < M; m0 += NWH * 4) {
                u32x4 xo[4], xg[4];
#pragma unroll
                for (int u = 0; u < 4; ++u) { const int m = m0 + u * NWH; const bf16_t* ur = U + (size_t)m * LDU0 + c8; xo[u] = *(const u32x4*)(ur + 1024); xg[u] = *(const u32x4*)(ur + 1536); }
#pragma unroll
                for (int u = 0; u < 4; ++u) { const int m = m0 + u * NWH; {
                    const float o[8] = {bflo(xo[u].x), bfhi(xo[u].x), bflo(xo[u].y), bfhi(xo[u].y), bflo(xo[u].z), bfhi(xo[u].z), bflo(xo[u].w), bfhi(xo[u].w)};
                    const float g[8] = {bflo(xg[u].x), bfhi(xg[u].x), bflo(xg[u].y), bfhi(xg[u].y), bflo(xg[u].z), bfhi(xg[u].z), bflo(xg[u].w), bfhi(xg[u].w)};
                    float ss = 0.f;
#pragma unroll
                    for (int e = 0; e < 8; ++e) ss = fmaf(o[e], o[e], ss);
                    const float rs = 1.0f / sqrtf(row_sum16(ss) * (1.f / 128.f) + RMS_EPS);
                    u32x4 w; w.x = pk2(o[0] * rs * an0[0] * siluf_(g[0]), o[1] * rs * an0[1] * siluf_(g[1])); w.y = pk2(o[2] * rs * an0[2] * siluf_(g[2]), o[3] * rs * an0[3] * siluf_(g[3]));
                    w.z = pk2(o[4] * rs * an1[0] * siluf_(g[4]), o[5] * rs * an1[1] * siluf_(g[5])); w.w = pk2(o[6] * rs * an1[2] * siluf_(g[6]), o[7] * rs * an1[3] * siluf_(g[7]));
                    *(u32x4*)(YC + (size_t)m * DM + c8) = w; } }
            }
        } else {
            const f32x4 lw0 = *(const f32x4*)(p.in[17] + c8), lw1 = *(const f32x4*)(p.in[17] + c8 + 4), lb0 = *(const f32x4*)(p.in[18] + c8), lb1 = *(const f32x4*)(p.in[18] + c8 + 4);
            for (int m0 = gw >> 1; m0 < M; m0 += NWH * 4) {
                u32x4 xy[4], xg[4], xb[4];
#pragma unroll
                for (int u = 0; u < 4; ++u) { const int m = m0 + u * NWH; const size_t i = (size_t)m * 512 + c8; xy[u] = *(const u32x4*)(Vv + i); xg[u] = *(const u32x4*)(Gg + i); xb[u] = *(const u32x4*)(BVG + i); }
#pragma unroll
                for (int u = 0; u < 4; ++u) { const int m = m0 + u * NWH; {
                    const float y[8] = {bflo(xy[u].x), bfhi(xy[u].x), bflo(xy[u].y), bfhi(xy[u].y), bflo(xy[u].z), bfhi(xy[u].z), bflo(xy[u].w), bfhi(xy[u].w)};
                    const float g[8] = {bflo(xg[u].x), bfhi(xg[u].x), bflo(xg[u].y), bfhi(xg[u].y), bflo(xg[u].z), bfhi(xg[u].z), bflo(xg[u].w), bfhi(xg[u].w)};
                    const float bv[8] = {bflo(xb[u].x), bfhi(xb[u].x), bflo(xb[u].y), bfhi(xb[u].y), bflo(xb[u].z), bfhi(xb[u].z), bflo(xb[u].w), bfhi(xb[u].w)};
                    float s1 = 0.f;
#pragma unroll
                    for (int e = 0; e < 8; ++e) s1 += y[e];
                    s1 += dpp_mov<0xB1>(s1); s1 += dpp_mov<0x4E>(s1); s1 += dpp_mov<0x141>(s1);
                    const float mean = s1 * (1.f / 64.f); float s2 = 0.f;
#pragma unroll
                    for (int e = 0; e < 8; ++e) { const float d = y[e] - mean; s2 = fmaf(d, d, s2); }
                    s2 += dpp_mov<0xB1>(s2); s2 += dpp_mov<0x4E>(s2); s2 += dpp_mov<0x141>(s2);
                    const float rs = 1.0f / sqrtf(s2 * (1.f / 64.f) + 64e-5f);
                    float r8[8];
#pragma unroll
                    for (int e = 0; e < 8; ++e) { const float lw = e < 4 ? lw0[e] : lw1[e - 4], lb = e < 4 ? lb0[e] : lb1[e - 4]; r8[e] = ((y[e] - mean) * rs * lw + lb) * g[e] + bv[e]; }
                    u32x4 w; w.x = pk2(r8[0], r8[1]); w.y = pk2(r8[2], r8[3]); w.z = pk2(r8[4], r8[5]); w.w = pk2(r8[6], r8[7]);
                    *(u32x4*)(YC + (size_t)m * DM + 512 + c8) = w; } }
            }
        }
    }
    GSYNC();
    STAMP(5);

    { pg8::Gemm g{YC, (const bf16_t*)(p.ws + WS_OUT0), DM, DM, M, DM, DM}; pg8::StaticOrder S; S.init(M, DM, G, bid);
      pg8::EpiResidual<true, true> E{p.in[0], nullptr, XB, SS1}; pg8::gemm_phase<pg8::EpiResidual<true, true>, pg8::StaticOrder, true, true>(lds, g, S, E); }
    GSYNC();
    STAMP(6);
#define HID U
    { pg8::Gemm g{XB, (const bf16_t*)(p.ws + WS_GU0), DM, DM, M, 2 * FFN, DM}; pg8::StaticOrder S; S.init(M, 2 * FFN, G, bid);
      pg8::EpiSwiGlu E{HID, FFN, SS1}; pg8::gemm_phase<pg8::EpiSwiGlu, pg8::StaticOrder, true, true>(lds, g, S, E); }
    GSYNC();
    STAMP(7);
    { pg8::Gemm g{HID, (const bf16_t*)(p.ws + WS_D0), FFN, FFN, M, DM, FFN}; pg8::StaticOrder S; S.init(M, DM, G, bid);
      pg8::EpiResidual<false, true> E{nullptr, XB, XB, SS2}; pg8::gemm_phase<pg8::EpiResidual<false, true>, pg8::StaticOrder, true, true>(lds, g, S, E); }
    GSYNC();
    STAMP(8);
    { pg8::Gemm g{XB, (const bf16_t*)(p.ws + WS_IN1), DM, DM, M, NP1, DM}; pg8::StaticOrder S; S.init(M, NP1, G, bid);
      pg8::EpiScaleBf16 E{U, LDU1, SS2}; pg8::gemm_phase<pg8::EpiScaleBf16, pg8::StaticOrder, true, true>(lds, g, S, E); }
    GSYNC();
    STAMP(9);

#define Qc ((bf16_t*)(p.ws + WS_YC))
#define Kc ((bf16_t*)(p.ws + WS_MS))
#define gSI ((float*)(p.ws + WS_MS + 48 * MiB))
#define gBI (gSI + (size_t)M * 4)
#define gBT (gSI + (size_t)M * 8)
#define gWL (gSI + (size_t)M * 12)
#define gDP ((float*)(p.ws + WS_MS + 50 * MiB))
#define gDEN ((float*)(p.ws + WS_MS + 51 * MiB))
    {
        PHASE_IDS
        const float* cq = p.in[31]; const float* ck = p.in[32];
        const int gw = bid * 8 + wave, NW = G * 8;
        for (int item = gw; item < (M / 16) * 3; item += NW) {
            const int run = item / 3, m0 = run * 16, c = (item % 3) * 512 + lane * 8; const bool s0 = (m0 & (SEQ - 1)) == 0;
            const bool isk = c >= 768; const int cc = isk ? c - 768 : c; const float* cw = (isk ? ck : cq) + cc; const float sc = isk ? 0.07216878364870322f : 1.f;
            u32x4 x[19];
#pragma unroll
            for (int i = 0; i < 19; ++i) { const int mm = (i < 3 && s0) ? m0 : m0 - 3 + i; x[i] = *(const u32x4*)(U + (size_t)mm * LDU1 + 256 + c); }
            f32x4 w0[4], w1[4];
#pragma unroll
            for (int j = 0; j < 4; ++j) { w0[j] = *(const f32x4*)(cw + j * 768); w1[j] = *(const f32x4*)(cw + j * 768 + 4); }
            if (s0) { const u32x4 z = {0u, 0u, 0u, 0u}; x[0] = z; x[1] = z; x[2] = z; }
            bf16_t* dst = (isk ? Kc : Qc) + (size_t)m0 * 768 + cc;
#pragma unroll
            for (int tk = 0; tk < 16; ++tk) {
                float acc[8];
#pragma unroll
                for (int e = 0; e < 8; ++e) acc[e] = 0.f;
#pragma unroll
                for (int j = 0; j < 4; ++j) { const u32x4 xv = x[tk + j];
                    acc[0] = fmaf(w0[j][0], bflo(xv.x), acc[0]); acc[1] = fmaf(w0[j][1], bfhi(xv.x), acc[1]); acc[2] = fmaf(w0[j][2], bflo(xv.y), acc[2]); acc[3] = fmaf(w0[j][3], bfhi(xv.y), acc[3]);
                    acc[4] = fmaf(w1[j][0], bflo(xv.z), acc[4]); acc[5] = fmaf(w1[j][1], bfhi(xv.z), acc[5]); acc[6] = fmaf(w1[j][2], bflo(xv.w), acc[6]); acc[7] = fmaf(w1[j][3], bfhi(xv.w), acc[7]); }
                u32x4 o; o.x = pk2(siluf_(acc[0]) * sc, siluf_(acc[1]) * sc); o.y = pk2(siluf_(acc[2]) * sc, siluf_(acc[3]) * sc); o.z = pk2(siluf_(acc[4]) * sc, siluf_(acc[5]) * sc); o.w = pk2(siluf_(acc[6]) * sc, siluf_(acc[7]) * sc);
                *(u32x4*)(dst + (size_t)tk * 768) = o; }
        }
        for (int it = gw; it < (M / 64) * 4; it += NW) {
            const int ch = it >> 2, hh = it & 3; const size_t m = (size_t)ch * 64 + lane; const bf16_t* ur = U + m * LDU1;
            const float lf = -softplusf_(-(bf2f(ur[3332 + hh]) + p.in[34][hh]));
            const float li = bf2f(ur[3328 + hh]) + p.in[33][hh];
            float bs = lf;
#pragma unroll
            for (int o = 1; o < 64; o <<= 1) { const float t = __shfl_up(bs, o); if (lane >= o) bs += t; }
            const float bL = __shfl(bs, 63);
            gSI[m * 4 + hh] = __expf(bs); gBI[m * 4 + hh] = li - bs; gBT[m * 4 + hh] = bs; gWL[m * 4 + hh] = __expf(bL - bs + li);
            if (lane == 0) gDP[ch * 4 + hh] = __expf(bL);
        }
    }
    GSYNC();
    STAMP(10);

    if (bid < 192) {
        PHASE_IDS
        const int w = __builtin_amdgcn_readfirstlane(tid >> 6);
        const int grp_ = (bid & 7) * 4 + (bid >> 3) / 6;
        const int vs = (bid >> 3) % 6, h = grp_ & 3, b = grp_ >> 2;
        constexpr int QS = 400, TS = 144;
        constexpr int oQ = 0, oK = 25600, oKT = 51200, oVT = 78848, oVW = 85760, oP = 92672, oCT = 101888, oG = 121088;
        LAS unsigned char* L = lds;
        for (int i = tid; i < 19200 / 4; i += 512) ((LAS unsigned*)(L + oCT))[i] = 0u;
        for (int i = tid; i < 64 * TS / 4; i += 512) ((LAS unsigned*)(L + oP))[i] = 0u;
        for (int i = tid; i < 16 * TS / 4; i += 512) { ((LAS unsigned*)(L + oVT + 32 * TS))[i] = (i < TS / 4) ? 0x3F803F80u : 0u; ((LAS unsigned*)(L + oVW + 32 * TS))[i] = 0u; }
        const size_t tok0 = (size_t)b * SEQ;
        const int fr = lane & 15, fq = lane >> 4;
        u32x4 qa[3], ka[3], va = {0u, 0u, 0u, 0u}; float gsi = 0.f, gbi = 0.f, gbt = 0.f, gwl = 0.f, wlr = 0.f;
        int prow[3], pc8[3];
#pragma unroll
        for (int i = 0; i < 3; ++i) { const int pp = tid + 512 * i; prow[i] = pp / 24; pc8[i] = (pp % 24) * 8; }
        const int vrow = tid & 63, vpart = tid >> 6;
#define MM_FETCH(c_) { const size_t tb_ = tok0 + (size_t)(c_) * 64; _Pragma("unroll") for (int i_ = 0; i_ < 3; ++i_) { const size_t o_ = (tb_ + prow[i_]) * 768 + h * 192 + pc8[i_]; qa[i_] = *(const u32x4*)(Qc + o_); ka[i_] = *(const u32x4*)(Kc + o_); } \
            { va = *(const u32x4*)(U + (tb_ + vrow) * LDU1 + 1792 + h * 192 + vs * 32 + (vpart & 3) * 8); wlr = gWL[(tb_ + vrow) * 4 + h]; } \
            { const size_t g_ = (tb_ + (tid & 63)) * 4 + h; gsi = gSI[g_]; gbi = gBI[g_]; gbt = gBT[g_]; gwl = gWL[g_]; } }
#define MM_H(w_, j_) ((bf16_t)(((j_) & 1) ? ((w_) >> 16) : ((w_) & 0xffffu)))
#define MM_STORE() { _Pragma("unroll") for (int i_ = 0; i_ < 3; ++i_) { *(LAS u32x4*)(L + oQ + prow[i_] * QS + pc8[i_] * 2) = qa[i_]; *(LAS u32x4*)(L + oK + prow[i_] * QS + pc8[i_] * 2) = ka[i_]; \
            } \
            if (tid < 256) { LAS bf16_t* vt_ = (LAS bf16_t*)(L + oVT + (vpart * 8) * TS + vrow * 2); LAS bf16_t* vw_ = (LAS bf16_t*)(L + oVW + (vpart * 8) * TS + vrow * 2); const unsigned vw4_[4] = {va.x, va.y, va.z, va.w}; \
                _Pragma("unroll") for (int j_ = 0; j_ < 8; ++j_) { const bf16_t e_ = MM_H(vw4_[j_ >> 1], j_); vt_[j_ * (TS / 2)] = e_; vw_[j_ * (TS / 2)] = f2bf(bf2f(e_) * wlr); } } \
            if (tid < 64) { ((LAS bf16_t*)(L + oVW + 32 * TS))[tid] = f2bf(gwl); ((LAS float*)(L + oG))[tid] = gsi; ((LAS float*)(L + oG))[64 + tid] = gbi; ((LAS float*)(L + oG))[128 + tid] = gbt; } }
#define MM_TR4(off_) __builtin_amdgcn_ds_read_tr16_b64_v4i16((LAS s16x4*)(ktb + (off_)))
#define MM_TRF(off_) __builtin_shufflevector(MM_TR4(off_), MM_TR4((off_) + 4 * QS), 0, 1, 2, 3, 4, 5, 6, 7)
#define MM_FRAG(off_, row_, stride_, kk_) (*(const LAS bf16x8*)(L + (off_) + ((row_) + fr) * (stride_) + ((kk_) * 32 + 8 * fq) * 2))
        __syncthreads();
        MM_FETCH(0); MM_STORE();
        LBAR();
        f32x4 Cacc[3][2];
#pragma unroll
        for (int i = 0; i < 3; ++i) { Cacc[i][0] = (f32x4){0.f, 0.f, 0.f, 0.f}; Cacc[i][1] = (f32x4){0.f, 0.f, 0.f, 0.f}; }
        const int nvt = (w < 4) ? 1 : 2, vt0 = (w < 4) ? 0 : 1, db0 = 3 * (w & 3);
        const LAS unsigned char* ktb = L + oK + ((lane >> 4) * 8 + ((lane >> 2) & 3)) * QS + (db0 * 16 + (lane & 3) * 4) * 2;
        const LAS float* gSIl = (const LAS float*)(L + oG); const LAS float* gBIl = gSIl + 64; const LAS float* gBTl = gSIl + 128;
        for (int c = 0; c < SEQ / 64; ++c) {
            int fr_o = lane & 15, fq_o = lane >> 4; asm volatile("" : "+v"(fr_o), "+v"(fq_o));
            const int fr = fr_o, fq = fq_o;
            const float dp = gDP[(b * (SEQ / 64) + c) * 4 + h];
            MM_FETCH((c + 1 < SEQ / 64) ? c + 1 : c);
            { const int sb = w >> 1, tb0 = (w & 1) * 2;
              if (sb <= tb0 + 1) {
              const bool two = sb <= tb0;
              bf16x8 kf[6], q0f[6], q1f[6];
#pragma unroll
              for (int kk = 0; kk < 6; ++kk) { kf[kk] = MM_FRAG(oK, sb * 16, QS, kk); q1f[kk] = MM_FRAG(oQ, tb0 * 16 + 16, QS, kk); }
              if (two) {
#pragma unroll
                  for (int kk = 0; kk < 6; ++kk) q0f[kk] = MM_FRAG(oQ, tb0 * 16, QS, kk); }
              const int s0 = sb * 16 + 4 * fq;
              const float bi0 = gBIl[s0], bi1 = gBIl[s0 + 1], bi2 = gBIl[s0 + 2], bi3 = gBIl[s0 + 3];
              const float bt0 = gBTl[tb0 * 16 + fr], bt1 = gBTl[tb0 * 16 + 16 + fr];
              asm volatile("s_waitcnt lgkmcnt(0)" ::: "memory");
              f32x4 a0 = {0.f, 0.f, 0.f, 0.f}, a1 = {0.f, 0.f, 0.f, 0.f};
              if (two) {
#pragma unroll
                  for (int kk = 0; kk < 6; ++kk) { a0 = __builtin_amdgcn_mfma_f32_16x16x32_bf16(kf[kk], q0f[kk], a0, 0, 0, 0); a1 = __builtin_amdgcn_mfma_f32_16x16x32_bf16(kf[kk], q1f[kk], a1, 0, 0, 0); }
              } else {
#pragma unroll
                  for (int kk = 0; kk < 6; ++kk) a1 = __builtin_amdgcn_mfma_f32_16x16x32_bf16(kf[kk], q1f[kk], a1, 0, 0, 0);
              }
#pragma unroll
              for (int j = 0; j < 2; ++j) { if (j == 1 || two) { const int t = (tb0 + j) * 16 + fr; const float bt = j ? bt1 : bt0; const f32x4 a = j ? a1 : a0;
                  const float p0 = (s0 <= t) ? a[0] * __expf(bt + bi0) : 0.f, p1 = (s0 + 1 <= t) ? a[1] * __expf(bt + bi1) : 0.f, p2 = (s0 + 2 <= t) ? a[2] * __expf(bt + bi2) : 0.f, p3 = (s0 + 3 <= t) ? a[3] * __expf(bt + bi3) : 0.f;
                  u32x2 pw; pw.x = pk2(p0, p1); pw.y = pk2(p2, p3); *(LAS u32x2*)(L + oP + t * TS + s0 * 2) = pw; } } } }
            LBAR();
            { const int tb = w & 3;
              const int n2 = (w < 4) ? 2 : 1;
              bf16x8 qf[6], pf[2], vtf[2][2], ctf[2][6];
#pragma unroll
              for (int kk = 0; kk < 6; ++kk) qf[kk] = MM_FRAG(oQ, tb * 16, QS, kk);
#pragma unroll
              for (int kk = 0; kk < 2; ++kk) pf[kk] = MM_FRAG(oP, tb * 16, TS, kk);
#pragma unroll
              for (int j = 0; j < 2; ++j) { if (j < n2) { const int vt = (w < 4) ? j : 2;
#pragma unroll
                  for (int kk = 0; kk < 2; ++kk) vtf[j][kk] = MM_FRAG(oVT, vt * 16, TS, kk);
#pragma unroll
                  for (int kk = 0; kk < 6; ++kk) ctf[j][kk] = MM_FRAG(oCT, vt * 16, QS, kk); } }
              const int t0r = tb * 16 + 4 * fq;
              const float si0 = gSIl[t0r], si1 = gSIl[t0r + 1], si2 = gSIl[t0r + 2], si3 = gSIl[t0r + 3];
              asm volatile("s_waitcnt lgkmcnt(0)" ::: "memory");
              bf16x8 ktf[3][2], vwf[2][2];
#pragma unroll
              for (int i = 0; i < 3; ++i) { ktf[i][0] = MM_TRF(i * 32); ktf[i][1] = MM_TRF(32 * QS + i * 32); }
#pragma unroll
              for (int j = 0; j < 2; ++j) { if (j < nvt) { vwf[j][0] = MM_FRAG(oVW, (vt0 + j) * 16, TS, 0); vwf[j][1] = MM_FRAG(oVW, (vt0 + j) * 16, TS, 1); } }
#pragma unroll
              for (int j = 0; j < 2; ++j) { if (j < n2) { const int vt = (w < 4) ? j : 2;
                  f32x4 d2 = {0.f, 0.f, 0.f, 0.f}, d3 = {0.f, 0.f, 0.f, 0.f};
#pragma unroll
                  for (int kk = 0; kk < 2; ++kk) d2 = __builtin_amdgcn_mfma_f32_16x16x32_bf16(pf[kk], vtf[j][kk], d2, 0, 0, 0);
#pragma unroll
                  for (int kk = 0; kk < 6; ++kk) d3 = __builtin_amdgcn_mfma_f32_16x16x32_bf16(qf[kk], ctf[j][kk], d3, 0, 0, 0);
                  const float o0 = si0 * d3[0] + d2[0], o1 = si1 * d3[1] + d2[1], o2 = si2 * d3[2] + d2[2], o3 = si3 * d3[3] + d2[3];
                  const size_t tg = tok0 + (size_t)c * 64 + t0r;
                  if (w < 4) { bf16_t* op = U + tg * LDU1 + 1792 + h * 192 + vs * 32 + vt * 16 + fr; op[0] = f2bf(o0); op[LDU1] = f2bf(o1); op[2 * LDU1] = f2bf(o2); op[3 * LDU1] = f2bf(o3); }
                  else if (fr == 0 && vs == 0) { float* dn = gDEN + tg * 4 + h; dn[0] = o0; dn[4] = o1; dn[8] = o2; dn[12] = o3; } } }
              asm volatile("s_waitcnt lgkmcnt(0)" ::: "memory");
#pragma unroll
              for (int i = 0; i < 3; ++i)
#pragma unroll
                  for (int j = 0; j < 2; ++j) { if (j < nvt) { f32x4 ca = Cacc[i][j] * dp;
                      ca = __builtin_amdgcn_mfma_f32_16x16x32_bf16(ktf[i][0], vwf[j][0], ca, 0, 0, 0);
                      ca = __builtin_amdgcn_mfma_f32_16x16x32_bf16(ktf[i][1], vwf[j][1], ca, 0, 0, 0); Cacc[i][j] = ca; } } }
            LBAR();
#pragma unroll
            for (int i = 0; i < 3; ++i)
#pragma unroll
                for (int j = 0; j < 2; ++j) { if (j < nvt) { const f32x4 ca = Cacc[i][j]; u32x2 cw; cw.x = pk2(ca[0], ca[1]); cw.y = pk2(ca[2], ca[3]);
                    *(LAS u32x2*)(L + oCT + ((vt0 + j) * 16 + fr) * QS + ((db0 + i) * 16 + 4 * fq) * 2) = cw; } }
            if (c + 1 < SEQ / 64) MM_STORE();
            LBAR();
        }
        STAMP2(18, 0);
#undef MM_FETCH
#undef MM_STORE
#undef MM_FRAG
#undef MM_TR4
#undef MM_TRF
#undef MM_H
    } else {
        PHASE_IDS
        const int w = __builtin_amdgcn_readfirstlane(tid >> 6), wq = w & 3, myc = w >> 2;
        const int fr = lane & 15, fq = lane >> 4;
        constexpr int US = 80, XS = 272, NB = SEQ / 32;
        constexpr int oU = 0, oW1 = 10240, oX = 20480, oH = 37888, oW2 = 55296, oZ = 59648, CH = 61696;
        LAS unsigned char* Lc = lds + myc * CH;
        __syncthreads();
        for (int i = tid; i < 2 * CH / 4; i += 512) ((LAS unsigned*)lds)[i] = 0u;
        __syncthreads();
        for (int i = tid; i < 2 * 128 * 16; i += 512) { const int cc = i >> 11, n = (i >> 4) & 127, k = i & 15; const int g_ = ((bid - 192) * 2 + cc) & 15;
            const float v = (n < 64) ? BBR[(g_ * 64 + n) * 16 + k] : BBI[(g_ * 64 + n - 64) * 16 + k];
            ((LAS bf16_t*)(lds + cc * CH + oW1 + n * US))[k] = f2bf(v); }
        for (int i = tid; i < 2 * 16 * 128; i += 512) { const int cc = i >> 11, hh = (i >> 7) & 15, k = i & 127; const int g_ = ((bid - 192) * 2 + cc) & 15;
            const float v = (k < 64) ? p.in[26][(g_ * 16 + hh) * 64 + k] : -p.in[27][(g_ * 16 + hh) * 64 + k - 64];
            ((LAS bf16_t*)(lds + cc * CH + oW2 + hh * XS))[k] = f2bf(v); }
        const int chain = (bid - 192) * 2 + myc, g = chain & 15, b = chain >> 4;
        bf16_t* gU = U + ((size_t)b * SEQ + (lane >> 1)) * LDU1 + g * 16 + (lane & 1) * 8;
        __syncthreads();
        if (wq == 3) {
            u32x4 sA, sB;
            const int lo = (lane >> 1) * US + (lane & 1) * 16, zo = (lane >> 1) * 32 + (lane & 1) * 16;
#define S5_LD(i_) (*(const u32x4*)(gU + (size_t)(((i_) < NB ? (i_) : NB - 1) * 32) * LDU1))
            sA = S5_LD(0); *(LAS u32x4*)(Lc + oU + 0 * 2560 + lo) = sA; sB = S5_LD(1); *(LAS u32x4*)(Lc + oU + 1 * 2560 + lo) = sB;
            sA = S5_LD(2); sB = S5_LD(3);
            LBAR(); LBAR();
            for (int it = 0; it < NB + 2; it += 2) {
                if (it + 2 < NB) *(LAS u32x4*)(Lc + oU + ((it + 2) & 3) * 2560 + lo) = sA;
                if (it >= 2) *(u32x4*)(gU + (size_t)((it - 2) * 32) * LDU1) = *(const LAS u32x4*)(Lc + oZ + (it & 1) * 1024 + zo);
                sA = S5_LD(it + 4);
                LBAR();
                if (it + 3 < NB) *(LAS u32x4*)(Lc + oU + ((it + 3) & 3) * 2560 + lo) = sB;
                if (it >= 1 && it - 1 < NB) *(u32x4*)(gU + (size_t)((it - 1) * 32) * LDU1) = *(const LAS u32x4*)(Lc + oZ + ((it + 1) & 1) * 1024 + zo);
                sB = S5_LD(it + 5);
                LBAR();
            }
#undef S5_LD
        } else if (wq == 1) {
            bf16x8 w1f[8];
#pragma unroll
            for (int j = 0; j < 8; ++j) w1f[j] = *(const LAS bf16x8*)(Lc + oW1 + (j * 16 + fr) * US + (8 * fq) * 2);
            auto xblk = [&](int blk) {
                const LAS unsigned char* Ut = Lc + oU + (blk & 3) * 2560; LAS unsigned char* Xt = Lc + oX + (blk & 1) * 8704;
                const bf16x8 u0 = *(const LAS bf16x8*)(Ut + fr * US + (8 * fq) * 2), u1 = *(const LAS bf16x8*)(Ut + (16 + fr) * US + (8 * fq) * 2);
                const f32x4 z4 = {0.f, 0.f, 0.f, 0.f};
#pragma unroll
                for (int j = 0; j < 8; ++j) { const f32x4 d0 = __builtin_amdgcn_mfma_f32_16x16x32_bf16(u0, w1f[j], z4, 0, 0, 0), d1 = __builtin_amdgcn_mfma_f32_16x16x32_bf16(u1, w1f[j], z4, 0, 0, 0);
                    LAS bf16_t* xp = (LAS bf16_t*)(Xt + (4 * fq) * XS) + j * 16 + fr;
#pragma unroll
                    for (int r = 0; r < 4; ++r) { xp[r * (XS / 2)] = f2bf(d0[r]); xp[(16 + r) * (XS / 2)] = f2bf(d1[r]); } } };
            LBAR();
            xblk(0);
            LBAR();
            for (int it = 0; it < NB + 2; ++it) { if (it + 1 < NB) xblk(it + 1); LBAR(); }
        } else if (wq == 0) {
            const float ar = LBR[g * 64 + lane], ai = LBI[g * 64 + lane];
            float hr = 0.f, hi = 0.f;
            LBAR(); LBAR();
            for (int it = 0; it < NB + 2; ++it) {
                if (it < NB) { const LAS bf16_t* xp = (const LAS bf16_t*)(Lc + oX + (it & 1) * 8704) + lane; LAS bf16_t* hp = (LAS bf16_t*)(Lc + oH + (it & 1) * 8704) + lane;
                    for (int t8 = 0; t8 < 32; t8 += 8) {
                        bf16_t xr[8], xi[8], or_[8], oi_[8];
#pragma unroll
                        for (int u = 0; u < 8; ++u) { xr[u] = xp[(t8 + u) * (XS / 2)]; xi[u] = xp[(t8 + u) * (XS / 2) + 64]; }
#pragma unroll
                        for (int u = 0; u < 8; ++u) { const float nr = fmaf(ar, hr, fmaf(-ai, hi, bf2f(xr[u]))), ni = fmaf(ar, hi, fmaf(ai, hr, bf2f(xi[u]))); hr = nr; hi = ni; or_[u] = f2bf(hr); oi_[u] = f2bf(hi); }
#pragma unroll
                        for (int u = 0; u < 8; ++u) { hp[(t8 + u) * (XS / 2)] = or_[u]; hp[(t8 + u) * (XS / 2) + 64] = oi_[u]; } } }
                LBAR();
            }
        } else {
            bf16x8 w2f[4];
#pragma unroll
            for (int kk = 0; kk < 4; ++kk) w2f[kk] = *(const LAS bf16x8*)(Lc + oW2 + fr * XS + (kk * 32 + 8 * fq) * 2);
            const float dsk = p.in[28][g * 16 + fr];
            LBAR(); LBAR();
            for (int it = 0; it < NB + 2; ++it) {
                if (it >= 1 && it - 1 < NB) { const int blk = it - 1; const LAS unsigned char* Ht = Lc + oH + (blk & 1) * 8704; const LAS unsigned char* Ut = Lc + oU + (blk & 3) * 2560; LAS unsigned char* Zt = Lc + oZ + (blk & 1) * 1024;
#pragma unroll
                    for (int tb = 0; tb < 2; ++tb) { f32x4 d = {0.f, 0.f, 0.f, 0.f};
#pragma unroll
                        for (int kk = 0; kk < 4; ++kk) d = __builtin_amdgcn_mfma_f32_16x16x32_bf16(*(const LAS bf16x8*)(Ht + (tb * 16 + fr) * XS + (kk * 32 + 8 * fq) * 2), w2f[kk], d, 0, 0, 0);
#pragma unroll
                        for (int r = 0; r < 4; ++r) { const int t = tb * 16 + 4 * fq + r;
                            const float y = d[r] + dsk * bf2f(*(const LAS bf16_t*)(Ut + t * US + fr * 2));
                            const float z = 0.5f * y * (1.f + tanhf_(0.7978845608028654f * (y + 0.044715f * y * y * y)));
                            *(LAS bf16_t*)(Zt + t * 32 + fr * 2) = f2bf(z); } } }
                LBAR();
            }
        }
        STAMP2(19, 192);
    }
    GSYNC();
    STAMP(11);

    {
        PHASE_IDS
        const int w = __builtin_amdgcn_readfirstlane(tid >> 6), fr = lane & 15, fq = lane >> 4;
        constexpr int ZS = 528;
        const bf16_t* WT = (const bf16_t*)(p.ws + WS_GLU);
        bf16x8 wf[2][8];
#pragma unroll
        for (int nt = 0; nt < 2; ++nt)
#pragma unroll
            for (int kk = 0; kk < 8; ++kk) wf[nt][kk] = *(const bf16x8*)(WT + (size_t)(w * 32 + nt * 16 + fr) * 256 + kk * 32 + 8 * fq);
        f32x4 bias4[2];
#pragma unroll
        for (int nt = 0; nt < 2; ++nt) bias4[nt] = *(const f32x4*)(p.in[30] + w * 32 + nt * 16 + 4 * fq);
        for (int m0 = bid * 64; m0 < M; m0 += G * 64) {
            __syncthreads();
#pragma unroll
            for (int i = 0; i < 4; ++i) { const int pp = tid + 512 * i, row = pp >> 5, c8 = (pp & 31) * 8; *(LAS u32x4*)(lds + row * ZS + c8 * 2) = *(const u32x4*)(U + (size_t)(m0 + row) * LDU1 + c8); }
            __syncthreads();
#pragma unroll
            for (int tb = 0; tb < 4; ++tb) { f32x4 d0 = {0.f, 0.f, 0.f, 0.f}, d1 = {0.f, 0.f, 0.f, 0.f};
#pragma unroll
                for (int kk = 0; kk < 8; ++kk) { const bf16x8 zf = *(const LAS bf16x8*)(lds + (tb * 16 + fr) * ZS + (kk * 32 + 8 * fq) * 2);
                    d0 = __builtin_amdgcn_mfma_f32_16x16x32_bf16(wf[0][kk], zf, d0, 0, 0, 0); d1 = __builtin_amdgcn_mfma_f32_16x16x32_bf16(wf[1][kk], zf, d1, 0, 0, 0); }
                const int t = tb * 16 + fr;
#pragma unroll
                for (int nt = 0; nt < 2; ++nt) { const f32x4 a = (nt ? d1 : d0) + bias4[nt]; const int n0 = w * 32 + nt * 16 + 4 * fq;
                    const u32x2 zz = *(const LAS u32x2*)(lds + t * ZS + n0 * 2);
                    u32x2 o; o.x = pk2(bflo(zz.x) * sigmoidf_(a[0]), bfhi(zz.x) * sigmoidf_(a[1])); o.y = pk2(bflo(zz.y) * sigmoidf_(a[2]), bfhi(zz.y) * sigmoidf_(a[3]));
                    *(u32x2*)(YC + (size_t)(m0 + t) * DM + n0) = o; } }
        }
    }
    {
        PHASE_IDS
        const int gw = bid * 8 + wave, NW = G * 8, hh = lane >> 4, c12 = lane * 12;
        f32x4 nw[3];
#pragma unroll
        for (int j = 0; j < 3; ++j) nw[j] = *(const f32x4*)(p.in[35] + c12 + 4 * j);
        for (int m0 = gw; m0 < M; m0 += NW * 4) {
            u32x2 xn[4][3], xo[4][3]; float dn[4];
#pragma unroll
            for (int u = 0; u < 4; ++u) { const int m = m0 + u * NW; const bf16_t* ur = U + (size_t)m * LDU1 + c12; dn[u] = gDEN[(size_t)m * 4 + hh];
#pragma unroll
                for (int j = 0; j < 3; ++j) { xn[u][j] = *(const u32x2*)(ur + 1792 + 4 * j); xo[u][j] = *(const u32x2*)(ur + 2560 + 4 * j); } }
#pragma unroll
            for (int u = 0; u < 4; ++u) { const int m = m0 + u * NW; const float inv = 1.0f / fmaxf(fabsf(dn[u]), 1.0f);
                float hv[12], og[12]; float ss = 0.f;
#pragma unroll
                for (int j = 0; j < 3; ++j) { hv[4 * j] = bflo(xn[u][j].x) * inv; hv[4 * j + 1] = bfhi(xn[u][j].x) * inv; hv[4 * j + 2] = bflo(xn[u][j].y) * inv; hv[4 * j + 3] = bfhi(xn[u][j].y) * inv;
                    og[4 * j] = bflo(xo[u][j].x); og[4 * j + 1] = bfhi(xo[u][j].x); og[4 * j + 2] = bflo(xo[u][j].y); og[4 * j + 3] = bfhi(xo[u][j].y); }
#pragma unroll
                for (int e = 0; e < 12; ++e) ss = fmaf(hv[e], hv[e], ss);
                const float rs = 1.0f / sqrtf(row_sum16(ss) * (1.f / 192.f) + RMS_EPS);
                bf16_t* yo = YC + (size_t)m * DM + 256 + c12;
#pragma unroll
                for (int j = 0; j < 3; ++j) { u32x2 w; w.x = pk2(hv[4 * j] * rs * nw[j][0] * sigmoidf_(og[4 * j]), hv[4 * j + 1] * rs * nw[j][1] * sigmoidf_(og[4 * j + 1]));
                    w.y = pk2(hv[4 * j + 2] * rs * nw[j][2] * sigmoidf_(og[4 * j + 2]), hv[4 * j + 3] * rs * nw[j][3] * sigmoidf_(og[4 * j + 3])); *(u32x2*)(yo + 4 * j) = w; } }
        }
    }
    GSYNC();
    STAMP(12);

    { pg8::Gemm g{YC, (const bf16_t*)(p.ws + WS_OUT1), DM, DM, M, DM, DM}; pg8::StaticOrder S; S.init(M, DM, G, bid);
      pg8::EpiResidual<false, true> E{nullptr, XB, XB, SS3}; pg8::gemm_phase<pg8::EpiResidual<false, true>, pg8::StaticOrder, true, true>(lds, g, S, E); }
    GSYNC();
    STAMP(13);
    { pg8::Gemm g{XB, (const bf16_t*)(p.ws + WS_GU1), DM, DM, M, 2 * FFN, DM}; pg8::StaticOrder S; S.init(M, 2 * FFN, G, bid);
      pg8::EpiSwiGlu E{HID, FFN, SS3}; pg8::gemm_phase<pg8::EpiSwiGlu, pg8::StaticOrder, true, true>(lds, g, S, E); }
    GSYNC();
    STAMP(14);
    { pg8::Gemm g{HID, (const bf16_t*)(p.ws + WS_D1), FFN, FFN, M, DM, FFN}; pg8::StaticOrder S; S.init(M, DM, G, bid);
      pg8::EpiResidual<false, false> E{nullptr, XB, XB, nullptr}; pg8::gemm_phase<pg8::EpiResidual<false, false>, pg8::StaticOrder, true, true>(lds, g, S, E); }
    GSYNC();
    STAMP(15);

    {
        PHASE_IDS
        const f32x4* gg = (const f32x4*)p.in[3] + lane;
        f32x4 gv[4];
#pragma unroll
        for (int j = 0; j < 4; ++j) gv[j] = gg[64 * j];
        for (int row = bid * 8 + wave; row < M; row += G * 32) {
            u32x2 w[4][4];
#pragma unroll
            for (int r = 0; r < 4; ++r)
#pragma unroll
                for (int j = 0; j < 4; ++j) w[r][j] = ((const u32x2*)(XB + (size_t)(row + r * G * 8) * DM))[64 * j + lane];
#pragma unroll
            for (int r = 0; r < 4; ++r) { f32x4 v[4]; float s = 0.f;
#pragma unroll
                for (int j = 0; j < 4; ++j) { v[j] = (f32x4){bflo(w[r][j].x), bfhi(w[r][j].x), bflo(w[r][j].y), bfhi(w[r][j].y)}; s += (v[j][0] * v[j][0] + v[j][1] * v[j][1]) + (v[j][2] * v[j][2] + v[j][3] * v[j][3]); }
                const float rs = 1.0f / sqrtf(wave_sum(s) * (1.f / DM) + RMS_EPS);
                f32x4* xr = (f32x4*)(p.out + (size_t)(row + r * G * 8) * DM) + lane;
#pragma unroll
                for (int j = 0; j < 4; ++j) xr[64 * j] = v[j] * rs * gv[j]; }
        }
    }
    STAMP(16);
#if PROBE
    if (bid == 0 && threadIdx.x == 0) {
        const unsigned long long* ts = (const unsigned long long*)(p.ws + CTL_TS);
        const int order[18] = {0, 1, 2, 3, 17, 4, 5, 6, 7, 8, 9, 10, 11, 12, 13, 14, 15, 16};
        unsigned long long extra = 0;
        for (int j = 0; j < 17; ++j) if ((PROBE_MASK >> j) & 1) extra += __hip_atomic_load(ts + order[j + 1], __ATOMIC_RELAXED, __HIP_MEMORY_SCOPE_AGENT) - __hip_atomic_load(ts + order[j], __ATOMIC_RELAXED, __HIP_MEMORY_SCOPE_AGENT);
#ifdef PROBE_A
        extra += __hip_atomic_load(ts + PROBE_B, __ATOMIC_RELAXED, __HIP_MEMORY_SCOPE_AGENT) - __hip_atomic_load(ts + PROBE_A, __ATOMIC_RELAXED, __HIP_MEMORY_SCOPE_AGENT);
#endif
        const unsigned long long t0 = __builtin_amdgcn_s_memrealtime();
        while (__builtin_amdgcn_s_memrealtime() - t0 < extra) __builtin_amdgcn_s_sleep(8);
    }
#endif
}

extern "C" void kernel_launch(void* const* d_in, const int* in_sizes, int n_in, void* d_out, int out_size, void* d_ws, size_t ws_size, hipStream_t stream) {
    static int ready = 0;
    if (!ready) {
        if (n_in != 39 || out_size != M * DM || ws_size < WS_END) { fprintf(stderr, "kernel_launch: unexpected problem shape (n_in %d out %d ws %zu)\n", n_in, out_size, ws_size); ready = -1; return; }
        if (hipFuncSetAttribute((const void*)mega, hipFuncAttributeMaxDynamicSharedMemorySize, LDS_BYTES) != hipSuccess) { fprintf(stderr, "kernel_launch: hipFuncSetAttribute failed\n"); ready = -1; return; }
        int per_cu = 0; (void)hipOccupancyMaxActiveBlocksPerMultiprocessor(&per_cu, (const void*)mega, 512, LDS_BYTES);
        if (per_cu < 1) fprintf(stderr, "kernel_launch: occupancy query says %d blocks per CU\n", per_cu);
        (void)hipGetLastError();
        ready = 1;
    }
    if (ready < 0) return;
    (void)hipMemsetAsync((char*)d_ws + WS_CTL, 0, CTL_BYTES, stream);
    Params p{};
    for (int i = 0; i < 39; ++i) p.in[i] = (const float*)d_in[i];
    p.out = (float*)d_out; p.ws = (unsigned char*)d_ws;
    void* args[] = {&p};
    hipError_t e = hipLaunchCooperativeKernel((const void*)mega, dim3(256), dim3(512), args, LDS_BYTES, stream);
    if (e != hipSuccess) fprintf(stderr, "kernel_launch: cooperative launch failed: %s\n", hipGetErrorString(e));
}
```

```cpp
#include <hip/hip_runtime.h>
#include <hip/hip_cooperative_groups.h>
#include <cstdio>
#include <cstdint>
#include <cmath>
namespace cg = cooperative_groups;

#define LAS __attribute__((address_space(3)))
typedef unsigned short bf16_t;
typedef short bf16x8 __attribute__((ext_vector_type(8)));
typedef short s16x4 __attribute__((ext_vector_type(4)));
typedef float f32x4 __attribute__((ext_vector_type(4)));
typedef unsigned u32x4 __attribute__((ext_vector_type(4)));
typedef unsigned u32x2 __attribute__((ext_vector_type(2)));

constexpr int SEQ = 4096, BATCH = 8, DM = 1024, M = BATCH * SEQ;
constexpr int EVEN_IN = 3744, LDU0 = 3840, ODD_IN = 3336, NP1 = 3584, LDU1 = 3712, FFN = 2816;
constexpr float RMS_EPS = 1e-6f;

constexpr size_t MiB = 1u << 20;
constexpr size_t WS_CTL = 0, CTL_BYTES = 1 * MiB;
constexpr size_t CTL_SS1 = 128 * 1024, CTL_SS2 = 256 * 1024, CTL_SS3 = 384 * 1024, CTL_SS0 = 512 * 1024;
constexpr size_t CTL_TS = 800 * 1024;
constexpr size_t CTL_LB = 640 * 1024, CTL_LBR = 644 * 1024, CTL_LBI = 648 * 1024, CTL_BBR = 656 * 1024, CTL_BBI = 720 * 1024;
constexpr size_t WS_IN0 = 1 * MiB, WS_OUT0 = WS_IN0 + (size_t)LDU0 * DM * 2, WS_GU0 = WS_OUT0 + 2 * MiB, WS_D0 = WS_GU0 + 11 * MiB;
constexpr size_t WS_IN1 = WS_D0 + (size_t)DM * FFN * 2, WS_OUT1 = WS_IN1 + (size_t)NP1 * DM * 2, WS_GU1 = WS_OUT1 + 2 * MiB, WS_D1 = WS_GU1 + 11 * MiB;
constexpr size_t WS_GLU = WS_D1 + (size_t)DM * FFN * 2;
constexpr size_t WS_LORA = WS_GLU + 256 * 256 * 2;
constexpr size_t WS_XB = 53 * MiB, WS_YC = 117 * MiB, WS_U = 181 * MiB, WS_MS = 421 * MiB, WS_END = 512 * MiB;
constexpr size_t WS_SSQ = WS_MS + 70 * MiB;
static_assert(WS_LORA + 512 * 160 * 2 <= WS_XB, "weights fit");
static_assert(WS_U + (size_t)M * LDU0 * 2 <= WS_MS, "U fits");

__device__ __forceinline__ float bf2f(bf16_t h) { return __uint_as_float(((unsigned)h) << 16); }
__device__ __forceinline__ float bflo(unsigned w) { return __uint_as_float(w << 16); }
__device__ __forceinline__ unsigned long long ss_fix(float s) { return (unsigned long long)(s * 1048576.0f); }
__device__ __forceinline__ float ss_flt(unsigned long long q) { return ((float)(unsigned)(q >> 32) * 4294967296.0f + (float)(unsigned)q) * (1.0f / 1048576.0f); }
__device__ __forceinline__ float bfhi(unsigned w) { return __uint_as_float(w & 0xffff0000u); }
typedef __bf16 bf16x2_t __attribute__((ext_vector_type(2)));
typedef float f32x2c_t __attribute__((ext_vector_type(2)));
__device__ __forceinline__ unsigned pk2(float lo, float hi) { const bf16x2_t v = __builtin_convertvector((f32x2c_t){lo, hi}, bf16x2_t); return __builtin_bit_cast(unsigned, v); }
__device__ __forceinline__ bf16_t f2bf(float f) { const __bf16 b = (__bf16)f; return __builtin_bit_cast(bf16_t, b); }
__device__ __forceinline__ float sigmoidf_(float x) { return __builtin_amdgcn_rcpf(1.f + __expf(-x)); }
__device__ __forceinline__ float rsqrtf_(float x) { return __builtin_amdgcn_rsqf(x); }
__device__ __forceinline__ float siluf_(float x) { return x * sigmoidf_(x); }
__device__ __forceinline__ float softplusf_(float x) { return fmaxf(x, 0.f) + __logf(1.f + __expf(-fabsf(x))); }
__device__ __forceinline__ float tanhf_(float x) { const float e = __expf(-2.f * fabsf(x)); const float t = (1.f - e) * __builtin_amdgcn_rcpf(1.f + e); return x < 0.f ? -t : t; }
template <int CTRL> __device__ __forceinline__ float dpp_mov(float x) { return __int_as_float(__builtin_amdgcn_update_dpp(0, __float_as_int(x), CTRL, 0xf, 0xf, true)); }
__device__ __forceinline__ float row_sum16(float v) { v += dpp_mov<0xB1>(v); v += dpp_mov<0x4E>(v); v += dpp_mov<0x141>(v); v += dpp_mov<0x140>(v); return v; }
__device__ __forceinline__ float xrow16(float v) { const auto r = __builtin_amdgcn_permlane16_swap(__float_as_uint(v), __float_as_uint(v), false, false); return __uint_as_float(r[0]) + __uint_as_float(r[1]); }
__device__ __forceinline__ float xrow32(float v) { const auto r = __builtin_amdgcn_permlane32_swap(__float_as_uint(v), __float_as_uint(v), false, false); return __uint_as_float(r[0]) + __uint_as_float(r[1]); }
__device__ __forceinline__ float half_sum(float v) { return xrow16(row_sum16(v)); }
__device__ __forceinline__ float wave_sum(float v) { return xrow32(half_sum(v)); }

typedef float f32x2 __attribute__((ext_vector_type(2)));
__device__ __forceinline__ void half_reduce8(const float (&p)[8], int lane, float& o0, float& o1) {
    const bool b0 = (lane & 1) != 0, b1 = (lane & 2) != 0;
    float r[4];
#pragma unroll
    for (int i = 0; i < 4; ++i) { const float keep = b0 ? p[2 * i + 1] : p[2 * i], send = b0 ? p[2 * i] : p[2 * i + 1]; r[i] = keep + dpp_mov<0xB1>(send); }
    float q0, q1;
    { const float keep = b1 ? r[1] : r[0], send = b1 ? r[0] : r[1]; q0 = keep + dpp_mov<0x4E>(send); }
    { const float keep = b1 ? r[3] : r[2], send = b1 ? r[2] : r[3]; q1 = keep + dpp_mov<0x4E>(send); }
    q0 += dpp_mov<0x124>(q0); q0 += dpp_mov<0x128>(q0);
    q1 += dpp_mov<0x124>(q1); q1 += dpp_mov<0x128>(q1);
    o0 = xrow16(q0); o1 = xrow16(q1);
}

#define LBAR() do { asm volatile("s_waitcnt lgkmcnt(0)" ::: "memory"); __builtin_amdgcn_s_barrier(); asm volatile("" ::: "memory"); } while (0)
namespace pg8 {
constexpr int BM = 256, BK = 64, HALF = 128, HTB = HALF * BK * 2, STAGE_BYTES = 8 * HTB, NXCD = 8, WGM = 8;
__device__ __forceinline__ int lds_byte(int r, int c) { const int st = (r >> 4) * 2 + (c >> 5), rr = r & 15, cc = c & 31, ob = rr * 64 + cc * 2; return st * 1024 + (ob ^ (((ob >> 9) & 1) << 5)); }
__device__ __forceinline__ void stage_rc(int b, int& R, int& C) { const int st = b / 1024, sb = b % 1024, swz = sb ^ (((sb >> 9) & 1) << 5); R = (st >> 1) * 16 + swz / 64; C = (st & 1) * 32 + (swz % 64) / 2; }
__device__ __forceinline__ int perm32(int rho) { const int n = rho >> 4, i = rho & 15; return 8 * (i >> 2) + 4 * n + (i & 3); }
struct Unit { int pm, pn; };
struct Gemm { const bf16_t* A; const bf16_t* Bt; int lda, ldb, M, N, K; };
struct StaticOrder {
    int nM, nN, nwg, G, c;
    __device__ void init(int M_, int N_, int G_, int c_) { nM = M_ / BM; nN = N_ / BM; nwg = nM * nN; G = G_; c = c_; }
    __device__ bool next(int i, Unit& u) const {
        const long L = (long)i * G + c; if (L >= nwg) return false;
        int wgid = (int)L; { const int q = nwg / NXCD, r = nwg % NXCD, xcd = wgid % NXCD, off = wgid / NXCD; wgid = (xcd < r ? xcd * (q + 1) : r * (q + 1) + (xcd - r) * q) + off; }
        const int nig = WGM * nN, gid = wgid / nig, fm = gid * WGM, gsz = (nM - fm) < WGM ? (nM - fm) : WGM;
        u.pm = fm + ((wgid % nig) % gsz); u.pn = (wgid % nig) / gsz; return true;
    }
};

struct EpiScaleBf16 {
    static constexpr bool PERM = true;
    bf16_t* O; int ldc; const unsigned long long* ss;
    __device__ __forceinline__ void operator()(const f32x4 (&acc)[2][2][4][2], const Unit& u, int wr, int wc, int fr, int fq) const {
        const int row0 = u.pm * BM + wr * 64 + fr, col0 = u.pn * BM + wc * 32 + 8 * fq;
#pragma unroll
        for (int ai = 0; ai < 2; ++ai)
#pragma unroll
            for (int m = 0; m < 4; ++m) { const int row = row0 + ai * HALF + m * 16; const float rs = rsqrtf_(ss_flt(ss[row]) * (1.f / DM) + RMS_EPS);
                bf16_t* rowp = O + (size_t)row * ldc + col0;
#pragma unroll
                for (int bj = 0; bj < 2; ++bj) { const f32x4 v0 = acc[ai][bj][m][0] * rs, v1 = acc[ai][bj][m][1] * rs;
                    u32x4 w; w.x = pk2(v0[0], v0[1]); w.y = pk2(v0[2], v0[3]); w.z = pk2(v1[0], v1[1]); w.w = pk2(v1[2], v1[3]);
                    *(u32x4*)(rowp + bj * HALF) = w; } }
    }
};
struct EpiSwiGlu {
    static constexpr bool PERM = true;
    bf16_t* O; int ldc; const unsigned long long* ss;
    __device__ __forceinline__ void operator()(const f32x4 (&acc)[2][2][4][2], const Unit& u, int wr, int wc, int fr, int fq) const {
        const int row0 = u.pm * BM + wr * 64 + fr, col0 = u.pn * HALF + wc * 32 + 8 * fq;
#pragma unroll
        for (int ai = 0; ai < 2; ++ai)
#pragma unroll
            for (int m = 0; m < 4; ++m) { const int row = row0 + ai * HALF + m * 16; const float rs = rsqrtf_(ss_flt(ss[row]) * (1.f / DM) + RMS_EPS);
                f32x4 h[2];
#pragma unroll
                for (int n = 0; n < 2; ++n) { const f32x4 g = acc[ai][0][m][n] * rs, up = acc[ai][1][m][n] * rs;
#pragma unroll
                    for (int e = 0; e < 4; ++e) h[n][e] = siluf_(g[e]) * up[e]; }
                u32x4 w; w.x = pk2(h[0][0], h[0][1]); w.y = pk2(h[0][2], h[0][3]); w.z = pk2(h[1][0], h[1][1]); w.w = pk2(h[1][2], h[1][3]);
                *(u32x4*)(O + (size_t)row * ldc + col0) = w; }
    }
};
template <bool BASE_F32, bool WITH_SS> struct EpiResidual {
    static constexpr bool PERM = true;
    const float* base32; const bf16_t* base16; bf16_t* xb; unsigned long long* ss;
    __device__ __forceinline__ void operator()(const f32x4 (&acc)[2][2][4][2], const Unit& u, int wr, int wc, int fr, int fq) const {
        const int row0 = u.pm * BM + wr * 64 + fr, col0 = u.pn * BM + wc * 32 + 8 * fq;
#pragma unroll
        for (int ai = 0; ai < 2; ++ai)
#pragma unroll
            for (int m = 0; m < 4; ++m) { const int row = row0 + ai * HALF + m * 16; const size_t off = (size_t)row * DM + col0; float s = 0.f;
#pragma unroll
                for (int bj = 0; bj < 2; ++bj) { const size_t o = off + bj * HALF; f32x4 r0, r1;
                    if (BASE_F32) { r0 = *(const f32x4*)(base32 + o); r1 = *(const f32x4*)(base32 + o + 4); }
                    else { const u32x4 rb = *(const u32x4*)(base16 + o); r0 = (f32x4){bflo(rb.x), bfhi(rb.x), bflo(rb.y), bfhi(rb.y)}; r1 = (f32x4){bflo(rb.z), bfhi(rb.z), bflo(rb.w), bfhi(rb.w)}; }
                    const f32x4 v0 = r0 + acc[ai][bj][m][0], v1 = r1 + acc[ai][bj][m][1];
                    u32x4 w; w.x = pk2(v0[0], v0[1]); w.y = pk2(v0[2], v0[3]); w.z = pk2(v1[0], v1[1]); w.w = pk2(v1[2], v1[3]); *(u32x4*)(xb + o) = w;
                    s += ((v0[0] * v0[0] + v0[1] * v0[1]) + (v0[2] * v0[2] + v0[3] * v0[3])) + ((v1[0] * v1[0] + v1[1] * v1[1]) + (v1[2] * v1[2] + v1[3] * v1[3])); }
                if (WITH_SS) { s = xrow32(xrow16(s)); if (fq == 0) atomicAdd(ss + row, ss_fix(s)); } }
    }
};

template <class Epi, class Sched, bool ALIGN_EPI, bool SP2>
__device__ __forceinline__ void gemm_phase(LAS unsigned char* lds, const Gemm g, const Sched& S, const Epi& E) {
    int tid_ = threadIdx.x; asm volatile("" : "+v"(tid_));
    const int tid = tid_, wid = __builtin_amdgcn_readfirstlane(tid >> 6), lane = tid & 63, wr = wid >> 2, wc = wid & 3, fr = lane & 15, fq = lane >> 4;
    const int K = g.K, nt = K / BK;
    unsigned voffA[2], voffB[2];
#pragma unroll
    for (int i = 0; i < 2; ++i) { int R, C; stage_rc(tid * 16 + i * 8192, R, C); const int Rb = Epi::PERM ? ((R & ~31) + perm32(R & 31)) : R;
        voffA[i] = (unsigned)(R * g.lda + C) * 2u; voffB[i] = (unsigned)(Rb * g.ldb + C) * 2u; }
    const size_t kstep = (size_t)(BK * 2);
    const size_t hstepA = (size_t)HALF * g.lda * 2, hstepB = (size_t)HALF * g.ldb * 2;
    const size_t tstepA = 2 * hstepA, tstepB = 2 * hstepB;
    const unsigned ldsw = (unsigned)wid * 1024u;
    const int aoff = lds_byte(wr * 64 + fr, fq * 8), boff = lds_byte(wc * 32 + fr, fq * 8);
#define PG8_SA(b, h) (((b) * 2 + (h)) * HTB)
#define PG8_SB(b, h) ((4 + (b) * 2 + (h)) * HTB)
#define PG8_STAGE(bufoff, gbase, voff) do { _Pragma("unroll") for (int _i = 0; _i < 2; ++_i) \
        __builtin_amdgcn_global_load_lds((const unsigned*)((const char*)(gbase) + (voff)[_i]), (LAS unsigned*)(lds + (bufoff) + ldsw + _i * 8192), 16, 0, 0); } while (0)
#define PG8_LDA(dst, b, h) do { _Pragma("unroll") for (int m = 0; m < 4; ++m) _Pragma("unroll") for (int k = 0; k < 2; ++k) dst[m][k] = *(const LAS bf16x8*)(lds + PG8_SA(b, h) + aoff + m * 2048 + k * 1024); } while (0)
#define PG8_LDB(dst, b, h) do { _Pragma("unroll") for (int n = 0; n < 2; ++n) _Pragma("unroll") for (int k = 0; k < 2; ++k) dst[n][k] = *(const LAS bf16x8*)(lds + PG8_SB(b, h) + boff + n * 2048 + k * 1024); } while (0)
#define PG8_MMA(ai, bj, At, Bt) do { __builtin_amdgcn_s_setprio(1); _Pragma("unroll") for (int m = 0; m < 4; ++m) _Pragma("unroll") for (int n = 0; n < 2; ++n) _Pragma("unroll") for (int k = 0; k < 2; ++k) \
        acc[ai][bj][m][n] = __builtin_amdgcn_mfma_f32_16x16x32_bf16(Bt[n][k], At[m][k], acc[ai][bj][m][n], 0, 0, 0); __builtin_amdgcn_s_setprio(0); } while (0)
#define PG8_WAIT_V(n) asm volatile("s_waitcnt vmcnt(" #n ")" ::: "memory")
#define PG8_WAIT_L(n) asm volatile("s_waitcnt lgkmcnt(" #n ")" ::: "memory")
#define PG8_BAR __builtin_amdgcn_s_barrier()
#define PG8_SCHED __builtin_amdgcn_sched_barrier(0)
    Unit cur, nxt; int ui = 0;
    if (!S.next(0, cur)) return;
    f32x4 acc[2][2][4][2];
#pragma unroll
    for (int a = 0; a < 2; ++a)
#pragma unroll
        for (int b = 0; b < 2; ++b)
#pragma unroll
            for (int m = 0; m < 4; ++m)
#pragma unroll
                for (int n = 0; n < 2; ++n) acc[a][b][m][n] = (f32x4){0.f, 0.f, 0.f, 0.f};
    bf16x8 At[4][2], B0[2][2], B1[2][2];
    const char* cA = (const char*)g.A + (size_t)cur.pm * tstepA; const char* cB = (const char*)g.Bt + (size_t)cur.pn * tstepB;
    if constexpr (SP2) {
        PG8_STAGE(PG8_SB(0, 0), cB, voffB); PG8_STAGE(PG8_SB(0, 1), cB + hstepB, voffB); PG8_STAGE(PG8_SA(0, 0), cA, voffA); PG8_STAGE(PG8_SA(0, 1), cA + hstepA, voffA);
        if (wr == 1) PG8_BAR;
        PG8_WAIT_V(2); PG8_BAR;
        PG8_STAGE(PG8_SB(1, 0), cB + kstep, voffB); PG8_STAGE(PG8_SA(1, 0), cA + kstep, voffA); PG8_STAGE(PG8_SB(1, 1), cB + hstepB + kstep, voffB);
        PG8_WAIT_V(6); PG8_BAR;
    } else {
        PG8_STAGE(PG8_SB(0, 0), cB, voffB); PG8_STAGE(PG8_SA(0, 0), cA, voffA); PG8_STAGE(PG8_SB(0, 1), cB + hstepB, voffB); PG8_STAGE(PG8_SA(0, 1), cA + hstepA, voffA);
        if (wr == 1) PG8_BAR;
        PG8_WAIT_V(4); PG8_BAR;
        PG8_STAGE(PG8_SB(1, 0), cB + kstep, voffB); PG8_STAGE(PG8_SA(1, 0), cA + kstep, voffA); PG8_STAGE(PG8_SB(1, 1), cB + hstepB + kstep, voffB);
        PG8_WAIT_V(6); PG8_BAR;
    }
    for (;;) {
        const bool has_next = S.next(ui + 1, nxt);
        const char* nA = has_next ? (const char*)g.A + (size_t)nxt.pm * tstepA : cA; const char* nB = has_next ? (const char*)g.Bt + (size_t)nxt.pn * tstepB : cB;
        for (int t = 0; t < nt; t += 2) {
            const bool last = (t == nt - 2);
            const char* a1 = cA + (size_t)(t + 1) * kstep;
            const char* a2 = last ? nA : cA + (size_t)(t + 2) * kstep; const char* b2 = last ? nB : cB + (size_t)(t + 2) * kstep;
            const char* a3 = a2 + kstep; const char* b3 = b2 + kstep;
            if constexpr (SP2) {
            PG8_LDB(B0, 0, 0); PG8_LDB(B1, 0, 1); PG8_SCHED; PG8_LDA(At, 0, 0); PG8_STAGE(PG8_SA(1, 1), a1 + hstepA, voffA);
            PG8_WAIT_V(8); PG8_WAIT_L(0); PG8_BAR; PG8_MMA(0, 0, At, B0); PG8_MMA(0, 1, At, B1); PG8_BAR; PG8_SCHED;
            PG8_LDA(At, 0, 1); PG8_STAGE(PG8_SB(0, 0), b2, voffB); PG8_STAGE(PG8_SB(0, 1), b2 + hstepB, voffB); PG8_STAGE(PG8_SA(0, 0), a2, voffA);
            PG8_WAIT_V(8); PG8_WAIT_L(0); PG8_BAR; PG8_MMA(1, 0, At, B0); PG8_MMA(1, 1, At, B1); PG8_BAR; PG8_SCHED;
            PG8_LDB(B0, 1, 0); PG8_LDB(B1, 1, 1); PG8_SCHED; PG8_LDA(At, 1, 0); PG8_STAGE(PG8_SA(0, 1), a2 + hstepA, voffA);
            PG8_WAIT_V(8); PG8_WAIT_L(0); PG8_BAR; PG8_MMA(0, 0, At, B0); PG8_MMA(0, 1, At, B1); PG8_BAR; PG8_SCHED;
            PG8_LDA(At, 1, 1); PG8_STAGE(PG8_SB(1, 0), b3, voffB); PG8_STAGE(PG8_SB(1, 1), b3 + hstepB, voffB); PG8_STAGE(PG8_SA(1, 0), a3, voffA);
            PG8_WAIT_V(8); PG8_WAIT_L(0); PG8_BAR; PG8_MMA(1, 0, At, B0); PG8_MMA(1, 1, At, B1); PG8_BAR; PG8_SCHED;
            } else {
            PG8_LDB(B0, 0, 0); PG8_SCHED; PG8_LDA(At, 0, 0); PG8_STAGE(PG8_SA(1, 1), a1 + hstepA, voffA);
            PG8_WAIT_L(8); PG8_BAR; PG8_WAIT_L(0); PG8_MMA(0, 0, At, B0); PG8_BAR; PG8_SCHED;
            PG8_LDB(B1, 0, 1); PG8_STAGE(PG8_SB(0, 0), b2, voffB);
            PG8_BAR; PG8_WAIT_L(0); PG8_MMA(0, 1, At, B1); PG8_BAR;
            PG8_LDA(At, 0, 1); PG8_STAGE(PG8_SA(0, 0), a2, voffA);
            PG8_BAR; PG8_WAIT_L(0); PG8_MMA(1, 0, At, B0); PG8_BAR; PG8_SCHED;
            PG8_STAGE(PG8_SB(0, 1), b2 + hstepB, voffB);
            PG8_WAIT_V(6); PG8_BAR; PG8_MMA(1, 1, At, B1); PG8_BAR;
            PG8_LDB(B0, 1, 0); PG8_SCHED; PG8_LDA(At, 1, 0); PG8_STAGE(PG8_SA(0, 1), a2 + hstepA, voffA);
            PG8_WAIT_L(8); PG8_BAR; PG8_WAIT_L(0); PG8_MMA(0, 0, At, B0); PG8_BAR; PG8_SCHED;
            PG8_LDB(B1, 1, 1); PG8_STAGE(PG8_SB(1, 0), b3, voffB);
            PG8_BAR; PG8_WAIT_L(0); PG8_MMA(0, 1, At, B1); PG8_BAR;
            PG8_LDA(At, 1, 1); PG8_STAGE(PG8_SA(1, 0), a3, voffA);
            PG8_BAR; PG8_WAIT_L(0); PG8_MMA(1, 0, At, B0); PG8_BAR; PG8_SCHED;
            PG8_STAGE(PG8_SB(1, 1), b3 + hstepB, voffB);
            PG8_WAIT_V(6); PG8_BAR; PG8_MMA(1, 1, At, B1); PG8_BAR;
            }
        }
        if constexpr (ALIGN_EPI) { if (wr == 0) PG8_BAR; }
        E(acc, cur, wr, wc, fr, fq);
        if (!has_next) break;
#pragma unroll
        for (int a = 0; a < 2; ++a)
#pragma unroll
            for (int b = 0; b < 2; ++b)
#pragma unroll
                for (int m = 0; m < 4; ++m)
#pragma unroll
                    for (int n = 0; n < 2; ++n) acc[a][b][m][n] = (f32x4){0.f, 0.f, 0.f, 0.f};
        cur = nxt; cA = nA; cB = nB; ++ui;
        if constexpr (ALIGN_EPI) { if (wr == 1) PG8_BAR; }
    }
    PG8_WAIT_V(0);
    if constexpr (!ALIGN_EPI) { if (wr == 0) PG8_BAR; }
    PG8_BAR;
#undef PG8_SA
#undef PG8_SB
#undef PG8_STAGE
#undef PG8_LDA
#undef PG8_LDB
#undef PG8_MMA
#undef PG8_WAIT_V
#undef PG8_WAIT_L
#undef PG8_BAR
#undef PG8_SCHED
}
}

#define XB_TMO      128
#define XB_XCNT(j)  (256  + 64 * (j))
#define XB_XSUB(j)  (1280 + 64 * (j))
#define XB_XGEN(j)  (2304 + 64 * (j))
#define XB_TOP      3328
#define XB_TOPGEN   3392
#define XCD_BAR_WORDS 3456
#define XB_SPIN_CAP (1u << 18)
__device__ __forceinline__ unsigned xb_ld(unsigned* p)              { return __hip_atomic_load(p, __ATOMIC_RELAXED, __HIP_MEMORY_SCOPE_AGENT); }
__device__ __forceinline__ unsigned xb_add(unsigned* p, unsigned v) { return __hip_atomic_fetch_add(p, v, __ATOMIC_RELAXED, __HIP_MEMORY_SCOPE_AGENT); }
__device__ __forceinline__ unsigned xb_xcc_id() { return (unsigned)__builtin_amdgcn_s_getreg((3 << 11) | 20) & 0xFu; }
#define XB_SPIN(cond, bar) do { unsigned _sp = 0; while (cond) { __builtin_amdgcn_s_sleep(1); \
    if ((++_sp & 255u) == 0u) { if (xb_ld(&(bar)[XB_TMO])) break; if (_sp > XB_SPIN_CAP) { atomicAdd(&(bar)[XB_TMO], 1u); break; } } } } while (0)
struct XcdBarrier { unsigned* bar; unsigned x; volatile LAS unsigned* st; };
__device__ __forceinline__ XcdBarrier xcd_barrier_post(unsigned* bar, volatile LAS unsigned* st) {
    XcdBarrier b; b.bar = bar; b.x = xb_xcc_id(); b.st = st;
    if (threadIdx.x == 0) (void)xb_add(&bar[XB_XCNT(b.x)], 1u);
    return b;
}
__device__ __forceinline__ void xcd_barrier_complete(unsigned* bar, unsigned x, unsigned& nloc, unsigned& nx) {
    const unsigned G = gridDim.x * gridDim.y * gridDim.z;
    unsigned sum, cnt, mine, sp = 0u;
    for (;;) {
        sum = 0u; cnt = 0u; mine = 0u;
#pragma unroll
        for (unsigned j = 0; j < 16; ++j) { const unsigned c = xb_ld(&bar[XB_XCNT(j)]); sum += c; cnt += (c > 0u) ? 1u : 0u; mine = (j == x) ? c : mine; }
        if (sum == G) break;
        __builtin_amdgcn_s_sleep(1);
        if ((++sp & 255u) == 0u) { if (xb_ld(&bar[XB_TMO])) break; if (sp > XB_SPIN_CAP) { atomicAdd(&bar[XB_TMO], 1u); break; } }
    }
    nloc = mine > 0u ? mine : 1u; nx = cnt > 0u ? cnt : 1u;
}
__device__ __forceinline__ void xcd_barrier(const XcdBarrier& b, const int tid0) {
    asm volatile("s_waitcnt vmcnt(0)" ::: "memory");
    __syncthreads();
    if (tid0 == 0) {
        unsigned* bar = b.bar;
        __builtin_amdgcn_s_waitcnt(0);
        unsigned nloc = b.st[0], nx = b.st[1];
        if (nloc == 0u) { xcd_barrier_complete(bar, b.x, nloc, nx); b.st[0] = nloc; b.st[1] = nx; }
        const unsigned old = xb_add(&bar[XB_XSUB(b.x)], 1u);
        const unsigned gen = old / nloc;
        if (old + 1u == (gen + 1u) * nloc) {
            __builtin_amdgcn_fence(__ATOMIC_RELEASE, "agent");
            asm volatile("s_waitcnt vmcnt(0)" ::: "memory");
            const unsigned og = xb_add(&bar[XB_TOP], 1u);
            const unsigned tg = og / nx;
            if (og + 1u == (tg + 1u) * nx) xb_add(&bar[XB_TOPGEN], 1u);
            else XB_SPIN(xb_ld(&bar[XB_TOPGEN]) == tg, bar);
            __builtin_amdgcn_fence(__ATOMIC_ACQUIRE, "agent");
            xb_add(&bar[XB_XGEN(b.x)], 1u);
            asm volatile("s_waitcnt vmcnt(0)" ::: "memory");
        } else {
            XB_SPIN(xb_ld(&bar[XB_XGEN(b.x)]) == gen, bar);
            __builtin_amdgcn_fence(__ATOMIC_ACQUIRE, "agent");
            asm volatile("s_waitcnt vmcnt(0)" ::: "memory");
        }
    }
    __syncthreads();
}

constexpr int LDS_BYTES = 147456;
struct Params { const float* in[39]; float* out; unsigned char* ws; };

struct TrTile { const float* W; const float* gain; bf16_t* dst; int N, Npad, ldb, mode, k0, n0; };
__device__ __forceinline__ void tr_load(const TrTile& t, int tid, f32x4 (&v)[8], float (&gv)[8]) {
    const float* gp = t.gain ? t.gain : t.W;
#pragma unroll
    for (int i = 0; i < 8; ++i) { const int pp = tid + 512 * i, kk = pp >> 6, n = t.n0 + (pp & 63) * 4; const bool inb = n + 3 < t.N;
        v[i] = *(const f32x4*)(t.W + (size_t)(t.k0 + kk) * t.N + (inb ? n : 0)); gv[i] = gp[t.k0 + kk]; }
}
__device__ __forceinline__ void tr_to_lds(const TrTile& t, int tid, const f32x4 (&v)[8], const float (&gv)[8], LAS unsigned char* l) {
#pragma unroll
    for (int i = 0; i < 8; ++i) { const int pp = tid + 512 * i, kk = pp >> 6, n4 = (pp & 63) * 4; const bool inb = t.n0 + n4 + 3 < t.N;
        const float g = t.gain ? gv[i] : 1.f; const f32x4 x = inb ? v[i] * g : (f32x4){0.f, 0.f, 0.f, 0.f};
        u32x2 w; w.x = pk2(x[0], x[1]); w.y = pk2(x[2], x[3]); *(LAS u32x2*)(l + kk * 528 + n4 * 2) = w; }
}
__device__ __forceinline__ void tr_store(const TrTile& t, int tid, const LAS unsigned char* l) {
#pragma unroll
    for (int i = 0; i < 4; ++i) { const int pp = tid + 512 * i, n = pp >> 3, c = pp & 7; const int jn = t.n0 + n;
        if (jn < t.Npad) { const LAS bf16_t* s = (const LAS bf16_t*)(l + (8 * c) * 528) + n;
            const int drow = t.mode == 0 ? jn : ((jn >> 7) * 256 + (jn & 127) + (t.mode == 2 ? 128 : 0));
            u32x4 o; o.x = (unsigned)s[0] | ((unsigned)s[264] << 16); o.y = (unsigned)s[2 * 264] | ((unsigned)s[3 * 264] << 16); o.z = (unsigned)s[4 * 264] | ((unsigned)s[5 * 264] << 16); o.w = (unsigned)s[6 * 264] | ((unsigned)s[7 * 264] << 16);
            *(u32x4*)(t.dst + (size_t)drow * t.ldb + t.k0 + 8 * c) = o; } }
}

__global__ void __launch_bounds__(512, 2) mega(Params p) {
    extern __shared__ __attribute__((aligned(16))) unsigned char lds_raw[];
    LAS unsigned char* lds = (LAS unsigned char*)lds_raw;
    cg::grid_group grid = cg::this_grid();
    const int G = gridDim.x, bid = blockIdx.x;
#define PHASE_IDS int tid_o = threadIdx.x; asm volatile("" : "+v"(tid_o)); const int tid = tid_o, lane = tid & 63, wave = tid >> 6; (void)lane; (void)wave;
#define SS0 ((unsigned long long*)(p.ws + WS_SSQ))
#define SS1 (SS0 + M)
#define SS2 (SS0 + 2 * M)
#define SS3 (SS0 + 3 * M)
#define LBT ((float*)(p.ws + CTL_LB))
#define LBR ((float*)(p.ws + CTL_LBR))
#define LBI ((float*)(p.ws + CTL_LBI))
#define BBR ((float*)(p.ws + CTL_BBR))
#define BBI ((float*)(p.ws + CTL_BBI))
#define XB ((bf16_t*)(p.ws + WS_XB))
#define YC ((bf16_t*)(p.ws + WS_YC))
#define U ((bf16_t*)(p.ws + WS_U))
    { volatile LAS unsigned* st0 = (volatile LAS unsigned*)(lds + LDS_BYTES - 64); if (threadIdx.x < 16) st0[threadIdx.x] = 0u; }
    __syncthreads();
    (void)xcd_barrier_post((unsigned*)(p.ws + WS_CTL), (volatile LAS unsigned*)(lds + LDS_BYTES - 64));
#ifndef PROBE
#define PROBE 0
#endif
#ifndef PROBE_MASK
#define PROBE_MASK 0
#endif
#define STAMP(k) do { if (PROBE && bid == 0 && threadIdx.x == 0) ((unsigned long long*)(p.ws + CTL_TS))[k] = __builtin_amdgcn_s_memrealtime(); } while (0)
#define STAMP2(k, blk) do { if (PROBE && bid == (blk) && threadIdx.x == 0) ((unsigned long long*)(p.ws + CTL_TS))[k] = __builtin_amdgcn_s_memrealtime(); } while (0)
    STAMP(0);
#define GSYNC() do { XcdBarrier xb_; xb_.bar = (unsigned*)(p.ws + WS_CTL); xb_.x = xb_xcc_id(); xb_.st = (volatile LAS unsigned*)(lds + LDS_BYTES - 64); xcd_barrier(xb_, (int)threadIdx.x); } while (0)

    {
        PHASE_IDS
        constexpr int T_IN0 = 16 * 15, T_SQ = 16 * 4, T_GU = 16 * 11, T_DN = 44 * 4, T_IN1 = 16 * 14, T_GL = 4 * 1;
        constexpr int NT = T_IN0 + T_SQ + 2 * T_GU + T_DN + T_IN1 + T_SQ + 2 * T_GU + T_DN + T_GL;
#define P0_DECODE(T_, it_) { int r = (it_); const float* W; const float* gain; bf16_t* dst; int N, Npad, nNt, ldb, mode; \
            if (r < T_IN0) { W = p.in[4]; gain = p.in[1]; dst = (bf16_t*)(p.ws + WS_IN0); N = EVEN_IN; Npad = LDU0; nNt = 15; ldb = DM; mode = 0; } \
            else if ((r -= T_IN0) < T_SQ) { W = p.in[5]; gain = nullptr; dst = (bf16_t*)(p.ws + WS_OUT0); N = DM; Npad = DM; nNt = 4; ldb = DM; mode = 0; } \
            else if ((r -= T_SQ) < T_GU) { W = p.in[36]; gain = p.in[2]; dst = (bf16_t*)(p.ws + WS_GU0); N = FFN; Npad = FFN; nNt = 11; ldb = DM; mode = 1; } \
            else if ((r -= T_GU) < T_GU) { W = p.in[37]; gain = p.in[2]; dst = (bf16_t*)(p.ws + WS_GU0); N = FFN; Npad = FFN; nNt = 11; ldb = DM; mode = 2; } \
            else if ((r -= T_GU) < T_DN) { W = p.in[38]; gain = nullptr; dst = (bf16_t*)(p.ws + WS_D0); N = DM; Npad = DM; nNt = 4; ldb = FFN; mode = 0; } \
            else if ((r -= T_DN) < T_IN1) { W = p.in[19]; gain = p.in[1] + DM; dst = (bf16_t*)(p.ws + WS_IN1); N = ODD_IN; Npad = NP1; nNt = 14; ldb = DM; mode = 0; } \
            else if ((r -= T_IN1) < T_SQ) { W = p.in[20]; gain = nullptr; dst = (bf16_t*)(p.ws + WS_OUT1); N = DM; Npad = DM; nNt = 4; ldb = DM; mode = 0; } \
            else if ((r -= T_SQ) < T_GU) { W = p.in[36] + (size_t)DM * FFN; gain = p.in[2] + DM; dst = (bf16_t*)(p.ws + WS_GU1); N = FFN; Npad = FFN; nNt = 11; ldb = DM; mode = 1; } \
            else if ((r -= T_GU) < T_GU) { W = p.in[37] + (size_t)DM * FFN; gain = p.in[2] + DM; dst = (bf16_t*)(p.ws + WS_GU1); N = FFN; Npad = FFN; nNt = 11; ldb = DM; mode = 2; } \
            else if ((r -= T_GU) < T_DN) { W = p.in[38] + (size_t)FFN * DM; gain = nullptr; dst = (bf16_t*)(p.ws + WS_D1); N = DM; Npad = DM; nNt = 4; ldb = FFN; mode = 0; } \
            else { r -= T_DN; W = p.in[29]; gain = nullptr; dst = (bf16_t*)(p.ws + WS_GLU); N = 256; Npad = 256; nNt = 1; ldb = 256; mode = 0; } \
            T_.W = W; T_.gain = gain; T_.dst = dst; T_.N = N; T_.Npad = Npad; T_.ldb = ldb; T_.mode = mode; T_.k0 = (r / nNt) * 64; T_.n0 = (r % nNt) * 256; }
        if (bid < NT) {
            TrTile cur, nxt; f32x4 tv[8]; float tg[8];
            P0_DECODE(cur, bid); tr_load(cur, tid, tv, tg);
            for (int it = bid; it < NT; it += G) {
                const int itn = (it + G < NT) ? it + G : it; P0_DECODE(nxt, itn);
                __syncthreads();
                tr_to_lds(cur, tid, tv, tg, lds);
                tr_load(nxt, tid, tv, tg);
                __syncthreads();
                tr_store(cur, tid, lds);
                cur = nxt;
            }
        }
#undef P0_DECODE
        const float* x = p.in[0];
        for (int row = bid * 8 + wave; row < M; row += G * 16) {
            const int row2 = row + G * 8; const bool has2 = row2 < M;
            const f32x4* xr = (const f32x4*)(x + (size_t)row * DM) + lane; const f32x4* xr2 = (const f32x4*)(x + (size_t)(has2 ? row2 : row) * DM) + lane; f32x4 v[4], v2[4]; float s = 0.f, s2 = 0.f;
#pragma unroll
            for (int j = 0; j < 4; ++j) { v[j] = xr[64 * j]; v2[j] = xr2[64 * j]; }
#pragma unroll
            for (int j = 0; j < 4; ++j) { s += (v[j][0] * v[j][0] + v[j][1] * v[j][1]) + (v[j][2] * v[j][2] + v[j][3] * v[j][3]); s2 += (v2[j][0] * v2[j][0] + v2[j][1] * v2[j][1]) + (v2[j][2] * v2[j][2] + v2[j][3] * v2[j][3]); }
            s = wave_sum(s); s2 = wave_sum(s2); if (lane == 0) { SS0[row] = ss_fix(s); if (has2) SS0[row2] = ss_fix(s2); }
            u32x2* o = (u32x2*)(XB + (size_t)row * DM) + lane; u32x2* o2 = (u32x2*)(XB + (size_t)row2 * DM) + lane;
#pragma unroll
            for (int j = 0; j < 4; ++j) { u32x2 w; w.x = pk2(v[j][0], v[j][1]); w.y = pk2(v[j][2], v[j][3]); o[64 * j] = w; if (has2) { u32x2 w2; w2.x = pk2(v2[j][0], v2[j][1]); w2.y = pk2(v2[j][2], v2[j][3]); o2[64 * j] = w2; } }
        }
        for (int i = bid * 512 + tid; i < 3 * M; i += G * 512) SS1[i] = 0ull;
        for (int i = bid * 512 + tid; i < 512 * 160; i += G * 512) { const int c = i / 160, k = i % 160;
            const float v = (k < 32) ? p.in[10][k * 512 + c] : (k < 64) ? p.in[12][(k - 32) * 512 + c] : p.in[13][(k - 64) * 512 + c]; ((bf16_t*)(p.ws + WS_LORA))[i] = f2bf(v); }
        { const int gt = bid * 512 + tid;
          if (gt < 512) { const float* lt = p.in[6]; const float l0 = lt[gt], l1 = lt[512 + gt], l2 = lt[1024 + gt]; const float mx = fmaxf(l0, fmaxf(l1, l2));
              const float e0 = expf(l0 - mx), e1 = expf(l1 - mx), e2 = expf(l2 - mx); LBT[gt] = e0 / (e0 + e1 + e2); }
          const int i = gt - 512;
          if (i >= 0 && i < 16384) { const int gp = i >> 4, h = i & 15, g = gp >> 6; const float step = expf(p.in[23][g]); const float lr = p.in[21][gp], li = p.in[22][gp];
              const float mag = expf(lr * step); const float br = mag * cosf(li * step), bi = mag * sinf(li * step);
              if (h == 0) { LBR[gp] = br; LBI[gp] = bi; }
              const float den = lr * lr + li * li, nr = br - 1.f, ni = bi; const float cr = (nr * lr + ni * li) / den, ci = (ni * lr - nr * li) / den;
              const float xr2 = p.in[24][gp * 16 + h], xi2 = p.in[25][gp * 16 + h]; BBR[gp * 16 + h] = cr * xr2 - ci * xi2; BBI[gp * 16 + h] = cr * xi2 + ci * xr2; } }
    }
    grid.sync();
    STAMP(1);

    { pg8::Gemm g{XB, (const bf16_t*)(p.ws + WS_IN0), DM, DM, M, LDU0, DM}; pg8::StaticOrder S; S.init(M, LDU0, G, bid);
      pg8::EpiScaleBf16 E{U, LDU0, SS0}; pg8::gemm_phase<pg8::EpiScaleBf16, pg8::StaticOrder, true, true>(lds, g, S, E); }
    GSYNC();
    STAMP(2);

#define Rt ((bf16_t*)p.out)
#define At (Rt + (size_t)M * 512)
#define Bh (Rt + (size_t)M * 1024)
#define Kh (Rt + (size_t)M * 1536)
#define Vv XB
#define BVG (XB + (size_t)M * 512)
#define Gg ((bf16_t*)(p.ws + WS_MS))
#define GLc ((float*)(p.ws + WS_MS + 32 * MiB))
#define HEM ((float*)(p.ws + WS_MS + 64 * MiB))
#define HEL ((float*)(p.ws + WS_MS + 65 * MiB))
#define HELM ((float*)(p.ws + WS_MS + 66 * MiB))

    {
        PHASE_IDS
        const int hd = __builtin_amdgcn_readfirstlane(tid >> 6), fr = lane & 15, fq = lane >> 4;
        constexpr int SLS = 336;
        const bf16_t* LT = (const bf16_t*)(p.ws + WS_LORA);
        float mu_r[4], mu_k[4], mu_v[4], w0c[4], a0c[4], kkc[4], kac[4], rkc[4];
#pragma unroll
        for (int nt = 0; nt < 4; ++nt) { const int c = hd * 64 + 4 * fr + nt; mu_r[nt] = p.in[8][c]; mu_k[nt] = p.in[8][512 + c]; mu_v[nt] = p.in[8][1024 + c];
            w0c[nt] = p.in[9][c]; a0c[nt] = p.in[11][c]; kkc[nt] = p.in[14][c]; kac[nt] = p.in[15][c]; rkc[nt] = p.in[16][c]; }
        bf16_t sa_c[5], sa_p[5];
        const unsigned char* zsrc = p.ws + WS_CTL + 128 * 1024;
#define P2_FETCH(cidx_, RAWn_) { const int m0_ = (cidx_) * 16; const bool sq_ = (m0_ & (SEQ - 1)) == 0; \
            _Pragma("unroll") for (int i_ = 0; i_ < 5; ++i_) { const int id_ = tid + 512 * i_, t_ = id_ / 160, j_ = id_ % 160; const bf16_t* ur_ = U + (size_t)(m0_ + t_) * LDU0 + 3584 + j_; sa_c[i_] = ur_[0]; sa_p[i_] = ur_[-LDU0]; } \
            _Pragma("unroll") for (int i_ = 0; i_ < 7; ++i_) { const int q_ = hd + 8 * i_; if (q_ < 51) { const int row_ = q_ / 3, th_ = q_ % 3; \
                const unsigned char* g_ = (row_ == 0 && sq_) ? zsrc + th_ * 1024 + lane * 16 : (const unsigned char*)(U + ((size_t)m0_ + row_) * LDU0 - LDU0 + 2048 + th_ * 512 + lane * 8); \
                __builtin_amdgcn_global_load_lds((const unsigned*)g_, (LAS unsigned*)((RAWn_) + row_ * 3088 + th_ * 1024), 16, 0, 0); } } }
        P2_FETCH(bid, lds + 12288);
        int it = 0;
        for (int cidx = bid; cidx < M / 16; cidx += G, ++it) {
            const int m0 = cidx * 16; const bool seq0 = (m0 & (SEQ - 1)) == 0;
            LAS unsigned char* SL = lds + (it & 1) * (16 * SLS);
            LAS unsigned char* RAW = lds + 12288 + (it & 1) * 52496;
#pragma unroll
            for (int i = 0; i < 5; ++i) { const int id = tid + 512 * i, t = id / 160, j = id % 160;
                const float cur = bf2f(sa_c[i]); const float prev = (t == 0 && seq0) ? 0.f : bf2f(sa_p[i]); const float v = cur + (prev - cur) * p.in[8][1536 + j];
                *(LAS bf16_t*)(SL + t * SLS + j * 2) = f2bf((j < 32) ? tanhf_(v) : (j < 64 ? v : sigmoidf_(v))); }
            asm volatile("s_waitcnt vmcnt(0)" ::: "memory");
            __syncthreads();
            f32x4 dw[4], da[4], dg[4];
            { bf16x8 sf[5];
#pragma unroll
              for (int kk = 0; kk < 5; ++kk) sf[kk] = *(const LAS bf16x8*)(SL + fr * SLS + (kk * 32 + 8 * fq) * 2);
              const f32x4 z4 = {0.f, 0.f, 0.f, 0.f};
#pragma unroll
              for (int nt = 0; nt < 4; ++nt) { const bf16_t* lr = LT + (size_t)(hd * 64 + 4 * fr + nt) * 160 + 8 * fq;
                  const bf16x8 wf = *(const bf16x8*)lr, af = *(const bf16x8*)(lr + 32), g0 = *(const bf16x8*)(lr + 64), g1 = *(const bf16x8*)(lr + 96), g2 = *(const bf16x8*)(lr + 128);
                  dw[nt] = __builtin_amdgcn_mfma_f32_16x16x32_bf16(sf[0], wf, z4, 0, 0, 0); da[nt] = __builtin_amdgcn_mfma_f32_16x16x32_bf16(sf[1], af, z4, 0, 0, 0);
                  f32x4 g = __builtin_amdgcn_mfma_f32_16x16x32_bf16(sf[2], g0, z4, 0, 0, 0); g = __builtin_amdgcn_mfma_f32_16x16x32_bf16(sf[3], g1, g, 0, 0, 0); dg[nt] = __builtin_amdgcn_mfma_f32_16x16x32_bf16(sf[4], g2, g, 0, 0, 0); } }
            { const int cn = (cidx + G < M / 16) ? cidx + G : cidx; P2_FETCH(cn, lds + 12288 + ((it + 1) & 1) * 52496); }
            float as_[4][4], wd_[4][4];
            float ssq[4] = {0.f, 0.f, 0.f, 0.f}, bon[4] = {0.f, 0.f, 0.f, 0.f};
#pragma unroll
            for (int nt = 0; nt < 4; ++nt)
#pragma unroll
                for (int r = 0; r < 4; ++r) { const LAS bf16_t* rw = (const LAS bf16_t*)(RAW + (4 * fq + r) * 3088) + hd * 64 + 4 * fr + nt;
                    const float c0 = bf2f(rw[1544]), c1 = bf2f(rw[1544 + 512]);
                    const float p0 = bf2f(rw[0]), p1 = bf2f(rw[512]);
                    const float rv = c0 + (p0 - c0) * mu_r[nt], kv = c1 + (p1 - c1) * mu_k[nt];
                    const float wlog = -softplusf_(-(w0c[nt] + dw[nt][r])) - 0.5f;
                    wd_[nt][r] = __expf(-__expf(wlog));
                    const float a = sigmoidf_(a0c[nt] + da[nt][r]); as_[nt][r] = a;
                    const float kkv = kv * kkc[nt]; ssq[r] = fmaf(kkv, kkv, ssq[r]);
                    bon[r] = fmaf(rv * kv * (1.f + (a - 1.f) * kac[nt]), rkc[nt], bon[r]); }
#pragma unroll
            for (int r = 0; r < 4; ++r) { ssq[r] = 1.0f / fmaxf(sqrtf(row_sum16(ssq[r])), 1e-12f); bon[r] = row_sum16(bon[r]); }
            float gam[4][5];
#pragma unroll
            for (int nt = 0; nt < 4; ++nt) {
                const float q1 = wd_[nt][0], q2 = q1 * wd_[nt][1], q3 = q2 * wd_[nt][2], q4 = q3 * wd_[nt][3];
                const float t0 = __shfl(q4, fr), t1 = __shfl(q4, fr + 16), t2 = __shfl(q4, fr + 32);
                const float pre = (fq == 0) ? 1.f : (fq == 1) ? t0 : (fq == 2) ? t0 * t1 : t0 * t1 * t2;
                gam[nt][0] = pre; gam[nt][1] = pre * q1; gam[nt][2] = pre * q2; gam[nt][3] = pre * q3; gam[nt][4] = pre * q4; }
#pragma unroll
            for (int r = 0; r < 4; ++r) { const size_t o = (size_t)(m0 + 4 * fq + r) * 512 + hd * 64 + 4 * fr; const LAS bf16_t* rw = (const LAS bf16_t*)(RAW + (4 * fq + r) * 3088) + hd * 64 + 4 * fr;
                float oa[4], orr[4], ob[4], okk[4], ov[4], og[4], obv[4];
#pragma unroll
                for (int nt = 0; nt < 4; ++nt) {
                    const float c0 = bf2f(rw[1544 + nt]), c1 = bf2f(rw[1544 + 512 + nt]), c2 = bf2f(rw[1544 + 1024 + nt]);
                    const float p0 = bf2f(rw[nt]), p1 = bf2f(rw[512 + nt]), p2 = bf2f(rw[1024 + nt]);
                    const float rv = c0 + (p0 - c0) * mu_r[nt], kv = c1 + (p1 - c1) * mu_k[nt], vv = c2 + (p2 - c2) * mu_v[nt];
                    const float a = as_[nt][r], kk = kv * kkc[nt] * ssq[r], kp = kv * (1.f + (a - 1.f) * kac[nt]), ig = __builtin_amdgcn_rcpf(gam[nt][r + 1]), g = dg[nt][r];
                    oa[nt] = -kk * gam[nt][r]; orr[nt] = rv * gam[nt][r + 1]; ob[nt] = kk * a * ig; okk[nt] = kp * ig; ov[nt] = vv; og[nt] = g; obv[nt] = bon[r] * vv * g; }
                u32x2 w;
                w.x = pk2(oa[0], oa[1]); w.y = pk2(oa[2], oa[3]); *(u32x2*)(At + o) = w;
                w.x = pk2(orr[0], orr[1]); w.y = pk2(orr[2], orr[3]); *(u32x2*)(Rt + o) = w;
                w.x = pk2(ob[0], ob[1]); w.y = pk2(ob[2], ob[3]); *(u32x2*)(Bh + o) = w;
                w.x = pk2(okk[0], okk[1]); w.y = pk2(okk[2], okk[3]); *(u32x2*)(Kh + o) = w;
                w.x = pk2(ov[0], ov[1]); w.y = pk2(ov[2], ov[3]); *(u32x2*)(Vv + o) = w;
                w.x = pk2(og[0], og[1]); w.y = pk2(og[2], og[3]); *(u32x2*)(Gg + o) = w;
                w.x = pk2(obv[0], obv[1]); w.y = pk2(obv[2], obv[3]); *(u32x2*)(BVG + o) = w; }
            if (fq == 3) *(f32x4*)(GLc + (size_t)cidx * 512 + hd * 64 + 4 * fr) = (f32x4){gam[0][4], gam[1][4], gam[2][4], gam[3][4]};
        }
#undef P2_FETCH
        STAMP2(20, 0);
#define HP_ROW(it_) (U + ((size_t)((it_) >> 6) * 64 + lane) * LDU0 + (((it_) >> 4) & 3) * 128 + ((it_) & 15) * 8)
#define HP_LB(it_) (LBT + (((it_) >> 4) & 3) * 128 + ((it_) & 15) * 8)
        u32x4 wq_n, wf_n; f32x4 lb_n0, lb_n1;
        { const bf16_t* r0 = HP_ROW(bid * 8 + wave); wq_n = *(const u32x4*)r0; wf_n = *(const u32x4*)(r0 + 512); const float* l0 = HP_LB(bid * 8 + wave); lb_n0 = *(const f32x4*)l0; lb_n1 = *(const f32x4*)(l0 + 4); }
        for (int it = bid * 8 + wave; it < (M / 64) * 64; it += G * 8) {
            const int ch = it >> 6, hh = (it >> 4) & 3, cg = it & 15; const int c0 = hh * 128 + cg * 8;
            bf16_t* r = HP_ROW(it);
            const u32x4 wq = wq_n, wf = wf_n; const float lbv[8] = {lb_n0[0], lb_n0[1], lb_n0[2], lb_n0[3], lb_n1[0], lb_n1[1], lb_n1[2], lb_n1[3]};
            { const int itn = (it + G * 8 < (M / 64) * 64) ? it + G * 8 : it; const bf16_t* rn = HP_ROW(itn); wq_n = *(const u32x4*)rn; wf_n = *(const u32x4*)(rn + 512); const float* ln = HP_LB(itn); lb_n0 = *(const f32x4*)ln; lb_n1 = *(const f32x4*)(ln + 4); }
            const unsigned wqa[4] = {wq.x, wq.y, wq.z, wq.w}, wfa[4] = {wf.x, wf.y, wf.z, wf.w};
            unsigned oq[4], ok[4];
#pragma unroll
            for (int j = 0; j < 8; ++j) { const float aq = (j & 1) ? bfhi(wqa[j >> 1]) : bflo(wqa[j >> 1]), af = (j & 1) ? bfhi(wfa[j >> 1]) : bflo(wfa[j >> 1]);
                const float kv = (1.f - lbv[j]) * sigmoidf_(-af);
                float bs = __logf(1.f - kv);
                bs += __int_as_float(__builtin_amdgcn_update_dpp(0, __float_as_int(bs), 0x111, 0xf, 0xf, true)); bs += __int_as_float(__builtin_amdgcn_update_dpp(0, __float_as_int(bs), 0x112, 0xf, 0xf, true));
                bs += __int_as_float(__builtin_amdgcn_update_dpp(0, __float_as_int(bs), 0x114, 0xf, 0xf, true)); bs += __int_as_float(__builtin_amdgcn_update_dpp(0, __float_as_int(bs), 0x118, 0xf, 0xf, true));
                bs += __int_as_float(__builtin_amdgcn_update_dpp(0, __float_as_int(bs), 0x142, 0xa, 0xf, false)); bs += __int_as_float(__builtin_amdgcn_update_dpp(0, __float_as_int(bs), 0x143, 0xc, 0xf, false));
                const float bm = __int_as_float(__builtin_amdgcn_readlane(__float_as_int(bs), 31)), bL = __int_as_float(__builtin_amdgcn_readlane(__float_as_int(bs), 63));
                const float qt = siluf_(aq) * __expf(bs - bm), kt = kv * __expf(bm - bs);
                if (j & 1) { oq[j >> 1] = pk2(__uint_as_float(oq[j >> 1]), qt); ok[j >> 1] = pk2(__uint_as_float(ok[j >> 1]), kt); } else { oq[j >> 1] = __float_as_uint(qt); ok[j >> 1] = __float_as_uint(kt); }
                if (lane == 0) { const size_t vo = (size_t)ch * 512 + c0 + j; HEM[vo] = __expf(bm); HEL[vo] = __expf(bL); HELM[vo] = __expf(bL - bm); } }
            u32x4 w; w.x = oq[0]; w.y = oq[1]; w.z = oq[2]; w.w = oq[3]; *(u32x4*)r = w;
            w.x = ok[0]; w.y = ok[1]; w.z = ok[2]; w.w = ok[3]; *(u32x4*)(r + 512) = w;
        }
#undef HP_ROW
#undef HP_LB
    }
    GSYNC();
    STAMP(3);

    for (int item = bid; item < 256; item += G) {
        PHASE_IDS
        const int w = __builtin_amdgcn_readfirstlane(tid >> 6), fr = lane & 15, fq = lane >> 4;
        const int vt = item & 3, h = (item >> 2) & 7, b = item >> 5;
        constexpr int BUF = 20992, oRt = 0, oAt = 2304, oBh = 4608, oKh = 6912, oBT = 9216, oKT = 14336, oVT = 19456, oGL = 20736;
        constexpr int oMS = 4 * BUF, MSET = 3840, oAf = oMS + 3 * MSET, oTT = oAf + 2 * 1024, oWT = oTT + 2 * 1280, oUT = oWT + 1280, oST = oUT + 1280, LTOT = oST + 2304;
        constexpr int NCH = SEQ / 16;
        LAS unsigned char* L = lds;
        __syncthreads();
        for (int i = tid; i < LTOT / 4; i += 512) ((LAS unsigned*)L)[i] = 0u;
        __syncthreads();
        const size_t tok0 = (size_t)b * SEQ; const size_t colb = (size_t)h * 64;
#define RC_F144(B_, off_, kk_) (*(const LAS bf16x8*)((B_) + (off_) + fr * 144 + ((kk_) * 32 + 8 * fq) * 2))
#define RC_F80(base_, row0_) (*(const LAS bf16x8*)((base_) + ((row0_) + fr) * 80 + (8 * fq) * 2))
        if (w >= 3) {
            const int lt = tid - 192;
            const bf16_t* arr[4] = {Rt, At, Bh, Kh};
            const int q0 = lt, q1 = lt + 320;
            const int kind1 = (q1 < 512) ? 0 : (q1 < 544) ? 1 : (q1 < 560) ? 2 : 3;
            const char* gp0 = (const char*)(arr[q0 >> 7] + (tok0 + ((q0 >> 3) & 15)) * 512 + colb + (q0 & 7) * 8);
            const char* gp1 = kind1 == 0 ? (const char*)(arr[(q1 >> 7) & 3] + (tok0 + ((q1 >> 3) & 15)) * 512 + colb + (q1 & 7) * 8)
                            : kind1 == 1 ? (const char*)(Vv + (tok0 + ((q1 - 512) >> 1)) * 512 + colb + vt * 16 + ((q1 - 512) & 1) * 8)
                            : kind1 == 2 ? (const char*)(GLc + ((size_t)b * NCH) * 512 + colb + (q1 - 544) * 4) : gp0;
            const size_t st1 = (kind1 == 2) ? (size_t)512 * 4 : (size_t)16 * 512 * 2;
            u32x4 d0[2], d1[2], d2[2], d3[2];
#define RP_H(w_, j_) ((bf16_t)(((j_) & 1) ? ((w_) >> 16) : ((w_) & 0xffffu)))
#define RP_FETCH(D_, c_) { const size_t cc_ = (size_t)((c_) < NCH ? (c_) : NCH - 1); D_[0] = *(const u32x4*)(gp0 + cc_ * (size_t)(16 * 512 * 2)); D_[1] = *(const u32x4*)(gp1 + cc_ * st1); }
#define RP_TILE(B_, q_, D_) { const int tl_ = (q_) >> 7, t_ = ((q_) >> 3) & 15, k_ = ((q_) & 7) * 8; const unsigned w4_[4] = {D_.x, D_.y, D_.z, D_.w}; *(LAS u32x4*)((B_) + tl_ * 2304 + t_ * 144 + k_ * 2) = D_; \
                if (tl_ >= 2) { LAS bf16_t* x_ = (LAS bf16_t*)((B_) + (tl_ == 2 ? oBT : oKT) + k_ * 80 + t_ * 2); const int g_ = (q_) & 7; \
                    _Pragma("unroll") for (int j_ = 0; j_ < 8; ++j_) { const int jj_ = (j_ + g_) & 7; const unsigned ww_ = (jj_ >> 1) == 0 ? w4_[0] : (jj_ >> 1) == 1 ? w4_[1] : (jj_ >> 1) == 2 ? w4_[2] : w4_[3]; x_[jj_ * 40] = (bf16_t)(ww_ >> ((jj_ & 1) * 16)); } } }
#define RP_STORE(D_, buf_) { LAS unsigned char* B_ = L + (buf_) * BUF; RP_TILE(B_, q0, D_[0]); \
                if (kind1 == 0) { RP_TILE(B_, q1, D_[1]); } \
                else if (kind1 == 1) { const int vq_ = q1 - 512; const unsigned w4_[4] = {D_[1].x, D_[1].y, D_[1].z, D_[1].w}; LAS bf16_t* x_ = (LAS bf16_t*)(B_ + oVT + ((vq_ & 1) * 8) * 80 + (vq_ >> 1) * 2); _Pragma("unroll") for (int j_ = 0; j_ < 8; ++j_) x_[j_ * 40] = RP_H(w4_[j_ >> 1], j_); } \
                else if (kind1 == 2) *(LAS u32x4*)(B_ + oGL + (q1 - 544) * 16) = D_[1]; }
            RP_FETCH(d0, 0); RP_STORE(d0, 0); RP_FETCH(d0, 1); RP_STORE(d0, 1); RP_FETCH(d0, 2); RP_STORE(d0, 2);
            RP_FETCH(d3, 3); RP_FETCH(d0, 4); RP_FETCH(d1, 5); RP_FETCH(d2, 6);
            LBAR(); LBAR(); LBAR();
            for (int i = 0; i < NCH; i += 4) {
                if (i + 3 < NCH) RP_STORE(d3, (i + 3) & 3);
                RP_FETCH(d3, i + 7);
                LBAR();
                if (i + 4 < NCH) RP_STORE(d0, (i + 4) & 3);
                RP_FETCH(d0, i + 8);
                LBAR();
                if (i + 5 < NCH) RP_STORE(d1, (i + 5) & 3);
                RP_FETCH(d1, i + 9);
                LBAR();
                if (i + 6 < NCH) RP_STORE(d2, (i + 6) & 3);
                RP_FETCH(d2, i + 10);
                LBAR();
            }
#undef RP_TILE
#undef RP_FETCH
#undef RP_H
#undef RP_STORE
        } else if (w == 1) {
            auto amats = [&](int cc) {
                const LAS unsigned char* B_ = L + (cc & 3) * BUF; LAS unsigned char* Ms = L + oMS + (cc % 3) * MSET; LAS unsigned char* Af = L + oAf + (cc & 1) * 1024;
                const bf16x8 a0 = RC_F144(B_, oAt, 0), a1 = RC_F144(B_, oAt, 1), r0 = RC_F144(B_, oRt, 0), r1 = RC_F144(B_, oRt, 1), b0 = RC_F144(B_, oBh, 0), b1 = RC_F144(B_, oBh, 1), k0 = RC_F144(B_, oKh, 0), k1 = RC_F144(B_, oKh, 1);
                const f32x4 z4 = {0.f, 0.f, 0.f, 0.f};
                f32x4 dab = __builtin_amdgcn_mfma_f32_16x16x32_bf16(a0, b0, z4, 0, 0, 0); dab = __builtin_amdgcn_mfma_f32_16x16x32_bf16(a1, b1, dab, 0, 0, 0);
                f32x4 dak = __builtin_amdgcn_mfma_f32_16x16x32_bf16(a0, k0, z4, 0, 0, 0); dak = __builtin_amdgcn_mfma_f32_16x16x32_bf16(a1, k1, dak, 0, 0, 0);
                f32x4 drb = __builtin_amdgcn_mfma_f32_16x16x32_bf16(r0, b0, z4, 0, 0, 0); drb = __builtin_amdgcn_mfma_f32_16x16x32_bf16(r1, b1, drb, 0, 0, 0);
                f32x4 drk = __builtin_amdgcn_mfma_f32_16x16x32_bf16(r0, k0, z4, 0, 0, 0); drk = __builtin_amdgcn_mfma_f32_16x16x32_bf16(r1, k1, drk, 0, 0, 0);
#pragma unroll
                for (int r = 0; r < 4; ++r) { const int t = 4 * fq + r; const bool st = fr < t, le = fr <= t;
                    *(LAS float*)(Af + t * 64 + fr * 4) = st ? dab[r] : 0.f;
                    *(LAS bf16_t*)(Ms + t * 80 + fr * 2) = f2bf(st ? dak[r] : 0.f);
                    *(LAS bf16_t*)(Ms + 1280 + t * 80 + fr * 2) = f2bf(le ? drb[r] : 0.f);
                    *(LAS bf16_t*)(Ms + 2560 + t * 80 + fr * 2) = f2bf(le ? drk[r] : 0.f); } };
            LBAR();
            amats(0);
            LBAR();
            amats(1);
            LBAR();
            for (int i = 0; i < NCH; ++i) { if (i + 2 < NCH) amats(i + 2); LBAR(); }
        } else if (w == 2) {
            auto tinv = [&](int cc) {
                const LAS unsigned char* Af = L + oAf + (cc & 1) * 1024; LAS unsigned char* Tt = L + oTT + (cc & 1) * 1280;
                f32x4 am[16][4];
#pragma unroll
                for (int t = 1; t < 16; ++t)
#pragma unroll
                    for (int sq = 0; sq < 4; ++sq) if (4 * sq < t) am[t][sq] = *(const LAS f32x4*)(Af + t * 64 + sq * 16);
                asm volatile("s_waitcnt lgkmcnt(0)" ::: "memory");
                float x[16];
#pragma unroll
                for (int t = 0; t < 16; ++t) {
                    float acc0 = (t == fr) ? 1.f : 0.f, acc1 = 0.f;
#pragma unroll
                    for (int sq = 0; sq < 4; ++sq) { if (4 * sq < t) {
#pragma unroll
                        for (int e = 0; e < 4; ++e) { const int s = 4 * sq + e; if (s < t) { if (s & 1) acc1 = fmaf(am[t][sq][e], x[s], acc1); else acc0 = fmaf(am[t][sq][e], x[s], acc0); } } } }
                    x[t] = acc0 + acc1; }
                if (fq == 0) {
#pragma unroll
                    for (int t = 0; t < 16; ++t) *(LAS bf16_t*)(Tt + t * 80 + fr * 2) = f2bf(x[t]); } };
            LBAR(); LBAR();
            tinv(0);
            LBAR();
            for (int i = 0; i < NCH; ++i) { if (i + 1 < NCH) tinv(i + 1); LBAR(); }
        } else {
            f32x4 Sacc[4];
#pragma unroll
            for (int kt = 0; kt < 4; ++kt) Sacc[kt] = (f32x4){0.f, 0.f, 0.f, 0.f};
            bf16_t* yg = Vv + tok0 * 512 + colb + vt * 16 + fr;
            LBAR(); LBAR(); LBAR();
            for (int i = 0; i < NCH; ++i) {
                const LAS unsigned char* B_ = L + (i & 3) * BUF; const LAS unsigned char* Ms = L + oMS + (i % 3) * MSET; const LAS unsigned char* Tt = L + oTT + (i & 1) * 1280;
                const bf16x8 a0 = RC_F144(B_, oAt, 0), a1 = RC_F144(B_, oAt, 1), r0 = RC_F144(B_, oRt, 0), r1 = RC_F144(B_, oRt, 1);
                const bf16x8 s0 = *(const LAS bf16x8*)(L + oST + fr * 144 + (8 * fq) * 2), s1 = *(const LAS bf16x8*)(L + oST + fr * 144 + (32 + 8 * fq) * 2);
                const bf16x8 vtf = RC_F80(B_ + oVT, 0), makf = RC_F80(Ms, 0), mrbf = RC_F80(Ms + 1280, 0), mrkf = RC_F80(Ms + 2560, 0), ttf = RC_F80(Tt, 0);
                bf16x8 btf[4], ktf[4]; f32x4 glv[4];
#pragma unroll
                for (int kt = 0; kt < 4; ++kt) { btf[kt] = RC_F80(B_ + oBT, kt * 16); ktf[kt] = RC_F80(B_ + oKT, kt * 16); glv[kt] = *(const LAS f32x4*)(B_ + oGL + (kt * 16 + 4 * fq) * 4); }
                asm volatile("s_waitcnt lgkmcnt(0)" ::: "memory");
                const f32x4 z4 = {0.f, 0.f, 0.f, 0.f};
                f32x4 dw = __builtin_amdgcn_mfma_f32_16x16x32_bf16(a0, s0, z4, 0, 0, 0); dw = __builtin_amdgcn_mfma_f32_16x16x32_bf16(a1, s1, dw, 0, 0, 0);
                dw = __builtin_amdgcn_mfma_f32_16x16x32_bf16(makf, vtf, dw, 0, 0, 0);
                f32x4 dy = __builtin_amdgcn_mfma_f32_16x16x32_bf16(r0, s0, z4, 0, 0, 0); dy = __builtin_amdgcn_mfma_f32_16x16x32_bf16(r1, s1, dy, 0, 0, 0);
                dy = __builtin_amdgcn_mfma_f32_16x16x32_bf16(mrkf, vtf, dy, 0, 0, 0);
                { u32x2 ww; ww.x = pk2(dw[0], dw[1]); ww.y = pk2(dw[2], dw[3]); *(LAS u32x2*)(L + oWT + fr * 80 + (4 * fq) * 2) = ww; }
                f32x4 sk[4];
#pragma unroll
                for (int kt = 0; kt < 4; ++kt) sk[kt] = __builtin_amdgcn_mfma_f32_16x16x32_bf16(ktf[kt], vtf, Sacc[kt], 0, 0, 0);
                f32x4 du = __builtin_amdgcn_mfma_f32_16x16x32_bf16(ttf, RC_F80(L + oWT, 0), z4, 0, 0, 0);
                { u32x2 uw; uw.x = pk2(du[0], du[1]); uw.y = pk2(du[2], du[3]); *(LAS u32x2*)(L + oUT + fr * 80 + (4 * fq) * 2) = uw; }
                const bf16x8 utf = RC_F80(L + oUT, 0);
                dy = __builtin_amdgcn_mfma_f32_16x16x32_bf16(mrbf, utf, dy, 0, 0, 0);
#pragma unroll
                for (int kt = 0; kt < 4; ++kt) {
                    f32x4 sa = __builtin_amdgcn_mfma_f32_16x16x32_bf16(btf[kt], utf, sk[kt], 0, 0, 0);
                    sa = sa * glv[kt]; Sacc[kt] = sa;
                    u32x2 sw; sw.x = pk2(sa[0], sa[1]); sw.y = pk2(sa[2], sa[3]); *(LAS u32x2*)(L + oST + fr * 144 + (kt * 16 + 4 * fq) * 2) = sw; }
                { bf16_t* yo = yg + (size_t)(i * 16 + 4 * fq) * 512; yo[0] = f2bf(dy[0]); yo[512] = f2bf(dy[1]); yo[1024] = f2bf(dy[2]); yo[1536] = f2bf(dy[3]); }
                LBAR();
            }
        }
#undef RC_F144
#undef RC_F80
    }
    STAMP(17);
    for (int item = bid; item < 256; item += G) {
        PHASE_IDS
        const int w = __builtin_amdgcn_readfirstlane(tid >> 6), fr = lane & 15, fq = lane >> 4;
        const int vs = item & 7, h = (item >> 3) & 3, b = item >> 5;
        constexpr int QS = 272, TS = 144;
        constexpr int BUFB = 38656, oQ = 0, oK = 17408, oVT = 34816, oV = 37120, oP = 2 * BUFB, oCT = oP + 9216;
        LAS unsigned char* L = lds;
        const size_t tok0 = (size_t)b * SEQ;
        int prow[2], pc8[2];
#pragma unroll
        for (int i = 0; i < 2; ++i) { const int pp = tid + 512 * i; prow[i] = pp >> 4; pc8[i] = (pp & 15) * 8; }
        const int vrow = tid & 63, vpart = (tid >> 6) & 1;
        u32x4 qa[2], ka[2], va = {0u, 0u, 0u, 0u}; float vem = 0.f, vel = 0.f, velm = 0.f;
#define HM_FETCH(c_) { const size_t tb_ = tok0 + (size_t)(c_) * 64; _Pragma("unroll") for (int i_ = 0; i_ < 2; ++i_) { const bf16_t* r_ = U + (tb_ + prow[i_]) * LDU0 + h * 128 + pc8[i_]; qa[i_] = *(const u32x4*)r_; ka[i_] = *(const u32x4*)(r_ + 512); } \
            { va = *(const u32x4*)(U + (tb_ + vrow) * LDU0 + 1024 + h * 128 + vs * 16 + vpart * 8); const size_t vo_ = ((size_t)b * (SEQ / 64) + (c_)) * 512 + h * 128 + (tid & 127); vem = HEM[vo_]; vel = HEL[vo_]; velm = HELM[vo_]; } }
#define HM_H(w_, j_) ((bf16_t)(((j_) & 1) ? ((w_) >> 16) : ((w_) & 0xffffu)))
#define HM_STORE(bo_) { _Pragma("unroll") for (int i_ = 0; i_ < 2; ++i_) { *(LAS u32x4*)(L + (bo_) + oQ + prow[i_] * QS + pc8[i_] * 2) = qa[i_]; *(LAS u32x4*)(L + (bo_) + oK + prow[i_] * QS + pc8[i_] * 2) = ka[i_]; } \
            if (tid < 128) { LAS bf16_t* vt_ = (LAS bf16_t*)(L + (bo_) + oVT + (vpart * 8) * TS + vrow * 2); const unsigned vw4_[4] = {va.x, va.y, va.z, va.w}; \
                _Pragma("unroll") for (int j_ = 0; j_ < 8; ++j_) vt_[j_ * (TS / 2)] = HM_H(vw4_[j_ >> 1], j_); \
                ((LAS float*)(L + (bo_) + oV))[tid] = vem; ((LAS float*)(L + (bo_) + oV))[128 + tid] = vel; ((LAS float*)(L + (bo_) + oV))[256 + tid] = velm; } }
#define HM_FRAG(off_, row_, stride_, kk_) (*(const LAS bf16x8*)(L + (off_) + ((row_) + fr) * (stride_) + ((kk_) * 32 + 8 * fq) * 2))
#define HM_TR4(p_) __builtin_amdgcn_ds_read_tr16_b64_v4i16((LAS s16x4*)(p_))
        __syncthreads();
        for (int i = tid; i < (9216 + 4352) / 4; i += 512) ((LAS unsigned*)(L + oP))[i] = 0u;
        HM_FETCH(0); HM_STORE(0); HM_FETCH(1);
        LBAR();
        f32x4 Cacc = {0.f, 0.f, 0.f, 0.f};
        const int ktoff = oK + ((lane >> 4) * 8 + ((lane >> 2) & 3)) * QS + (w * 16 + (lane & 3) * 4) * 2;
        for (int c = 0; c < SEQ / 64; ++c) {
            const int bo = (c & 1) * BUFB, bn = BUFB - bo;
            { const int k0 = w * 16 + 4 * fq; const LAS float* vEM = (const LAS float*)(L + bo + oV);
              u32x2 cw; cw.x = pk2(Cacc[0] * vEM[k0], Cacc[1] * vEM[k0 + 1]); cw.y = pk2(Cacc[2] * vEM[k0 + 2], Cacc[3] * vEM[k0 + 3]);
              *(LAS u32x2*)(L + oCT + fr * QS + k0 * 2) = cw; }
            { const int sb = w >> 1, tb0 = (w & 1) * 2;
              if (sb <= tb0 + 1) { const bool two = sb <= tb0;
                  bf16x8 kf[4], q0f[4], q1f[4];
#pragma unroll
                  for (int kk = 0; kk < 4; ++kk) { kf[kk] = HM_FRAG(bo + oK, sb * 16, QS, kk); q1f[kk] = HM_FRAG(bo + oQ, tb0 * 16 + 16, QS, kk); }
                  if (two) {
#pragma unroll
                      for (int kk = 0; kk < 4; ++kk) q0f[kk] = HM_FRAG(bo + oQ, tb0 * 16, QS, kk); }
                  f32x4 a0 = {0.f, 0.f, 0.f, 0.f}, a1 = {0.f, 0.f, 0.f, 0.f};
                  if (two) {
#pragma unroll
                      for (int kk = 0; kk < 4; ++kk) { a0 = __builtin_amdgcn_mfma_f32_16x16x32_bf16(kf[kk], q0f[kk], a0, 0, 0, 0); a1 = __builtin_amdgcn_mfma_f32_16x16x32_bf16(kf[kk], q1f[kk], a1, 0, 0, 0); }
                  } else {
#pragma unroll
                      for (int kk = 0; kk < 4; ++kk) a1 = __builtin_amdgcn_mfma_f32_16x16x32_bf16(kf[kk], q1f[kk], a1, 0, 0, 0);
                  }
                  const int s0 = sb * 16 + 4 * fq;
#pragma unroll
                  for (int j = 0; j < 2; ++j) { if (j == 1 || two) { const int t = (tb0 + j) * 16 + fr; const f32x4 a = j ? a1 : a0;
                      u32x2 pw; pw.x = pk2((s0 <= t) ? a[0] : 0.f, (s0 + 1 <= t) ? a[1] : 0.f); pw.y = pk2((s0 + 2 <= t) ? a[2] : 0.f, (s0 + 3 <= t) ? a[3] : 0.f);
                      *(LAS u32x2*)(L + oP + t * TS + s0 * 2) = pw; } } } }
            LBAR();
            if (c + 1 < SEQ / 64) HM_STORE(bn);
            HM_FETCH((c + 2 < SEQ / 64) ? c + 2 : c);
            if (w < 4) { f32x4 d = {0.f, 0.f, 0.f, 0.f};
#pragma unroll
                for (int kk = 0; kk < 2; ++kk) d = __builtin_amdgcn_mfma_f32_16x16x32_bf16(HM_FRAG(oP, w * 16, TS, kk), HM_FRAG(bo + oVT, 0, TS, kk), d, 0, 0, 0);
#pragma unroll
                for (int kk = 0; kk < 4; ++kk) d = __builtin_amdgcn_mfma_f32_16x16x32_bf16(HM_FRAG(bo + oQ, w * 16, QS, kk), HM_FRAG(oCT, 0, QS, kk), d, 0, 0, 0);
                bf16_t* op = U + (tok0 + (size_t)c * 64 + w * 16 + 4 * fq) * LDU0 + 1024 + h * 128 + vs * 16 + fr;
                op[0] = f2bf(d[0]); op[LDU0] = f2bf(d[1]); op[2 * LDU0] = f2bf(d[2]); op[3 * LDU0] = f2bf(d[3]); }
            { f32x4 tmp = {0.f, 0.f, 0.f, 0.f};
              const LAS unsigned char* kt = L + bo + ktoff;
#pragma unroll
              for (int kk = 0; kk < 2; ++kk) { const bf16x8 ktf = __builtin_shufflevector(HM_TR4(kt + kk * 32 * QS), HM_TR4(kt + kk * 32 * QS + 4 * QS), 0, 1, 2, 3, 4, 5, 6, 7);
                  tmp = __builtin_amdgcn_mfma_f32_16x16x32_bf16(ktf, HM_FRAG(bo + oVT, 0, TS, kk), tmp, 0, 0, 0); }
              const int k0 = w * 16 + 4 * fq; const LAS float* vEL = (const LAS float*)(L + bo + oV) + 128; const LAS float* vELM = vEL + 128;
#pragma unroll
              for (int r = 0; r < 4; ++r) Cacc[r] = Cacc[r] * vEL[k0 + r] + tmp[r] * vELM[k0 + r]; }
            LBAR();
        }
#undef HM_TR4
#undef HM_FETCH
#undef HM_STORE
#undef HM_FRAG
#undef HM_H
    }
    GSYNC();
    STAMP(4);

    {
        PHASE_IDS
        const int gw = bid * 8 + wave, NWH = G * 4;
        const int c8 = lane * 8;
        if ((gw & 1) == 0) {
            const f32x4 an0 = *(const f32x4*)(p.in[7] + c8), an1 = *(const f32x4*)(p.in[7] + c8 + 4);
            for (int m0 = gw >> 1; m0 < M; m0 += NWH * 4) {
                u32x4 xo[4], xg[4];
#pragma unroll
                for (int u = 0; u < 4; ++u) { const int m = m0 + u * NWH; const bf16_t* ur = U + (size_t)m * LDU0 + c8; xo[u] = *(const u32x4*)(ur + 1024); xg[u] = *(const u32x4*)(ur + 1536); }
#pragma unroll
                for (int u = 0; u < 4; ++u) { const int m = m0 + u * NWH; {
                    const float o[8] = {bflo(xo[u].x), bfhi(xo[u].x), bflo(xo[u].y), bfhi(xo[u].y), bflo(xo[u].z), bfhi(xo[u].z), bflo(xo[u].w), bfhi(xo[u].w)};
                    const float g[8] = {bflo(xg[u].x), bfhi(xg[u].x), bflo(xg[u].y), bfhi(xg[u].y), bflo(xg[u].z), bfhi(xg[u].z), bflo(xg[u].w), bfhi(xg[u].w)};
                    float ss = 0.f;
#pragma unroll
                    for (int e = 0; e < 8; ++e) ss = fmaf(o[e], o[e], ss);
                    const float rs = 1.0f / sqrtf(row_sum16(ss) * (1.f / 128.f) + RMS_EPS);
                    u32x4 w; w.x = pk2(o[0] * rs * an0[0] * siluf_(g[0]), o[1] * rs * an0[1] * siluf_(g[1])); w.y = pk2(o[2] * rs * an0[2] * siluf_(g[2]), o[3] * rs * an0[3] * siluf_(g[3]));
                    w.z = pk2(o[4] * rs * an1[0] * siluf_(g[4]), o[5] * rs * an1[1] * siluf_(g[5])); w.w = pk2(o[6] * rs * an1[2] * siluf_(g[6]), o[7] * rs * an1[3] * siluf_(g[7]));
                    *(u32x4*)(YC + (size_t)m * DM + c8) = w; } }
            }
        } else {
            const f32x4 lw0 = *(const f32x4*)(p.in[17] + c8), lw1 = *(const f32x4*)(p.in[17] + c8 + 4), lb0 = *(const f32x4*)(p.in[18] + c8), lb1 = *(const f32x4*)(p.in[18] + c8 + 4);
            for (int m0 = gw >> 1; m0 < M; m0 += NWH * 4) {
                u32x4 xy[4], xg[4], xb[4];
#pragma unroll
                for (int u = 0; u < 4; ++u) { const int m = m0 + u * NWH; const size_t i = (size_t)m * 512 + c8; xy[u] = *(const u32x4*)(Vv + i); xg[u] = *(const u32x4*)(Gg + i); xb[u] = *(const u32x4*)(BVG + i); }
#pragma unroll
                for (int u = 0; u < 4; ++u) { const int m = m0 + u * NWH; {
                    const float y[8] = {bflo(xy[u].x), bfhi(xy[u].x), bflo(xy[u].y), bfhi(xy[u].y), bflo(xy[u].z), bfhi(xy[u].z), bflo(xy[u].w), bfhi(xy[u].w)};
                    const float g[8] = {bflo(xg[u].x), bfhi(xg[u].x), bflo(xg[u].y), bfhi(xg[u].y), bflo(xg[u].z), bfhi(xg[u].z), bflo(xg[u].w), bfhi(xg[u].w)};
                    const float bv[8] = {bflo(xb[u].x), bfhi(xb[u].x), bflo(xb[u].y), bfhi(xb[u].y), bflo(xb[u].z), bfhi(xb[u].z), bflo(xb[u].w), bfhi(xb[u].w)};
                    float s1 = 0.f;
#pragma unroll
                    for (int e = 0; e < 8; ++e) s1 += y[e];
                    s1 += dpp_mov<0xB1>(s1); s1 += dpp_mov<0x4E>(s1); s1 += dpp_mov<0x141>(s1);
                    const float mean = s1 * (1.f / 64.f); float s2 = 0.f;
#pragma unroll
                    for (int e = 0; e < 8; ++e) { const float d = y[e] - mean; s2 = fmaf(d, d, s2); }
                    s2 += dpp_mov<0xB1>(s2); s2 += dpp_mov<0x4E>(s2); s2 += dpp_mov<0x141>(s2);
                    const float rs = 1.0f / sqrtf(s2 * (1.f / 64.f) + 64e-5f);
                    float r8[8];
#pragma unroll
                    for (int e = 0; e < 8; ++e) { const float lw = e < 4 ? lw0[e] : lw1[e - 4], lb = e < 4 ? lb0[e] : lb1[e - 4]; r8[e] = ((y[e] - mean) * rs * lw + lb) * g[e] + bv[e]; }
                    u32x4 w; w.x = pk2(r8[0], r8[1]); w.y = pk2(r8[2], r8[3]); w.z = pk2(r8[4], r8[5]); w.w = pk2(r8[6], r8[7]);
                    *(u32x4*)(YC + (size_t)m * DM + 512 + c8) = w; } }
            }
        }
    }
    GSYNC();
    STAMP(5);

    { pg8::Gemm g{YC, (const bf16_t*)(p.ws + WS_OUT0), DM, DM, M, DM, DM}; pg8::StaticOrder S; S.init(M, DM, G, bid);
      pg8::EpiResidual<true, true> E{p.in[0], nullptr, XB, SS1}; pg8::gemm_phase<pg8::EpiResidual<true, true>, pg8::StaticOrder, true, true>(lds, g, S, E); }
    GSYNC();
    STAMP(6);
#define HID U
    { pg8::Gemm g{XB, (const bf16_t*)(p.ws + WS_GU0), DM, DM, M, 2 * FFN, DM}; pg8::StaticOrder S; S.init(M, 2 * FFN, G, bid);
      pg8::EpiSwiGlu E{HID, FFN, SS1}; pg8::gemm_phase<pg8::EpiSwiGlu, pg8::StaticOrder, true, true>(lds, g, S, E); }
    GSYNC();
    STAMP(7);
    { pg8::Gemm g{HID, (const bf16_t*)(p.ws + WS_D0), FFN, FFN, M, DM, FFN}; pg8::StaticOrder S; S.init(M, DM, G, bid);
      pg8::EpiResidual<false, true> E{nullptr, XB, XB, SS2}; pg8::gemm_phase<pg8::EpiResidual<false, true>, pg8::StaticOrder, true, true>(lds, g, S, E); }
    GSYNC();
    STAMP(8);
    { pg8::Gemm g{XB, (const bf16_t*)(p.ws + WS_IN1), DM, DM, M, NP1, DM}; pg8::StaticOrder S; S.init(M, NP1, G, bid);
      pg8::EpiScaleBf16 E{U, LDU1, SS2}; pg8::gemm_phase<pg8::EpiScaleBf16, pg8::StaticOrder, true, true>(lds, g, S, E); }
    GSYNC();
    STAMP(9);

#define Qc ((bf16_t*)(p.ws + WS_YC))
#define Kc ((bf16_t*)(p.ws + WS_MS))
#define gSI ((float*)(p.ws + WS_MS + 48 * MiB))
#define gBI (gSI + (size_t)M * 4)
#define gBT (gSI + (size_t)M * 8)
#define gWL (gSI + (size_t)M * 12)
#define gDP ((float*)(p.ws + WS_MS + 50 * MiB))
#define gDEN ((float*)(p.ws + WS_MS + 51 * MiB))
    {
        PHASE_IDS
        const float* cq = p.in[31]; const float* ck = p.in[32];
        const int gw = bid * 8 + wave, NW = G * 8;
        for (int item = gw; item < (M / 16) * 3; item += NW) {
            const int run = item / 3, m0 = run * 16, c = (item % 3) * 512 + lane * 8; const bool s0 = (m0 & (SEQ - 1)) == 0;
            const bool isk = c >= 768; const int cc = isk ? c - 768 : c; const float* cw = (isk ? ck : cq) + cc; const float sc = isk ? 0.07216878364870322f : 1.f;
            u32x4 x[19];
#pragma unroll
            for (int i = 0; i < 19; ++i) { const int mm = (i < 3 && s0) ? m0 : m0 - 3 + i; x[i] = *(const u32x4*)(U + (size_t)mm * LDU1 + 256 + c); }
            f32x4 w0[4], w1[4];
#pragma unroll
            for (int j = 0; j < 4; ++j) { w0[j] = *(const f32x4*)(cw + j * 768); w1[j] = *(const f32x4*)(cw + j * 768 + 4); }
            if (s0) { const u32x4 z = {0u, 0u, 0u, 0u}; x[0] = z; x[1] = z; x[2] = z; }
            bf16_t* dst = (isk ? Kc : Qc) + (size_t)m0 * 768 + cc;
#pragma unroll
            for (int tk = 0; tk < 16; ++tk) {
                float acc[8];
#pragma unroll
                for (int e = 0; e < 8; ++e) acc[e] = 0.f;
#pragma unroll
                for (int j = 0; j < 4; ++j) { const u32x4 xv = x[tk + j];
                    acc[0] = fmaf(w0[j][0], bflo(xv.x), acc[0]); acc[1] = fmaf(w0[j][1], bfhi(xv.x), acc[1]); acc[2] = fmaf(w0[j][2], bflo(xv.y), acc[2]); acc[3] = fmaf(w0[j][3], bfhi(xv.y), acc[3]);
                    acc[4] = fmaf(w1[j][0], bflo(xv.z), acc[4]); acc[5] = fmaf(w1[j][1], bfhi(xv.z), acc[5]); acc[6] = fmaf(w1[j][2], bflo(xv.w), acc[6]); acc[7] = fmaf(w1[j][3], bfhi(xv.w), acc[7]); }
                u32x4 o; o.x = pk2(siluf_(acc[0]) * sc, siluf_(acc[1]) * sc); o.y = pk2(siluf_(acc[2]) * sc, siluf_(acc[3]) * sc); o.z = pk2(siluf_(acc[4]) * sc, siluf_(acc[5]) * sc); o.w = pk2(siluf_(acc[6]) * sc, siluf_(acc[7]) * sc);
                *(u32x4*)(dst + (size_t)tk * 768) = o; }
        }
        for (int it = gw; it < (M / 64) * 4; it += NW) {
            const int ch = it >> 2, hh = it & 3; const size_t m = (size_t)ch * 64 + lane; const bf16_t* ur = U + m * LDU1;
            const float lf = -softplusf_(-(bf2f(ur[3332 + hh]) + p.in[34][hh]));
            const float li = bf2f(ur[3328 + hh]) + p.in[33][hh];
            float bs = lf;
#pragma unroll
            for (int o = 1; o < 64; o <<= 1) { const float t = __shfl_up(bs, o); if (lane >= o) bs += t; }
            const float bL = __shfl(bs, 63);
            gSI[m * 4 + hh] = __expf(bs); gBI[m * 4 + hh] = li - bs; gBT[m * 4 + hh] = bs; gWL[m * 4 + hh] = __expf(bL - bs + li);
            if (lane == 0) gDP[ch * 4 + hh] = __expf(bL);
        }
    }
    GSYNC();
    STAMP(10);

    if (bid < 192) {
        PHASE_IDS
        const int w = __builtin_amdgcn_readfirstlane(tid >> 6);
        const int grp_ = (bid & 7) * 4 + (bid >> 3) / 6;
        const int vs = (bid >> 3) % 6, h = grp_ & 3, b = grp_ >> 2;
        constexpr int QS = 400, TS = 144;
        constexpr int oQ = 0, oK = 25600, oKT = 51200, oVT = 78848, oVW = 85760, oP = 92672, oCT = 101888, oG = 121088;
        LAS unsigned char* L = lds;
        for (int i = tid; i < 19200 / 4; i += 512) ((LAS unsigned*)(L + oCT))[i] = 0u;
        for (int i = tid; i < 64 * TS / 4; i += 512) ((LAS unsigned*)(L + oP))[i] = 0u;
        for (int i = tid; i < 16 * TS / 4; i += 512) { ((LAS unsigned*)(L + oVT + 32 * TS))[i] = (i < TS / 4) ? 0x3F803F80u : 0u; ((LAS unsigned*)(L + oVW + 32 * TS))[i] = 0u; }
        const size_t tok0 = (size_t)b * SEQ;
        const int fr = lane & 15, fq = lane >> 4;
        u32x4 qa[3], ka[3], va = {0u, 0u, 0u, 0u}; float gsi = 0.f, gbi = 0.f, gbt = 0.f, gwl = 0.f, wlr = 0.f;
        int prow[3], pc8[3];
#pragma unroll
        for (int i = 0; i < 3; ++i) { const int pp = tid + 512 * i; prow[i] = pp / 24; pc8[i] = (pp % 24) * 8; }
        const int vrow = tid & 63, vpart = tid >> 6;
#define MM_FETCH(c_) { const size_t tb_ = tok0 + (size_t)(c_) * 64; _Pragma("unroll") for (int i_ = 0; i_ < 3; ++i_) { const size_t o_ = (tb_ + prow[i_]) * 768 + h * 192 + pc8[i_]; qa[i_] = *(const u32x4*)(Qc + o_); ka[i_] = *(const u32x4*)(Kc + o_); } \
            { va = *(const u32x4*)(U + (tb_ + vrow) * LDU1 + 1792 + h * 192 + vs * 32 + (vpart & 3) * 8); wlr = gWL[(tb_ + vrow) * 4 + h]; } \
            { const size_t g_ = (tb_ + (tid & 63)) * 4 + h; gsi = gSI[g_]; gbi = gBI[g_]; gbt = gBT[g_]; gwl = gWL[g_]; } }
#define MM_H(w_, j_) ((bf16_t)(((j_) & 1) ? ((w_) >> 16) : ((w_) & 0xffffu)))
#define MM_STORE() { _Pragma("unroll") for (int i_ = 0; i_ < 3; ++i_) { *(LAS u32x4*)(L + oQ + prow[i_] * QS + pc8[i_] * 2) = qa[i_]; *(LAS u32x4*)(L + oK + prow[i_] * QS + pc8[i_] * 2) = ka[i_]; \
            } \
            if (tid < 256) { LAS bf16_t* vt_ = (LAS bf16_t*)(L + oVT + (vpart * 8) * TS + vrow * 2); LAS bf16_t* vw_ = (LAS bf16_t*)(L + oVW + (vpart * 8) * TS + vrow * 2); const unsigned vw4_[4] = {va.x, va.y, va.z, va.w}; \
                _Pragma("unroll") for (int j_ = 0; j_ < 8; ++j_) { const bf16_t e_ = MM_H(vw4_[j_ >> 1], j_); vt_[j_ * (TS / 2)] = e_; vw_[j_ * (TS / 2)] = f2bf(bf2f(e_) * wlr); } } \
            if (tid < 64) { ((LAS bf16_t*)(L + oVW + 32 * TS))[tid] = f2bf(gwl); ((LAS float*)(L + oG))[tid] = gsi; ((LAS float*)(L + oG))[64 + tid] = gbi; ((LAS float*)(L + oG))[128 + tid] = gbt; } }
#define MM_TR4(off_) __builtin_amdgcn_ds_read_tr16_b64_v4i16((LAS s16x4*)(ktb + (off_)))
#define MM_TRF(off_) __builtin_shufflevector(MM_TR4(off_), MM_TR4((off_) + 4 * QS), 0, 1, 2, 3, 4, 5, 6, 7)
#define MM_FRAG(off_, row_, stride_, kk_) (*(const LAS bf16x8*)(L + (off_) + ((row_) + fr) * (stride_) + ((kk_) * 32 + 8 * fq) * 2))
        __syncthreads();
        MM_FETCH(0); MM_STORE();
        LBAR();
        f32x4 Cacc[3][2];
#pragma unroll
        for (int i = 0; i < 3; ++i) { Cacc[i][0] = (f32x4){0.f, 0.f, 0.f, 0.f}; Cacc[i][1] = (f32x4){0.f, 0.f, 0.f, 0.f}; }
        const int nvt = (w < 4) ? 1 : 2, vt0 = (w < 4) ? 0 : 1, db0 = 3 * (w & 3);
        const LAS unsigned char* ktb = L + oK + ((lane >> 4) * 8 + ((lane >> 2) & 3)) * QS + (db0 * 16 + (lane & 3) * 4) * 2;
        const LAS float* gSIl = (const LAS float*)(L + oG); const LAS float* gBIl = gSIl + 64; const LAS float* gBTl = gSIl + 128;
        for (int c = 0; c < SEQ / 64; ++c) {
            int fr_o = lane & 15, fq_o = lane >> 4; asm volatile("" : "+v"(fr_o), "+v"(fq_o));
            const int fr = fr_o, fq = fq_o;
            const float dp = gDP[(b * (SEQ / 64) + c) * 4 + h];
            MM_FETCH((c + 1 < SEQ / 64) ? c + 1 : c);
            { const int sb = w >> 1, tb0 = (w & 1) * 2;
              if (sb <= tb0 + 1) {
              const bool two = sb <= tb0;
              bf16x8 kf[6], q0f[6], q1f[6];
#pragma unroll
              for (int kk = 0; kk < 6; ++kk) { kf[kk] = MM_FRAG(oK, sb * 16, QS, kk); q1f[kk] = MM_FRAG(oQ, tb0 * 16 + 16, QS, kk); }
              if (two) {
#pragma unroll
                  for (int kk = 0; kk < 6; ++kk) q0f[kk] = MM_FRAG(oQ, tb0 * 16, QS, kk); }
              const int s0 = sb * 16 + 4 * fq;
              const float bi0 = gBIl[s0], bi1 = gBIl[s0 + 1], bi2 = gBIl[s0 + 2], bi3 = gBIl[s0 + 3];
              const float bt0 = gBTl[tb0 * 16 + fr], bt1 = gBTl[tb0 * 16 + 16 + fr];
              asm volatile("s_waitcnt lgkmcnt(0)" ::: "memory");
              f32x4 a0 = {0.f, 0.f, 0.f, 0.f}, a1 = {0.f, 0.f, 0.f, 0.f};
              if (two) {
#pragma unroll
                  for (int kk = 0; kk < 6; ++kk) { a0 = __builtin_amdgcn_mfma_f32_16x16x32_bf16(kf[kk], q0f[kk], a0, 0, 0, 0); a1 = __builtin_amdgcn_mfma_f32_16x16x32_bf16(kf[kk], q1f[kk], a1, 0, 0, 0); }
              } else {
#pragma unroll
                  for (int kk = 0; kk < 6; ++kk) a1 = __builtin_amdgcn_mfma_f32_16x16x32_bf16(kf[kk], q1f[kk], a1, 0, 0, 0);
              }
#pragma unroll
              for (int j = 0; j < 2; ++j) { if (j == 1 || two) { const int t = (tb0 + j) * 16 + fr; const float bt = j ? bt1 : bt0; const f32x4 a = j ? a1 : a0;
                  const float p0 = (s0 <= t) ? a[0] * __expf(bt + bi0) : 0.f, p1 = (s0 + 1 <= t) ? a[1] * __expf(bt + bi1) : 0.f, p2 = (s0 + 2 <= t) ? a[2] * __expf(bt + bi2) : 0.f, p3 = (s0 + 3 <= t) ? a[3] * __expf(bt + bi3) : 0.f;
                  u32x2 pw; pw.x = pk2(p0, p1); pw.y = pk2(p2, p3); *(LAS u32x2*)(L + oP + t * TS + s0 * 2) = pw; } } } }
            LBAR();
            { const int tb = w & 3;
              const int n2 = (w < 4) ? 2 : 1;
              bf16x8 qf[6], pf[2], vtf[2][2], ctf[2][6];
#pragma unroll
              for (int kk = 0; kk < 6; ++kk) qf[kk] = MM_FRAG(oQ, tb * 16, QS, kk);
#pragma unroll
              for (int kk = 0; kk < 2; ++kk) pf[kk] = MM_FRAG(oP, tb * 16, TS, kk);
#pragma unroll
              for (int j = 0; j < 2; ++j) { if (j < n2) { const int vt = (w < 4) ? j : 2;
#pragma unroll
                  for (int kk = 0; kk < 2; ++kk) vtf[j][kk] = MM_FRAG(oVT, vt * 16, TS, kk);
#pragma unroll
                  for (int kk = 0; kk < 6; ++kk) ctf[j][kk] = MM_FRAG(oCT, vt * 16, QS, kk); } }
              const int t0r = tb * 16 + 4 * fq;
              const float si0 = gSIl[t0r], si1 = gSIl[t0r + 1], si2 = gSIl[t0r + 2], si3 = gSIl[t0r + 3];
              asm volatile("s_waitcnt lgkmcnt(0)" ::: "memory");
              bf16x8 ktf[3][2], vwf[2][2];
#pragma unroll
              for (int i = 0; i < 3; ++i) { ktf[i][0] = MM_TRF(i * 32); ktf[i][1] = MM_TRF(32 * QS + i * 32); }
#pragma unroll
              for (int j = 0; j < 2; ++j) { if (j < nvt) { vwf[j][0] = MM_FRAG(oVW, (vt0 + j) * 16, TS, 0); vwf[j][1] = MM_FRAG(oVW, (vt0 + j) * 16, TS, 1); } }
#pragma unroll
              for (int j = 0; j < 2; ++j) { if (j < n2) { const int vt = (w < 4) ? j : 2;
                  f32x4 d2 = {0.f, 0.f, 0.f, 0.f}, d3 = {0.f, 0.f, 0.f, 0.f};
#pragma unroll
                  for (int kk = 0; kk < 2; ++kk) d2 = __builtin_amdgcn_mfma_f32_16x16x32_bf16(pf[kk], vtf[j][kk], d2, 0, 0, 0);
#pragma unroll
                  for (int kk = 0; kk < 6; ++kk) d3 = __builtin_amdgcn_mfma_f32_16x16x32_bf16(qf[kk], ctf[j][kk], d3, 0, 0, 0);
                  const float o0 = si0 * d3[0] + d2[0], o1 = si1 * d3[1] + d2[1], o2 = si2 * d3[2] + d2[2], o3 = si3 * d3[3] + d2[3];
                  const size_t tg = tok0 + (size_t)c * 64 + t0r;
                  if (w < 4) { bf16_t* op = U + tg * LDU1 + 1792 + h * 192 + vs * 32 + vt * 16 + fr; op[0] = f2bf(o0); op[LDU1] = f2bf(o1); op[2 * LDU1] = f2bf(o2); op[3 * LDU1] = f2bf(o3); }
                  else if (fr == 0 && vs == 0) { float* dn = gDEN + tg * 4 + h; dn[0] = o0; dn[4] = o1; dn[8] = o2; dn[12] = o3; } } }
              asm volatile("s_waitcnt lgkmcnt(0)" ::: "memory");
#pragma unroll
              for (int i = 0; i < 3; ++i)
#pragma unroll
                  for (int j = 0; j < 2; ++j) { if (j < nvt) { f32x4 ca = Cacc[i][j] * dp;
                      ca = __builtin_amdgcn_mfma_f32_16x16x32_bf16(ktf[i][0], vwf[j][0], ca, 0, 0, 0);
                      ca = __builtin_amdgcn_mfma_f32_16x16x32_bf16(ktf[i][1], vwf[j][1], ca, 0, 0, 0); Cacc[i][j] = ca; } } }
            LBAR();
#pragma unroll
            for (int i = 0; i < 3; ++i)
#pragma unroll
                for (int j = 0; j < 2; ++j) { if (j < nvt) { const f32x4 ca = Cacc[i][j]; u32x2 cw; cw.x = pk2(ca[0], ca[1]); cw.y = pk2(ca[2], ca[3]);
                    *(LAS u32x2*)(L + oCT + ((vt0 + j) * 16 + fr) * QS + ((db0 + i) * 16 + 4 * fq) * 2) = cw; } }
            if (c + 1 < SEQ / 64) MM_STORE();
            LBAR();
        }
        STAMP2(18, 0);
#undef MM_FETCH
#undef MM_STORE
#undef MM_FRAG
#undef MM_TR4
#undef MM_TRF
#undef MM_H
    } else {
        PHASE_IDS
        const int w = __builtin_amdgcn_readfirstlane(tid >> 6), wq = w & 3, myc = w >> 2;
        const int fr = lane & 15, fq = lane >> 4;
        constexpr int US = 80, XS = 272, NB = SEQ / 32;
        constexpr int oU = 0, oW1 = 10240, oX = 20480, oH = 37888, oW2 = 55296, oZ = 59648, CH = 61696;
        LAS unsigned char* Lc = lds + myc * CH;
        __syncthreads();
        for (int i = tid; i < 2 * CH / 4; i += 512) ((LAS unsigned*)lds)[i] = 0u;
        __syncthreads();
        for (int i = tid; i < 2 * 128 * 16; i += 512) { const int cc = i >> 11, n = (i >> 4) & 127, k = i & 15; const int g_ = ((bid - 192) * 2 + cc) & 15;
            const float v = (n < 64) ? BBR[(g_ * 64 + n) * 16 + k] : BBI[(g_ * 64 + n - 64) * 16 + k];
            ((LAS bf16_t*)(lds + cc * CH + oW1 + n * US))[k] = f2bf(v); }
        for (int i = tid; i < 2 * 16 * 128; i += 512) { const int cc = i >> 11, hh = (i >> 7) & 15, k = i & 127; const int g_ = ((bid - 192) * 2 + cc) & 15;
            const float v = (k < 64) ? p.in[26][(g_ * 16 + hh) * 64 + k] : -p.in[27][(g_ * 16 + hh) * 64 + k - 64];
            ((LAS bf16_t*)(lds + cc * CH + oW2 + hh * XS))[k] = f2bf(v); }
        const int chain = (bid - 192) * 2 + myc, g = chain & 15, b = chain >> 4;
        bf16_t* gU = U + ((size_t)b * SEQ + (lane >> 1)) * LDU1 + g * 16 + (lane & 1) * 8;
        __syncthreads();
        if (wq == 3) {
            u32x4 sA, sB;
            const int lo = (lane >> 1) * US + (lane & 1) * 16, zo = (lane >> 1) * 32 + (lane & 1) * 16;
#define S5_LD(i_) (*(const u32x4*)(gU + (size_t)(((i_) < NB ? (i_) : NB - 1) * 32) * LDU1))
            sA = S5_LD(0); *(LAS u32x4*)(Lc + oU + 0 * 2560 + lo) = sA; sB = S5_LD(1); *(LAS u32x4*)(Lc + oU + 1 * 2560 + lo) = sB;
            sA = S5_LD(2); sB = S5_LD(3);
            LBAR(); LBAR();
            for (int it = 0; it < NB + 2; it += 2) {
                if (it + 2 < NB) *(LAS u32x4*)(Lc + oU + ((it + 2) & 3) * 2560 + lo) = sA;
                if (it >= 2) *(u32x4*)(gU + (size_t)((it - 2) * 32) * LDU1) = *(const LAS u32x4*)(Lc + oZ + (it & 1) * 1024 + zo);
                sA = S5_LD(it + 4);
                LBAR();
                if (it + 3 < NB) *(LAS u32x4*)(Lc + oU + ((it + 3) & 3) * 2560 + lo) = sB;
                if (it >= 1 && it - 1 < NB) *(u32x4*)(gU + (size_t)((it - 1) * 32) * LDU1) = *(const LAS u32x4*)(Lc + oZ + ((it + 1) & 1) * 1024 + zo);
                sB = S5_LD(it + 5);
                LBAR();
            }
#undef S5_LD
        } else if (wq == 1) {
            bf16x8 w1f[8];
#pragma unroll
            for (int j = 0; j < 8; ++j) w1f[j] = *(const LAS bf16x8*)(Lc + oW1 + (j * 16 + fr) * US + (8 * fq) * 2);
            auto xblk = [&](int blk) {
                const LAS unsigned char* Ut = Lc + oU + (blk & 3) * 2560; LAS unsigned char* Xt = Lc + oX + (blk & 1) * 8704;
                const bf16x8 u0 = *(const LAS bf16x8*)(Ut + fr * US + (8 * fq) * 2), u1 = *(const LAS bf16x8*)(Ut + (16 + fr) * US + (8 * fq) * 2);
                const f32x4 z4 = {0.f, 0.f, 0.f, 0.f};
#pragma unroll
                for (int j = 0; j < 8; ++j) { const f32x4 d0 = __builtin_amdgcn_mfma_f32_16x16x32_bf16(u0, w1f[j], z4, 0, 0, 0), d1 = __builtin_amdgcn_mfma_f32_16x16x32_bf16(u1, w1f[j], z4, 0, 0, 0);
                    LAS bf16_t* xp = (LAS bf16_t*)(Xt + (4 * fq) * XS) + j * 16 + fr;
#pragma unroll
                    for (int r = 0; r < 4; ++r) { xp[r * (XS / 2)] = f2bf(d0[r]); xp[(16 + r) * (XS / 2)] = f2bf(d1[r]); } } };
            LBAR();
            xblk(0);
            LBAR();
            for (int it = 0; it < NB + 2; ++it) { if (it + 1 < NB) xblk(it + 1); LBAR(); }
        } else if (wq == 0) {
            const float ar = LBR[g * 64 + lane], ai = LBI[g * 64 + lane];
            float hr = 0.f, hi = 0.f;
            LBAR(); LBAR();
            for (int it = 0; it < NB + 2; ++it) {
                if (it < NB) { const LAS bf16_t* xp = (const LAS bf16_t*)(Lc + oX + (it & 1) * 8704) + lane; LAS bf16_t* hp = (LAS bf16_t*)(Lc + oH + (it & 1) * 8704) + lane;
                    for (int t8 = 0; t8 < 32; t8 += 8) {
                        bf16_t xr[8], xi[8], or_[8], oi_[8];
#pragma unroll
                        for (int u = 0; u < 8; ++u) { xr[u] = xp[(t8 + u) * (XS / 2)]; xi[u] = xp[(t8 + u) * (XS / 2) + 64]; }
#pragma unroll
                        for (int u = 0; u < 8; ++u) { const float nr = fmaf(ar, hr, fmaf(-ai, hi, bf2f(xr[u]))), ni = fmaf(ar, hi, fmaf(ai, hr, bf2f(xi[u]))); hr = nr; hi = ni; or_[u] = f2bf(hr); oi_[u] = f2bf(hi); }
#pragma unroll
                        for (int u = 0; u < 8; ++u) { hp[(t8 + u) * (XS / 2)] = or_[u]; hp[(t8 + u) * (XS / 2) + 64] = oi_[u]; } } }
                LBAR();
            }
        } else {
            bf16x8 w2f[4];
#pragma unroll
            for (int kk = 0; kk < 4; ++kk) w2f[kk] = *(const LAS bf16x8*)(Lc + oW2 + fr * XS + (kk * 32 + 8 * fq) * 2);
            const float dsk = p.in[28][g * 16 + fr];
            LBAR(); LBAR();
            for (int it = 0; it < NB + 2; ++it) {
                if (it >= 1 && it - 1 < NB) { const int blk = it - 1; const LAS unsigned char* Ht = Lc + oH + (blk & 1) * 8704; const LAS unsigned char* Ut = Lc + oU + (blk & 3) * 2560; LAS unsigned char* Zt = Lc + oZ + (blk & 1) * 1024;
#pragma unroll
                    for (int tb = 0; tb < 2; ++tb) { f32x4 d = {0.f, 0.f, 0.f, 0.f};
#pragma unroll
                        for (int kk = 0; kk < 4; ++kk) d = __builtin_amdgcn_mfma_f32_16x16x32_bf16(*(const LAS bf16x8*)(Ht + (tb * 16 + fr) * XS + (kk * 32 + 8 * fq) * 2), w2f[kk], d, 0, 0, 0);
#pragma unroll
                        for (int r = 0; r < 4; ++r) { const int t = tb * 16 + 4 * fq + r;
                            const float y = d[r] + dsk * bf2f(*(const LAS bf16_t*)(Ut + t * US + fr * 2));
                            const float z = 0.5f * y * (1.f + tanhf_(0.7978845608028654f * (y + 0.044715f * y * y * y)));
                            *(LAS bf16_t*)(Zt + t * 32 + fr * 2) = f2bf(z); } } }
                LBAR();
            }
        }
        STAMP2(19, 192);
    }
    GSYNC();
    STAMP(11);

    {
        PHASE_IDS
        const int w = __builtin_amdgcn_readfirstlane(tid >> 6), fr = lane & 15, fq = lane >> 4;
        constexpr int ZS = 528;
        const bf16_t* WT = (const bf16_t*)(p.ws + WS_GLU);
        bf16x8 wf[2][8];
#pragma unroll
        for (int nt = 0; nt < 2; ++nt)
#pragma unroll
            for (int kk = 0; kk < 8; ++kk) wf[nt][kk] = *(const bf16x8*)(WT + (size_t)(w * 32 + nt * 16 + fr) * 256 + kk * 32 + 8 * fq);
        f32x4 bias4[2];
#pragma unroll
        for (int nt = 0; nt < 2; ++nt) bias4[nt] = *(const f32x4*)(p.in[30] + w * 32 + nt * 16 + 4 * fq);
        for (int m0 = bid * 64; m0 < M; m0 += G * 64) {
            __syncthreads();
#pragma unroll
            for (int i = 0; i < 4; ++i) { const int pp = tid + 512 * i, row = pp >> 5, c8 = (pp & 31) * 8; *(LAS u32x4*)(lds + row * ZS + c8 * 2) = *(const u32x4*)(U + (size_t)(m0 + row) * LDU1 + c8); }
            __syncthreads();
#pragma unroll
            for (int tb = 0; tb < 4; ++tb) { f32x4 d0 = {0.f, 0.f, 0.f, 0.f}, d1 = {0.f, 0.f, 0.f, 0.f};
#pragma unroll
                for (int kk = 0; kk < 8; ++kk) { const bf16x8 zf = *(const LAS bf16x8*)(lds + (tb * 16 + fr) * ZS + (kk * 32 + 8 * fq) * 2);
                    d0 = __builtin_amdgcn_mfma_f32_16x16x32_bf16(wf[0][kk], zf, d0, 0, 0, 0); d1 = __builtin_amdgcn_mfma_f32_16x16x32_bf16(wf[1][kk], zf, d1, 0, 0, 0); }
                const int t = tb * 16 + fr;
#pragma unroll
                for (int nt = 0; nt < 2; ++nt) { const f32x4 a = (nt ? d1 : d0) + bias4[nt]; const int n0 = w * 32 + nt * 16 + 4 * fq;
                    const u32x2 zz = *(const LAS u32x2*)(lds + t * ZS + n0 * 2);
                    u32x2 o; o.x = pk2(bflo(zz.x) * sigmoidf_(a[0]), bfhi(zz.x) * sigmoidf_(a[1])); o.y = pk2(bflo(zz.y) * sigmoidf_(a[2]), bfhi(zz.y) * sigmoidf_(a[3]));
                    *(u32x2*)(YC + (size_t)(m0 + t) * DM + n0) = o; } }
        }
    }
    {
        PHASE_IDS
        const int gw = bid * 8 + wave, NW = G * 8, hh = lane >> 4, c12 = lane * 12;
        f32x4 nw[3];
#pragma unroll
        for (int j = 0; j < 3; ++j) nw[j] = *(const f32x4*)(p.in[35] + c12 + 4 * j);
        for (int m0 = gw; m0 < M; m0 += NW * 4) {
            u32x2 xn[4][3], xo[4][3]; float dn[4];
#pragma unroll
            for (int u = 0; u < 4; ++u) { const int m = m0 + u * NW; const bf16_t* ur = U + (size_t)m * LDU1 + c12; dn[u] = gDEN[(size_t)m * 4 + hh];
#pragma unroll
                for (int j = 0; j < 3; ++j) { xn[u][j] = *(const u32x2*)(ur + 1792 + 4 * j); xo[u][j] = *(const u32x2*)(ur + 2560 + 4 * j); } }
#pragma unroll
            for (int u = 0; u < 4; ++u) { const int m = m0 + u * NW; const float inv = 1.0f / fmaxf(fabsf(dn[u]), 1.0f);
                float hv[12], og[12]; float ss = 0.f;
#pragma unroll
                for (int j = 0; j < 3; ++j) { hv[4 * j] = bflo(xn[u][j].x) * inv; hv[4 * j + 1] = bfhi(xn[u][j].x) * inv; hv[4 * j + 2] = bflo(xn[u][j].y) * inv; hv[4 * j + 3] = bfhi(xn[u][j].y) * inv;
                    og[4 * j] = bflo(xo[u][j].x); og[4 * j + 1] = bfhi(xo[u][j].x); og[4 * j + 2] = bflo(xo[u][j].y); og[4 * j + 3] = bfhi(xo[u][j].y); }
#pragma unroll
                for (int e = 0; e < 12; ++e) ss = fmaf(hv[e], hv[e], ss);
                const float rs = 1.0f / sqrtf(row_sum16(ss) * (1.f / 192.f) + RMS_EPS);
                bf16_t* yo = YC + (size_t)m * DM + 256 + c12;
#pragma unroll
                for (int j = 0; j < 3; ++j) { u32x2 w; w.x = pk2(hv[4 * j] * rs * nw[j][0] * sigmoidf_(og[4 * j]), hv[4 * j + 1] * rs * nw[j][1] * sigmoidf_(og[4 * j + 1]));
                    w.y = pk2(hv[4 * j + 2] * rs * nw[j][2] * sigmoidf_(og[4 * j + 2]), hv[4 * j + 3] * rs * nw[j][3] * sigmoidf_(og[4 * j + 3])); *(u32x2*)(yo + 4 * j) = w; } }
        }
    }
    GSYNC();
    STAMP(12);

    { pg8::Gemm g{YC, (const bf16_t*)(p.ws + WS_OUT1), DM, DM, M, DM, DM}; pg8::StaticOrder S; S.init(M, DM, G, bid);
      pg8::EpiResidual<false, true> E{nullptr, XB, XB, SS3}; pg8::gemm_phase<pg8::EpiResidual<false, true>, pg8::StaticOrder, true, true>(lds, g, S, E); }
    GSYNC();
    STAMP(13);
    { pg8::Gemm g{XB, (const bf16_t*)(p.ws + WS_GU1), DM, DM, M, 2 * FFN, DM}; pg8::StaticOrder S; S.init(M, 2 * FFN, G, bid);
      pg8::EpiSwiGlu E{HID, FFN, SS3}; pg8::gemm_phase<pg8::EpiSwiGlu, pg8::StaticOrder, true, true>(lds, g, S, E); }
    GSYNC();
    STAMP(14);
    { pg8::Gemm g{HID, (const bf16_t*)(p.ws + WS_D1), FFN, FFN, M, DM, FFN}; pg8::StaticOrder S; S.init(M, DM, G, bid);
      pg8::EpiResidual<false, false> E{nullptr, XB, XB, nullptr}; pg8::gemm_phase<pg8::EpiResidual<false, false>, pg8::StaticOrder, true, true>(lds, g, S, E); }
    GSYNC();
    STAMP(15);

    {
        PHASE_IDS
        const f32x4* gg = (const f32x4*)p.in[3] + lane;
        f32x4 gv[4];
#pragma unroll
        for (int j = 0; j < 4; ++j) gv[j] = gg[64 * j];
        for (int row = bid * 8 + wave; row < M; row += G * 32) {
            u32x2 w[4][4];
#pragma unroll
            for (int r = 0; r < 4; ++r)
#pragma unroll
                for (int j = 0; j < 4; ++j) w[r][j] = ((const u32x2*)(XB + (size_t)(row + r * G * 8) * DM))[64 * j + lane];
#pragma unroll
            for (int r = 0; r < 4; ++r) { f32x4 v[4]; float s = 0.f;
#pragma unroll
                for (int j = 0; j < 4; ++j) { v[j] = (f32x4){bflo(w[r][j].x), bfhi(w[r][j].x), bflo(w[r][j].y), bfhi(w[r][j].y)}; s += (v[j][0] * v[j][0] + v[j][1] * v[j][1]) + (v[j][2] * v[j][2] + v[j][3] * v[j][3]); }
                const float rs = 1.0f / sqrtf(wave_sum(s) * (1.f / DM) + RMS_EPS);
                f32x4* xr = (f32x4*)(p.out + (size_t)(row + r * G * 8) * DM) + lane;
#pragma unroll
                for (int j = 0; j < 4; ++j) xr[64 * j] = v[j] * rs * gv[j]; }
        }
    }
    STAMP(16);
#if PROBE
    if (bid == 0 && threadIdx.x == 0) {
        const unsigned long long* ts = (const unsigned long long*)(p.ws + CTL_TS);
        const int order[18] = {0, 1, 2, 3, 17, 4, 5, 6, 7, 8, 9, 10, 11, 12, 13, 14, 15, 16};
        unsigned long long extra = 0;
        for (int j = 0; j < 17; ++j) if ((PROBE_MASK >> j) & 1) extra += __hip_atomic_load(ts + order[j + 1], __ATOMIC_RELAXED, __HIP_MEMORY_SCOPE_AGENT) - __hip_atomic_load(ts + order[j], __ATOMIC_RELAXED, __HIP_MEMORY_SCOPE_AGENT);
#ifdef PROBE_A
        extra += __hip_atomic_load(ts + PROBE_B, __ATOMIC_RELAXED, __HIP_MEMORY_SCOPE_AGENT) - __hip_atomic_load(ts + PROBE_A, __ATOMIC_RELAXED, __HIP_MEMORY_SCOPE_AGENT);
#endif
        const unsigned long long t0 = __builtin_amdgcn_s_memrealtime();
        while (__builtin_amdgcn_s_memrealtime() - t0 < extra) __builtin_amdgcn_s_sleep(8);
    }
#endif
}

extern "C" void kernel_launch(void* const* d_in, const int* in_sizes, int n_in, void* d_out, int out_size, void* d_ws, size_t ws_size, hipStream_t stream) {
    static int ready = 0;
    if (!ready) {
        if (n_in != 39 || out_size != M * DM || ws_size < WS_END) { fprintf(stderr, "kernel_launch: unexpected problem shape (n_in %d out %d ws %zu)\n", n_in, out_size, ws_size); ready = -1; return; }
        if (hipFuncSetAttribute((const void*)mega, hipFuncAttributeMaxDynamicSharedMemorySize, LDS_BYTES) != hipSuccess) { fprintf(stderr, "kernel_launch: hipFuncSetAttribute failed\n"); ready = -1; return; }
        int per_cu = 0; (void)hipOccupancyMaxActiveBlocksPerMultiprocessor(&per_cu, (const void*)mega, 512, LDS_BYTES);
        if (per_cu < 1) fprintf(stderr, "kernel_launch: occupancy query says %d blocks per CU\n", per_cu);
        (void)hipGetLastError();
        ready = 1;
    }
    if (ready < 0) return;
    (void)hipMemsetAsync((char*)d_ws + WS_CTL, 0, CTL_BYTES, stream);
    Params p{};
    for (int i = 0; i < 39; ++i) p.in[i] = (const float*)d_in[i];
    p.out = (float*)d_out; p.ws = (unsigned char*)d_ws;
    void* args[] = {&p};
    hipError_t e = hipLaunchCooperativeKernel((const void*)mega, dim3(256), dim3(512), args, LDS_BYTES, stream);
    if (e != hipSuccess) fprintf(stderr, "kernel_launch: cooperative launch failed: %s\n", hipGetErrorString(e));
}
```

```cpp
#include <hip/hip_runtime.h>
#include <hip/hip_cooperative_groups.h>
#include <cstdio>
#include <cstdint>
#include <cmath>
namespace cg = cooperative_groups;

#define LAS __attribute__((address_space(3)))
typedef unsigned short bf16_t;
typedef short bf16x8 __attribute__((ext_vector_type(8)));
typedef short s16x4 __attribute__((ext_vector_type(4)));
typedef float f32x4 __attribute__((ext_vector_type(4)));
typedef unsigned u32x4 __attribute__((ext_vector_type(4)));
typedef unsigned u32x2 __attribute__((ext_vector_type(2)));

constexpr int SEQ = 4096, BATCH = 8, DM = 1024, M = BATCH * SEQ;
constexpr int EVEN_IN = 3744, LDU0 = 3840, ODD_IN = 3336, NP1 = 3584, LDU1 = 3712, FFN = 2816;
constexpr float RMS_EPS = 1e-6f;

constexpr size_t MiB = 1u << 20;
constexpr size_t WS_CTL = 0, CTL_BYTES = 1 * MiB;
constexpr size_t CTL_SS1 = 128 * 1024, CTL_SS2 = 256 * 1024, CTL_SS3 = 384 * 1024, CTL_SS0 = 512 * 1024;
constexpr size_t CTL_TS = 800 * 1024;
constexpr size_t CTL_LB = 640 * 1024, CTL_LBR = 644 * 1024, CTL_LBI = 648 * 1024, CTL_BBR = 656 * 1024, CTL_BBI = 720 * 1024;
constexpr size_t WS_IN0 = 1 * MiB, WS_OUT0 = WS_IN0 + (size_t)LDU0 * DM * 2, WS_GU0 = WS_OUT0 + 2 * MiB, WS_D0 = WS_GU0 + 11 * MiB;
constexpr size_t WS_IN1 = WS_D0 + (size_t)DM * FFN * 2, WS_OUT1 = WS_IN1 + (size_t)NP1 * DM * 2, WS_GU1 = WS_OUT1 + 2 * MiB, WS_D1 = WS_GU1 + 11 * MiB;
constexpr size_t WS_GLU = WS_D1 + (size_t)DM * FFN * 2;
constexpr size_t WS_LORA = WS_GLU + 256 * 256 * 2;
constexpr size_t WS_XB = 53 * MiB, WS_YC = 117 * MiB, WS_U = 181 * MiB, WS_MS = 421 * MiB, WS_END = 512 * MiB;
constexpr size_t WS_SSQ = WS_MS + 70 * MiB;
static_assert(WS_LORA + 512 * 160 * 2 <= WS_XB, "weights fit");
static_assert(WS_U + (size_t)M * LDU0 * 2 <= WS_MS, "U fits");

__device__ __forceinline__ float bf2f(bf16_t h) { return __uint_as_float(((unsigned)h) << 16); }
__device__ __forceinline__ float bflo(unsigned w) { return __uint_as_float(w << 16); }
__device__ __forceinline__ unsigned long long ss_fix(float s) { return (unsigned long long)(s * 1048576.0f); }
__device__ __forceinline__ float ss_flt(unsigned long long q) { return ((float)(unsigned)(q >> 32) * 4294967296.0f + (float)(unsigned)q) * (1.0f / 1048576.0f); }
__device__ __forceinline__ float bfhi(unsigned w) { return __uint_as_float(w & 0xffff0000u); }
typedef __bf16 bf16x2_t __attribute__((ext_vector_type(2)));
typedef float f32x2c_t __attribute__((ext_vector_type(2)));
__device__ __forceinline__ unsigned pk2(float lo, float hi) { const bf16x2_t v = __builtin_convertvector((f32x2c_t){lo, hi}, bf16x2_t); return __builtin_bit_cast(unsigned, v); }
__device__ __forceinline__ bf16_t f2bf(float f) { const __bf16 b = (__bf16)f; return __builtin_bit_cast(bf16_t, b); }
__device__ __forceinline__ float sigmoidf_(float x) { return __builtin_amdgcn_rcpf(1.f + __expf(-x)); }
__device__ __forceinline__ float rsqrtf_(float x) { return __builtin_amdgcn_rsqf(x); }
__device__ __forceinline__ float siluf_(float x) { return x * sigmoidf_(x); }
__device__ __forceinline__ float softplusf_(float x) { return fmaxf(x, 0.f) + __logf(1.f + __expf(-fabsf(x))); }
__device__ __forceinline__ float tanhf_(float x) { const float e = __expf(-2.f * fabsf(x)); const float t = (1.f - e) * __builtin_amdgcn_rcpf(1.f + e); return x < 0.f ? -t : t; }
template <int CTRL> __device__ __forceinline__ float dpp_mov(float x) { return __int_as_float(__builtin_amdgcn_update_dpp(0, __float_as_int(x), CTRL, 0xf, 0xf, true)); }
__device__ __forceinline__ float row_sum16(float v) { v += dpp_mov<0xB1>(v); v += dpp_mov<0x4E>(v); v += dpp_mov<0x141>(v); v += dpp_mov<0x140>(v); return v; }
__device__ __forceinline__ float xrow16(float v) { const auto r = __builtin_amdgcn_permlane16_swap(__float_as_uint(v), __float_as_uint(v), false, false); return __uint_as_float(r[0]) + __uint_as_float(r[1]); }
__device__ __forceinline__ float xrow32(float v) { const auto r = __builtin_amdgcn_permlane32_swap(__float_as_uint(v), __float_as_uint(v), false, false); return __uint_as_float(r[0]) + __uint_as_float(r[1]); }
__device__ __forceinline__ float half_sum(float v) { return xrow16(row_sum16(v)); }
__device__ __forceinline__ float wave_sum(float v) { return xrow32(half_sum(v)); }

typedef float f32x2 __attribute__((ext_vector_type(2)));
__device__ __forceinline__ void half_reduce8(const float (&p)[8], int lane, float& o0, float& o1) {
    const bool b0 = (lane & 1) != 0, b1 = (lane & 2) != 0;
    float r[4];
#pragma unroll
    for (int i = 0; i < 4; ++i) { const float keep = b0 ? p[2 * i + 1] : p[2 * i], send = b0 ? p[2 * i] : p[2 * i + 1]; r[i] = keep + dpp_mov<0xB1>(send); }
    float q0, q1;
    { const float keep = b1 ? r[1] : r[0], send = b1 ? r[0] : r[1]; q0 = keep + dpp_mov<0x4E>(send); }
    { const float keep = b1 ? r[3] : r[2], send = b1 ? r[2] : r[3]; q1 = keep + dpp_mov<0x4E>(send); }
    q0 += dpp_mov<0x124>(q0); q0 += dpp_mov<0x128>(q0);
    q1 += dpp_mov<0x124>(q1); q1 += dpp_mov<0x128>(q1);
    o0 = xrow16(q0); o1 = xrow16(q1);
}

#define LBAR() do { asm volatile("s_waitcnt lgkmcnt(0)" ::: "memory"); __builtin_amdgcn_s_barrier(); asm volatile("" ::: "memory"); } while (0)
namespace pg8 {
constexpr int BM = 256, BK = 64, HALF = 128, HTB = HALF * BK * 2, STAGE_BYTES = 8 * HTB, NXCD = 8, WGM = 8;
__device__ __forceinline__ int lds_byte(int r, int c) { const int st = (r >> 4) * 2 + (c >> 5), rr = r & 15, cc = c & 31, ob = rr * 64 + cc * 2; return st * 1024 + (ob ^ (((ob >> 9) & 1) << 5)); }
__device__ __forceinline__ void stage_rc(int b, int& R, int& C) { const int st = b / 1024, sb = b % 1024, swz = sb ^ (((sb >> 9) & 1) << 5); R = (st >> 1) * 16 + swz / 64; C = (st & 1) * 32 + (swz % 64) / 2; }
__device__ __forceinline__ int perm32(int rho) { const int n = rho >> 4, i = rho & 15; return 8 * (i >> 2) + 4 * n + (i & 3); }
struct Unit { int pm, pn; };
struct Gemm { const bf16_t* A; const bf16_t* Bt; int lda, ldb, M, N, K; };
struct StaticOrder {
    int nM, nN, nwg, G, c;
    __device__ void init(int M_, int N_, int G_, int c_) { nM = M_ / BM; nN = N_ / BM; nwg = nM * nN; G = G_; c = c_; }
    __device__ bool next(int i, Unit& u) const {
        const long L = (long)i * G + c; if (L >= nwg) return false;
        int wgid = (int)L; { const int q = nwg / NXCD, r = nwg % NXCD, xcd = wgid % NXCD, off = wgid / NXCD; wgid = (xcd < r ? xcd * (q + 1) : r * (q + 1) + (xcd - r) * q) + off; }
        const int nig = WGM * nN, gid = wgid / nig, fm = gid * WGM, gsz = (nM - fm) < WGM ? (nM - fm) : WGM;
        u.pm = fm + ((wgid % nig) % gsz); u.pn = (wgid % nig) / gsz; return true;
    }
};

struct EpiScaleBf16 {
    static constexpr bool PERM = true;
    bf16_t* O; int ldc; const unsigned long long* ss;
    __device__ __forceinline__ void operator()(const f32x4 (&acc)[2][2][4][2], const Unit& u, int wr, int wc, int fr, int fq) const {
        const int row0 = u.pm * BM + wr * 64 + fr, col0 = u.pn * BM + wc * 32 + 8 * fq;
#pragma unroll
        for (int ai = 0; ai < 2; ++ai)
#pragma unroll
            for (int m = 0; m < 4; ++m) { const int row = row0 + ai * HALF + m * 16; const float rs = rsqrtf_(ss_flt(ss[row]) * (1.f / DM) + RMS_EPS);
                bf16_t* rowp = O + (size_t)row * ldc + col0;
#pragma unroll
                for (int bj = 0; bj < 2; ++bj) { const f32x4 v0 = acc[ai][bj][m][0] * rs, v1 = acc[ai][bj][m][1] * rs;
                    u32x4 w; w.x = pk2(v0[0], v0[1]); w.y = pk2(v0[2], v0[3]); w.z = pk2(v1[0], v1[1]); w.w = pk2(v1[2], v1[3]);
                    *(u32x4*)(rowp + bj * HALF) = w; } }
    }
};
struct EpiSwiGlu {
    static constexpr bool PERM = true;
    bf16_t* O; int ldc; const unsigned long long* ss;
    __device__ __forceinline__ void operator()(const f32x4 (&acc)[2][2][4][2], const Unit& u, int wr, int wc, int fr, int fq) const {
        const int row0 = u.pm * BM + wr * 64 + fr, col0 = u.pn * HALF + wc * 32 + 8 * fq;
#pragma unroll
        for (int ai = 0; ai < 2; ++ai)
#pragma unroll
            for (int m = 0; m < 4; ++m) { const int row = row0 + ai * HALF + m * 16; const float rs = rsqrtf_(ss_flt(ss[row]) * (1.f / DM) + RMS_EPS);
                f32x4 h[2];
#pragma unroll
                for (int n = 0; n < 2; ++n) { const f32x4 g = acc[ai][0][m][n] * rs, up = acc[ai][1][m][n] * rs;
#pragma unroll
                    for (int e = 0; e < 4; ++e) h[n][e] = siluf_(g[e]) * up[e]; }
                u32x4 w; w.x = pk2(h[0][0], h[0][1]); w.y = pk2(h[0][2], h[0][3]); w.z = pk2(h[1][0], h[1][1]); w.w = pk2(h[1][2], h[1][3]);
                *(u32x4*)(O + (size_t)row * ldc + col0) = w; }
    }
};
template <bool BASE_F32, bool WITH_SS> struct EpiResidual {
    static constexpr bool PERM = true;
    const float* base32; const bf16_t* base16; bf16_t* xb; unsigned long long* ss;
    __device__ __forceinline__ void operator()(const f32x4 (&acc)[2][2][4][2], const Unit& u, int wr, int wc, int fr, int fq) const {
        const int row0 = u.pm * BM + wr * 64 + fr, col0 = u.pn * BM + wc * 32 + 8 * fq;
#pragma unroll
        for (int ai = 0; ai < 2; ++ai)
#pragma unroll
            for (int m = 0; m < 4; ++m) { const int row = row0 + ai * HALF + m * 16; const size_t off = (size_t)row * DM + col0; float s = 0.f;
#pragma unroll
                for (int bj = 0; bj < 2; ++bj) { const size_t o = off + bj * HALF; f32x4 r0, r1;
                    if (BASE_F32) { r0 = *(const f32x4*)(base32 + o); r1 = *(const f32x4*)(base32 + o + 4); }
                    else { const u32x4 rb = *(const u32x4*)(base16 + o); r0 = (f32x4){bflo(rb.x), bfhi(rb.x), bflo(rb.y), bfhi(rb.y)}; r1 = (f32x4){bflo(rb.z), bfhi(rb.z), bflo(rb.w), bfhi(rb.w)}; }
                    const f32x4 v0 = r0 + acc[ai][bj][m][0], v1 = r1 + acc[ai][bj][m][1];
                    u32x4 w; w.x = pk2(v0[0], v0[1]); w.y = pk2(v0[2], v0[3]); w.z = pk2(v1[0], v1[1]); w.w = pk2(v1[2], v1[3]); *(u32x4*)(xb + o) = w;
                    s += ((v0[0] * v0[0] + v0[1] * v0[1]) + (v0[2] * v0[2] + v0[3] * v0[3])) + ((v1[0] * v1[0] + v1[1] * v1[1]) + (v1[2] * v1[2] + v1[3] * v1[3])); }
                if (WITH_SS) { s = xrow32(xrow16(s)); if (fq == 0) atomicAdd(ss + row, ss_fix(s)); } }
    }
};

template <class Epi, class Sched, bool ALIGN_EPI, bool SP2>
__device__ __forceinline__ void gemm_phase(LAS unsigned char* lds, const Gemm g, const Sched& S, const Epi& E) {
    int tid_ = threadIdx.x; asm volatile("" : "+v"(tid_));
    const int tid = tid_, wid = __builtin_amdgcn_readfirstlane(tid >> 6), lane = tid & 63, wr = wid >> 2, wc = wid & 3, fr = lane & 15, fq = lane >> 4;
    const int K = g.K, nt = K / BK;
    unsigned voffA[2], voffB[2];
#pragma unroll
    for (int i = 0; i < 2; ++i) { int R, C; stage_rc(tid * 16 + i * 8192, R, C); const int Rb = Epi::PERM ? ((R & ~31) + perm32(R & 31)) : R;
        voffA[i] = (unsigned)(R * g.lda + C) * 2u; voffB[i] = (unsigned)(Rb * g.ldb + C) * 2u; }
    const size_t kstep = (size_t)(BK * 2);
    const size_t hstepA = (size_t)HALF * g.lda * 2, hstepB = (size_t)HALF * g.ldb * 2;
    const size_t tstepA = 2 * hstepA, tstepB = 2 * hstepB;
    const unsigned ldsw = (unsigned)wid * 1024u;
    const int aoff = lds_byte(wr * 64 + fr, fq * 8), boff = lds_byte(wc * 32 + fr, fq * 8);
#define PG8_SA(b, h) (((b) * 2 + (h)) * HTB)
#define PG8_SB(b, h) ((4 + (b) * 2 + (h)) * HTB)
#define PG8_STAGE(bufoff, gbase, voff) do { _Pragma("unroll") for (int _i = 0; _i < 2; ++_i) \
        __builtin_amdgcn_global_load_lds((const unsigned*)((const char*)(gbase) + (voff)[_i]), (LAS unsigned*)(lds + (bufoff) + ldsw + _i * 8192), 16, 0, 0); } while (0)
#define PG8_LDA(dst, b, h) do { _Pragma("unroll") for (int m = 0; m < 4; ++m) _Pragma("unroll") for (int k = 0; k < 2; ++k) dst[m][k] = *(const LAS bf16x8*)(lds + PG8_SA(b, h) + aoff + m * 2048 + k * 1024); } while (0)
#define PG8_LDB(dst, b, h) do { _Pragma("unroll") for (int n = 0; n < 2; ++n) _Pragma("unroll") for (int k = 0; k < 2; ++k) dst[n][k] = *(const LAS bf16x8*)(lds + PG8_SB(b, h) + boff + n * 2048 + k * 1024); } while (0)
#define PG8_MMA(ai, bj, At, Bt) do { __builtin_amdgcn_s_setprio(1); _Pragma("unroll") for (int m = 0; m < 4; ++m) _Pragma("unroll") for (int n = 0; n < 2; ++n) _Pragma("unroll") for (int k = 0; k < 2; ++k) \
        acc[ai][bj][m][n] = __builtin_amdgcn_mfma_f32_16x16x32_bf16(Bt[n][k], At[m][k], acc[ai][bj][m][n], 0, 0, 0); __builtin_amdgcn_s_setprio(0); } while (0)
#define PG8_WAIT_V(n) asm volatile("s_waitcnt vmcnt(" #n ")" ::: "memory")
#define PG8_WAIT_L(n) asm volatile("s_waitcnt lgkmcnt(" #n ")" ::: "memory")
#define PG8_BAR __builtin_amdgcn_s_barrier()
#define PG8_SCHED __builtin_amdgcn_sched_barrier(0)
    Unit cur, nxt; int ui = 0;
    if (!S.next(0, cur)) return;
    f32x4 acc[2][2][4][2];
#pragma unroll
    for (int a = 0; a < 2; ++a)
#pragma unroll
        for (int b = 0; b < 2; ++b)
#pragma unroll
            for (int m = 0; m < 4; ++m)
#pragma unroll
                for (int n = 0; n < 2; ++n) acc[a][b][m][n] = (f32x4){0.f, 0.f, 0.f, 0.f};
    bf16x8 At[4][2], B0[2][2], B1[2][2];
    const char* cA = (const char*)g.A + (size_t)cur.pm * tstepA; const char* cB = (const char*)g.Bt + (size_t)cur.pn * tstepB;
    if constexpr (SP2) {
        PG8_STAGE(PG8_SB(0, 0), cB, voffB); PG8_STAGE(PG8_SB(0, 1), cB + hstepB, voffB); PG8_STAGE(PG8_SA(0, 0), cA, voffA); PG8_STAGE(PG8_SA(0, 1), cA + hstepA, voffA);
        if (wr == 1) PG8_BAR;
        PG8_WAIT_V(2); PG8_BAR;
        PG8_STAGE(PG8_SB(1, 0), cB + kstep, voffB); PG8_STAGE(PG8_SA(1, 0), cA + kstep, voffA); PG8_STAGE(PG8_SB(1, 1), cB + hstepB + kstep, voffB);
        PG8_WAIT_V(6); PG8_BAR;
    } else {
        PG8_STAGE(PG8_SB(0, 0), cB, voffB); PG8_STAGE(PG8_SA(0, 0), cA, voffA); PG8_STAGE(PG8_SB(0, 1), cB + hstepB, voffB); PG8_STAGE(PG8_SA(0, 1), cA + hstepA, voffA);
        if (wr == 1) PG8_BAR;
        PG8_WAIT_V(4); PG8_BAR;
        PG8_STAGE(PG8_SB(1, 0), cB + kstep, voffB); PG8_STAGE(PG8_SA(1, 0), cA + kstep, voffA); PG8_STAGE(PG8_SB(1, 1), cB + hstepB + kstep, voffB);
        PG8_WAIT_V(6); PG8_BAR;
    }
    for (;;) {
        const bool has_next = S.next(ui + 1, nxt);
        const char* nA = has_next ? (const char*)g.A + (size_t)nxt.pm * tstepA : cA; const char* nB = has_next ? (const char*)g.Bt + (size_t)nxt.pn * tstepB : cB;
        for (int t = 0; t < nt; t += 2) {
            const bool last = (t == nt - 2);
            const char* a1 = cA + (size_t)(t + 1) * kstep;
            const char* a2 = last ? nA : cA + (size_t)(t + 2) * kstep; const char* b2 = last ? nB : cB + (size_t)(t + 2) * kstep;
            const char* a3 = a2 + kstep; const char* b3 = b2 + kstep;
            if constexpr (SP2) {
            PG8_LDB(B0, 0, 0); PG8_LDB(B1, 0, 1); PG8_SCHED; PG8_LDA(At, 0, 0); PG8_STAGE(PG8_SA(1, 1), a1 + hstepA, voffA);
            PG8_WAIT_V(8); PG8_WAIT_L(0); PG8_BAR; PG8_MMA(0, 0, At, B0); PG8_MMA(0, 1, At, B1); PG8_BAR; PG8_SCHED;
            PG8_LDA(At, 0, 1); PG8_STAGE(PG8_SB(0, 0), b2, voffB); PG8_STAGE(PG8_SB(0, 1), b2 + hstepB, voffB); PG8_STAGE(PG8_SA(0, 0), a2, voffA);
            PG8_WAIT_V(8); PG8_WAIT_L(0); PG8_BAR; PG8_MMA(1, 0, At, B0); PG8_MMA(1, 1, At, B1); PG8_BAR; PG8_SCHED;
            PG8_LDB(B0, 1, 0); PG8_LDB(B1, 1, 1); PG8_SCHED; PG8_LDA(At, 1, 0); PG8_STAGE(PG8_SA(0, 1), a2 + hstepA, voffA);
            PG8_WAIT_V(8); PG8_WAIT_L(0); PG8_BAR; PG8_MMA(0, 0, At, B0); PG8_MMA(0, 1, At, B1); PG8_BAR; PG8_SCHED;
            PG8_LDA(At, 1, 1); PG8_STAGE(PG8_SB(1, 0), b3, voffB); PG8_STAGE(PG8_SB(1, 1), b3 + hstepB, voffB); PG8_STAGE(PG8_SA(1, 0), a3, voffA);
            PG8_WAIT_V(8); PG8_WAIT_L(0); PG8_BAR; PG8_MMA(1, 0, At, B0); PG8_MMA(1, 1, At, B1); PG8_BAR; PG8_SCHED;
            } else {
            PG8_LDB(B0, 0, 0); PG8_SCHED; PG8_LDA(At, 0, 0); PG8_STAGE(PG8_SA(1, 1), a1 + hstepA, voffA);
            PG8_WAIT_L(8); PG8_BAR; PG8_WAIT_L(0); PG8_MMA(0, 0, At, B0); PG8_BAR; PG8_SCHED;
            PG8_LDB(B1, 0, 1); PG8_STAGE(PG8_SB(0, 0), b2, voffB);
            PG8_BAR; PG8_WAIT_L(0); PG8_MMA(0, 1, At, B1); PG8_BAR;
            PG8_LDA(At, 0, 1); PG8_STAGE(PG8_SA(0, 0), a2, voffA);
            PG8_BAR; PG8_WAIT_L(0); PG8_MMA(1, 0, At, B0); PG8_BAR; PG8_SCHED;
            PG8_STAGE(PG8_SB(0, 1), b2 + hstepB, voffB);
            PG8_WAIT_V(6); PG8_BAR; PG8_MMA(1, 1, At, B1); PG8_BAR;
            PG8_LDB(B0, 1, 0); PG8_SCHED; PG8_LDA(At, 1, 0); PG8_STAGE(PG8_SA(0, 1), a2 + hstepA, voffA);
            PG8_WAIT_L(8); PG8_BAR; PG8_WAIT_L(0); PG8_MMA(0, 0, At, B0); PG8_BAR; PG8_SCHED;
            PG8_LDB(B1, 1, 1); PG8_STAGE(PG8_SB(1, 0), b3, voffB);
            PG8_BAR; PG8_WAIT_L(0); PG8_MMA(0, 1, At, B1); PG8_BAR;
            PG8_LDA(At, 1, 1); PG8_STAGE(PG8_SA(1, 0), a3, voffA);
            PG8_BAR; PG8_WAIT_L(0); PG8_MMA(1, 0, At, B0); PG8_BAR; PG8_SCHED;
            PG8_STAGE(PG8_SB(1, 1), b3 + hstepB, voffB);
            PG8_WAIT_V(6); PG8_BAR; PG8_MMA(1, 1, At, B1); PG8_BAR;
            }
        }
        if constexpr (ALIGN_EPI) { if (wr == 0) PG8_BAR; }
        E(acc, cur, wr, wc, fr, fq);
        if (!has_next) break;
#pragma unroll
        for (int a = 0; a < 2; ++a)
#pragma unroll
            for (int b = 0; b < 2; ++b)
#pragma unroll
                for (int m = 0; m < 4; ++m)
#pragma unroll
                    for (int n = 0; n < 2; ++n) acc[a][b][m][n] = (f32x4){0.f, 0.f, 0.f, 0.f};
        cur = nxt; cA = nA; cB = nB; ++ui;
        if constexpr (ALIGN_EPI) { if (wr == 1) PG8_BAR; }
    }
    PG8_WAIT_V(0);
    if constexpr (!ALIGN_EPI) { if (wr == 0) PG8_BAR; }
    PG8_BAR;
#undef PG8_SA
#undef PG8_SB
#undef PG8_STAGE
#undef PG8_LDA
#undef PG8_LDB
#undef PG8_MMA
#undef PG8_WAIT_V
#undef PG8_WAIT_L
#undef PG8_BAR
#undef PG8_SCHED
}
}

#define XB_TMO      128
#define XB_XCNT(j)  (256  + 64 * (j))
#define XB_XSUB(j)  (1280 + 64 * (j))
#define XB_XGEN(j)  (2304 + 64 * (j))
#define XB_TOP      3328
#define XB_TOPGEN   3392
#define XCD_BAR_WORDS 3456
#define XB_SPIN_CAP (1u << 18)
__device__ __forceinline__ unsigned xb_ld(unsigned* p)              { return __hip_atomic_load(p, __ATOMIC_RELAXED, __HIP_MEMORY_SCOPE_AGENT); }
__device__ __forceinline__ unsigned xb_add(unsigned* p, unsigned v) { return __hip_atomic_fetch_add(p, v, __ATOMIC_RELAXED, __HIP_MEMORY_SCOPE_AGENT); }
__device__ __forceinline__ unsigned xb_xcc_id() { return (unsigned)__builtin_amdgcn_s_getreg((3 << 11) | 20) & 0xFu; }
#define XB_SPIN(cond, bar) do { unsigned _sp = 0; while (cond) { __builtin_amdgcn_s_sleep(1); \
    if ((++_sp & 255u) == 0u) { if (xb_ld(&(bar)[XB_TMO])) break; if (_sp > XB_SPIN_CAP) { atomicAdd(&(bar)[XB_TMO], 1u); break; } } } } while (0)
struct XcdBarrier { unsigned* bar; unsigned x; volatile LAS unsigned* st; };
__device__ __forceinline__ XcdBarrier xcd_barrier_post(unsigned* bar, volatile LAS unsigned* st) {
    XcdBarrier b; b.bar = bar; b.x = xb_xcc_id(); b.st = st;
    if (threadIdx.x == 0) (void)xb_add(&bar[XB_XCNT(b.x)], 1u);
    return b;
}
__device__ __forceinline__ void xcd_barrier_complete(unsigned* bar, unsigned x, unsigned& nloc, unsigned& nx) {
    const unsigned G = gridDim.x * gridDim.y * gridDim.z;
    unsigned sum, cnt, mine, sp = 0u;
    for (;;) {
        sum = 0u; cnt = 0u; mine = 0u;
#pragma unroll
        for (unsigned j = 0; j < 16; ++j) { const unsigned c = xb_ld(&bar[XB_XCNT(j)]); sum += c; cnt += (c > 0u) ? 1u : 0u; mine = (j == x) ? c : mine; }
        if (sum == G) break;
        __builtin_amdgcn_s_sleep(1);
        if ((++sp & 255u) == 0u) { if (xb_ld(&bar[XB_TMO])) break; if (sp > XB_SPIN_CAP) { atomicAdd(&bar[XB_TMO], 1u); break; } }
    }
    nloc = mine > 0u ? mine : 1u; nx = cnt > 0u ? cnt : 1u;
}
__device__ __forceinline__ void xcd_barrier(const XcdBarrier& b, const int tid0) {
    asm volatile("s_waitcnt vmcnt(0)" ::: "memory");
    __syncthreads();
    if (tid0 == 0) {
        unsigned* bar = b.bar;
        __builtin_amdgcn_s_waitcnt(0);
        unsigned nloc = b.st[0], nx = b.st[1];
        if (nloc == 0u) { xcd_barrier_complete(bar, b.x, nloc, nx); b.st[0] = nloc; b.st[1] = nx; }
        const unsigned old = xb_add(&bar[XB_XSUB(b.x)], 1u);
        const unsigned gen = old / nloc;
        if (old + 1u == (gen + 1u) * nloc) {
            __builtin_amdgcn_fence(__ATOMIC_RELEASE, "agent");
            asm volatile("s_waitcnt vmcnt(0)" ::: "memory");
            const unsigned og = xb_add(&bar[XB_TOP], 1u);
            const unsigned tg = og / nx;
            if (og + 1u == (tg + 1u) * nx) xb_add(&bar[XB_TOPGEN], 1u);
            else XB_SPIN(xb_ld(&bar[XB_TOPGEN]) == tg, bar);
            __builtin_amdgcn_fence(__ATOMIC_ACQUIRE, "agent");
            xb_add(&bar[XB_XGEN(b.x)], 1u);
            asm volatile("s_waitcnt vmcnt(0)" ::: "memory");
        } else {
            XB_SPIN(xb_ld(&bar[XB_XGEN(b.x)]) == gen, bar);
            __builtin_amdgcn_fence(__ATOMIC_ACQUIRE, "agent");
            asm volatile("s_waitcnt vmcnt(0)" ::: "memory");
        }
    }
    __syncthreads();
}

constexpr int LDS_BYTES = 147456;
struct Params { const float* in[39]; float* out; unsigned char* ws; };

struct TrTile { const float* W; const float* gain; bf16_t* dst; int N, Npad, ldb, mode, k0, n0; };
__device__ __forceinline__ void tr_load(const TrTile& t, int tid, f32x4 (&v)[8], float (&gv)[8]) {
    const float* gp = t.gain ? t.gain : t.W;
#pragma unroll
    for (int i = 0; i < 8; ++i) { const int pp = tid + 512 * i, kk = pp >> 6, n = t.n0 + (pp & 63) * 4; const bool inb = n + 3 < t.N;
        v[i] = *(const f32x4*)(t.W + (size_t)(t.k0 + kk) * t.N + (inb ? n : 0)); gv[i] = gp[t.k0 + kk]; }
}
__device__ __forceinline__ void tr_to_lds(const TrTile& t, int tid, const f32x4 (&v)[8], const float (&gv)[8], LAS unsigned char* l) {
#pragma unroll
    for (int i = 0; i < 8; ++i) { const int pp = tid + 512 * i, kk = pp >> 6, n4 = (pp & 63) * 4; const bool inb = t.n0 + n4 + 3 < t.N;
        const float g = t.gain ? gv[i] : 1.f; const f32x4 x = inb ? v[i] * g : (f32x4){0.f, 0.f, 0.f, 0.f};
        u32x2 w; w.x = pk2(x[0], x[1]); w.y = pk2(x[2], x[3]); *(LAS u32x2*)(l + kk * 528 + n4 * 2) = w; }
}
__device__ __forceinline__ void tr_store(const TrTile& t, int tid, const LAS unsigned char* l) {
#pragma unroll
    for (int i = 0; i < 4; ++i) { const int pp = tid + 512 * i, n = pp >> 3, c = pp & 7; const int jn = t.n0 + n;
        if (jn < t.Npad) { const LAS bf16_t* s = (const LAS bf16_t*)(l + (8 * c) * 528) + n;
            const int drow = t.mode == 0 ? jn : ((jn >> 7) * 256 + (jn & 127) + (t.mode == 2 ? 128 : 0));
            u32x4 o; o.x = (unsigned)s[0] | ((unsigned)s[264] << 16); o.y = (unsigned)s[2 * 264] | ((unsigned)s[3 * 264] << 16); o.z = (unsigned)s[4 * 264] | ((unsigned)s[5 * 264] << 16); o.w = (unsigned)s[6 * 264] | ((unsigned)s[7 * 264] << 16);
            *(u32x4*)(t.dst + (size_t)drow * t.ldb + t.k0 + 8 * c) = o; } }
}

__global__ void __launch_bounds__(512, 2) mega(Params p) {
    extern __shared__ __attribute__((aligned(16))) unsigned char lds_raw[];
    LAS unsigned char* lds = (LAS unsigned char*)lds_raw;
    cg::grid_group grid = cg::this_grid();
    const int G = gridDim.x, bid = blockIdx.x;
#define PHASE_IDS int tid_o = threadIdx.x; asm volatile("" : "+v"(tid_o)); const int tid = tid_o, lane = tid & 63, wave = tid >> 6; (void)lane; (void)wave;
#define SS0 ((unsigned long long*)(p.ws + WS_SSQ))
#define SS1 (SS0 + M)
#define SS2 (SS0 + 2 * M)
#define SS3 (SS0 + 3 * M)
#define LBT ((float*)(p.ws + CTL_LB))
#define LBR ((float*)(p.ws + CTL_LBR))
#define LBI ((float*)(p.ws + CTL_LBI))
#define BBR ((float*)(p.ws + CTL_BBR))
#define BBI ((float*)(p.ws + CTL_BBI))
#define XB ((bf16_t*)(p.ws + WS_XB))
#define YC ((bf16_t*)(p.ws + WS_YC))
#define U ((bf16_t*)(p.ws + WS_U))
    { volatile LAS unsigned* st0 = (volatile LAS unsigned*)(lds + LDS_BYTES - 64); if (threadIdx.x < 16) st0[threadIdx.x] = 0u; }
    __syncthreads();
    (void)xcd_barrier_post((unsigned*)(p.ws + WS_CTL), (volatile LAS unsigned*)(lds + LDS_BYTES - 64));
#ifndef PROBE
#define PROBE 0
#endif
#ifndef PROBE_MASK
#define PROBE_MASK 0
#endif
#define STAMP(k) do { if (PROBE && bid == 0 && threadIdx.x == 0) ((unsigned long long*)(p.ws + CTL_TS))[k] = __builtin_amdgcn_s_memrealtime(); } while (0)
#define STAMP2(k, blk) do { if (PROBE && bid == (blk) && threadIdx.x == 0) ((unsigned long long*)(p.ws + CTL_TS))[k] = __builtin_amdgcn_s_memrealtime(); } while (0)
    STAMP(0);
#define GSYNC() do { XcdBarrier xb_; xb_.bar = (unsigned*)(p.ws + WS_CTL); xb_.x = xb_xcc_id(); xb_.st = (volatile LAS unsigned*)(lds + LDS_BYTES - 64); xcd_barrier(xb_, (int)threadIdx.x); } while (0)

    {
        PHASE_IDS
        constexpr int T_IN0 = 16 * 15, T_SQ = 16 * 4, T_GU = 16 * 11, T_DN = 44 * 4, T_IN1 = 16 * 14, T_GL = 4 * 1;
        constexpr int NT = T_IN0 + T_SQ + 2 * T_GU + T_DN + T_IN1 + T_SQ + 2 * T_GU + T_DN + T_GL;
#define P0_DECODE(T_, it_) { int r = (it_); const float* W; const float* gain; bf16_t* dst; int N, Npad, nNt, ldb, mode; \
            if (r < T_IN0) { W = p.in[4]; gain = p.in[1]; dst = (bf16_t*)(p.ws + WS_IN0); N = EVEN_IN; Npad = LDU0; nNt = 15; ldb = DM; mode = 0; } \
            else if ((r -= T_IN0) < T_SQ) { W = p.in[5]; gain = nullptr; dst = (bf16_t*)(p.ws + WS_OUT0); N = DM; Npad = DM; nNt = 4; ldb = DM; mode = 0; } \
            else if ((r -= T_SQ) < T_GU) { W = p.in[36]; gain = p.in[2]; dst = (bf16_t*)(p.ws + WS_GU0); N = FFN; Npad = FFN; nNt = 11; ldb = DM; mode = 1; } \
            else if ((r -= T_GU) < T_GU) { W = p.in[37]; gain = p.in[2]; dst = (bf16_t*)(p.ws + WS_GU0); N = FFN; Npad = FFN; nNt = 11; ldb = DM; mode = 2; } \
            else if ((r -= T_GU) < T_DN) { W = p.in[38]; gain = nullptr; dst = (bf16_t*)(p.ws + WS_D0); N = DM; Npad = DM; nNt = 4; ldb = FFN; mode = 0; } \
            else if ((r -= T_DN) < T_IN1) { W = p.in[19]; gain = p.in[1] + DM; dst = (bf16_t*)(p.ws + WS_IN1); N = ODD_IN; Npad = NP1; nNt = 14; ldb = DM; mode = 0; } \
            else if ((r -= T_IN1) < T_SQ) { W = p.in[20]; gain = nullptr; dst = (bf16_t*)(p.ws + WS_OUT1); N = DM; Npad = DM; nNt = 4; ldb = DM; mode = 0; } \
            else if ((r -= T_SQ) < T_GU) { W = p.in[36] + (size_t)DM * FFN; gain = p.in[2] + DM; dst = (bf16_t*)(p.ws + WS_GU1); N = FFN; Npad = FFN; nNt = 11; ldb = DM; mode = 1; } \
            else if ((r -= T_GU) < T_GU) { W = p.in[37] + (size_t)DM * FFN; gain = p.in[2] + DM; dst = (bf16_t*)(p.ws + WS_GU1); N = FFN; Npad = FFN; nNt = 11; ldb = DM; mode = 2; } \
            else if ((r -= T_GU) < T_DN) { W = p.in[38] + (size_t)FFN * DM; gain = nullptr; dst = (bf16_t*)(p.ws + WS_D1); N = DM; Npad = DM; nNt = 4; ldb = FFN; mode = 0; } \
            else { r -= T_DN; W = p.in[29]; gain = nullptr; dst = (bf16_t*)(p.ws + WS_GLU); N = 256; Npad = 256; nNt = 1; ldb = 256; mode = 0; } \
            T_.W = W; T_.gain = gain; T_.dst = dst; T_.N = N; T_.Npad = Npad; T_.ldb = ldb; T_.mode = mode; T_.k0 = (r / nNt) * 64; T_.n0 = (r % nNt) * 256; }
        if (bid < NT) {
            TrTile cur, nxt; f32x4 tv[8]; float tg[8];
            P0_DECODE(cur, bid); tr_load(cur, tid, tv, tg);
            for (int it = bid; it < NT; it += G) {
                const int itn = (it + G < NT) ? it + G : it; P0_DECODE(nxt, itn);
                __syncthreads();
                tr_to_lds(cur, tid, tv, tg, lds);
                tr_load(nxt, tid, tv, tg);
                __syncthreads();
                tr_store(cur, tid, lds);
                cur = nxt;
            }
        }
#undef P0_DECODE
        const float* x = p.in[0];
        for (int row = bid * 8 + wave; row < M; row += G * 16) {
            const int row2 = row + G * 8; const bool has2 = row2 < M;
            const f32x4* xr = (const f32x4*)(x + (size_t)row * DM) + lane; const f32x4* xr2 = (const f32x4*)(x + (size_t)(has2 ? row2 : row) * DM) + lane; f32x4 v[4], v2[4]; float s = 0.f, s2 = 0.f;
#pragma unroll
            for (int j = 0; j < 4; ++j) { v[j] = xr[64 * j]; v2[j] = xr2[64 * j]; }
#pragma unroll
            for (int j = 0; j < 4; ++j) { s += (v[j][0] * v[j][0] + v[j][1] * v[j][1]) + (v[j][2] * v[j][2] + v[j][3] * v[j][3]); s2 += (v2[j][0] * v2[j][0] + v2[j][1] * v2[j][1]) + (v2[j][2] * v2[j][2] + v2[j][3] * v2[j][3]); }
            s = wave_sum(s); s2 = wave_sum(s2); if (lane == 0) { SS0[row] = ss_fix(s); if (has2) SS0[row2] = ss_fix(s2); }
            u32x2* o = (u32x2*)(XB + (size_t)row * DM) + lane; u32x2* o2 = (u32x2*)(XB + (size_t)row2 * DM) + lane;
#pragma unroll
            for (int j = 0; j < 4; ++j) { u32x2 w; w.x = pk2(v[j][0], v[j][1]); w.y = pk2(v[j][2], v[j][3]); o[64 * j] = w; if (has2) { u32x2 w2; w2.x = pk2(v2[j][0], v2[j][1]); w2.y = pk2(v2[j][2], v2[j][3]); o2[64 * j] = w2; } }
        }
        for (int i = bid * 512 + tid; i < 3 * M; i += G * 512) SS1[i] = 0ull;
        for (int i = bid * 512 + tid; i < 512 * 160; i += G * 512) { const int c = i / 160, k = i % 160;
            const float v = (k < 32) ? p.in[10][k * 512 + c] : (k < 64) ? p.in[12][(k - 32) * 512 + c] : p.in[13][(k - 64) * 512 + c]; ((bf16_t*)(p.ws + WS_LORA))[i] = f2bf(v); }
        { const int gt = bid * 512 + tid;
          if (gt < 512) { const float* lt = p.in[6]; const float l0 = lt[gt], l1 = lt[512 + gt], l2 = lt[1024 + gt]; const float mx = fmaxf(l0, fmaxf(l1, l2));
              const float e0 = expf(l0 - mx), e1 = expf(l1 - mx), e2 = expf(l2 - mx); LBT[gt] = e0 / (e0 + e1 + e2); }
          const int i = gt - 512;
          if (i >= 0 && i < 16384) { const int gp = i >> 4, h = i & 15, g = gp >> 6; const float step = expf(p.in[23][g]); const float lr = p.in[21][gp], li = p.in[22][gp];
              const float mag = expf(lr * step); const float br = mag * cosf(li * step), bi = mag * sinf(li * step);
              if (h == 0) { LBR[gp] = br; LBI[gp] = bi; }
              const float den = lr * lr + li * li, nr = br - 1.f, ni = bi; const float cr = (nr * lr + ni * li) / den, ci = (ni * lr - nr * li) / den;
              const float xr2 = p.in[24][gp * 16 + h], xi2 = p.in[25][gp * 16 + h]; BBR[gp * 16 + h] = cr * xr2 - ci * xi2; BBI[gp * 16 + h] = cr * xi2 + ci * xr2; } }
    }
    grid.sync();
    STAMP(1);

    { pg8::Gemm g{XB, (const bf16_t*)(p.ws + WS_IN0), DM, DM, M, LDU0, DM}; pg8::StaticOrder S; S.init(M, LDU0, G, bid);
      pg8::EpiScaleBf16 E{U, LDU0, SS0}; pg8::gemm_phase<pg8::EpiScaleBf16, pg8::StaticOrder, true, true>(lds, g, S, E); }
    GSYNC();
    STAMP(2);

#define Rt ((bf16_t*)p.out)
#define At (Rt + (size_t)M * 512)
#define Bh (Rt + (size_t)M * 1024)
#define Kh (Rt + (size_t)M * 1536)
#define Vv XB
#define BVG (XB + (size_t)M * 512)
#define Gg ((bf16_t*)(p.ws + WS_MS))
#define GLc ((float*)(p.ws + WS_MS + 32 * MiB))
#define HEM ((float*)(p.ws + WS_MS + 64 * MiB))
#define HEL ((float*)(p.ws + WS_MS + 65 * MiB))
#define HELM ((float*)(p.ws + WS_MS + 66 * MiB))

    {
        PHASE_IDS
        const int hd = __builtin_amdgcn_readfirstlane(tid >> 6), fr = lane & 15, fq = lane >> 4;
        constexpr int SLS = 336;
        const bf16_t* LT = (const bf16_t*)(p.ws + WS_LORA);
        float mu_r[4], mu_k[4], mu_v[4], w0c[4], a0c[4], kkc[4], kac[4], rkc[4];
#pragma unroll
        for (int nt = 0; nt < 4; ++nt) { const int c = hd * 64 + 4 * fr + nt; mu_r[nt] = p.in[8][c]; mu_k[nt] = p.in[8][512 + c]; mu_v[nt] = p.in[8][1024 + c];
            w0c[nt] = p.in[9][c]; a0c[nt] = p.in[11][c]; kkc[nt] = p.in[14][c]; kac[nt] = p.in[15][c]; rkc[nt] = p.in[16][c]; }
        bf16_t sa_c[5], sa_p[5];
        const unsigned char* zsrc = p.ws + WS_CTL + 128 * 1024;
#define P2_FETCH(cidx_, RAWn_) { const int m0_ = (cidx_) * 16; const bool sq_ = (m0_ & (SEQ - 1)) == 0; \
            _Pragma("unroll") for (int i_ = 0; i_ < 5; ++i_) { const int id_ = tid + 512 * i_, t_ = id_ / 160, j_ = id_ % 160; const bf16_t* ur_ = U + (size_t)(m0_ + t_) * LDU0 + 3584 + j_; sa_c[i_] = ur_[0]; sa_p[i_] = ur_[-LDU0]; } \
            _Pragma("unroll") for (int i_ = 0; i_ < 7; ++i_) { const int q_ = hd + 8 * i_; if (q_ < 51) { const int row_ = q_ / 3, th_ = q_ % 3; \
                const unsigned char* g_ = (row_ == 0 && sq_) ? zsrc + th_ * 1024 + lane * 16 : (const unsigned char*)(U + ((size_t)m0_ + row_) * LDU0 - LDU0 + 2048 + th_ * 512 + lane * 8); \
                __builtin_amdgcn_global_load_lds((const unsigned*)g_, (LAS unsigned*)((RAWn_) + row_ * 3088 + th_ * 1024), 16, 0, 0); } } }
        P2_FETCH(bid, lds + 12288);
        int it = 0;
        for (int cidx = bid; cidx < M / 16; cidx += G, ++it) {
            const int m0 = cidx * 16; const bool seq0 = (m0 & (SEQ - 1)) == 0;
            LAS unsigned char* SL = lds + (it & 1) * (16 * SLS);
            LAS unsigned char* RAW = lds + 12288 + (it & 1) * 52496;
#pragma unroll
            for (int i = 0; i < 5; ++i) { const int id = tid + 512 * i, t = id / 160, j = id % 160;
                const float cur = bf2f(sa_c[i]); const float prev = (t == 0 && seq0) ? 0.f : bf2f(sa_p[i]); const float v = cur + (prev - cur) * p.in[8][1536 + j];
                *(LAS bf16_t*)(SL + t * SLS + j * 2) = f2bf((j < 32) ? tanhf_(v) : (j < 64 ? v : sigmoidf_(v))); }
            asm volatile("s_waitcnt vmcnt(0)" ::: "memory");
            __syncthreads();
            f32x4 dw[4], da[4], dg[4];
            { bf16x8 sf[5];
#pragma unroll
              for (int kk = 0; kk < 5; ++kk) sf[kk] = *(const LAS bf16x8*)(SL + fr * SLS + (kk * 32 + 8 * fq) * 2);
              const f32x4 z4 = {0.f, 0.f, 0.f, 0.f};
#pragma unroll
              for (int nt = 0; nt < 4; ++nt) { const bf16_t* lr = LT + (size_t)(hd * 64 + 4 * fr + nt) * 160 + 8 * fq;
                  const bf16x8 wf = *(const bf16x8*)lr, af = *(const bf16x8*)(lr + 32), g0 = *(const bf16x8*)(lr + 64), g1 = *(const bf16x8*)(lr + 96), g2 = *(const bf16x8*)(lr + 128);
                  dw[nt] = __builtin_amdgcn_mfma_f32_16x16x32_bf16(sf[0], wf, z4, 0, 0, 0); da[nt] = __builtin_amdgcn_mfma_f32_16x16x32_bf16(sf[1], af, z4, 0, 0, 0);
                  f32x4 g = __builtin_amdgcn_mfma_f32_16x16x32_bf16(sf[2], g0, z4, 0, 0, 0); g = __builtin_amdgcn_mfma_f32_16x16x32_bf16(sf[3], g1, g, 0, 0, 0); dg[nt] = __builtin_amdgcn_mfma_f32_16x16x32_bf16(sf[4], g2, g, 0, 0, 0); } }
            { const int cn = (cidx + G < M / 16) ? cidx + G : cidx; P2_FETCH(cn, lds + 12288 + ((it + 1) & 1) * 52496); }
            float as_[4][4], wd_[4][4];
            float ssq[4] = {0.f, 0.f, 0.f, 0.f}, bon[4] = {0.f, 0.f, 0.f, 0.f};
#pragma unroll
            for (int nt = 0; nt < 4; ++nt)
#pragma unroll
                for (int r = 0; r < 4; ++r) { const LAS bf16_t* rw = (const LAS bf16_t*)(RAW + (4 * fq + r) * 3088) + hd * 64 + 4 * fr + nt;
                    const float c0 = bf2f(rw[1544]), c1 = bf2f(rw[1544 + 512]);
                    const float p0 = bf2f(rw[0]), p1 = bf2f(rw[512]);
                    const float rv = c0 + (p0 - c0) * mu_r[nt], kv = c1 + (p1 - c1) * mu_k[nt];
                    const float wlog = -softplusf_(-(w0c[nt] + dw[nt][r])) - 0.5f;
                    wd_[nt][r] = __expf(-__expf(wlog));
                    const float a = sigmoidf_(a0c[nt] + da[nt][r]); as_[nt][r] = a;
                    const float kkv = kv * kkc[nt]; ssq[r] = fmaf(kkv, kkv, ssq[r]);
                    bon[r] = fmaf(rv * kv * (1.f + (a - 1.f) * kac[nt]), rkc[nt], bon[r]); }
#pragma unroll
            for (int r = 0; r < 4; ++r) { ssq[r] = 1.0f / fmaxf(sqrtf(row_sum16(ssq[r])), 1e-12f); bon[r] = row_sum16(bon[r]); }
            float gam[4][5];
#pragma unroll
            for (int nt = 0; nt < 4; ++nt) {
                const float q1 = wd_[nt][0], q2 = q1 * wd_[nt][1], q3 = q2 * wd_[nt][2], q4 = q3 * wd_[nt][3];
                const float t0 = __shfl(q4, fr), t1 = __shfl(q4, fr + 16), t2 = __shfl(q4, fr + 32);
                const float pre = (fq == 0) ? 1.f : (fq == 1) ? t0 : (fq == 2) ? t0 * t1 : t0 * t1 * t2;
                gam[nt][0] = pre; gam[nt][1] = pre * q1; gam[nt][2] = pre * q2; gam[nt][3] = pre * q3; gam[nt][4] = pre * q4; }
#pragma unroll
            for (int r = 0; r < 4; ++r) { const size_t o = (size_t)(m0 + 4 * fq + r) * 512 + hd * 64 + 4 * fr; const LAS bf16_t* rw = (const LAS bf16_t*)(RAW + (4 * fq + r) * 3088) + hd * 64 + 4 * fr;
                float oa[4], orr[4], ob[4], okk[4], ov[4], og[4], obv[4];
#pragma unroll
                for (int nt = 0; nt < 4; ++nt) {
                    const float c0 = bf2f(rw[1544 + nt]), c1 = bf2f(rw[1544 + 512 + nt]), c2 = bf2f(rw[1544 + 1024 + nt]);
                    const float p0 = bf2f(rw[nt]), p1 = bf2f(rw[512 + nt]), p2 = bf2f(rw[1024 + nt]);
                    const float rv = c0 + (p0 - c0) * mu_r[nt], kv = c1 + (p1 - c1) * mu_k[nt], vv = c2 + (p2 - c2) * mu_v[nt];
                    const float a = as_[nt][r], kk = kv * kkc[nt] * ssq[r], kp = kv * (1.f + (a - 1.f) * kac[nt]), ig = __builtin_amdgcn_rcpf(gam[nt][r + 1]), g = dg[nt][r];
                    oa[nt] = -kk * gam[nt][r]; orr[nt] = rv * gam[nt][r + 1]; ob[nt] = kk * a * ig; okk[nt] = kp * ig; ov[nt] = vv; og[nt] = g; obv[nt] = bon[r] * vv * g; }
                u32x2 w;
                w.x = pk2(oa[0], oa[1]); w.y = pk2(oa[2], oa[3]); *(u32x2*)(At + o) = w;
                w.x = pk2(orr[0], orr[1]); w.y = pk2(orr[2], orr[3]); *(u32x2*)(Rt + o) = w;
                w.x = pk2(ob[0], ob[1]); w.y = pk2(ob[2], ob[3]); *(u32x2*)(Bh + o) = w;
                w.x = pk2(okk[0], okk[1]); w.y = pk2(okk[2], okk[3]); *(u32x2*)(Kh + o) = w;
                w.x = pk2(ov[0], ov[1]); w.y = pk2(ov[2], ov[3]); *(u32x2*)(Vv + o) = w;
                w.x = pk2(og[0], og[1]); w.y = pk2(og[2], og[3]); *(u32x2*)(Gg + o) = w;
                w.x = pk2(obv[0], obv[1]); w.y = pk2(obv[2], obv[3]); *(u32x2*)(BVG + o) = w; }
            if (fq == 3) *(f32x4*)(GLc + (size_t)cidx * 512 + hd * 64 + 4 * fr) = (f32x4){gam[0][4], gam[1][4], gam[2][4], gam[3][4]};
        }
#undef P2_FETCH
        STAMP2(20, 0);
#define HP_ROW(it_) (U + ((size_t)((it_) >> 6) * 64 + lane) * LDU0 + (((it_) >> 4) & 3) * 128 + ((it_) & 15) * 8)
#define HP_LB(it_) (LBT + (((it_) >> 4) & 3) * 128 + ((it_) & 15) * 8)
        u32x4 wq_n, wf_n; f32x4 lb_n0, lb_n1;
        { const bf16_t* r0 = HP_ROW(bid * 8 + wave); wq_n = *(const u32x4*)r0; wf_n = *(const u32x4*)(r0 + 512); const float* l0 = HP_LB(bid * 8 + wave); lb_n0 = *(const f32x4*)l0; lb_n1 = *(const f32x4*)(l0 + 4); }
        for (int it = bid * 8 + wave; it < (M / 64) * 64; it += G * 8) {
            const int ch = it >> 6, hh = (it >> 4) & 3, cg = it & 15; const int c0 = hh * 128 + cg * 8;
            bf16_t* r = HP_ROW(it);
            const u32x4 wq = wq_n, wf = wf_n; const float lbv[8] = {lb_n0[0], lb_n0[1], lb_n0[2], lb_n0[3], lb_n1[0], lb_n1[1], lb_n1[2], lb_n1[3]};
            { const int itn = (it + G * 8 < (M / 64) * 64) ? it + G * 8 : it; const bf16_t* rn = HP_ROW(itn); wq_n = *(const u32x4*)rn; wf_n = *(const u32x4*)(rn + 512); const float* ln = HP_LB(itn); lb_n0 = *(const f32x4*)ln; lb_n1 = *(const f32x4*)(ln + 4); }
            const unsigned wqa[4] = {wq.x, wq.y, wq.z, wq.w}, wfa[4] = {wf.x, wf.y, wf.z, wf.w};
            unsigned oq[4], ok[4];
#pragma unroll
            for (int j = 0; j < 8; ++j) { const float aq = (j & 1) ? bfhi(wqa[j >> 1]) : bflo(wqa[j >> 1]), af = (j & 1) ? bfhi(wfa[j >> 1]) : bflo(wfa[j >> 1]);
                const float kv = (1.f - lbv[j]) * sigmoidf_(-af);
                float bs = __logf(1.f - kv);
                bs += __int_as_float(__builtin_amdgcn_update_dpp(0, __float_as_int(bs), 0x111, 0xf, 0xf, true)); bs += __int_as_float(__builtin_amdgcn_update_dpp(0, __float_as_int(bs), 0x112, 0xf, 0xf, true));
                bs += __int_as_float(__builtin_amdgcn_update_dpp(0, __float_as_int(bs), 0x114, 0xf, 0xf, true)); bs += __int_as_float(__builtin_amdgcn_update_dpp(0, __float_as_int(bs), 0x118, 0xf, 0xf, true));
                bs += __int_as_float(__builtin_amdgcn_update_dpp(0, __float_as_int(bs), 0x142, 0xa, 0xf, false)); bs += __int_as_float(__builtin_amdgcn_update_dpp(0, __float_as_int(bs), 0x143, 0xc, 0xf, false));
                const float bm = __int_as_float(__builtin_amdgcn_readlane(__float_as_int(bs), 31)), bL = __int_as_float(__builtin_amdgcn_readlane(__float_as_int(bs), 63));
                const float qt = siluf_(aq) * __expf(bs - bm), kt = kv * __expf(bm - bs);
                if (j & 1) { oq[j >> 1] = pk2(__uint_as_float(oq[j >> 1]), qt); ok[j >> 1] = pk2(__uint_as_float(ok[j >> 1]), kt); } else { oq[j >> 1] = __float_as_uint(qt); ok[j >> 1] = __float_as_uint(kt); }
                if (lane == 0) { const size_t vo = (size_t)ch * 512 + c0 + j; HEM[vo] = __expf(bm); HEL[vo] = __expf(bL); HELM[vo] = __expf(bL - bm); } }
            u32x4 w; w.x = oq[0]; w.y = oq[1]; w.z = oq[2]; w.w = oq[3]; *(u32x4*)r = w;
            w.x = ok[0]; w.y = ok[1]; w.z = ok[2]; w.w = ok[3]; *(u32x4*)(r + 512) = w;
        }
#undef HP_ROW
#undef HP_LB
    }
    GSYNC();
    STAMP(3);

    for (int item = bid; item < 256; item += G) {
        PHASE_IDS
        const int w = __builtin_amdgcn_readfirstlane(tid >> 6), fr = lane & 15, fq = lane >> 4;
        const int grp_ = (item & 7) * 8 + (item >> 5), vt = (item >> 3) & 3, h = grp_ & 7, b = grp_ >> 3;
        constexpr int BUF = 20992, oRt = 0, oAt = 2304, oBh = 4608, oKh = 6912, oBT = 9216, oKT = 14336, oVT = 19456, oGL = 20736;
        constexpr int oMS = 4 * BUF, MSET = 3840, oAf = oMS + 3 * MSET, oTT = oAf + 2 * 1024, oWT = oTT + 2 * 1280, oUT = oWT + 1280, oST = oUT + 1280, LTOT = oST + 2304;
        constexpr int NCH = SEQ / 16;
        LAS unsigned char* L = lds;
        __syncthreads();
        for (int i = tid; i < LTOT / 4; i += 512) ((LAS unsigned*)L)[i] = 0u;
        __syncthreads();
        const size_t tok0 = (size_t)b * SEQ; const size_t colb = (size_t)h * 64;
#define RC_F144(B_, off_, kk_) (*(const LAS bf16x8*)((B_) + (off_) + fr * 144 + ((kk_) * 32 + 8 * fq) * 2))
#define RC_F80(base_, row0_) (*(const LAS bf16x8*)((base_) + ((row0_) + fr) * 80 + (8 * fq) * 2))
        if (w >= 3) {
            const int lt = tid - 192;
            const bf16_t* arr[4] = {Rt, At, Bh, Kh};
            const int q0 = lt, q1 = lt + 320;
            const int kind1 = (q1 < 512) ? 0 : (q1 < 544) ? 1 : (q1 < 560) ? 2 : 3;
            const char* gp0 = (const char*)(arr[q0 >> 7] + (tok0 + ((q0 >> 3) & 15)) * 512 + colb + (q0 & 7) * 8);
            const char* gp1 = kind1 == 0 ? (const char*)(arr[(q1 >> 7) & 3] + (tok0 + ((q1 >> 3) & 15)) * 512 + colb + (q1 & 7) * 8)
                            : kind1 == 1 ? (const char*)(Vv + (tok0 + ((q1 - 512) >> 1)) * 512 + colb + vt * 16 + ((q1 - 512) & 1) * 8)
                            : kind1 == 2 ? (const char*)(GLc + ((size_t)b * NCH) * 512 + colb + (q1 - 544) * 4) : gp0;
            const size_t st1 = (kind1 == 2) ? (size_t)512 * 4 : (size_t)16 * 512 * 2;
            u32x4 d0[2], d1[2], d2[2], d3[2];
#define RP_H(w_, j_) ((bf16_t)(((j_) & 1) ? ((w_) >> 16) : ((w_) & 0xffffu)))
#define RP_FETCH(D_, c_) { const size_t cc_ = (size_t)((c_) < NCH ? (c_) : NCH - 1); D_[0] = *(const u32x4*)(gp0 + cc_ * (size_t)(16 * 512 * 2)); D_[1] = *(const u32x4*)(gp1 + cc_ * st1); }
#define RP_TILE(B_, q_, D_) { const int tl_ = (q_) >> 7, t_ = ((q_) >> 3) & 15, k_ = ((q_) & 7) * 8; const unsigned w4_[4] = {D_.x, D_.y, D_.z, D_.w}; *(LAS u32x4*)((B_) + tl_ * 2304 + t_ * 144 + k_ * 2) = D_; \
                if (tl_ >= 2) { LAS bf16_t* x_ = (LAS bf16_t*)((B_) + (tl_ == 2 ? oBT : oKT) + k_ * 80 + t_ * 2); const int g_ = (q_) & 7; \
                    _Pragma("unroll") for (int j_ = 0; j_ < 8; ++j_) { const int jj_ = (j_ + g_) & 7; const unsigned ww_ = (jj_ >> 1) == 0 ? w4_[0] : (jj_ >> 1) == 1 ? w4_[1] : (jj_ >> 1) == 2 ? w4_[2] : w4_[3]; x_[jj_ * 40] = (bf16_t)(ww_ >> ((jj_ & 1) * 16)); } } }
#define RP_STORE(D_, buf_) { LAS unsigned char* B_ = L + (buf_) * BUF; RP_TILE(B_, q0, D_[0]); \
                if (kind1 == 0) { RP_TILE(B_, q1, D_[1]); } \
                else if (kind1 == 1) { const int vq_ = q1 - 512; const unsigned w4_[4] = {D_[1].x, D_[1].y, D_[1].z, D_[1].w}; LAS bf16_t* x_ = (LAS bf16_t*)(B_ + oVT + ((vq_ & 1) * 8) * 80 + (vq_ >> 1) * 2); _Pragma("unroll") for (int j_ = 0; j_ < 8; ++j_) x_[j_ * 40] = RP_H(w4_[j_ >> 1], j_); } \
                else if (kind1 == 2) *(LAS u32x4*)(B_ + oGL + (q1 - 544) * 16) = D_[1]; }
            RP_FETCH(d0, 0); RP_STORE(d0, 0); RP_FETCH(d0, 1); RP_STORE(d0, 1); RP_FETCH(d0, 2); RP_STORE(d0, 2);
            RP_FETCH(d3, 3); RP_FETCH(d0, 4); RP_FETCH(d1, 5); RP_FETCH(d2, 6);
            LBAR(); LBAR(); LBAR();
            for (int i = 0; i < NCH; i += 4) {
                if (i + 3 < NCH) RP_STORE(d3, (i + 3) & 3);
                RP_FETCH(d3, i + 7);
                LBAR();
                if (i + 4 < NCH) RP_STORE(d0, (i + 4) & 3);
                RP_FETCH(d0, i + 8);
                LBAR();
                if (i + 5 < NCH) RP_STORE(d1, (i + 5) & 3);
                RP_FETCH(d1, i + 9);
                LBAR();
                if (i + 6 < NCH) RP_STORE(d2, (i + 6) & 3);
                RP_FETCH(d2, i + 10);
                LBAR();
            }
#undef RP_TILE
#undef RP_FETCH
#undef RP_H
#undef RP_STORE
        } else if (w == 1) {
            auto amats = [&](int cc) {
                const LAS unsigned char* B_ = L + (cc & 3) * BUF; LAS unsigned char* Ms = L + oMS + (cc % 3) * MSET; LAS unsigned char* Af = L + oAf + (cc & 1) * 1024;
                const bf16x8 a0 = RC_F144(B_, oAt, 0), a1 = RC_F144(B_, oAt, 1), r0 = RC_F144(B_, oRt, 0), r1 = RC_F144(B_, oRt, 1), b0 = RC_F144(B_, oBh, 0), b1 = RC_F144(B_, oBh, 1), k0 = RC_F144(B_, oKh, 0), k1 = RC_F144(B_, oKh, 1);
                const f32x4 z4 = {0.f, 0.f, 0.f, 0.f};
                f32x4 dab = __builtin_amdgcn_mfma_f32_16x16x32_bf16(a0, b0, z4, 0, 0, 0); dab = __builtin_amdgcn_mfma_f32_16x16x32_bf16(a1, b1, dab, 0, 0, 0);
                f32x4 dak = __builtin_amdgcn_mfma_f32_16x16x32_bf16(a0, k0, z4, 0, 0, 0); dak = __builtin_amdgcn_mfma_f32_16x16x32_bf16(a1, k1, dak, 0, 0, 0);
                f32x4 drb = __builtin_amdgcn_mfma_f32_16x16x32_bf16(r0, b0, z4, 0, 0, 0); drb = __builtin_amdgcn_mfma_f32_16x16x32_bf16(r1, b1, drb, 0, 0, 0);
                f32x4 drk = __builtin_amdgcn_mfma_f32_16x16x32_bf16(r0, k0, z4, 0, 0, 0); drk = __builtin_amdgcn_mfma_f32_16x16x32_bf16(r1, k1, drk, 0, 0, 0);
#pragma unroll
                for (int r = 0; r < 4; ++r) { const int t = 4 * fq + r; const bool st = fr < t, le = fr <= t;
                    *(LAS float*)(Af + t * 64 + fr * 4) = st ? dab[r] : 0.f;
                    *(LAS bf16_t*)(Ms + t * 80 + fr * 2) = f2bf(st ? dak[r] : 0.f);
                    *(LAS bf16_t*)(Ms + 1280 + t * 80 + fr * 2) = f2bf(le ? drb[r] : 0.f);
                    *(LAS bf16_t*)(Ms + 2560 + t * 80 + fr * 2) = f2bf(le ? drk[r] : 0.f); } };
            LBAR();
            amats(0);
            LBAR();
            amats(1);
            LBAR();
            for (int i = 0; i < NCH; ++i) { if (i + 2 < NCH) amats(i + 2); LBAR(); }
        } else if (w == 2) {
            auto tinv = [&](int cc) {
                const LAS unsigned char* Af = L + oAf + (cc & 1) * 1024; LAS unsigned char* Tt = L + oTT + (cc & 1) * 1280;
                f32x4 am[16][4];
#pragma unroll
                for (int t = 1; t < 16; ++t)
#pragma unroll
                    for (int sq = 0; sq < 4; ++sq) if (4 * sq < t) am[t][sq] = *(const LAS f32x4*)(Af + t * 64 + sq * 16);
                asm volatile("s_waitcnt lgkmcnt(0)" ::: "memory");
                float x[16];
#pragma unroll
                for (int t = 0; t < 16; ++t) {
                    float acc0 = (t == fr) ? 1.f : 0.f, acc1 = 0.f;
#pragma unroll
                    for (int sq = 0; sq < 4; ++sq) { if (4 * sq < t) {
#pragma unroll
                        for (int e = 0; e < 4; ++e) { const int s = 4 * sq + e; if (s < t) { if (s & 1) acc1 = fmaf(am[t][sq][e], x[s], acc1); else acc0 = fmaf(am[t][sq][e], x[s], acc0); } } } }
                    x[t] = acc0 + acc1; }
                if (fq == 0) {
#pragma unroll
                    for (int t = 0; t < 16; ++t) *(LAS bf16_t*)(Tt + t * 80 + fr * 2) = f2bf(x[t]); } };
            LBAR(); LBAR();
            tinv(0);
            LBAR();
            for (int i = 0; i < NCH; ++i) { if (i + 1 < NCH) tinv(i + 1); LBAR(); }
        } else {
            f32x4 Sacc[4];
#pragma unroll
            for (int kt = 0; kt < 4; ++kt) Sacc[kt] = (f32x4){0.f, 0.f, 0.f, 0.f};
            bf16_t* yg = Vv + tok0 * 512 + colb + vt * 16 + fr;
            LBAR(); LBAR(); LBAR();
            for (int i = 0; i < NCH; ++i) {
                const LAS unsigned char* B_ = L + (i & 3) * BUF; const LAS unsigned char* Ms = L + oMS + (i % 3) * MSET; const LAS unsigned char* Tt = L + oTT + (i & 1) * 1280;
                const bf16x8 a0 = RC_F144(B_, oAt, 0), a1 = RC_F144(B_, oAt, 1), r0 = RC_F144(B_, oRt, 0), r1 = RC_F144(B_, oRt, 1);
                const bf16x8 s0 = *(const LAS bf16x8*)(L + oST + fr * 144 + (8 * fq) * 2), s1 = *(const LAS bf16x8*)(L + oST + fr * 144 + (32 + 8 * fq) * 2);
                const bf16x8 vtf = RC_F80(B_ + oVT, 0), makf = RC_F80(Ms, 0), mrbf = RC_F80(Ms + 1280, 0), mrkf = RC_F80(Ms + 2560, 0), ttf = RC_F80(Tt, 0);
                bf16x8 btf[4], ktf[4]; f32x4 glv[4];
#pragma unroll
                for (int kt = 0; kt < 4; ++kt) { btf[kt] = RC_F80(B_ + oBT, kt * 16); ktf[kt] = RC_F80(B_ + oKT, kt * 16); glv[kt] = *(const LAS f32x4*)(B_ + oGL + (kt * 16 + 4 * fq) * 4); }
                asm volatile("s_waitcnt lgkmcnt(0)" ::: "memory");
                const f32x4 z4 = {0.f, 0.f, 0.f, 0.f};
                f32x4 dw = __builtin_amdgcn_mfma_f32_16x16x32_bf16(a0, s0, z4, 0, 0, 0); dw = __builtin_amdgcn_mfma_f32_16x16x32_bf16(a1, s1, dw, 0, 0, 0);
                dw = __builtin_amdgcn_mfma_f32_16x16x32_bf16(makf, vtf, dw, 0, 0, 0);
                f32x4 dy = __builtin_amdgcn_mfma_f32_16x16x32_bf16(r0, s0, z4, 0, 0, 0); dy = __builtin_amdgcn_mfma_f32_16x16x32_bf16(r1, s1, dy, 0, 0, 0);
                dy = __builtin_amdgcn_mfma_f32_16x16x32_bf16(mrkf, vtf, dy, 0, 0, 0);
                { u32x2 ww; ww.x = pk2(dw[0], dw[1]); ww.y = pk2(dw[2], dw[3]); *(LAS u32x2*)(L + oWT + fr * 80 + (4 * fq) * 2) = ww; }
                f32x4 sk[4];
#pragma unroll
                for (int kt = 0; kt < 4; ++kt) sk[kt] = __builtin_amdgcn_mfma_f32_16x16x32_bf16(ktf[kt], vtf, Sacc[kt], 0, 0, 0);
                f32x4 du = __builtin_amdgcn_mfma_f32_16x16x32_bf16(ttf, RC_F80(L + oWT, 0), z4, 0, 0, 0);
                { u32x2 uw; uw.x = pk2(du[0], du[1]); uw.y = pk2(du[2], du[3]); *(LAS u32x2*)(L + oUT + fr * 80 + (4 * fq) * 2) = uw; }
                const bf16x8 utf = RC_F80(L + oUT, 0);
                dy = __builtin_amdgcn_mfma_f32_16x16x32_bf16(mrbf, utf, dy, 0, 0, 0);
#pragma unroll
                for (int kt = 0; kt < 4; ++kt) {
                    f32x4 sa = __builtin_amdgcn_mfma_f32_16x16x32_bf16(btf[kt], utf, sk[kt], 0, 0, 0);
                    sa = sa * glv[kt]; Sacc[kt] = sa;
                    u32x2 sw; sw.x = pk2(sa[0], sa[1]); sw.y = pk2(sa[2], sa[3]); *(LAS u32x2*)(L + oST + fr * 144 + (kt * 16 + 4 * fq) * 2) = sw; }
                { bf16_t* yo = yg + (size_t)(i * 16 + 4 * fq) * 512; yo[0] = f2bf(dy[0]); yo[512] = f2bf(dy[1]); yo[1024] = f2bf(dy[2]); yo[1536] = f2bf(dy[3]); }
                LBAR();
            }
        }
#undef RC_F144
#undef RC_F80
    }
    STAMP(17);
    for (int item = bid; item < 256; item += G) {
        PHASE_IDS
        const int w = __builtin_amdgcn_readfirstlane(tid >> 6), fr = lane & 15, fq = lane >> 4;
        const int grp_ = (item & 7) * 4 + (item >> 6), vs = (item >> 3) & 7, h = grp_ & 3, b = grp_ >> 2;
        constexpr int QS = 272, TS = 144;
        constexpr int BUFB = 38656, oQ = 0, oK = 17408, oVT = 34816, oV = 37120, oP = 2 * BUFB, oCT = oP + 9216;
        LAS unsigned char* L = lds;
        const size_t tok0 = (size_t)b * SEQ;
        int prow[2], pc8[2];
#pragma unroll
        for (int i = 0; i < 2; ++i) { const int pp = tid + 512 * i; prow[i] = pp >> 4; pc8[i] = (pp & 15) * 8; }
        const int vrow = tid & 63, vpart = (tid >> 6) & 1;
        u32x4 qa[2], ka[2], va = {0u, 0u, 0u, 0u}; float vem = 0.f, vel = 0.f, velm = 0.f;
#define HM_FETCH(c_) { const size_t tb_ = tok0 + (size_t)(c_) * 64; _Pragma("unroll") for (int i_ = 0; i_ < 2; ++i_) { const bf16_t* r_ = U + (tb_ + prow[i_]) * LDU0 + h * 128 + pc8[i_]; qa[i_] = *(const u32x4*)r_; ka[i_] = *(const u32x4*)(r_ + 512); } \
            { va = *(const u32x4*)(U + (tb_ + vrow) * LDU0 + 1024 + h * 128 + vs * 16 + vpart * 8); const size_t vo_ = ((size_t)b * (SEQ / 64) + (c_)) * 512 + h * 128 + (tid & 127); vem = HEM[vo_]; vel = HEL[vo_]; velm = HELM[vo_]; } }
#define HM_H(w_, j_) ((bf16_t)(((j_) & 1) ? ((w_) >> 16) : ((w_) & 0xffffu)))
#define HM_STORE(bo_) { _Pragma("unroll") for (int i_ = 0; i_ < 2; ++i_) { *(LAS u32x4*)(L + (bo_) + oQ + prow[i_] * QS + pc8[i_] * 2) = qa[i_]; *(LAS u32x4*)(L + (bo_) + oK + prow[i_] * QS + pc8[i_] * 2) = ka[i_]; } \
            if (tid < 128) { LAS bf16_t* vt_ = (LAS bf16_t*)(L + (bo_) + oVT + (vpart * 8) * TS + vrow * 2); const unsigned vw4_[4] = {va.x, va.y, va.z, va.w}; \
                _Pragma("unroll") for (int j_ = 0; j_ < 8; ++j_) vt_[j_ * (TS / 2)] = HM_H(vw4_[j_ >> 1], j_); \
                ((LAS float*)(L + (bo_) + oV))[tid] = vem; ((LAS float*)(L + (bo_) + oV))[128 + tid] = vel; ((LAS float*)(L + (bo_) + oV))[256 + tid] = velm; } }
#define HM_FRAG(off_, row_, stride_, kk_) (*(const LAS bf16x8*)(L + (off_) + ((row_) + fr) * (stride_) + ((kk_) * 32 + 8 * fq) * 2))
#define HM_TR4(p_) __builtin_amdgcn_ds_read_tr16_b64_v4i16((LAS s16x4*)(p_))
        __syncthreads();
        for (int i = tid; i < (9216 + 4352) / 4; i += 512) ((LAS unsigned*)(L + oP))[i] = 0u;
        HM_FETCH(0); HM_STORE(0); HM_FETCH(1);
        LBAR();
        f32x4 Cacc = {0.f, 0.f, 0.f, 0.f};
        const int ktoff = oK + ((lane >> 4) * 8 + ((lane >> 2) & 3)) * QS + (w * 16 + (lane & 3) * 4) * 2;
        for (int c = 0; c < SEQ / 64; ++c) {
            const int bo = (c & 1) * BUFB, bn = BUFB - bo;
            { const int k0 = w * 16 + 4 * fq; const LAS float* vEM = (const LAS float*)(L + bo + oV);
              u32x2 cw; cw.x = pk2(Cacc[0] * vEM[k0], Cacc[1] * vEM[k0 + 1]); cw.y = pk2(Cacc[2] * vEM[k0 + 2], Cacc[3] * vEM[k0 + 3]);
              *(LAS u32x2*)(L + oCT + fr * QS + k0 * 2) = cw; }
            { const int sb = w >> 1, tb0 = (w & 1) * 2;
              if (sb <= tb0 + 1) { const bool two = sb <= tb0;
                  bf16x8 kf[4], q0f[4], q1f[4];
#pragma unroll
                  for (int kk = 0; kk < 4; ++kk) { kf[kk] = HM_FRAG(bo + oK, sb * 16, QS, kk); q1f[kk] = HM_FRAG(bo + oQ, tb0 * 16 + 16, QS, kk); }
                  if (two) {
#pragma unroll
                      for (int kk = 0; kk < 4; ++kk) q0f[kk] = HM_FRAG(bo + oQ, tb0 * 16, QS, kk); }
                  f32x4 a0 = {0.f, 0.f, 0.f, 0.f}, a1 = {0.f, 0.f, 0.f, 0.f};
                  if (two) {
#pragma unroll
                      for (int kk = 0; kk < 4; ++kk) { a0 = __builtin_amdgcn_mfma_f32_16x16x32_bf16(kf[kk], q0f[kk], a0, 0, 0, 0); a1 = __builtin_amdgcn_mfma_f32_16x16x32_bf16(kf[kk], q1f[kk], a1, 0, 0, 0); }
                  } else {
#pragma unroll
                      for (int kk = 0; kk < 4; ++kk) a1 = __builtin_amdgcn_mfma_f32_16x16x32_bf16(kf[kk], q1f[kk], a1, 0, 0, 0);
                  }
                  const int s0 = sb * 16 + 4 * fq;
#pragma unroll
                  for (int j = 0; j < 2; ++j) { if (j == 1 || two) { const int t = (tb0 + j) * 16 + fr; const f32x4 a = j ? a1 : a0;
                      u32x2 pw; pw.x = pk2((s0 <= t) ? a[0] : 0.f, (s0 + 1 <= t) ? a[1] : 0.f); pw.y = pk2((s0 + 2 <= t) ? a[2] : 0.f, (s0 + 3 <= t) ? a[3] : 0.f);
                      *(LAS u32x2*)(L + oP + t * TS + s0 * 2) = pw; } } } }
            LBAR();
            if (c + 1 < SEQ / 64) HM_STORE(bn);
            HM_FETCH((c + 2 < SEQ / 64) ? c + 2 : c);
            if (w < 4) { f32x4 d = {0.f, 0.f, 0.f, 0.f};
#pragma unroll
                for (int kk = 0; kk < 2; ++kk) d = __builtin_amdgcn_mfma_f32_16x16x32_bf16(HM_FRAG(oP, w * 16, TS, kk), HM_FRAG(bo + oVT, 0, TS, kk), d, 0, 0, 0);
#pragma unroll
                for (int kk = 0; kk < 4; ++kk) d = __builtin_amdgcn_mfma_f32_16x16x32_bf16(HM_FRAG(bo + oQ, w * 16, QS, kk), HM_FRAG(oCT, 0, QS, kk), d, 0, 0, 0);
                bf16_t* op = U + (tok0 + (size_t)c * 64 + w * 16 + 4 * fq) * LDU0 + 1024 + h * 128 + vs * 16 + fr;
                op[0] = f2bf(d[0]); op[LDU0] = f2bf(d[1]); op[2 * LDU0] = f2bf(d[2]); op[3 * LDU0] = f2bf(d[3]); }
            { f32x4 tmp = {0.f, 0.f, 0.f, 0.f};
              const LAS unsigned char* kt = L + bo + ktoff;
#pragma unroll
              for (int kk = 0; kk < 2; ++kk) { const bf16x8 ktf = __builtin_shufflevector(HM_TR4(kt + kk * 32 * QS), HM_TR4(kt + kk * 32 * QS + 4 * QS), 0, 1, 2, 3, 4, 5, 6, 7);
                  tmp = __builtin_amdgcn_mfma_f32_16x16x32_bf16(ktf, HM_FRAG(bo + oVT, 0, TS, kk), tmp, 0, 0, 0); }
              const int k0 = w * 16 + 4 * fq; const LAS float* vEL = (const LAS float*)(L + bo + oV) + 128; const LAS float* vELM = vEL + 128;
#pragma unroll
              for (int r = 0; r < 4; ++r) Cacc[r] = Cacc[r] * vEL[k0 + r] + tmp[r] * vELM[k0 + r]; }
            LBAR();
        }
#undef HM_TR4
#undef HM_FETCH
#undef HM_STORE
#undef HM_FRAG
#undef HM_H
    }
    GSYNC();
    STAMP(4);

    {
        PHASE_IDS
        const int gw = bid * 8 + wave, NWH = G * 4;
        const int c8 = lane * 8;
        if ((gw & 1) == 0) {
            const f32x4 an0 = *(const f32x4*)(p.in[7] + c8), an1 = *(const f32x4*)(p.in[7] + c8 + 4);
            for (int m0 = gw >> 1; m0 < M; m0 += NWH * 4) {
                u32x4 xo[4], xg[4];
#pragma unroll
                for (int u = 0; u < 4; ++u) { const int m = m0 + u * NWH; const bf16_t* ur = U + (size_t)m * LDU0 + c8; xo[u] = *(const u32x4*)(ur + 1024); xg[u] = *(const u32x4*)(ur + 1536); }
#pragma unroll
                for (int u = 0; u < 4; ++u) { const int m = m0 + u * NWH; {
                    const float o[8] = {bflo(xo[u].x), bfhi(xo[u].x), bflo(xo[u].y), bfhi(xo[u].y), bflo(xo[u].z), bfhi(xo[u].z), bflo(xo[u].w), bfhi(xo[u].w)};
                    const float g[8] = {bflo(xg[u].x), bfhi(xg[u].x), bflo(xg[u].y), bfhi(xg[u].y), bflo(xg[u].z), bfhi(xg[u].z), bflo(xg[u].w), bfhi(xg[u].w)};
                    float ss = 0.f;
#pragma unroll
                    for (int e = 0; e < 8; ++e) ss = fmaf(o[e], o[e], ss);
                    const float rs = 1.0f / sqrtf(row_sum16(ss) * (1.f / 128.f) + RMS_EPS);
                    u32x4 w; w.x = pk2(o[0] * rs * an0[0] * siluf_(g[0]), o[1] * rs * an0[1] * siluf_(g[1])); w.y = pk2(o[2] * rs * an0[2] * siluf_(g[2]), o[3] * rs * an0[3] * siluf_(g[3]));
                    w.z = pk2(o[4] * rs * an1[0] * siluf_(g[4]), o[5] * rs * an1[1] * siluf_(g[5])); w.w = pk2(o[6] * rs * an1[2] * siluf_(g[6]), o[7] * rs * an1[3] * siluf_(g[7]));
                    *(u32x4*)(YC + (size_t)m * DM + c8) = w; } }
            }
        } else {
            const f32x4 lw0 = *(const f32x4*)(p.in[17] + c8), lw1 = *(const f32x4*)(p.in[17] + c8 + 4), lb0 = *(const f32x4*)(p.in[18] + c8), lb1 = *(const f32x4*)(p.in[18] + c8 + 4);
            for (int m0 = gw >> 1; m0 < M; m0 += NWH * 4) {
                u32x4 xy[4], xg[4], xb[4];
#pragma unroll
                for (int u = 0; u < 4; ++u) { const int m = m0 + u * NWH; const size_t i = (size_t)m * 512 + c8; xy[u] = *(const u32x4*)(Vv + i); xg[u] = *(const u32x4*)(Gg + i); xb[u] = *(const u32x4*)(BVG + i); }
#pragma unroll
                for (int u = 0; u < 4; ++u) { const int m = m0 + u * NWH; {
                    const float y[8] = {bflo(xy[u].x), bfhi(xy[u].x), bflo(xy[u].y), bfhi(xy[u].y), bflo(xy[u].z), bfhi(xy[u].z), bflo(xy[u].w), bfhi(xy[u].w)};
                    const float g[8] = {bflo(xg[u].x), bfhi(xg[u].x), bflo(xg[u].y), bfhi(xg[u].y), bflo(xg[u].z), bfhi(xg[u].z), bflo(xg[u].w), bfhi(xg[u].w)};
                    const float bv[8] = {bflo(xb[u].x), bfhi(xb[u].x), bflo(xb[u].y), bfhi(xb[u].y), bflo(xb[u].z), bfhi(xb[u].z), bflo(xb[u].w), bfhi(xb[u].w)};
                    float s1 = 0.f;
#pragma unroll
                    for (int e = 0; e < 8; ++e) s1 += y[e];
                    s1 += dpp_mov<0xB1>(s1); s1 += dpp_mov<0x4E>(s1); s1 += dpp_mov<0x141>(s1);
                    const float mean = s1 * (1.f / 64.f); float s2 = 0.f;
#pragma unroll
                    for (int e = 0; e < 8; ++e) { const float d = y[e] - mean; s2 = fmaf(d, d, s2); }
                    s2 += dpp_mov<0xB1>(s2); s2 += dpp_mov<0x4E>(s2); s2 += dpp_mov<0x141>(s2);
                    const float rs = 1.0f / sqrtf(s2 * (1.f / 64.f) + 64e-5f);
                    float r8[8];
#pragma unroll
                    for (int e = 0; e < 8; ++e) { const float lw = e < 4 ? lw0[e] : lw1[e - 4], lb = e < 4 ? lb0[e] : lb1[e - 4]; r8[e] = ((y[e] - mean) * rs * lw + lb) * g[e] + bv[e]; }
                    u32x4 w; w.x = pk2(r8[0], r8[1]); w.y = pk2(r8[2], r8[3]); w.z = pk2(r8[4], r8[5]); w.w = pk2(r8[6], r8[7]);
                    *(u32x4*)(YC + (size_t)m * DM + 512 + c8) = w; } }
            }
        }
    }
    GSYNC();
    STAMP(5);

    { pg8::Gemm g{YC, (const bf16_t*)(p.ws + WS_OUT0), DM, DM, M, DM, DM}; pg8::StaticOrder S; S.init(M, DM, G, bid);
      pg8::EpiResidual<true, true> E{p.in[0], nullptr, XB, SS1}; pg8::gemm_phase<pg8::EpiResidual<true, true>, pg8::StaticOrder, true, true>(lds, g, S, E); }
    GSYNC();
    STAMP(6);
#define HID U
    { pg8::Gemm g{XB, (const bf16_t*)(p.ws + WS_GU0), DM, DM, M, 2 * FFN, DM}; pg8::StaticOrder S; S.init(M, 2 * FFN, G, bid);
      pg8::EpiSwiGlu E{HID, FFN, SS1}; pg8::gemm_phase<pg8::EpiSwiGlu, pg8::StaticOrder, true, true>(lds, g, S, E); }
    GSYNC();
    STAMP(7);
    { pg8::Gemm g{HID, (const bf16_t*)(p.ws + WS_D0), FFN, FFN, M, DM, FFN}; pg8::StaticOrder S; S.init(M, DM, G, bid);
      pg8::EpiResidual<false, true> E{nullptr, XB, XB, SS2}; pg8::gemm_phase<pg8::EpiResidual<false, true>, pg8::StaticOrder, true, true>(lds, g, S, E); }
    GSYNC();
    STAMP(8);
    { pg8::Gemm g{XB, (const bf16_t*)(p.ws + WS_IN1), DM, DM, M, NP1, DM}; pg8::StaticOrder S; S.init(M, NP1, G, bid);
      pg8::EpiScaleBf16 E{U, LDU1, SS2}; pg8::gemm_phase<pg8::EpiScaleBf16, pg8::StaticOrder, true, true>(lds, g, S, E); }
    GSYNC();
    STAMP(9);

#define Qc ((bf16_t*)(p.ws + WS_YC))
#define Kc ((bf16_t*)(p.ws + WS_MS))
#define gSI ((float*)(p.ws + WS_MS + 48 * MiB))
#define gBI (gSI + (size_t)M * 4)
#define gBT (gSI + (size_t)M * 8)
#define gWL (gSI + (size_t)M * 12)
#define gDP ((float*)(p.ws + WS_MS + 50 * MiB))
#define gDEN ((float*)(p.ws + WS_MS + 51 * MiB))
    {
        PHASE_IDS
        const float* cq = p.in[31]; const float* ck = p.in[32];
        const int gw = bid * 8 + wave, NW = G * 8;
        for (int item = gw; item < (M / 16) * 3; item += NW) {
            const int run = item / 3, m0 = run * 16, c = (item % 3) * 512 + lane * 8; const bool s0 = (m0 & (SEQ - 1)) == 0;
            const bool isk = c >= 768; const int cc = isk ? c - 768 : c; const float* cw = (isk ? ck : cq) + cc; const float sc = isk ? 0.07216878364870322f : 1.f;
            u32x4 x[19];
#pragma unroll
            for (int i = 0; i < 19; ++i) { const int mm = (i < 3 && s0) ? m0 : m0 - 3 + i; x[i] = *(const u32x4*)(U + (size_t)mm * LDU1 + 256 + c); }
            f32x4 w0[4], w1[4];
#pragma unroll
            for (int j = 0; j < 4; ++j) { w0[j] = *(const f32x4*)(cw + j * 768); w1[j] = *(const f32x4*)(cw + j * 768 + 4); }
            if (s0) { const u32x4 z = {0u, 0u, 0u, 0u}; x[0] = z; x[1] = z; x[2] = z; }
            bf16_t* dst = (isk ? Kc : Qc) + (size_t)m0 * 768 + cc;
#pragma unroll
            for (int tk = 0; tk < 16; ++tk) {
                float acc[8];
#pragma unroll
                for (int e = 0; e < 8; ++e) acc[e] = 0.f;
#pragma unroll
                for (int j = 0; j < 4; ++j) { const u32x4 xv = x[tk + j];
                    acc[0] = fmaf(w0[j][0], bflo(xv.x), acc[0]); acc[1] = fmaf(w0[j][1], bfhi(xv.x), acc[1]); acc[2] = fmaf(w0[j][2], bflo(xv.y), acc[2]); acc[3] = fmaf(w0[j][3], bfhi(xv.y), acc[3]);
                    acc[4] = fmaf(w1[j][0], bflo(xv.z), acc[4]); acc[5] = fmaf(w1[j][1], bfhi(xv.z), acc[5]); acc[6] = fmaf(w1[j][2], bflo(xv.w), acc[6]); acc[7] = fmaf(w1[j][3], bfhi(xv.w), acc[7]); }
                u32x4 o; o.x = pk2(siluf_(acc[0]) * sc, siluf_(acc[1]) * sc); o.y = pk2(siluf_(acc[2]) * sc, siluf_(acc[3]) * sc); o.z = pk2(siluf_(acc[4]) * sc, siluf_(acc[5]) * sc); o.w = pk2(siluf_(acc[6]) * sc, siluf_(acc[7]) * sc);
                *(u32x4*)(dst + (size_t)tk * 768) = o; }
        }
        for (int it = gw; it < (M / 64) * 4; it += NW) {
            const int ch = it >> 2, hh = it & 3; const size_t m = (size_t)ch * 64 + lane; const bf16_t* ur = U + m * LDU1;
            const float lf = -softplusf_(-(bf2f(ur[3332 + hh]) + p.in[34][hh]));
            const float li = bf2f(ur[3328 + hh]) + p.in[33][hh];
            float bs = lf;
#pragma unroll
            for (int o = 1; o < 64; o <<= 1) { const float t = __shfl_up(bs, o); if (lane >= o) bs += t; }
            const float bL = __shfl(bs, 63);
            gSI[m * 4 + hh] = __expf(bs); gBI[m * 4 + hh] = li - bs; gBT[m * 4 + hh] = bs; gWL[m * 4 + hh] = __expf(bL - bs + li);
            if (lane == 0) gDP[ch * 4 + hh] = __expf(bL);
        }
    }
    GSYNC();
    STAMP(10);

    if (bid < 192) {
        PHASE_IDS
        const int w = __builtin_amdgcn_readfirstlane(tid >> 6);
        const int grp_ = (bid & 7) * 4 + (bid >> 3) / 6;
        const int vs = (bid >> 3) % 6, h = grp_ & 3, b = grp_ >> 2;
        constexpr int QS = 400, TS = 144;
        constexpr int oQ = 0, oK = 25600, oKT = 51200, oVT = 78848, oVW = 85760, oP = 92672, oCT = 101888, oG = 121088;
        LAS unsigned char* L = lds;
        for (int i = tid; i < 19200 / 4; i += 512) ((LAS unsigned*)(L + oCT))[i] = 0u;
        for (int i = tid; i < 64 * TS / 4; i += 512) ((LAS unsigned*)(L + oP))[i] = 0u;
        for (int i = tid; i < 16 * TS / 4; i += 512) { ((LAS unsigned*)(L + oVT + 32 * TS))[i] = (i < TS / 4) ? 0x3F803F80u : 0u; ((LAS unsigned*)(L + oVW + 32 * TS))[i] = 0u; }
        const size_t tok0 = (size_t)b * SEQ;
        const int fr = lane & 15, fq = lane >> 4;
        u32x4 qa[3], ka[3], va = {0u, 0u, 0u, 0u}; float gsi = 0.f, gbi = 0.f, gbt = 0.f, gwl = 0.f, wlr = 0.f;
        int prow[3], pc8[3];
#pragma unroll
        for (int i = 0; i < 3; ++i) { const int pp = tid + 512 * i; prow[i] = pp / 24; pc8[i] = (pp % 24) * 8; }
        const int vrow = tid & 63, vpart = tid >> 6;
#define MM_FETCH(c_) { const size_t tb_ = tok0 + (size_t)(c_) * 64; _Pragma("unroll") for (int i_ = 0; i_ < 3; ++i_) { const size_t o_ = (tb_ + prow[i_]) * 768 + h * 192 + pc8[i_]; qa[i_] = *(const u32x4*)(Qc + o_); ka[i_] = *(const u32x4*)(Kc + o_); } \
            { va = *(const u32x4*)(U + (tb_ + vrow) * LDU1 + 1792 + h * 192 + vs * 32 + (vpart & 3) * 8); wlr = gWL[(tb_ + vrow) * 4 + h]; } \
            { const size_t g_ = (tb_ + (tid & 63)) * 4 + h; gsi = gSI[g_]; gbi = gBI[g_]; gbt = gBT[g_]; gwl = gWL[g_]; } }
#define MM_H(w_, j_) ((bf16_t)(((j_) & 1) ? ((w_) >> 16) : ((w_) & 0xffffu)))
#define MM_STORE() { _Pragma("unroll") for (int i_ = 0; i_ < 3; ++i_) { *(LAS u32x4*)(L + oQ + prow[i_] * QS + pc8[i_] * 2) = qa[i_]; *(LAS u32x4*)(L + oK + prow[i_] * QS + pc8[i_] * 2) = ka[i_]; \
            } \
            if (tid < 256) { LAS bf16_t* vt_ = (LAS bf16_t*)(L + oVT + (vpart * 8) * TS + vrow * 2); LAS bf16_t* vw_ = (LAS bf16_t*)(L + oVW + (vpart * 8) * TS + vrow * 2); const unsigned vw4_[4] = {va.x, va.y, va.z, va.w}; \
                _Pragma("unroll") for (int j_ = 0; j_ < 8; ++j_) { const bf16_t e_ = MM_H(vw4_[j_ >> 1], j_); vt_[j_ * (TS / 2)] = e_; vw_[j_ * (TS / 2)] = f2bf(bf2f(e_) * wlr); } } \
            if (tid < 64) { ((LAS bf16_t*)(L + oVW + 32 * TS))[tid] = f2bf(gwl); ((LAS float*)(L + oG))[tid] = gsi; ((LAS float*)(L + oG))[64 + tid] = gbi; ((LAS float*)(L + oG))[128 + tid] = gbt; } }
#define MM_TR4(off_) __builtin_amdgcn_ds_read_tr16_b64_v4i16((LAS s16x4*)(ktb + (off_)))
#define MM_TRF(off_) __builtin_shufflevector(MM_TR4(off_), MM_TR4((off_) + 4 * QS), 0, 1, 2, 3, 4, 5, 6, 7)
#define MM_FRAG(off_, row_, stride_, kk_) (*(const LAS bf16x8*)(L + (off_) + ((row_) + fr) * (stride_) + ((kk_) * 32 + 8 * fq) * 2))
        __syncthreads();
        MM_FETCH(0); MM_STORE();
        LBAR();
        f32x4 Cacc[3][2];
#pragma unroll
        for (int i = 0; i < 3; ++i) { Cacc[i][0] = (f32x4){0.f, 0.f, 0.f, 0.f}; Cacc[i][1] = (f32x4){0.f, 0.f, 0.f, 0.f}; }
        const int nvt = (w < 4) ? 1 : 2, vt0 = (w < 4) ? 0 : 1, db0 = 3 * (w & 3);
        const LAS unsigned char* ktb = L + oK + ((lane >> 4) * 8 + ((lane >> 2) & 3)) * QS + (db0 * 16 + (lane & 3) * 4) * 2;
        const LAS float* gSIl = (const LAS float*)(L + oG); const LAS float* gBIl = gSIl + 64; const LAS float* gBTl = gSIl + 128;
        for (int c = 0; c < SEQ / 64; ++c) {
            int fr_o = lane & 15, fq_o = lane >> 4; asm volatile("" : "+v"(fr_o), "+v"(fq_o));
            const int fr = fr_o, fq = fq_o;
            const float dp = gDP[(b * (SEQ / 64) + c) * 4 + h];
            MM_FETCH((c + 1 < SEQ / 64) ? c + 1 : c);
            { const int sb = w >> 1, tb0 = (w & 1) * 2;
              if (sb <= tb0 + 1) {
              const bool two = sb <= tb0;
              bf16x8 kf[6], q0f[6], q1f[6];
#pragma unroll
              for (int kk = 0; kk < 6; ++kk) { kf[kk] = MM_FRAG(oK, sb * 16, QS, kk); q1f[kk] = MM_FRAG(oQ, tb0 * 16 + 16, QS, kk); }
              if (two) {
#pragma unroll
                  for (int kk = 0; kk < 6; ++kk) q0f[kk] = MM_FRAG(oQ, tb0 * 16, QS, kk); }
              const int s0 = sb * 16 + 4 * fq;
              const float bi0 = gBIl[s0], bi1 = gBIl[s0 + 1], bi2 = gBIl[s0 + 2], bi3 = gBIl[s0 + 3];
              const float bt0 = gBTl[tb0 * 16 + fr], bt1 = gBTl[tb0 * 16 + 16 + fr];
              asm volatile("s_waitcnt lgkmcnt(0)" ::: "memory");
              f32x4 a0 = {0.f, 0.f, 0.f, 0.f}, a1 = {0.f, 0.f, 0.f, 0.f};
              if (two) {
#pragma unroll
                  for (int kk = 0; kk < 6; ++kk) { a0 = __builtin_amdgcn_mfma_f32_16x16x32_bf16(kf[kk], q0f[kk], a0, 0, 0, 0); a1 = __builtin_amdgcn_mfma_f32_16x16x32_bf16(kf[kk], q1f[kk], a1, 0, 0, 0); }
              } else {
#pragma unroll
                  for (int kk = 0; kk < 6; ++kk) a1 = __builtin_amdgcn_mfma_f32_16x16x32_bf16(kf[kk], q1f[kk], a1, 0, 0, 0);
              }
#pragma unroll
              for (int j = 0; j < 2; ++j) { if (j == 1 || two) { const int t = (tb0 + j) * 16 + fr; const float bt = j ? bt1 : bt0; const f32x4 a = j ? a1 : a0;
                  const float p0 = (s0 <= t) ? a[0] * __expf(bt + bi0) : 0.f, p1 = (s0 + 1 <= t) ? a[1] * __expf(bt + bi1) : 0.f, p2 = (s0 + 2 <= t) ? a[2] * __expf(bt + bi2) : 0.f, p3 = (s0 + 3 <= t) ? a[3] * __expf(bt + bi3) : 0.f;
                  u32x2 pw; pw.x = pk2(p0, p1); pw.y = pk2(p2, p3); *(LAS u32x2*)(L + oP + t * TS + s0 * 2) = pw; } } } }
            LBAR();
            { const int tb = w & 3;
              const int n2 = (w < 4) ? 2 : 1;
              bf16x8 qf[6], pf[2], vtf[2][2], ctf[2][6];
#pragma unroll
              for (int kk = 0; kk < 6; ++kk) qf[kk] = MM_FRAG(oQ, tb * 16, QS, kk);
#pragma unroll
              for (int kk = 0; kk < 2; ++kk) pf[kk] = MM_FRAG(oP, tb * 16, TS, kk);
#pragma unroll
              for (int j = 0; j < 2; ++j) { if (j < n2) { const int vt = (w < 4) ? j : 2;
#pragma unroll
                  for (int kk = 0; kk < 2; ++kk) vtf[j][kk] = MM_FRAG(oVT, vt * 16, TS, kk);
#pragma unroll
                  for (int kk = 0; kk < 6; ++kk) ctf[j][kk] = MM_FRAG(oCT, vt * 16, QS, kk); } }
              const int t0r = tb * 16 + 4 * fq;
              const float si0 = gSIl[t0r], si1 = gSIl[t0r + 1], si2 = gSIl[t0r + 2], si3 = gSIl[t0r + 3];
              asm volatile("s_waitcnt lgkmcnt(0)" ::: "memory");
              bf16x8 ktf[3][2], vwf[2][2];
#pragma unroll
              for (int i = 0; i < 3; ++i) { ktf[i][0] = MM_TRF(i * 32); ktf[i][1] = MM_TRF(32 * QS + i * 32); }
#pragma unroll
              for (int j = 0; j < 2; ++j) { if (j < nvt) { vwf[j][0] = MM_FRAG(oVW, (vt0 + j) * 16, TS, 0); vwf[j][1] = MM_FRAG(oVW, (vt0 + j) * 16, TS, 1); } }
#pragma unroll
              for (int j = 0; j < 2; ++j) { if (j < n2) { const int vt = (w < 4) ? j : 2;
                  f32x4 d2 = {0.f, 0.f, 0.f, 0.f}, d3 = {0.f, 0.f, 0.f, 0.f};
#pragma unroll
                  for (int kk = 0; kk < 2; ++kk) d2 = __builtin_amdgcn_mfma_f32_16x16x32_bf16(pf[kk], vtf[j][kk], d2, 0, 0, 0);
#pragma unroll
                  for (int kk = 0; kk < 6; ++kk) d3 = __builtin_amdgcn_mfma_f32_16x16x32_bf16(qf[kk], ctf[j][kk], d3, 0, 0, 0);
                  const float o0 = si0 * d3[0] + d2[0], o1 = si1 * d3[1] + d2[1], o2 = si2 * d3[2] + d2[2], o3 = si3 * d3[3] + d2[3];
                  const size_t tg = tok0 + (size_t)c * 64 + t0r;
                  if (w < 4) { bf16_t* op = U + tg * LDU1 + 1792 + h * 192 + vs * 32 + vt * 16 + fr; op[0] = f2bf(o0); op[LDU1] = f2bf(o1); op[2 * LDU1] = f2bf(o2); op[3 * LDU1] = f2bf(o3); }
                  else if (fr == 0 && vs == 0) { float* dn = gDEN + tg * 4 + h; dn[0] = o0; dn[4] = o1; dn[8] = o2; dn[12] = o3; } } }
              asm volatile("s_waitcnt lgkmcnt(0)" ::: "memory");
#pragma unroll
              for (int i = 0; i < 3; ++i)
#pragma unroll
                  for (int j = 0; j < 2; ++j) { if (j < nvt) { f32x4 ca = Cacc[i][j] * dp;
                      ca = __builtin_amdgcn_mfma_f32_16x16x32_bf16(ktf[i][0], vwf[j][0], ca, 0, 0, 0);
                      ca = __builtin_amdgcn_mfma_f32_16x16x32_bf16(ktf[i][1], vwf[j][1], ca, 0, 0, 0); Cacc[i][j] = ca; } } }
            LBAR();
#pragma unroll
            for (int i = 0; i < 3; ++i)
#pragma unroll
                for (int j = 0; j < 2; ++j) { if (j < nvt) { const f32x4 ca = Cacc[i][j]; u32x2 cw; cw.x = pk2(ca[0], ca[1]); cw.y = pk2(ca[2], ca[3]);
                    *(LAS u32x2*)(L + oCT + ((vt0 + j) * 16 + fr) * QS + ((db0 + i) * 16 + 4 * fq) * 2) = cw; } }
            if (c + 1 < SEQ / 64) MM_STORE();
            LBAR();
        }
        STAMP2(18, 0);
#undef MM_FETCH
#undef MM_STORE
#undef MM_FRAG
#undef MM_TR4
#undef MM_TRF
#undef MM_H
    } else {
        PHASE_IDS
        const int w = __builtin_amdgcn_readfirstlane(tid >> 6), wq = w & 3, myc = w >> 2;
        const int fr = lane & 15, fq = lane >> 4;
        constexpr int US = 80, XS = 272, NB = SEQ / 32;
        constexpr int oU = 0, oW1 = 10240, oX = 20480, oH = 37888, oW2 = 55296, oZ = 59648, CH = 61696;
        LAS unsigned char* Lc = lds + myc * CH;
        __syncthreads();
        for (int i = tid; i < 2 * CH / 4; i += 512) ((LAS unsigned*)lds)[i] = 0u;
        __syncthreads();
        for (int i = tid; i < 2 * 128 * 16; i += 512) { const int cc = i >> 11, n = (i >> 4) & 127, k = i & 15; const int g_ = ((bid - 192) * 2 + cc) & 15;
            const float v = (n < 64) ? BBR[(g_ * 64 + n) * 16 + k] : BBI[(g_ * 64 + n - 64) * 16 + k];
            ((LAS bf16_t*)(lds + cc * CH + oW1 + n * US))[k] = f2bf(v); }
        for (int i = tid; i < 2 * 16 * 128; i += 512) { const int cc = i >> 11, hh = (i >> 7) & 15, k = i & 127; const int g_ = ((bid - 192) * 2 + cc) & 15;
            const float v = (k < 64) ? p.in[26][(g_ * 16 + hh) * 64 + k] : -p.in[27][(g_ * 16 + hh) * 64 + k - 64];
            ((LAS bf16_t*)(lds + cc * CH + oW2 + hh * XS))[k] = f2bf(v); }
        const int chain = (bid - 192) * 2 + myc, g = chain & 15, b = chain >> 4;
        bf16_t* gU = U + ((size_t)b * SEQ + (lane >> 1)) * LDU1 + g * 16 + (lane & 1) * 8;
        __syncthreads();
        if (wq == 3) {
            u32x4 sA, sB;
            const int lo = (lane >> 1) * US + (lane & 1) * 16, zo = (lane >> 1) * 32 + (lane & 1) * 16;
#define S5_LD(i_) (*(const u32x4*)(gU + (size_t)(((i_) < NB ? (i_) : NB - 1) * 32) * LDU1))
            sA = S5_LD(0); *(LAS u32x4*)(Lc + oU + 0 * 2560 + lo) = sA; sB = S5_LD(1); *(LAS u32x4*)(Lc + oU + 1 * 2560 + lo) = sB;
            sA = S5_LD(2); sB = S5_LD(3);
            LBAR(); LBAR();
            for (int it = 0; it < NB + 2; it += 2) {
                if (it + 2 < NB) *(LAS u32x4*)(Lc + oU + ((it + 2) & 3) * 2560 + lo) = sA;
                if (it >= 2) *(u32x4*)(gU + (size_t)((it - 2) * 32) * LDU1) = *(const LAS u32x4*)(Lc + oZ + (it & 1) * 1024 + zo);
                sA = S5_LD(it + 4);
                LBAR();
                if (it + 3 < NB) *(LAS u32x4*)(Lc + oU + ((it + 3) & 3) * 2560 + lo) = sB;
                if (it >= 1 && it - 1 < NB) *(u32x4*)(gU + (size_t)((it - 1) * 32) * LDU1) = *(const LAS u32x4*)(Lc + oZ + ((it + 1) & 1) * 1024 + zo);
                sB = S5_LD(it + 5);
                LBAR();
            }
#undef S5_LD
        } else if (wq == 1) {
            bf16x8 w1f[8];
#pragma unroll
            for (int j = 0; j < 8; ++j) w1f[j] = *(const LAS bf16x8*)(Lc + oW1 + (j * 16 + fr) * US + (8 * fq) * 2);
            auto xblk = [&](int blk) {
                const LAS unsigned char* Ut = Lc + oU + (blk & 3) * 2560; LAS unsigned char* Xt = Lc + oX + (blk & 1) * 8704;
                const bf16x8 u0 = *(const LAS bf16x8*)(Ut + fr * US + (8 * fq) * 2), u1 = *(const LAS bf16x8*)(Ut + (16 + fr) * US + (8 * fq) * 2);
                const f32x4 z4 = {0.f, 0.f, 0.f, 0.f};
#pragma unroll
                for (int j = 0; j < 8; ++j) { const f32x4 d0 = __builtin_amdgcn_mfma_f32_16x16x32_bf16(u0, w1f[j], z4, 0, 0, 0), d1 = __builtin_amdgcn_mfma_f32_16x16x32_bf16(u1, w1f[j], z4, 0, 0, 0);
                    LAS bf16_t* xp = (LAS bf16_t*)(Xt + (4 * fq) * XS) + j * 16 + fr;
#pragma unroll
                    for (int r = 0; r < 4; ++r) { xp[r * (XS / 2)] = f2bf(d0[r]); xp[(16 + r) * (XS / 2)] = f2bf(d1[r]); } } };
            LBAR();
            xblk(0);
            LBAR();
            for (int it = 0; it < NB + 2; ++it) { if (it + 1 < NB) xblk(it + 1); LBAR(); }
        } else if (wq == 0) {
            const float ar = LBR[g * 64 + lane], ai = LBI[g * 64 + lane];
            float hr = 0.f, hi = 0.f;
            LBAR(); LBAR();
            for (int it = 0; it < NB + 2; ++it) {
                if (it < NB) { const LAS bf16_t* xp = (const LAS bf16_t*)(Lc + oX + (it & 1) * 8704) + lane; LAS bf16_t* hp = (LAS bf16_t*)(Lc + oH + (it & 1) * 8704) + lane;
                    for (int t8 = 0; t8 < 32; t8 += 8) {
                        bf16_t xr[8], xi[8], or_[8], oi_[8];
#pragma unroll
                        for (int u = 0; u < 8; ++u) { xr[u] = xp[(t8 + u) * (XS / 2)]; xi[u] = xp[(t8 + u) * (XS / 2) + 64]; }
#pragma unroll
                        for (int u = 0; u < 8; ++u) { const float nr = fmaf(ar, hr, fmaf(-ai, hi, bf2f(xr[u]))), ni = fmaf(ar, hi, fmaf(ai, hr, bf2f(xi[u]))); hr = nr; hi = ni; or_[u] = f2bf(hr); oi_[u] = f2bf(hi); }
#pragma unroll
                        for (int u = 0; u < 8; ++u) { hp[(t8 + u) * (XS / 2)] = or_[u]; hp[(t8 + u) * (XS / 2) + 64] = oi_[u]; } } }
                LBAR();
            }
        } else {
            bf16x8 w2f[4];
#pragma unroll
            for (int kk = 0; kk < 4; ++kk) w2f[kk] = *(const LAS bf16x8*)(Lc + oW2 + fr * XS + (kk * 32 + 8 * fq) * 2);
            const float dsk = p.in[28][g * 16 + fr];
            LBAR(); LBAR();
            for (int it = 0; it < NB + 2; ++it) {
                if (it >= 1 && it - 1 < NB) { const int blk = it - 1; const LAS unsigned char* Ht = Lc + oH + (blk & 1) * 8704; const LAS unsigned char* Ut = Lc + oU + (blk & 3) * 2560; LAS unsigned char* Zt = Lc + oZ + (blk & 1) * 1024;
#pragma unroll
                    for (int tb = 0; tb < 2; ++tb) { f32x4 d = {0.f, 0.f, 0.f, 0.f};
#pragma unroll
                        for (int kk = 0; kk < 4; ++kk) d = __builtin_amdgcn_mfma_f32_16x16x32_bf16(*(const LAS bf16x8*)(Ht + (tb * 16 + fr) * XS + (kk * 32 + 8 * fq) * 2), w2f[kk], d, 0, 0, 0);
#pragma unroll
                        for (int r = 0; r < 4; ++r) { const int t = tb * 16 + 4 * fq + r;
                            const float y = d[r] + dsk * bf2f(*(const LAS bf16_t*)(Ut + t * US + fr * 2));
                            const float z = 0.5f * y * (1.f + tanhf_(0.7978845608028654f * (y + 0.044715f * y * y * y)));
                            *(LAS bf16_t*)(Zt + t * 32 + fr * 2) = f2bf(z); } } }
                LBAR();
            }
        }
        STAMP2(19, 192);
    }
    GSYNC();
    STAMP(11);

    {
        PHASE_IDS
        const int w = __builtin_amdgcn_readfirstlane(tid >> 6), fr = lane & 15, fq = lane >> 4;
        constexpr int ZS = 528;
        const bf16_t* WT = (const bf16_t*)(p.ws + WS_GLU);
        bf16x8 wf[2][8];
#pragma unroll
        for (int nt = 0; nt < 2; ++nt)
#pragma unroll
            for (int kk = 0; kk < 8; ++kk) wf[nt][kk] = *(const bf16x8*)(WT + (size_t)(w * 32 + nt * 16 + fr) * 256 + kk * 32 + 8 * fq);
        f32x4 bias4[2];
#pragma unroll
        for (int nt = 0; nt < 2; ++nt) bias4[nt] = *(const f32x4*)(p.in[30] + w * 32 + nt * 16 + 4 * fq);
        for (int m0 = bid * 64; m0 < M; m0 += G * 64) {
            __syncthreads();
#pragma unroll
            for (int i = 0; i < 4; ++i) { const int pp = tid + 512 * i, row = pp >> 5, c8 = (pp & 31) * 8; *(LAS u32x4*)(lds + row * ZS + c8 * 2) = *(const u32x4*)(U + (size_t)(m0 + row) * LDU1 + c8); }
            __syncthreads();
#pragma unroll
            for (int tb = 0; tb < 4; ++tb) { f32x4 d0 = {0.f, 0.f, 0.f, 0.f}, d1 = {0.f, 0.f, 0.f, 0.f};
#pragma unroll
                for (int kk = 0; kk < 8; ++kk) { const bf16x8 zf = *(const LAS bf16x8*)(lds + (tb * 16 + fr) * ZS + (kk * 32 + 8 * fq) * 2);
                    d0 = __builtin_amdgcn_mfma_f32_16x16x32_bf16(wf[0][kk], zf, d0, 0, 0, 0); d1 = __builtin_amdgcn_mfma_f32_16x16x32_bf16(wf[1][kk], zf, d1, 0, 0, 0); }
                const int t = tb * 16 + fr;
#pragma unroll
                for (int nt = 0; nt < 2; ++nt) { const f32x4 a = (nt ? d1 : d0) + bias4[nt]; const int n0 = w * 32 + nt * 16 + 4 * fq;
                    const u32x2 zz = *(const LAS u32x2*)(lds + t * ZS + n0 * 2);
                    u32x2 o; o.x = pk2(bflo(zz.x) * sigmoidf_(a[0]), bfhi(zz.x) * sigmoidf_(a[1])); o.y = pk2(bflo(zz.y) * sigmoidf_(a[2]), bfhi(zz.y) * sigmoidf_(a[3]));
                    *(u32x2*)(YC + (size_t)(m0 + t) * DM + n0) = o; } }
        }
    }
    {
        PHASE_IDS
        const int gw = bid * 8 + wave, NW = G * 8, hh = lane >> 4, c12 = lane * 12;
        f32x4 nw[3];
#pragma unroll
        for (int j = 0; j < 3; ++j) nw[j] = *(const f32x4*)(p.in[35] + c12 + 4 * j);
        for (int m0 = gw; m0 < M; m0 += NW * 4) {
            u32x2 xn[4][3], xo[4][3]; float dn[4];
#pragma unroll
            for (int u = 0; u < 4; ++u) { const int m = m0 + u * NW; const bf16_t* ur = U + (size_t)m * LDU1 + c12; dn[u] = gDEN[(size_t)m * 4 + hh];
#pragma unroll
                for (int j = 0; j < 3; ++j) { xn[u][j] = *(const u32x2*)(ur + 1792 + 4 * j); xo[u][j] = *(const u32x2*)(ur + 2560 + 4 * j); } }
#pragma unroll
            for (int u = 0; u < 4; ++u) { const int m = m0 + u * NW; const float inv = 1.0f / fmaxf(fabsf(dn[u]), 1.0f);
                float hv[12], og[12]; float ss = 0.f;
#pragma unroll
                for (int j = 0; j < 3; ++j) { hv[4 * j] = bflo(xn[u][j].x) * inv; hv[4 * j + 1] = bfhi(xn[u][j].x) * inv; hv[4 * j + 2] = bflo(xn[u][j].y) * inv; hv[4 * j + 3] = bfhi(xn[u][j].y) * inv;
                    og[4 * j] = bflo(xo[u][j].x); og[4 * j + 1] = bfhi(xo[u][j].x); og[4 * j + 2] = bflo(xo[u][j].y); og[4 * j + 3] = bfhi(xo[u][j].y); }
#pragma unroll
                for (int e = 0; e < 12; ++e) ss = fmaf(hv[e], hv[e], ss);
                const float rs = 1.0f / sqrtf(row_sum16(ss) * (1.f / 192.f) + RMS_EPS);
                bf16_t* yo = YC + (size_t)m * DM + 256 + c12;
#pragma unroll
                for (int j = 0; j < 3; ++j) { u32x2 w; w.x = pk2(hv[4 * j] * rs * nw[j][0] * sigmoidf_(og[4 * j]), hv[4 * j + 1] * rs * nw[j][1] * sigmoidf_(og[4 * j + 1]));
                    w.y = pk2(hv[4 * j + 2] * rs * nw[j][2] * sigmoidf_(og[4 * j + 2]), hv[4 * j + 3] * rs * nw[j][3] * sigmoidf_(og[4 * j + 3])); *(u32x2*)(yo + 4 * j) = w; } }
        }
    }
    GSYNC();
    STAMP(12);

    { pg8::Gemm g{YC, (const bf16_t*)(p.ws + WS_OUT1), DM, DM, M, DM, DM}; pg8::StaticOrder S; S.init(M, DM, G, bid);
      pg8::EpiResidual<false, true> E{nullptr, XB, XB, SS3}; pg8::gemm_phase<pg8::EpiResidual<false, true>, pg8::StaticOrder, true, true>(lds, g, S, E); }
    GSYNC();
    STAMP(13);
    { pg8::Gemm g{XB, (const bf16_t*)(p.ws + WS_GU1), DM, DM, M, 2 * FFN, DM}; pg8::StaticOrder S; S.init(M, 2 * FFN, G, bid);
      pg8::EpiSwiGlu E{HID, FFN, SS3}; pg8::gemm_phase<pg8::EpiSwiGlu, pg8::StaticOrder, true, true>(lds, g, S, E); }
    GSYNC();
    STAMP(14);
    { pg8::Gemm g{HID, (const bf16_t*)(p.ws + WS_D1), FFN, FFN, M, DM, FFN}; pg8::StaticOrder S; S.init(M, DM, G, bid);
      pg8::EpiResidual<false, false> E{nullptr, XB, XB, nullptr}; pg8::gemm_phase<pg8::EpiResidual<false, false>, pg8::StaticOrder, true, true>(lds, g, S, E); }
    GSYNC();
    STAMP(15);

    {
        PHASE_IDS
        const f32x4* gg = (const f32x4*)p.in[3] + lane;
        f32x4 gv[4];
#pragma unroll
        for (int j = 0; j < 4; ++j) gv[j] = gg[64 * j];
        for (int row = bid * 8 + wave; row < M; row += G * 32) {
            u32x2 w[4][4];
#pragma unroll
            for (int r = 0; r < 4; ++r)
#pragma unroll
                for (int j = 0; j < 4; ++j) w[r][j] = ((const u32x2*)(XB + (size_t)(row + r * G * 8) * DM))[64 * j + lane];
#pragma unroll
            for (int r = 0; r < 4; ++r) { f32x4 v[4]; float s = 0.f;
#pragma unroll
                for (int j = 0; j < 4; ++j) { v[j] = (f32x4){bflo(w[r][j].x), bfhi(w[r][j].x), bflo(w[r][j].y), bfhi(w[r][j].y)}; s += (v[j][0] * v[j][0] + v[j][1] * v[j][1]) + (v[j][2] * v[j][2] + v[j][3] * v[j][3]); }
                const float rs = 1.0f / sqrtf(wave_sum(s) * (1.f / DM) + RMS_EPS);
                f32x4* xr = (f32x4*)(p.out + (size_t)(row + r * G * 8) * DM) + lane;
#pragma unroll
                for (int j = 0; j < 4; ++j) xr[64 * j] = v[j] * rs * gv[j]; }
        }
    }
    STAMP(16);
#if PROBE
    if (bid == 0 && threadIdx.x == 0) {
        const unsigned long long* ts = (const unsigned long long*)(p.ws + CTL_TS);
        const int order[18] = {0, 1, 2, 3, 17, 4, 5, 6, 7, 8, 9, 10, 11, 12, 13, 14, 15, 16};
        unsigned long long extra = 0;
        for (int j = 0; j < 17; ++j) if ((PROBE_MASK >> j) & 1) extra += __hip_atomic_load(ts + order[j + 1], __ATOMIC_RELAXED, __HIP_MEMORY_SCOPE_AGENT) - __hip_atomic_load(ts + order[j], __ATOMIC_RELAXED, __HIP_MEMORY_SCOPE_AGENT);
#ifdef PROBE_A
        extra += __hip_atomic_load(ts + PROBE_B, __ATOMIC_RELAXED, __HIP_MEMORY_SCOPE_AGENT) - __hip_atomic_load(ts + PROBE_A, __ATOMIC_RELAXED, __HIP_MEMORY_SCOPE_AGENT);
#endif
        const unsigned long long t0 = __builtin_amdgcn_s_memrealtime();
        while (__builtin_amdgcn_s_memrealtime() - t0 < extra) __builtin_amdgcn_s_sleep(8);
    }
#endif
}

extern "C" void kernel_launch(void* const* d_in, const int* in_sizes, int n_in, void* d_out, int out_size, void* d_ws, size_t ws_size, hipStream_t stream) {
    static int ready = 0;
    if (!ready) {
        if (n_in != 39 || out_size != M * DM || ws_size < WS_END) { fprintf(stderr, "kernel_launch: unexpected problem shape (n_in %d out %d ws %zu)\n", n_in, out_size, ws_size); ready = -1; return; }
        if (hipFuncSetAttribute((const void*)mega, hipFuncAttributeMaxDynamicSharedMemorySize, LDS_BYTES) != hipSuccess) { fprintf(stderr, "kernel_launch: hipFuncSetAttribute failed\n"); ready = -1; return; }
        int per_cu = 0; (void)hipOccupancyMaxActiveBlocksPerMultiprocessor(&per_cu, (const void*)mega, 512, LDS_BYTES);
        if (per_cu < 1) fprintf(stderr, "kernel_launch: occupancy query says %d blocks per CU\n", per_cu);
        (void)hipGetLastError();
        ready = 1;
    }
    if (ready < 0) return;
    (void)hipMemsetAsync((char*)d_ws + WS_CTL, 0, CTL_BYTES, stream);
    Params p{};
    for (int i = 0; i < 39; ++i) p.in[i] = (const float*)d_in[i];
    p.out = (float*)d_out; p.ws = (unsigned char*)d_ws;
    void* args[] = {&p};
    hipError_t e = hipLaunchCooperativeKernel((const void*)mega, dim3(256), dim3(512), args, LDS_BYTES, stream);
    if (e != hipSuccess) fprintf(stderr, "kernel_launch: cooperative launch failed: %s\n", hipGetErrorString(e));
}
```

```cpp
#include <hip/hip_runtime.h>
#include <hip/hip_cooperative_groups.h>
#include <cstdio>
#include <cstdint>
#include <cmath>
namespace cg = cooperative_groups;

#define LAS __attribute__((address_space(3)))
typedef unsigned short bf16_t;
typedef short bf16x8 __attribute__((ext_vector_type(8)));
typedef short s16x4 __attribute__((ext_vector_type(4)));
typedef float f32x4 __attribute__((ext_vector_type(4)));
typedef unsigned u32x4 __attribute__((ext_vector_type(4)));
typedef unsigned u32x2 __attribute__((ext_vector_type(2)));

constexpr int SEQ = 4096, BATCH = 8, DM = 1024, M = BATCH * SEQ;
constexpr int EVEN_IN = 3744, LDU0 = 3840, ODD_IN = 3336, NP1 = 3584, LDU1 = 3712, FFN = 2816;
constexpr float RMS_EPS = 1e-6f;

constexpr size_t MiB = 1u << 20;
constexpr size_t WS_CTL = 0, CTL_BYTES = 1 * MiB;
constexpr size_t CTL_SS1 = 128 * 1024, CTL_SS2 = 256 * 1024, CTL_SS3 = 384 * 1024, CTL_SS0 = 512 * 1024;
constexpr size_t CTL_TS = 800 * 1024;
constexpr size_t CTL_LB = 640 * 1024, CTL_LBR = 644 * 1024, CTL_LBI = 648 * 1024, CTL_BBR = 656 * 1024, CTL_BBI = 720 * 1024;
constexpr size_t WS_IN0 = 1 * MiB, WS_OUT0 = WS_IN0 + (size_t)LDU0 * DM * 2, WS_GU0 = WS_OUT0 + 2 * MiB, WS_D0 = WS_GU0 + 11 * MiB;
constexpr size_t WS_IN1 = WS_D0 + (size_t)DM * FFN * 2, WS_OUT1 = WS_IN1 + (size_t)NP1 * DM * 2, WS_GU1 = WS_OUT1 + 2 * MiB, WS_D1 = WS_GU1 + 11 * MiB;
constexpr size_t WS_GLU = WS_D1 + (size_t)DM * FFN * 2;
constexpr size_t WS_LORA = WS_GLU + 256 * 256 * 2;
constexpr size_t WS_XB = 53 * MiB, WS_YC = 117 * MiB, WS_U = 181 * MiB, WS_MS = 421 * MiB, WS_END = 512 * MiB;
constexpr size_t WS_SSQ = WS_MS + 70 * MiB;
static_assert(WS_LORA + 512 * 160 * 2 <= WS_XB, "weights fit");
static_assert(WS_U + (size_t)M * LDU0 * 2 <= WS_MS, "U fits");

__device__ __forceinline__ float bf2f(bf16_t h) { return __uint_as_float(((unsigned)h) << 16); }
__device__ __forceinline__ float bflo(unsigned w) { return __uint_as_float(w << 16); }
__device__ __forceinline__ unsigned long long ss_fix(float s) { return (unsigned long long)(s * 1048576.0f); }
__device__ __forceinline__ float ss_flt(unsigned long long q) { return ((float)(unsigned)(q >> 32) * 4294967296.0f + (float)(unsigned)q) * (1.0f / 1048576.0f); }
__device__ __forceinline__ float bfhi(unsigned w) { return __uint_as_float(w & 0xffff0000u); }
typedef __bf16 bf16x2_t __attribute__((ext_vector_type(2)));
typedef float f32x2c_t __attribute__((ext_vector_type(2)));
__device__ __forceinline__ unsigned pk2(float lo, float hi) { const bf16x2_t v = __builtin_convertvector((f32x2c_t){lo, hi}, bf16x2_t); return __builtin_bit_cast(unsigned, v); }
__device__ __forceinline__ bf16_t f2bf(float f) { const __bf16 b = (__bf16)f; return __builtin_bit_cast(bf16_t, b); }
__device__ __forceinline__ float sigmoidf_(float x) { return __builtin_amdgcn_rcpf(1.f + __expf(-x)); }
__device__ __forceinline__ float rsqrtf_(float x) { return __builtin_amdgcn_rsqf(x); }
__device__ __forceinline__ float siluf_(float x) { return x * sigmoidf_(x); }
__device__ __forceinline__ float softplusf_(float x) { return fmaxf(x, 0.f) + __logf(1.f + __expf(-fabsf(x))); }
__device__ __forceinline__ float tanhf_(float x) { const float e = __expf(-2.f * fabsf(x)); const float t = (1.f - e) * __builtin_amdgcn_rcpf(1.f + e); return x < 0.f ? -t : t; }
template <int CTRL> __device__ __forceinline__ float dpp_mov(float x) { return __int_as_float(__builtin_amdgcn_update_dpp(0, __float_as_int(x), CTRL, 0xf, 0xf, true)); }
__device__ __forceinline__ float row_sum16(float v) { v += dpp_mov<0xB1>(v); v += dpp_mov<0x4E>(v); v += dpp_mov<0x141>(v); v += dpp_mov<0x140>(v); return v; }
__device__ __forceinline__ float xrow16(float v) { const auto r = __builtin_amdgcn_permlane16_swap(__float_as_uint(v), __float_as_uint(v), false, false); return __uint_as_float(r[0]) + __uint_as_float(r[1]); }
__device__ __forceinline__ float xrow32(float v) { const auto r = __builtin_amdgcn_permlane32_swap(__float_as_uint(v), __float_as_uint(v), false, false); return __uint_as_float(r[0]) + __uint_as_float(r[1]); }
__device__ __forceinline__ float half_sum(float v) { return xrow16(row_sum16(v)); }
__device__ __forceinline__ float wave_sum(float v) { return xrow32(half_sum(v)); }

typedef float f32x2 __attribute__((ext_vector_type(2)));
__device__ __forceinline__ void half_reduce8(const float (&p)[8], int lane, float& o0, float& o1) {
    const bool b0 = (lane & 1) != 0, b1 = (lane & 2) != 0;
    float r[4];
#pragma unroll
    for (int i = 0; i < 4; ++i) { const float keep = b0 ? p[2 * i + 1] : p[2 * i], send = b0 ? p[2 * i] : p[2 * i + 1]; r[i] = keep + dpp_mov<0xB1>(send); }
    float q0, q1;
    { const float keep = b1 ? r[1] : r[0], send = b1 ? r[0] : r[1]; q0 = keep + dpp_mov<0x4E>(send); }
    { const float keep = b1 ? r[3] : r[2], send = b1 ? r[2] : r[3]; q1 = keep + dpp_mov<0x4E>(send); }
    q0 += dpp_mov<0x124>(q0); q0 += dpp_mov<0x128>(q0);
    q1 += dpp_mov<0x124>(q1); q1 += dpp_mov<0x128>(q1);
    o0 = xrow16(q0); o1 = xrow16(q1);
}

#define LBAR() do { asm volatile("s_waitcnt lgkmcnt(0)" ::: "memory"); __builtin_amdgcn_s_barrier(); asm volatile("" ::: "memory"); } while (0)
namespace pg8 {
constexpr int BM = 256, BK = 64, HALF = 128, HTB = HALF * BK * 2, STAGE_BYTES = 8 * HTB, NXCD = 8, WGM = 8;
__device__ __forceinline__ int lds_byte(int r, int c) { const int st = (r >> 4) * 2 + (c >> 5), rr = r & 15, cc = c & 31, ob = rr * 64 + cc * 2; return st * 1024 + (ob ^ (((ob >> 9) & 1) << 5)); }
__device__ __forceinline__ void stage_rc(int b, int& R, int& C) { const int st = b / 1024, sb = b % 1024, swz = sb ^ (((sb >> 9) & 1) << 5); R = (st >> 1) * 16 + swz / 64; C = (st & 1) * 32 + (swz % 64) / 2; }
__device__ __forceinline__ int perm32(int rho) { const int n = rho >> 4, i = rho & 15; return 8 * (i >> 2) + 4 * n + (i & 3); }
struct Unit { int pm, pn; };
struct Gemm { const bf16_t* A; const bf16_t* Bt; int lda, ldb, M, N, K; };
struct StaticOrder {
    int nM, nN, nwg, G, c;
    __device__ void init(int M_, int N_, int G_, int c_) { nM = M_ / BM; nN = N_ / BM; nwg = nM * nN; G = G_; c = c_; }
    __device__ bool next(int i, Unit& u) const {
        const long L = (long)i * G + c; if (L >= nwg) return false;
        int wgid = (int)L; { const int q = nwg / NXCD, r = nwg % NXCD, xcd = wgid % NXCD, off = wgid / NXCD; wgid = (xcd < r ? xcd * (q + 1) : r * (q + 1) + (xcd - r) * q) + off; }
        const int nig = WGM * nN, gid = wgid / nig, fm = gid * WGM, gsz = (nM - fm) < WGM ? (nM - fm) : WGM;
        u.pm = fm + ((wgid % nig) % gsz); u.pn = (wgid % nig) / gsz; return true;
    }
};

struct EpiScaleBf16 {
    static constexpr bool PERM = true;
    bf16_t* O; int ldc; const unsigned long long* ss;
    __device__ __forceinline__ void operator()(const f32x4 (&acc)[2][2][4][2], const Unit& u, int wr, int wc, int fr, int fq) const {
        const int row0 = u.pm * BM + wr * 64 + fr, col0 = u.pn * BM + wc * 32 + 8 * fq;
#pragma unroll
        for (int ai = 0; ai < 2; ++ai)
#pragma unroll
            for (int m = 0; m < 4; ++m) { const int row = row0 + ai * HALF + m * 16; const float rs = rsqrtf_(ss_flt(ss[row]) * (1.f / DM) + RMS_EPS);
                bf16_t* rowp = O + (size_t)row * ldc + col0;
#pragma unroll
                for (int bj = 0; bj < 2; ++bj) { const f32x4 v0 = acc[ai][bj][m][0] * rs, v1 = acc[ai][bj][m][1] * rs;
                    u32x4 w; w.x = pk2(v0[0], v0[1]); w.y = pk2(v0[2], v0[3]); w.z = pk2(v1[0], v1[1]); w.w = pk2(v1[2], v1[3]);
                    *(u32x4*)(rowp + bj * HALF) = w; } }
    }
};
struct EpiSwiGlu {
    static constexpr bool PERM = true;
    bf16_t* O; int ldc; const unsigned long long* ss;
    __device__ __forceinline__ void operator()(const f32x4 (&acc)[2][2][4][2], const Unit& u, int wr, int wc, int fr, int fq) const {
        const int row0 = u.pm * BM + wr * 64 + fr, col0 = u.pn * HALF + wc * 32 + 8 * fq;
#pragma unroll
        for (int ai = 0; ai < 2; ++ai)
#pragma unroll
            for (int m = 0; m < 4; ++m) { const int row = row0 + ai * HALF + m * 16; const float rs = rsqrtf_(ss_flt(ss[row]) * (1.f / DM) + RMS_EPS);
                f32x4 h[2];
#pragma unroll
                for (int n = 0; n < 2; ++n) { const f32x4 g = acc[ai][0][m][n] * rs, up = acc[ai][1][m][n] * rs;
#pragma unroll
                    for (int e = 0; e < 4; ++e) h[n][e] = siluf_(g[e]) * up[e]; }
                u32x4 w; w.x = pk2(h[0][0], h[0][1]); w.y = pk2(h[0][2], h[0][3]); w.z = pk2(h[1][0], h[1][1]); w.w = pk2(h[1][2], h[1][3]);
                *(u32x4*)(O + (size_t)row * ldc + col0) = w; }
    }
};
template <bool BASE_F32, bool WITH_SS> struct EpiResidual {
    static constexpr bool PERM = true;
    const float* base32; const bf16_t* base16; bf16_t* xb; unsigned long long* ss;
    __device__ __forceinline__ void operator()(const f32x4 (&acc)[2][2][4][2], const Unit& u, int wr, int wc, int fr, int fq) const {
        const int row0 = u.pm * BM + wr * 64 + fr, col0 = u.pn * BM + wc * 32 + 8 * fq;
#pragma unroll
        for (int ai = 0; ai < 2; ++ai)
#pragma unroll
            for (int m = 0; m < 4; ++m) { const int row = row0 + ai * HALF + m * 16; const size_t off = (size_t)row * DM + col0; float s = 0.f;
#pragma unroll
                for (int bj = 0; bj < 2; ++bj) { const size_t o = off + bj * HALF; f32x4 r0, r1;
                    if (BASE_F32) { r0 = *(const f32x4*)(base32 + o); r1 = *(const f32x4*)(base32 + o + 4); }
                    else { const u32x4 rb = *(const u32x4*)(base16 + o); r0 = (f32x4){bflo(rb.x), bfhi(rb.x), bflo(rb.y), bfhi(rb.y)}; r1 = (f32x4){bflo(rb.z), bfhi(rb.z), bflo(rb.w), bfhi(rb.w)}; }
                    const f32x4 v0 = r0 + acc[ai][bj][m][0], v1 = r1 + acc[ai][bj][m][1];
                    u32x4 w; w.x = pk2(v0[0], v0[1]); w.y = pk2(v0[2], v0[3]); w.z = pk2(v1[0], v1[1]); w.w = pk2(v1[2], v1[3]); *(u32x4*)(xb + o) = w;
                    s += ((v0[0] * v0[0] + v0[1] * v0[1]) + (v0[2] * v0[2] + v0[3] * v0[3])) + ((v1[0] * v1[0] + v1[1] * v1[1]) + (v1[2] * v1[2] + v1[3] * v1[3])); }
                if (WITH_SS) { s = xrow32(xrow16(s)); if (fq == 0) atomicAdd(ss + row, ss_fix(s)); } }
    }
};

template <class Epi, class Sched, bool ALIGN_EPI, bool SP2>
__device__ __forceinline__ void gemm_phase(LAS unsigned char* lds, const Gemm g, const Sched& S, const Epi& E) {
    int tid_ = threadIdx.x; asm volatile("" : "+v"(tid_));
    const int tid = tid_, wid = __builtin_amdgcn_readfirstlane(tid >> 6), lane = tid & 63, wr = wid >> 2, wc = wid & 3, fr = lane & 15, fq = lane >> 4;
    const int K = g.K, nt = K / BK;
    unsigned voffA[2], voffB[2];
#pragma unroll
    for (int i = 0; i < 2; ++i) { int R, C; stage_rc(tid * 16 + i * 8192, R, C); const int Rb = Epi::PERM ? ((R & ~31) + perm32(R & 31)) : R;
        voffA[i] = (unsigned)(R * g.lda + C) * 2u; voffB[i] = (unsigned)(Rb * g.ldb + C) * 2u; }
    const size_t kstep = (size_t)(BK * 2);
    const size_t hstepA = (size_t)HALF * g.lda * 2, hstepB = (size_t)HALF * g.ldb * 2;
    const size_t tstepA = 2 * hstepA, tstepB = 2 * hstepB;
    const unsigned ldsw = (unsigned)wid * 1024u;
    const int aoff = lds_byte(wr * 64 + fr, fq * 8), boff = lds_byte(wc * 32 + fr, fq * 8);
#define PG8_SA(b, h) (((b) * 2 + (h)) * HTB)
#define PG8_SB(b, h) ((4 + (b) * 2 + (h)) * HTB)
#define PG8_STAGE(bufoff, gbase, voff) do { _Pragma("unroll") for (int _i = 0; _i < 2; ++_i) \
        __builtin_amdgcn_global_load_lds((const unsigned*)((const char*)(gbase) + (voff)[_i]), (LAS unsigned*)(lds + (bufoff) + ldsw + _i * 8192), 16, 0, 0); } while (0)
#define PG8_LDA(dst, b, h) do { _Pragma("unroll") for (int m = 0; m < 4; ++m) _Pragma("unroll") for (int k = 0; k < 2; ++k) dst[m][k] = *(const LAS bf16x8*)(lds + PG8_SA(b, h) + aoff + m * 2048 + k * 1024); } while (0)
#define PG8_LDB(dst, b, h) do { _Pragma("unroll") for (int n = 0; n < 2; ++n) _Pragma("unroll") for (int k = 0; k < 2; ++k) dst[n][k] = *(const LAS bf16x8*)(lds + PG8_SB(b, h) + boff + n * 2048 + k * 1024); } while (0)
#define PG8_MMA(ai, bj, At, Bt) do { __builtin_amdgcn_s_setprio(1); _Pragma("unroll") for (int m = 0; m < 4; ++m) _Pragma("unroll") for (int n = 0; n < 2; ++n) _Pragma("unroll") for (int k = 0; k < 2; ++k) \
        acc[ai][bj][m][n] = __builtin_amdgcn_mfma_f32_16x16x32_bf16(Bt[n][k], At[m][k], acc[ai][bj][m][n], 0, 0, 0); __builtin_amdgcn_s_setprio(0); } while (0)
#define PG8_WAIT_V(n) asm volatile("s_waitcnt vmcnt(" #n ")" ::: "memory")
#define PG8_WAIT_L(n) asm volatile("s_waitcnt lgkmcnt(" #n ")" ::: "memory")
#define PG8_BAR __builtin_amdgcn_s_barrier()
#define PG8_SCHED __builtin_amdgcn_sched_barrier(0)
    Unit cur, nxt; int ui = 0;
    if (!S.next(0, cur)) return;
    f32x4 acc[2][2][4][2];
#pragma unroll
    for (int a = 0; a < 2; ++a)
#pragma unroll
        for (int b = 0; b < 2; ++b)
#pragma unroll
            for (int m = 0; m < 4; ++m)
#pragma unroll
                for (int n = 0; n < 2; ++n) acc[a][b][m][n] = (f32x4){0.f, 0.f, 0.f, 0.f};
    bf16x8 At[4][2], B0[2][2], B1[2][2];
    const char* cA = (const char*)g.A + (size_t)cur.pm * tstepA; const char* cB = (const char*)g.Bt + (size_t)cur.pn * tstepB;
    if constexpr (SP2) {
        PG8_STAGE(PG8_SB(0, 0), cB, voffB); PG8_STAGE(PG8_SB(0, 1), cB + hstepB, voffB); PG8_STAGE(PG8_SA(0, 0), cA, voffA); PG8_STAGE(PG8_SA(0, 1), cA + hstepA, voffA);
        if (wr == 1) PG8_BAR;
        PG8_WAIT_V(2); PG8_BAR;
        PG8_STAGE(PG8_SB(1, 0), cB + kstep, voffB); PG8_STAGE(PG8_SA(1, 0), cA + kstep, voffA); PG8_STAGE(PG8_SB(1, 1), cB + hstepB + kstep, voffB);
        PG8_WAIT_V(6); PG8_BAR;
    } else {
        PG8_STAGE(PG8_SB(0, 0), cB, voffB); PG8_STAGE(PG8_SA(0, 0), cA, voffA); PG8_STAGE(PG8_SB(0, 1), cB + hstepB, voffB); PG8_STAGE(PG8_SA(0, 1), cA + hstepA, voffA);
        if (wr == 1) PG8_BAR;
        PG8_WAIT_V(4); PG8_BAR;
        PG8_STAGE(PG8_SB(1, 0), cB + kstep, voffB); PG8_STAGE(PG8_SA(1, 0), cA + kstep, voffA); PG8_STAGE(PG8_SB(1, 1), cB + hstepB + kstep, voffB);
        PG8_WAIT_V(6); PG8_BAR;
    }
    for (;;) {
        const bool has_next = S.next(ui + 1, nxt);
        const char* nA = has_next ? (const char*)g.A + (size_t)nxt.pm * tstepA : cA; const char* nB = has_next ? (const char*)g.Bt + (size_t)nxt.pn * tstepB : cB;
        for (int t = 0; t < nt; t += 2) {
            const bool last = (t == nt - 2);
            const char* a1 = cA + (size_t)(t + 1) * kstep;
            const char* a2 = last ? nA : cA + (size_t)(t + 2) * kstep; const char* b2 = last ? nB : cB + (size_t)(t + 2) * kstep;
            const char* a3 = a2 + kstep; const char* b3 = b2 + kstep;
            if constexpr (SP2) {
            PG8_LDB(B0, 0, 0); PG8_LDB(B1, 0, 1); PG8_SCHED; PG8_LDA(At, 0, 0); PG8_STAGE(PG8_SA(1, 1), a1 + hstepA, voffA);
            PG8_WAIT_V(8); PG8_WAIT_L(0); PG8_BAR; PG8_MMA(0, 0, At, B0); PG8_MMA(0, 1, At, B1); PG8_BAR; PG8_SCHED;
            PG8_LDA(At, 0, 1); PG8_STAGE(PG8_SB(0, 0), b2, voffB); PG8_STAGE(PG8_SB(0, 1), b2 + hstepB, voffB); PG8_STAGE(PG8_SA(0, 0), a2, voffA);
            PG8_WAIT_V(8); PG8_WAIT_L(0); PG8_BAR; PG8_MMA(1, 0, At, B0); PG8_MMA(1, 1, At, B1); PG8_BAR; PG8_SCHED;
            PG8_LDB(B0, 1, 0); PG8_LDB(B1, 1, 1); PG8_SCHED; PG8_LDA(At, 1, 0); PG8_STAGE(PG8_SA(0, 1), a2 + hstepA, voffA);
            PG8_WAIT_V(8); PG8_WAIT_L(0); PG8_BAR; PG8_MMA(0, 0, At, B0); PG8_MMA(0, 1, At, B1); PG8_BAR; PG8_SCHED;
            PG8_LDA(At, 1, 1); PG8_STAGE(PG8_SB(1, 0), b3, voffB); PG8_STAGE(PG8_SB(1, 1), b3 + hstepB, voffB); PG8_STAGE(PG8_SA(1, 0), a3, voffA);
            PG8_WAIT_V(8); PG8_WAIT_L(0); PG8_BAR; PG8_MMA(1, 0, At, B0); PG8_MMA(1, 1, At, B1); PG8_BAR; PG8_SCHED;
            } else {
            PG8_LDB(B0, 0, 0); PG8_SCHED; PG8_LDA(At, 0, 0); PG8_STAGE(PG8_SA(1, 1), a1 + hstepA, voffA);
            PG8_WAIT_L(8); PG8_BAR; PG8_WAIT_L(0); PG8_MMA(0, 0, At, B0); PG8_BAR; PG8_SCHED;
            PG8_LDB(B1, 0, 1); PG8_STAGE(PG8_SB(0, 0), b2, voffB);
            PG8_BAR; PG8_WAIT_L(0); PG8_MMA(0, 1, At, B1); PG8_BAR;
            PG8_LDA(At, 0, 1); PG8_STAGE(PG8_SA(0, 0), a2, voffA);
            PG8_BAR; PG8_WAIT_L(0); PG8_MMA(1, 0, At, B0); PG8_BAR; PG8_SCHED;
            PG8_STAGE(PG8_SB(0, 1), b2 + hstepB, voffB);
            PG8_WAIT_V(6); PG8_BAR; PG8_MMA(1, 1, At, B1); PG8_BAR;
            PG8_LDB(B0, 1, 0); PG8_SCHED; PG8_LDA(At, 1, 0); PG8_STAGE(PG8_SA(0, 1), a2 + hstepA, voffA);
            PG8_WAIT_L(8); PG8_BAR; PG8_WAIT_L(0); PG8_MMA(0, 0, At, B0); PG8_BAR; PG8_SCHED;
            PG8_LDB(B1, 1, 1); PG8_STAGE(PG8_SB(1, 0), b3, voffB);
            PG8_BAR; PG8_WAIT_L(0); PG8_MMA(0, 1, At, B1); PG8_BAR;
            PG8_LDA(At, 1, 1); PG8_STAGE(PG8_SA(1, 0), a3, voffA);
            PG8_BAR; PG8_WAIT_L(0); PG8_MMA(1, 0, At, B0); PG8_BAR; PG8_SCHED;
            PG8_STAGE(PG8_SB(1, 1), b3 + hstepB, voffB);
            PG8_WAIT_V(6); PG8_BAR; PG8_MMA(1, 1, At, B1); PG8_BAR;
            }
        }
        if constexpr (ALIGN_EPI) { if (wr == 0) PG8_BAR; }
        E(acc, cur, wr, wc, fr, fq);
        if (!has_next) break;
#pragma unroll
        for (int a = 0; a < 2; ++a)
#pragma unroll
            for (int b = 0; b < 2; ++b)
#pragma unroll
                for (int m = 0; m < 4; ++m)
#pragma unroll
                    for (int n = 0; n < 2; ++n) acc[a][b][m][n] = (f32x4){0.f, 0.f, 0.f, 0.f};
        cur = nxt; cA = nA; cB = nB; ++ui;
        if constexpr (ALIGN_EPI) { if (wr == 1) PG8_BAR; }
    }
    PG8_WAIT_V(0);
    if constexpr (!ALIGN_EPI) { if (wr == 0) PG8_BAR; }
    PG8_BAR;
#undef PG8_SA
#undef PG8_SB
#undef PG8_STAGE
#undef PG8_LDA
#undef PG8_LDB
#undef PG8_MMA
#undef PG8_WAIT_V
#undef PG8_WAIT_L
#undef PG8_BAR
#undef PG8_SCHED
}
}

#define XB_TMO      128
#define XB_XCNT(j)  (256  + 64 * (j))
#define XB_XSUB(j)  (1280 + 64 * (j))
#define XB_XGEN(j)  (2304 + 64 * (j))
#define XB_TOP      3328
#define XB_TOPGEN   3392
#define XCD_BAR_WORDS 3456
#define XB_SPIN_CAP (1u << 18)
__device__ __forceinline__ unsigned xb_ld(unsigned* p)              { return __hip_atomic_load(p, __ATOMIC_RELAXED, __HIP_MEMORY_SCOPE_AGENT); }
__device__ __forceinline__ unsigned xb_add(unsigned* p, unsigned v) { return __hip_atomic_fetch_add(p, v, __ATOMIC_RELAXED, __HIP_MEMORY_SCOPE_AGENT); }
__device__ __forceinline__ unsigned xb_xcc_id() { return (unsigned)__builtin_amdgcn_s_getreg((3 << 11) | 20) & 0xFu; }
#define XB_SPIN(cond, bar) do { unsigned _sp = 0; while (cond) { __builtin_amdgcn_s_sleep(1); \
    if ((++_sp & 255u) == 0u) { if (xb_ld(&(bar)[XB_TMO])) break; if (_sp > XB_SPIN_CAP) { atomicAdd(&(bar)[XB_TMO], 1u); break; } } } } while (0)
struct XcdBarrier { unsigned* bar; unsigned x; volatile LAS unsigned* st; };
__device__ __forceinline__ XcdBarrier xcd_barrier_post(unsigned* bar, volatile LAS unsigned* st) {
    XcdBarrier b; b.bar = bar; b.x = xb_xcc_id(); b.st = st;
    if (threadIdx.x == 0) (void)xb_add(&bar[XB_XCNT(b.x)], 1u);
    return b;
}
__device__ __forceinline__ void xcd_barrier_complete(unsigned* bar, unsigned x, unsigned& nloc, unsigned& nx) {
    const unsigned G = gridDim.x * gridDim.y * gridDim.z;
    unsigned sum, cnt, mine, sp = 0u;
    for (;;) {
        sum = 0u; cnt = 0u; mine = 0u;
#pragma unroll
        for (unsigned j = 0; j < 16; ++j) { const unsigned c = xb_ld(&bar[XB_XCNT(j)]); sum += c; cnt += (c > 0u) ? 1u : 0u; mine = (j == x) ? c : mine; }
        if (sum == G) break;
        __builtin_amdgcn_s_sleep(1);
        if ((++sp & 255u) == 0u) { if (xb_ld(&bar[XB_TMO])) break; if (sp > XB_SPIN_CAP) { atomicAdd(&bar[XB_TMO], 1u); break; } }
    }
    nloc = mine > 0u ? mine : 1u; nx = cnt > 0u ? cnt : 1u;
}
__device__ __forceinline__ void xcd_barrier(const XcdBarrier& b, const int tid0) {
    asm volatile("s_waitcnt vmcnt(0)" ::: "memory");
    __syncthreads();
    if (tid0 == 0) {
        unsigned* bar = b.bar;
        __builtin_amdgcn_s_waitcnt(0);
        unsigned nloc = b.st[0], nx = b.st[1];
        if (nloc == 0u) { xcd_barrier_complete(bar, b.x, nloc, nx); b.st[0] = nloc; b.st[1] = nx; }
        const unsigned old = xb_add(&bar[XB_XSUB(b.x)], 1u);
        const unsigned gen = old / nloc;
        if (old + 1u == (gen + 1u) * nloc) {
            __builtin_amdgcn_fence(__ATOMIC_RELEASE, "agent");
            asm volatile("s_waitcnt vmcnt(0)" ::: "memory");
            const unsigned og = xb_add(&bar[XB_TOP], 1u);
            const unsigned tg = og / nx;
            if (og + 1u == (tg + 1u) * nx) xb_add(&bar[XB_TOPGEN], 1u);
            else XB_SPIN(xb_ld(&bar[XB_TOPGEN]) == tg, bar);
            __builtin_amdgcn_fence(__ATOMIC_ACQUIRE, "agent");
            xb_add(&bar[XB_XGEN(b.x)], 1u);
            asm volatile("s_waitcnt vmcnt(0)" ::: "memory");
        } else {
            XB_SPIN(xb_ld(&bar[XB_XGEN(b.x)]) == gen, bar);
            __builtin_amdgcn_fence(__ATOMIC_ACQUIRE, "agent");
            asm volatile("s_waitcnt vmcnt(0)" ::: "memory");
        }
    }
    __syncthreads();
}

constexpr int LDS_BYTES = 147456;
struct Params { const float* in[39]; float* out; unsigned char* ws; };

struct TrTile { const float* W; const float* gain; bf16_t* dst; int N, Npad, ldb, mode, k0, n0; };
__device__ __forceinline__ void tr_load(const TrTile& t, int tid, f32x4 (&v)[8], float (&gv)[8]) {
    const float* gp = t.gain ? t.gain : t.W;
#pragma unroll
    for (int i = 0; i < 8; ++i) { const int pp = tid + 512 * i, kk = pp >> 6, n = t.n0 + (pp & 63) * 4; const bool inb = n + 3 < t.N;
        v[i] = *(const f32x4*)(t.W + (size_t)(t.k0 + kk) * t.N + (inb ? n : 0)); gv[i] = gp[t.k0 + kk]; }
}
__device__ __forceinline__ void tr_to_lds(const TrTile& t, int tid, const f32x4 (&v)[8], const float (&gv)[8], LAS unsigned char* l) {
#pragma unroll
    for (int i = 0; i < 8; ++i) { const int pp = tid + 512 * i, kk = pp >> 6, n4 = (pp & 63) * 4; const bool inb = t.n0 + n4 + 3 < t.N;
        const float g = t.gain ? gv[i] : 1.f; const f32x4 x = inb ? v[i] * g : (f32x4){0.f, 0.f, 0.f, 0.f};
        u32x2 w; w.x = pk2(x[0], x[1]); w.y = pk2(x[2], x[3]); *(LAS u32x2*)(l + kk * 528 + n4 * 2) = w; }
}
__device__ __forceinline__ void tr_store(const TrTile& t, int tid, const LAS unsigned char* l) {
#pragma unroll
    for (int i = 0; i < 4; ++i) { const int pp = tid + 512 * i, n = pp >> 3, c = pp & 7; const int jn = t.n0 + n;
        if (jn < t.Npad) { const LAS bf16_t* s = (const LAS bf16_t*)(l + (8 * c) * 528) + n;
            const int drow = t.mode == 0 ? jn : ((jn >> 7) * 256 + (jn & 127) + (t.mode == 2 ? 128 : 0));
            u32x4 o; o.x = (unsigned)s[0] | ((unsigned)s[264] << 16); o.y = (unsigned)s[2 * 264] | ((unsigned)s[3 * 264] << 16); o.z = (unsigned)s[4 * 264] | ((unsigned)s[5 * 264] << 16); o.w = (unsigned)s[6 * 264] | ((unsigned)s[7 * 264] << 16);
            *(u32x4*)(t.dst + (size_t)drow * t.ldb + t.k0 + 8 * c) = o; } }
}

__global__ void __launch_bounds__(512, 2) mega(Params p) {
    extern __shared__ __attribute__((aligned(16))) unsigned char lds_raw[];
    LAS unsigned char* lds = (LAS unsigned char*)lds_raw;
    cg::grid_group grid = cg::this_grid();
    const int G = gridDim.x, bid = blockIdx.x;
#define PHASE_IDS int tid_o = threadIdx.x; asm volatile("" : "+v"(tid_o)); const int tid = tid_o, lane = tid & 63, wave = tid >> 6; (void)lane; (void)wave;
#define SS0 ((unsigned long long*)(p.ws + WS_SSQ))
#define SS1 (SS0 + M)
#define SS2 (SS0 + 2 * M)
#define SS3 (SS0 + 3 * M)
#define LBT ((float*)(p.ws + CTL_LB))
#define LBR ((float*)(p.ws + CTL_LBR))
#define LBI ((float*)(p.ws + CTL_LBI))
#define BBR ((float*)(p.ws + CTL_BBR))
#define BBI ((float*)(p.ws + CTL_BBI))
#define XB ((bf16_t*)(p.ws + WS_XB))
#define YC ((bf16_t*)(p.ws + WS_YC))
#define U ((bf16_t*)(p.ws + WS_U))
    { volatile LAS unsigned* st0 = (volatile LAS unsigned*)(lds + LDS_BYTES - 64); if (threadIdx.x < 16) st0[threadIdx.x] = 0u; }
    __syncthreads();
    (void)xcd_barrier_post((unsigned*)(p.ws + WS_CTL), (volatile LAS unsigned*)(lds + LDS_BYTES - 64));
#ifndef PROBE
#define PROBE 0
#endif
#ifndef PROBE_MASK
#define PROBE_MASK 0
#endif
#define STAMP(k) do { if (PROBE && bid == 0 && threadIdx.x == 0) ((unsigned long long*)(p.ws + CTL_TS))[k] = __builtin_amdgcn_s_memrealtime(); } while (0)
#define STAMP2(k, blk) do { if (PROBE && bid == (blk) && threadIdx.x == 0) ((unsigned long long*)(p.ws + CTL_TS))[k] = __builtin_amdgcn_s_memrealtime(); } while (0)
    STAMP(0);
#define GSYNC() do { XcdBarrier xb_; xb_.bar = (unsigned*)(p.ws + WS_CTL); xb_.x = xb_xcc_id(); xb_.st = (volatile LAS unsigned*)(lds + LDS_BYTES - 64); xcd_barrier(xb_, (int)threadIdx.x); } while (0)

    {
        PHASE_IDS
        constexpr int T_IN0 = 16 * 15, T_SQ = 16 * 4, T_GU = 16 * 11, T_DN = 44 * 4, T_IN1 = 16 * 14, T_GL = 4 * 1;
        constexpr int NT = T_IN0 + T_SQ + 2 * T_GU + T_DN + T_IN1 + T_SQ + 2 * T_GU + T_DN + T_GL;
#define P0_DECODE(T_, it_) { int r = (it_); const float* W; const float* gain; bf16_t* dst; int N, Npad, nNt, ldb, mode; \
            if (r < T_IN0) { W = p.in[4]; gain = p.in[1]; dst = (bf16_t*)(p.ws + WS_IN0); N = EVEN_IN; Npad = LDU0; nNt = 15; ldb = DM; mode = 0; } \
            else if ((r -= T_IN0) < T_SQ) { W = p.in[5]; gain = nullptr; dst = (bf16_t*)(p.ws + WS_OUT0); N = DM; Npad = DM; nNt = 4; ldb = DM; mode = 0; } \
            else if ((r -= T_SQ) < T_GU) { W = p.in[36]; gain = p.in[2]; dst = (bf16_t*)(p.ws + WS_GU0); N = FFN; Npad = FFN; nNt = 11; ldb = DM; mode = 1; } \
            else if ((r -= T_GU) < T_GU) { W = p.in[37]; gain = p.in[2]; dst = (bf16_t*)(p.ws + WS_GU0); N = FFN; Npad = FFN; nNt = 11; ldb = DM; mode = 2; } \
            else if ((r -= T_GU) < T_DN) { W = p.in[38]; gain = nullptr; dst = (bf16_t*)(p.ws + WS_D0); N = DM; Npad = DM; nNt = 4; ldb = FFN; mode = 0; } \
            else if ((r -= T_DN) < T_IN1) { W = p.in[19]; gain = p.in[1] + DM; dst = (bf16_t*)(p.ws + WS_IN1); N = ODD_IN; Npad = NP1; nNt = 14; ldb = DM; mode = 0; } \
            else if ((r -= T_IN1) < T_SQ) { W = p.in[20]; gain = nullptr; dst = (bf16_t*)(p.ws + WS_OUT1); N = DM; Npad = DM; nNt = 4; ldb = DM; mode = 0; } \
            else if ((r -= T_SQ) < T_GU) { W = p.in[36] + (size_t)DM * FFN; gain = p.in[2] + DM; dst = (bf16_t*)(p.ws + WS_GU1); N = FFN; Npad = FFN; nNt = 11; ldb = DM; mode = 1; } \
            else if ((r -= T_GU) < T_GU) { W = p.in[37] + (size_t)DM * FFN; gain = p.in[2] + DM; dst = (bf16_t*)(p.ws + WS_GU1); N = FFN; Npad = FFN; nNt = 11; ldb = DM; mode = 2; } \
            else if ((r -= T_GU) < T_DN) { W = p.in[38] + (size_t)FFN * DM; gain = nullptr; dst = (bf16_t*)(p.ws + WS_D1); N = DM; Npad = DM; nNt = 4; ldb = FFN; mode = 0; } \
            else { r -= T_DN; W = p.in[29]; gain = nullptr; dst = (bf16_t*)(p.ws + WS_GLU); N = 256; Npad = 256; nNt = 1; ldb = 256; mode = 0; } \
            T_.W = W; T_.gain = gain; T_.dst = dst; T_.N = N; T_.Npad = Npad; T_.ldb = ldb; T_.mode = mode; T_.k0 = (r / nNt) * 64; T_.n0 = (r % nNt) * 256; }
        if (bid < NT) {
            TrTile cur, nxt; f32x4 tv[8]; float tg[8];
            P0_DECODE(cur, bid); tr_load(cur, tid, tv, tg);
            for (int it = bid; it < NT; it += G) {
                const int itn = (it + G < NT) ? it + G : it; P0_DECODE(nxt, itn);
                __syncthreads();
                tr_to_lds(cur, tid, tv, tg, lds);
                tr_load(nxt, tid, tv, tg);
                __syncthreads();
                tr_store(cur, tid, lds);
                cur = nxt;
            }
        }
#undef P0_DECODE
        const float* x = p.in[0];
        for (int row = bid * 8 + wave; row < M; row += G * 16) {
            const int row2 = row + G * 8; const bool has2 = row2 < M;
            const f32x4* xr = (const f32x4*)(x + (size_t)row * DM) + lane; const f32x4* xr2 = (const f32x4*)(x + (size_t)(has2 ? row2 : row) * DM) + lane; f32x4 v[4], v2[4]; float s = 0.f, s2 = 0.f;
#pragma unroll
            for (int j = 0; j < 4; ++j) { v[j] = xr[64 * j]; v2[j] = xr2[64 * j]; }
#pragma unroll
            for (int j = 0; j < 4; ++j) { s += (v[j][0] * v[j][0] + v[j][1] * v[j][1]) + (v[j][2] * v[j][2] + v[j][3] * v[j][3]); s2 += (v2[j][0] * v2[j][0] + v2[j][1] * v2[j][1]) + (v2[j][2] * v2[j][2] + v2[j][3] * v2[j][3]); }
            s = wave_sum(s); s2 = wave_sum(s2); if (lane == 0) { SS0[row] = ss_fix(s); if (has2) SS0[row2] = ss_fix(s2); }
            u32x2* o = (u32x2*)(XB + (size_t)row * DM) + lane; u32x2* o2 = (u32x2*)(XB + (size_t)row2 * DM) + lane;
#pragma unroll
            for (int j = 0; j < 4; ++j) { u32x2 w; w.x = pk2(v[j][0], v[j][1]); w.y = pk2(v[j][2], v[j][3]); o[64 * j] = w; if (has2) { u32x2 w2; w2.x = pk2(v2[j][0], v2[j][1]); w2.y = pk2(v2[j][2], v2[j][3]); o2[64 * j] = w2; } }
        }
        for (int i = bid * 512 + tid; i < 3 * M; i += G * 512) SS1[i] = 0ull;
        for (int i = bid * 512 + tid; i < 512 * 160; i += G * 512) { const int c = i / 160, k = i % 160;
            const float v = (k < 32) ? p.in[10][k * 512 + c] : (k < 64) ? p.in[12][(k - 32) * 512 + c] : p.in[13][(k - 64) * 512 + c]; ((bf16_t*)(p.ws + WS_LORA))[i] = f2bf(v); }
        { const int gt = bid * 512 + tid;
          if (gt < 512) { const float* lt = p.in[6]; const float l0 = lt[gt], l1 = lt[512 + gt], l2 = lt[1024 + gt]; const float mx = fmaxf(l0, fmaxf(l1, l2));
              const float e0 = expf(l0 - mx), e1 = expf(l1 - mx), e2 = expf(l2 - mx); LBT[gt] = e0 / (e0 + e1 + e2); }
          const int i = gt - 512;
          if (i >= 0 && i < 16384) { const int gp = i >> 4, h = i & 15, g = gp >> 6; const float step = expf(p.in[23][g]); const float lr = p.in[21][gp], li = p.in[22][gp];
              const float mag = expf(lr * step); const float br = mag * cosf(li * step), bi = mag * sinf(li * step);
              if (h == 0) { LBR[gp] = br; LBI[gp] = bi; }
              const float den = lr * lr + li * li, nr = br - 1.f, ni = bi; const float cr = (nr * lr + ni * li) / den, ci = (ni * lr - nr * li) / den;
              const float xr2 = p.in[24][gp * 16 + h], xi2 = p.in[25][gp * 16 + h]; BBR[gp * 16 + h] = cr * xr2 - ci * xi2; BBI[gp * 16 + h] = cr * xi2 + ci * xr2; } }
    }
    grid.sync();
    STAMP(1);

    { pg8::Gemm g{XB, (const bf16_t*)(p.ws + WS_IN0), DM, DM, M, LDU0, DM}; pg8::StaticOrder S; S.init(M, LDU0, G, bid);
      pg8::EpiScaleBf16 E{U, LDU0, SS0}; pg8::gemm_phase<pg8::EpiScaleBf16, pg8::StaticOrder, true, true>(lds, g, S, E); }
    GSYNC();
    STAMP(2);

#define Rt ((bf16_t*)p.out)
#define At (Rt + (size_t)M * 512)
#define Bh (Rt + (size_t)M * 1024)
#define Kh (Rt + (size_t)M * 1536)
#define Vv XB
#define BVG (XB + (size_t)M * 512)
#define Gg ((bf16_t*)(p.ws + WS_MS))
#define GLc ((float*)(p.ws + WS_MS + 32 * MiB))
#define HEM ((float*)(p.ws + WS_MS + 64 * MiB))
#define HEL ((float*)(p.ws + WS_MS + 65 * MiB))
#define HELM ((float*)(p.ws + WS_MS + 66 * MiB))

    {
        PHASE_IDS
        const int hd = __builtin_amdgcn_readfirstlane(tid >> 6), fr = lane & 15, fq = lane >> 4;
        constexpr int SLS = 336;
        const bf16_t* LT = (const bf16_t*)(p.ws + WS_LORA);
        float mu_r[4], mu_k[4], mu_v[4], w0c[4], a0c[4], kkc[4], kac[4], rkc[4];
#pragma unroll
        for (int nt = 0; nt < 4; ++nt) { const int c = hd * 64 + 4 * fr + nt; mu_r[nt] = p.in[8][c]; mu_k[nt] = p.in[8][512 + c]; mu_v[nt] = p.in[8][1024 + c];
            w0c[nt] = p.in[9][c]; a0c[nt] = p.in[11][c]; kkc[nt] = p.in[14][c]; kac[nt] = p.in[15][c]; rkc[nt] = p.in[16][c]; }
        bf16_t sa_c[5], sa_p[5];
        const unsigned char* zsrc = p.ws + WS_CTL + 128 * 1024;
#define P2_FETCH(cidx_, RAWn_) { const int m0_ = (cidx_) * 16; const bool sq_ = (m0_ & (SEQ - 1)) == 0; \
            _Pragma("unroll") for (int i_ = 0; i_ < 5; ++i_) { const int id_ = tid + 512 * i_, t_ = id_ / 160, j_ = id_ % 160; const bf16_t* ur_ = U + (size_t)(m0_ + t_) * LDU0 + 3584 + j_; sa_c[i_] = ur_[0]; sa_p[i_] = ur_[-LDU0]; } \
            _Pragma("unroll") for (int i_ = 0; i_ < 7; ++i_) { const int q_ = hd + 8 * i_; if (q_ < 51) { const int row_ = q_ / 3, th_ = q_ % 3; \
                const unsigned char* g_ = (row_ == 0 && sq_) ? zsrc + th_ * 1024 + lane * 16 : (const unsigned char*)(U + ((size_t)m0_ + row_) * LDU0 - LDU0 + 2048 + th_ * 512 + lane * 8); \
                __builtin_amdgcn_global_load_lds((const unsigned*)g_, (LAS unsigned*)((RAWn_) + row_ * 3088 + th_ * 1024), 16, 0, 0); } } }
        P2_FETCH(bid, lds + 12288);
        int it = 0;
        for (int cidx = bid; cidx < M / 16; cidx += G, ++it) {
            const int m0 = cidx * 16; const bool seq0 = (m0 & (SEQ - 1)) == 0;
            LAS unsigned char* SL = lds + (it & 1) * (16 * SLS);
            LAS unsigned char* RAW = lds + 12288 + (it & 1) * 52496;
#pragma unroll
            for (int i = 0; i < 5; ++i) { const int id = tid + 512 * i, t = id / 160, j = id % 160;
                const float cur = bf2f(sa_c[i]); const float prev = (t == 0 && seq0) ? 0.f : bf2f(sa_p[i]); const float v = cur + (prev - cur) * p.in[8][1536 + j];
                *(LAS bf16_t*)(SL + t * SLS + j * 2) = f2bf((j < 32) ? tanhf_(v) : (j < 64 ? v : sigmoidf_(v))); }
            asm volatile("s_waitcnt vmcnt(0)" ::: "memory");
            __syncthreads();
            f32x4 dw[4], da[4], dg[4];
            { bf16x8 sf[5];
#pragma unroll
              for (int kk = 0; kk < 5; ++kk) sf[kk] = *(const LAS bf16x8*)(SL + fr * SLS + (kk * 32 + 8 * fq) * 2);
              const f32x4 z4 = {0.f, 0.f, 0.f, 0.f};
#pragma unroll
              for (int nt = 0; nt < 4; ++nt) { const bf16_t* lr = LT + (size_t)(hd * 64 + 4 * fr + nt) * 160 + 8 * fq;
                  const bf16x8 wf = *(const bf16x8*)lr, af = *(const bf16x8*)(lr + 32), g0 = *(const bf16x8*)(lr + 64), g1 = *(const bf16x8*)(lr + 96), g2 = *(const bf16x8*)(lr + 128);
                  dw[nt] = __builtin_amdgcn_mfma_f32_16x16x32_bf16(sf[0], wf, z4, 0, 0, 0); da[nt] = __builtin_amdgcn_mfma_f32_16x16x32_bf16(sf[1], af, z4, 0, 0, 0);
                  f32x4 g = __builtin_amdgcn_mfma_f32_16x16x32_bf16(sf[2], g0, z4, 0, 0, 0); g = __builtin_amdgcn_mfma_f32_16x16x32_bf16(sf[3], g1, g, 0, 0, 0); dg[nt] = __builtin_amdgcn_mfma_f32_16x16x32_bf16(sf[4], g2, g, 0, 0, 0); } }
            { const int cn = (cidx + G < M / 16) ? cidx + G : cidx; P2_FETCH(cn, lds + 12288 + ((it + 1) & 1) * 52496); }
            float as_[4][4], wd_[4][4];
            float ssq[4] = {0.f, 0.f, 0.f, 0.f}, bon[4] = {0.f, 0.f, 0.f, 0.f};
#pragma unroll
            for (int nt = 0; nt < 4; ++nt)
#pragma unroll
                for (int r = 0; r < 4; ++r) { const LAS bf16_t* rw = (const LAS bf16_t*)(RAW + (4 * fq + r) * 3088) + hd * 64 + 4 * fr + nt;
                    const float c0 = bf2f(rw[1544]), c1 = bf2f(rw[1544 + 512]);
                    const float p0 = bf2f(rw[0]), p1 = bf2f(rw[512]);
                    const float rv = c0 + (p0 - c0) * mu_r[nt], kv = c1 + (p1 - c1) * mu_k[nt];
                    const float wlog = -softplusf_(-(w0c[nt] + dw[nt][r])) - 0.5f;
                    wd_[nt][r] = __expf(-__expf(wlog));
                    const float a = sigmoidf_(a0c[nt] + da[nt][r]); as_[nt][r] = a;
                    const float kkv = kv * kkc[nt]; ssq[r] = fmaf(kkv, kkv, ssq[r]);
                    bon[r] = fmaf(rv * kv * (1.f + (a - 1.f) * kac[nt]), rkc[nt], bon[r]); }
#pragma unroll
            for (int r = 0; r < 4; ++r) { ssq[r] = 1.0f / fmaxf(sqrtf(row_sum16(ssq[r])), 1e-12f); bon[r] = row_sum16(bon[r]); }
            float gam[4][5];
#pragma unroll
            for (int nt = 0; nt < 4; ++nt) {
                const float q1 = wd_[nt][0], q2 = q1 * wd_[nt][1], q3 = q2 * wd_[nt][2], q4 = q3 * wd_[nt][3];
                const float t0 = __shfl(q4, fr), t1 = __shfl(q4, fr + 16), t2 = __shfl(q4, fr + 32);
                const float pre = (fq == 0) ? 1.f : (fq == 1) ? t0 : (fq == 2) ? t0 * t1 : t0 * t1 * t2;
                gam[nt][0] = pre; gam[nt][1] = pre * q1; gam[nt][2] = pre * q2; gam[nt][3] = pre * q3; gam[nt][4] = pre * q4; }
#pragma unroll
            for (int r = 0; r < 4; ++r) { const size_t o = (size_t)(m0 + 4 * fq + r) * 512 + hd * 64 + 4 * fr; const LAS bf16_t* rw = (const LAS bf16_t*)(RAW + (4 * fq + r) * 3088) + hd * 64 + 4 * fr;
                float oa[4], orr[4], ob[4], okk[4], ov[4], og[4], obv[4];
#pragma unroll
                for (int nt = 0; nt < 4; ++nt) {
                    const float c0 = bf2f(rw[1544 + nt]), c1 = bf2f(rw[1544 + 512 + nt]), c2 = bf2f(rw[1544 + 1024 + nt]);
                    const float p0 = bf2f(rw[nt]), p1 = bf2f(rw[512 + nt]), p2 = bf2f(rw[1024 + nt]);
                    const float rv = c0 + (p0 - c0) * mu_r[nt], kv = c1 + (p1 - c1) * mu_k[nt], vv = c2 + (p2 - c2) * mu_v[nt];
                    const float a = as_[nt][r], kk = kv * kkc[nt] * ssq[r], kp = kv * (1.f + (a - 1.f) * kac[nt]), ig = __builtin_amdgcn_rcpf(gam[nt][r + 1]), g = dg[nt][r];
                    oa[nt] = -kk * gam[nt][r]; orr[nt] = rv * gam[nt][r + 1]; ob[nt] = kk * a * ig; okk[nt] = kp * ig; ov[nt] = vv; og[nt] = g; obv[nt] = bon[r] * vv * g; }
                u32x2 w;
                w.x = pk2(oa[0], oa[1]); w.y = pk2(oa[2], oa[3]); *(u32x2*)(At + o) = w;
                w.x = pk2(orr[0], orr[1]); w.y = pk2(orr[2], orr[3]); *(u32x2*)(Rt + o) = w;
                w.x = pk2(ob[0], ob[1]); w.y = pk2(ob[2], ob[3]); *(u32x2*)(Bh + o) = w;
                w.x = pk2(okk[0], okk[1]); w.y = pk2(okk[2], okk[3]); *(u32x2*)(Kh + o) = w;
                w.x = pk2(ov[0], ov[1]); w.y = pk2(ov[2], ov[3]); *(u32x2*)(Vv + o) = w;
                w.x = pk2(og[0], og[1]); w.y = pk2(og[2], og[3]); *(u32x2*)(Gg + o) = w;
                w.x = pk2(obv[0], obv[1]); w.y = pk2(obv[2], obv[3]); *(u32x2*)(BVG + o) = w; }
            if (fq == 3) *(f32x4*)(GLc + (size_t)cidx * 512 + hd * 64 + 4 * fr) = (f32x4){gam[0][4], gam[1][4], gam[2][4], gam[3][4]};
        }
#undef P2_FETCH
        STAMP2(20, 0);
        {
            constexpr int HS = 272;
            LAS unsigned char* LQ = lds; LAS unsigned char* LF = lds + 64 * HS;
            int prow[2], pc8[2];
#pragma unroll
            for (int i = 0; i < 2; ++i) { const int pp = tid + 512 * i; prow[i] = pp >> 4; pc8[i] = (pp & 15) * 8; }
            u32x4 rq[2], rf[2]; f32x4 lbn[2][2];
#define HP_FETCH(t_) { const int ch_ = (t_) >> 2, hh_ = (t_) & 3; _Pragma("unroll") for (int i_ = 0; i_ < 2; ++i_) { const bf16_t* r_ = U + ((size_t)ch_ * 64 + prow[i_]) * LDU0 + hh_ * 128 + pc8[i_]; rq[i_] = *(const u32x4*)r_; rf[i_] = *(const u32x4*)(r_ + 512); \
                const float* l_ = LBT + hh_ * 128 + (wave + 8 * i_) * 8; lbn[i_][0] = *(const f32x4*)l_; lbn[i_][1] = *(const f32x4*)(l_ + 4); } }
            asm volatile("s_waitcnt vmcnt(0)" ::: "memory");
            __syncthreads();
            HP_FETCH(bid);
            for (int tl = bid; tl < (M / 64) * 4; tl += G) {
                const int ch = tl >> 2, hh = tl & 3;
#pragma unroll
                for (int i = 0; i < 2; ++i) { *(LAS u32x4*)(LQ + prow[i] * HS + pc8[i] * 2) = rq[i]; *(LAS u32x4*)(LF + prow[i] * HS + pc8[i] * 2) = rf[i]; }
                const float lbv[2][8] = {{lbn[0][0][0], lbn[0][0][1], lbn[0][0][2], lbn[0][0][3], lbn[0][1][0], lbn[0][1][1], lbn[0][1][2], lbn[0][1][3]}, {lbn[1][0][0], lbn[1][0][1], lbn[1][0][2], lbn[1][0][3], lbn[1][1][0], lbn[1][1][1], lbn[1][1][2], lbn[1][1][3]}};
                __syncthreads();
                { const int tn = (tl + G < (M / 64) * 4) ? tl + G : tl; HP_FETCH(tn); }
#pragma unroll
                for (int gi = 0; gi < 2; ++gi) { const int cg = wave + 8 * gi, c0 = hh * 128 + cg * 8;
                    LAS u32x4* lq = (LAS u32x4*)(LQ + lane * HS + cg * 16); LAS u32x4* lf = (LAS u32x4*)(LF + lane * HS + cg * 16);
                    const u32x4 wq = *lq, wf = *lf;
                    const unsigned wqa[4] = {wq.x, wq.y, wq.z, wq.w}, wfa[4] = {wf.x, wf.y, wf.z, wf.w};
                    unsigned oq[4], ok[4];
#pragma unroll
                    for (int j = 0; j < 8; ++j) { const float aq = (j & 1) ? bfhi(wqa[j >> 1]) : bflo(wqa[j >> 1]), af = (j & 1) ? bfhi(wfa[j >> 1]) : bflo(wfa[j >> 1]);
                        const float kv = (1.f - lbv[gi][j]) * sigmoidf_(-af);
                        float bs = __logf(1.f - kv);
                        bs += __int_as_float(__builtin_amdgcn_update_dpp(0, __float_as_int(bs), 0x111, 0xf, 0xf, true)); bs += __int_as_float(__builtin_amdgcn_update_dpp(0, __float_as_int(bs), 0x112, 0xf, 0xf, true));
                        bs += __int_as_float(__builtin_amdgcn_update_dpp(0, __float_as_int(bs), 0x114, 0xf, 0xf, true)); bs += __int_as_float(__builtin_amdgcn_update_dpp(0, __float_as_int(bs), 0x118, 0xf, 0xf, true));
                        bs += __int_as_float(__builtin_amdgcn_update_dpp(0, __float_as_int(bs), 0x142, 0xa, 0xf, false)); bs += __int_as_float(__builtin_amdgcn_update_dpp(0, __float_as_int(bs), 0x143, 0xc, 0xf, false));
                        const float bm = __int_as_float(__builtin_amdgcn_readlane(__float_as_int(bs), 31)), bL = __int_as_float(__builtin_amdgcn_readlane(__float_as_int(bs), 63));
                        const float qt = siluf_(aq) * __expf(bs - bm), kt = kv * __expf(bm - bs);
                        if (j & 1) { oq[j >> 1] = pk2(__uint_as_float(oq[j >> 1]), qt); ok[j >> 1] = pk2(__uint_as_float(ok[j >> 1]), kt); } else { oq[j >> 1] = __float_as_uint(qt); ok[j >> 1] = __float_as_uint(kt); }
                        if (lane == 0) { const size_t vo = (size_t)ch * 512 + c0 + j; HEM[vo] = __expf(bm); HEL[vo] = __expf(bL); HELM[vo] = __expf(bL - bm); } }
                    u32x4 w; w.x = oq[0]; w.y = oq[1]; w.z = oq[2]; w.w = oq[3]; *lq = w;
                    w.x = ok[0]; w.y = ok[1]; w.z = ok[2]; w.w = ok[3]; *lf = w; }
                __syncthreads();
#pragma unroll
                for (int i = 0; i < 2; ++i) { bf16_t* r = U + ((size_t)ch * 64 + prow[i]) * LDU0 + hh * 128 + pc8[i];
                    *(u32x4*)r = *(const LAS u32x4*)(LQ + prow[i] * HS + pc8[i] * 2); *(u32x4*)(r + 512) = *(const LAS u32x4*)(LF + prow[i] * HS + pc8[i] * 2); }
            }
#undef HP_FETCH
        }
    }
    GSYNC();
    STAMP(3);

    for (int item = bid; item < 256; item += G) {
        PHASE_IDS
        const int w = __builtin_amdgcn_readfirstlane(tid >> 6), fr = lane & 15, fq = lane >> 4;
        const int grp_ = (item & 7) * 8 + (item >> 5), vt = (item >> 3) & 3, h = grp_ & 7, b = grp_ >> 3;
        constexpr int BUF = 20992, oRt = 0, oAt = 2304, oBh = 4608, oKh = 6912, oBT = 9216, oKT = 14336, oVT = 19456, oGL = 20736;
        constexpr int oMS = 4 * BUF, MSET = 3840, oAf = oMS + 3 * MSET, oTT = oAf + 2 * 1024, oWT = oTT + 2 * 1280, oUT = oWT + 1280, oST = oUT + 1280, LTOT = oST + 2304;
        constexpr int NCH = SEQ / 16;
        LAS unsigned char* L = lds;
        __syncthreads();
        for (int i = tid; i < LTOT / 4; i += 512) ((LAS unsigned*)L)[i] = 0u;
        __syncthreads();
        const size_t tok0 = (size_t)b * SEQ; const size_t colb = (size_t)h * 64;
#define RC_F144(B_, off_, kk_) (*(const LAS bf16x8*)((B_) + (off_) + fr * 144 + ((kk_) * 32 + 8 * fq) * 2))
#define RC_F80(base_, row0_) (*(const LAS bf16x8*)((base_) + ((row0_) + fr) * 80 + (8 * fq) * 2))
        if (w >= 3) {
            const int lt = tid - 192;
            const bf16_t* arr[4] = {Rt, At, Bh, Kh};
            const int q0 = lt, q1 = lt + 320;
            const int kind1 = (q1 < 512) ? 0 : (q1 < 544) ? 1 : (q1 < 560) ? 2 : 3;
            const char* gp0 = (const char*)(arr[q0 >> 7] + (tok0 + ((q0 >> 3) & 15)) * 512 + colb + (q0 & 7) * 8);
            const char* gp1 = kind1 == 0 ? (const char*)(arr[(q1 >> 7) & 3] + (tok0 + ((q1 >> 3) & 15)) * 512 + colb + (q1 & 7) * 8)
                            : kind1 == 1 ? (const char*)(Vv + (tok0 + ((q1 - 512) >> 1)) * 512 + colb + vt * 16 + ((q1 - 512) & 1) * 8)
                            : kind1 == 2 ? (const char*)(GLc + ((size_t)b * NCH) * 512 + colb + (q1 - 544) * 4) : gp0;
            const size_t st1 = (kind1 == 2) ? (size_t)512 * 4 : (size_t)16 * 512 * 2;
            u32x4 d0[2], d1[2], d2[2], d3[2];
#define RP_H(w_, j_) ((bf16_t)(((j_) & 1) ? ((w_) >> 16) : ((w_) & 0xffffu)))
#define RP_FETCH(D_, c_) { const size_t cc_ = (size_t)((c_) < NCH ? (c_) : NCH - 1); D_[0] = *(const u32x4*)(gp0 + cc_ * (size_t)(16 * 512 * 2)); D_[1] = *(const u32x4*)(gp1 + cc_ * st1); }
#define RP_TILE(B_, q_, D_) { const int tl_ = (q_) >> 7, t_ = ((q_) >> 3) & 15, k_ = ((q_) & 7) * 8; const unsigned w4_[4] = {D_.x, D_.y, D_.z, D_.w}; *(LAS u32x4*)((B_) + tl_ * 2304 + t_ * 144 + k_ * 2) = D_; \
                if (tl_ >= 2) { LAS bf16_t* x_ = (LAS bf16_t*)((B_) + (tl_ == 2 ? oBT : oKT) + k_ * 80 + t_ * 2); const int g_ = (q_) & 7; \
                    _Pragma("unroll") for (int j_ = 0; j_ < 8; ++j_) { const int jj_ = (j_ + g_) & 7; const unsigned ww_ = (jj_ >> 1) == 0 ? w4_[0] : (jj_ >> 1) == 1 ? w4_[1] : (jj_ >> 1) == 2 ? w4_[2] : w4_[3]; x_[jj_ * 40] = (bf16_t)(ww_ >> ((jj_ & 1) * 16)); } } }
#define RP_STORE(D_, buf_) { LAS unsigned char* B_ = L + (buf_) * BUF; RP_TILE(B_, q0, D_[0]); \
                if (kind1 == 0) { RP_TILE(B_, q1, D_[1]); } \
                else if (kind1 == 1) { const int vq_ = q1 - 512; const unsigned w4_[4] = {D_[1].x, D_[1].y, D_[1].z, D_[1].w}; LAS bf16_t* x_ = (LAS bf16_t*)(B_ + oVT + ((vq_ & 1) * 8) * 80 + (vq_ >> 1) * 2); _Pragma("unroll") for (int j_ = 0; j_ < 8; ++j_) x_[j_ * 40] = RP_H(w4_[j_ >> 1], j_); } \
                else if (kind1 == 2) *(LAS u32x4*)(B_ + oGL + (q1 - 544) * 16) = D_[1]; }
            RP_FETCH(d0, 0); RP_STORE(d0, 0); RP_FETCH(d0, 1); RP_STORE(d0, 1); RP_FETCH(d0, 2); RP_STORE(d0, 2);
            RP_FETCH(d3, 3); RP_FETCH(d0, 4); RP_FETCH(d1, 5); RP_FETCH(d2, 6);
            LBAR(); LBAR(); LBAR();
            for (int i = 0; i < NCH; i += 4) {
                if (i + 3 < NCH) RP_STORE(d3, (i + 3) & 3);
                RP_FETCH(d3, i + 7);
                LBAR();
                if (i + 4 < NCH) RP_STORE(d0, (i + 4) & 3);
                RP_FETCH(d0, i + 8);
                LBAR();
                if (i + 5 < NCH) RP_STORE(d1, (i + 5) & 3);
                RP_FETCH(d1, i + 9);
                LBAR();
                if (i + 6 < NCH) RP_STORE(d2, (i + 6) & 3);
                RP_FETCH(d2, i + 10);
                LBAR();
            }
#undef RP_TILE
#undef RP_FETCH
#undef RP_H
#undef RP_STORE
        } else if (w == 1) {
            auto amats = [&](int cc) {
                const LAS unsigned char* B_ = L + (cc & 3) * BUF; LAS unsigned char* Ms = L + oMS + (cc % 3) * MSET; LAS unsigned char* Af = L + oAf + (cc & 1) * 1024;
                const bf16x8 a0 = RC_F144(B_, oAt, 0), a1 = RC_F144(B_, oAt, 1), r0 = RC_F144(B_, oRt, 0), r1 = RC_F144(B_, oRt, 1), b0 = RC_F144(B_, oBh, 0), b1 = RC_F144(B_, oBh, 1), k0 = RC_F144(B_, oKh, 0), k1 = RC_F144(B_, oKh, 1);
                const f32x4 z4 = {0.f, 0.f, 0.f, 0.f};
                f32x4 dab = __builtin_amdgcn_mfma_f32_16x16x32_bf16(a0, b0, z4, 0, 0, 0); dab = __builtin_amdgcn_mfma_f32_16x16x32_bf16(a1, b1, dab, 0, 0, 0);
                f32x4 dak = __builtin_amdgcn_mfma_f32_16x16x32_bf16(a0, k0, z4, 0, 0, 0); dak = __builtin_amdgcn_mfma_f32_16x16x32_bf16(a1, k1, dak, 0, 0, 0);
                f32x4 drb = __builtin_amdgcn_mfma_f32_16x16x32_bf16(r0, b0, z4, 0, 0, 0); drb = __builtin_amdgcn_mfma_f32_16x16x32_bf16(r1, b1, drb, 0, 0, 0);
                f32x4 drk = __builtin_amdgcn_mfma_f32_16x16x32_bf16(r0, k0, z4, 0, 0, 0); drk = __builtin_amdgcn_mfma_f32_16x16x32_bf16(r1, k1, drk, 0, 0, 0);
#pragma unroll
                for (int r = 0; r < 4; ++r) { const int t = 4 * fq + r; const bool st = fr < t, le = fr <= t;
                    *(LAS float*)(Af + t * 64 + fr * 4) = st ? dab[r] : 0.f;
                    *(LAS bf16_t*)(Ms + t * 80 + fr * 2) = f2bf(st ? dak[r] : 0.f);
                    *(LAS bf16_t*)(Ms + 1280 + t * 80 + fr * 2) = f2bf(le ? drb[r] : 0.f);
                    *(LAS bf16_t*)(Ms + 2560 + t * 80 + fr * 2) = f2bf(le ? drk[r] : 0.f); } };
            LBAR();
            amats(0);
            LBAR();
            amats(1);
            LBAR();
            for (int i = 0; i < NCH; ++i) { if (i + 2 < NCH) amats(i + 2); LBAR(); }
        } else if (w == 2) {
            auto tinv = [&](int cc) {
                const LAS unsigned char* Af = L + oAf + (cc & 1) * 1024; LAS unsigned char* Tt = L + oTT + (cc & 1) * 1280;
                f32x4 am[16][4];
#pragma unroll
                for (int t = 1; t < 16; ++t)
#pragma unroll
                    for (int sq = 0; sq < 4; ++sq) if (4 * sq < t) am[t][sq] = *(const LAS f32x4*)(Af + t * 64 + sq * 16);
                asm volatile("s_waitcnt lgkmcnt(0)" ::: "memory");
                float x[16];
#pragma unroll
                for (int t = 0; t < 16; ++t) {
                    float acc0 = (t == fr) ? 1.f : 0.f, acc1 = 0.f;
#pragma unroll
                    for (int sq = 0; sq < 4; ++sq) { if (4 * sq < t) {
#pragma unroll
                        for (int e = 0; e < 4; ++e) { const int s = 4 * sq + e; if (s < t) { if (s & 1) acc1 = fmaf(am[t][sq][e], x[s], acc1); else acc0 = fmaf(am[t][sq][e], x[s], acc0); } } } }
                    x[t] = acc0 + acc1; }
                if (fq == 0) {
#pragma unroll
                    for (int t = 0; t < 16; ++t) *(LAS bf16_t*)(Tt + t * 80 + fr * 2) = f2bf(x[t]); } };
            LBAR(); LBAR();
            tinv(0);
            LBAR();
            for (int i = 0; i < NCH; ++i) { if (i + 1 < NCH) tinv(i + 1); LBAR(); }
        } else {
            f32x4 Sacc[4];
#pragma unroll
            for (int kt = 0; kt < 4; ++kt) Sacc[kt] = (f32x4){0.f, 0.f, 0.f, 0.f};
            bf16_t* yg = Vv + tok0 * 512 + colb + vt * 16 + fr;
            LBAR(); LBAR(); LBAR();
            for (int i = 0; i < NCH; ++i) {
                const LAS unsigned char* B_ = L + (i & 3) * BUF; const LAS unsigned char* Ms = L + oMS + (i % 3) * MSET; const LAS unsigned char* Tt = L + oTT + (i & 1) * 1280;
                const bf16x8 a0 = RC_F144(B_, oAt, 0), a1 = RC_F144(B_, oAt, 1), r0 = RC_F144(B_, oRt, 0), r1 = RC_F144(B_, oRt, 1);
                const bf16x8 s0 = *(const LAS bf16x8*)(L + oST + fr * 144 + (8 * fq) * 2), s1 = *(const LAS bf16x8*)(L + oST + fr * 144 + (32 + 8 * fq) * 2);
                const bf16x8 vtf = RC_F80(B_ + oVT, 0), makf = RC_F80(Ms, 0), mrbf = RC_F80(Ms + 1280, 0), mrkf = RC_F80(Ms + 2560, 0), ttf = RC_F80(Tt, 0);
                bf16x8 btf[4], ktf[4]; f32x4 glv[4];
#pragma unroll
                for (int kt = 0; kt < 4; ++kt) { btf[kt] = RC_F80(B_ + oBT, kt * 16); ktf[kt] = RC_F80(B_ + oKT, kt * 16); glv[kt] = *(const LAS f32x4*)(B_ + oGL + (kt * 16 + 4 * fq) * 4); }
                asm volatile("s_waitcnt lgkmcnt(0)" ::: "memory");
                const f32x4 z4 = {0.f, 0.f, 0.f, 0.f};
                f32x4 dw = __builtin_amdgcn_mfma_f32_16x16x32_bf16(a0, s0, z4, 0, 0, 0); dw = __builtin_amdgcn_mfma_f32_16x16x32_bf16(a1, s1, dw, 0, 0, 0);
                dw = __builtin_amdgcn_mfma_f32_16x16x32_bf16(makf, vtf, dw, 0, 0, 0);
                f32x4 dy = __builtin_amdgcn_mfma_f32_16x16x32_bf16(r0, s0, z4, 0, 0, 0); dy = __builtin_amdgcn_mfma_f32_16x16x32_bf16(r1, s1, dy, 0, 0, 0);
                dy = __builtin_amdgcn_mfma_f32_16x16x32_bf16(mrkf, vtf, dy, 0, 0, 0);
                { u32x2 ww; ww.x = pk2(dw[0], dw[1]); ww.y = pk2(dw[2], dw[3]); *(LAS u32x2*)(L + oWT + fr * 80 + (4 * fq) * 2) = ww; }
                f32x4 sk[4];
#pragma unroll
                for (int kt = 0; kt < 4; ++kt) sk[kt] = __builtin_amdgcn_mfma_f32_16x16x32_bf16(ktf[kt], vtf, Sacc[kt], 0, 0, 0);
                f32x4 du = __builtin_amdgcn_mfma_f32_16x16x32_bf16(ttf, RC_F80(L + oWT, 0), z4, 0, 0, 0);
                { u32x2 uw; uw.x = pk2(du[0], du[1]); uw.y = pk2(du[2], du[3]); *(LAS u32x2*)(L + oUT + fr * 80 + (4 * fq) * 2) = uw; }
                const bf16x8 utf = RC_F80(L + oUT, 0);
                dy = __builtin_amdgcn_mfma_f32_16x16x32_bf16(mrbf, utf, dy, 0, 0, 0);
#pragma unroll
                for (int kt = 0; kt < 4; ++kt) {
                    f32x4 sa = __builtin_amdgcn_mfma_f32_16x16x32_bf16(btf[kt], utf, sk[kt], 0, 0, 0);
                    sa = sa * glv[kt]; Sacc[kt] = sa;
                    u32x2 sw; sw.x = pk2(sa[0], sa[1]); sw.y = pk2(sa[2], sa[3]); *(LAS u32x2*)(L + oST + fr * 144 + (kt * 16 + 4 * fq) * 2) = sw; }
                { bf16_t* yo = yg + (size_t)(i * 16 + 4 * fq) * 512; yo[0] = f2bf(dy[0]); yo[512] = f2bf(dy[1]); yo[1024] = f2bf(dy[2]); yo[1536] = f2bf(dy[3]); }
                LBAR();
            }
        }
#undef RC_F144
#undef RC_F80
    }
    STAMP(17);
    for (int item = bid; item < 256; item += G) {
        PHASE_IDS
        const int w = __builtin_amdgcn_readfirstlane(tid >> 6), fr = lane & 15, fq = lane >> 4;
        const int grp_ = (item & 7) * 4 + (item >> 6), vs = (item >> 3) & 7, h = grp_ & 3, b = grp_ >> 2;
        constexpr int QS = 272, TS = 144;
        constexpr int BUFB = 38656, oQ = 0, oK = 17408, oVT = 34816, oV = 37120, oP = 2 * BUFB, oCT = oP + 9216;
        LAS unsigned char* L = lds;
        const size_t tok0 = (size_t)b * SEQ;
        int prow[2], pc8[2];
#pragma unroll
        for (int i = 0; i < 2; ++i) { const int pp = tid + 512 * i; prow[i] = pp >> 4; pc8[i] = (pp & 15) * 8; }
        const int vrow = tid & 63, vpart = (tid >> 6) & 1;
        u32x4 qa[2], ka[2], va = {0u, 0u, 0u, 0u}; float vem = 0.f, vel = 0.f, velm = 0.f;
#define HM_FETCH(c_) { const size_t tb_ = tok0 + (size_t)(c_) * 64; _Pragma("unroll") for (int i_ = 0; i_ < 2; ++i_) { const bf16_t* r_ = U + (tb_ + prow[i_]) * LDU0 + h * 128 + pc8[i_]; qa[i_] = *(const u32x4*)r_; ka[i_] = *(const u32x4*)(r_ + 512); } \
            { va = *(const u32x4*)(U + (tb_ + vrow) * LDU0 + 1024 + h * 128 + vs * 16 + vpart * 8); const size_t vo_ = ((size_t)b * (SEQ / 64) + (c_)) * 512 + h * 128 + (tid & 127); vem = HEM[vo_]; vel = HEL[vo_]; velm = HELM[vo_]; } }
#define HM_H(w_, j_) ((bf16_t)(((j_) & 1) ? ((w_) >> 16) : ((w_) & 0xffffu)))
#define HM_STORE(bo_) { _Pragma("unroll") for (int i_ = 0; i_ < 2; ++i_) { *(LAS u32x4*)(L + (bo_) + oQ + prow[i_] * QS + pc8[i_] * 2) = qa[i_]; *(LAS u32x4*)(L + (bo_) + oK + prow[i_] * QS + pc8[i_] * 2) = ka[i_]; } \
            if (tid < 128) { LAS bf16_t* vt_ = (LAS bf16_t*)(L + (bo_) + oVT + (vpart * 8) * TS + vrow * 2); const unsigned vw4_[4] = {va.x, va.y, va.z, va.w}; \
                _Pragma("unroll") for (int j_ = 0; j_ < 8; ++j_) vt_[j_ * (TS / 2)] = HM_H(vw4_[j_ >> 1], j_); \
                ((LAS float*)(L + (bo_) + oV))[tid] = vem; ((LAS float*)(L + (bo_) + oV))[128 + tid] = vel; ((LAS float*)(L + (bo_) + oV))[256 + tid] = velm; } }
#define HM_FRAG(off_, row_, stride_, kk_) (*(const LAS bf16x8*)(L + (off_) + ((row_) + fr) * (stride_) + ((kk_) * 32 + 8 * fq) * 2))
#define HM_TR4(p_) __builtin_amdgcn_ds_read_tr16_b64_v4i16((LAS s16x4*)(p_))
        __syncthreads();
        for (int i = tid; i < (9216 + 4352) / 4; i += 512) ((LAS unsigned*)(L + oP))[i] = 0u;
        HM_FETCH(0); HM_STORE(0); HM_FETCH(1);
        LBAR();
        f32x4 Cacc = {0.f, 0.f, 0.f, 0.f};
        const int ktoff = oK + ((lane >> 4) * 8 + ((lane >> 2) & 3)) * QS + (w * 16 + (lane & 3) * 4) * 2;
        for (int c = 0; c < SEQ / 64; ++c) {
            const int bo = (c & 1) * BUFB, bn = BUFB - bo;
            { const int k0 = w * 16 + 4 * fq; const LAS float* vEM = (const LAS float*)(L + bo + oV);
              u32x2 cw; cw.x = pk2(Cacc[0] * vEM[k0], Cacc[1] * vEM[k0 + 1]); cw.y = pk2(Cacc[2] * vEM[k0 + 2], Cacc[3] * vEM[k0 + 3]);
              *(LAS u32x2*)(L + oCT + fr * QS + k0 * 2) = cw; }
            { const int sb = w >> 1, tb0 = (w & 1) * 2;
              if (sb <= tb0 + 1) { const bool two = sb <= tb0;
                  bf16x8 kf[4], q0f[4], q1f[4];
#pragma unroll
                  for (int kk = 0; kk < 4; ++kk) { kf[kk] = HM_FRAG(bo + oK, sb * 16, QS, kk); q1f[kk] = HM_FRAG(bo + oQ, tb0 * 16 + 16, QS, kk); }
                  if (two) {
#pragma unroll
                      for (int kk = 0; kk < 4; ++kk) q0f[kk] = HM_FRAG(bo + oQ, tb0 * 16, QS, kk); }
                  f32x4 a0 = {0.f, 0.f, 0.f, 0.f}, a1 = {0.f, 0.f, 0.f, 0.f};
                  if (two) {
#pragma unroll
                      for (int kk = 0; kk < 4; ++kk) { a0 = __builtin_amdgcn_mfma_f32_16x16x32_bf16(kf[kk], q0f[kk], a0, 0, 0, 0); a1 = __builtin_amdgcn_mfma_f32_16x16x32_bf16(kf[kk], q1f[kk], a1, 0, 0, 0); }
                  } else {
#pragma unroll
                      for (int kk = 0; kk < 4; ++kk) a1 = __builtin_amdgcn_mfma_f32_16x16x32_bf16(kf[kk], q1f[kk], a1, 0, 0, 0);
                  }
                  const int s0 = sb * 16 + 4 * fq;
#pragma unroll
                  for (int j = 0; j < 2; ++j) { if (j == 1 || two) { const int t = (tb0 + j) * 16 + fr; const f32x4 a = j ? a1 : a0;
                      u32x2 pw; pw.x = pk2((s0 <= t) ? a[0] : 0.f, (s0 + 1 <= t) ? a[1] : 0.f); pw.y = pk2((s0 + 2 <= t) ? a[2] : 0.f, (s0 + 3 <= t) ? a[3] : 0.f);
                      *(LAS u32x2*)(L + oP + t * TS + s0 * 2) = pw; } } } }
            LBAR();
            if (c + 1 < SEQ / 64) HM_STORE(bn);
            HM_FETCH((c + 2 < SEQ / 64) ? c + 2 : c);
            if (w < 4) { f32x4 d = {0.f, 0.f, 0.f, 0.f};
#pragma unroll
                for (int kk = 0; kk < 2; ++kk) d = __builtin_amdgcn_mfma_f32_16x16x32_bf16(HM_FRAG(oP, w * 16, TS, kk), HM_FRAG(bo + oVT, 0, TS, kk), d, 0, 0, 0);
#pragma unroll
                for (int kk = 0; kk < 4; ++kk) d = __builtin_amdgcn_mfma_f32_16x16x32_bf16(HM_FRAG(bo + oQ, w * 16, QS, kk), HM_FRAG(oCT, 0, QS, kk), d, 0, 0, 0);
                bf16_t* op = U + (tok0 + (size_t)c * 64 + w * 16 + 4 * fq) * LDU0 + 1024 + h * 128 + vs * 16 + fr;
                op[0] = f2bf(d[0]); op[LDU0] = f2bf(d[1]); op[2 * LDU0] = f2bf(d[2]); op[3 * LDU0] = f2bf(d[3]); }
            { f32x4 tmp = {0.f, 0.f, 0.f, 0.f};
              const LAS unsigned char* kt = L + bo + ktoff;
#pragma unroll
              for (int kk = 0; kk < 2; ++kk) { const bf16x8 ktf = __builtin_shufflevector(HM_TR4(kt + kk * 32 * QS), HM_TR4(kt + kk * 32 * QS + 4 * QS), 0, 1, 2, 3, 4, 5, 6, 7);
                  tmp = __builtin_amdgcn_mfma_f32_16x16x32_bf16(ktf, HM_FRAG(bo + oVT, 0, TS, kk), tmp, 0, 0, 0); }
              const int k0 = w * 16 + 4 * fq; const LAS float* vEL = (const LAS float*)(L + bo + oV) + 128; const LAS float* vELM = vEL + 128;
#pragma unroll
              for (int r = 0; r < 4; ++r) Cacc[r] = Cacc[r] * vEL[k0 + r] + tmp[r] * vELM[k0 + r]; }
            LBAR();
        }
#undef HM_TR4
#undef HM_FETCH
#undef HM_STORE
#undef HM_FRAG
#undef HM_H
    }
    GSYNC();
    STAMP(4);

    {
        PHASE_IDS
        const int gw = bid * 8 + wave, NWH = G * 4;
        const int c8 = lane * 8;
        if ((gw & 1) == 0) {
            const f32x4 an0 = *(const f32x4*)(p.in[7] + c8), an1 = *(const f32x4*)(p.in[7] + c8 + 4);
            for (int m0 = gw >> 1; m0 < M; m0 += NWH * 4) {
                u32x4 xo[4], xg[4];
#pragma unroll
                for (int u = 0; u < 4; ++u) { const int m = m0 + u * NWH; const bf16_t* ur = U + (size_t)m * LDU0 + c8; xo[u] = *(const u32x4*)(ur + 1024); xg[u] = *(const u32x4*)(ur + 1536); }
#pragma unroll
                for (int u = 0; u < 4; ++u) { const int m = m0 + u * NWH; {
                    const float o[8] = {bflo(xo[u].x), bfhi(xo[u].x), bflo(xo[u].y), bfhi(xo[u].y), bflo(xo[u].z), bfhi(xo[u].z), bflo(xo[u].w), bfhi(xo[u].w)};
                    const float g[8] = {bflo(xg[u].x), bfhi(xg[u].x), bflo(xg[u].y), bfhi(xg[u].y), bflo(xg[u].z), bfhi(xg[u].z), bflo(xg[u].w), bfhi(xg[u].w)};
                    float ss = 0.f;
#pragma unroll
                    for (int e = 0; e < 8; ++e) ss = fmaf(o[e], o[e], ss);
                    const float rs = 1.0f / sqrtf(row_sum16(ss) * (1.f / 128.f) + RMS_EPS);
                    u32x4 w; w.x = pk2(o[0] * rs * an0[0] * siluf_(g[0]), o[1] * rs * an0[1] * siluf_(g[1])); w.y = pk2(o[2] * rs * an0[2] * siluf_(g[2]), o[3] * rs * an0[3] * siluf_(g[3]));
                    w.z = pk2(o[4] * rs * an1[0] * siluf_(g[4]), o[5] * rs * an1[1] * siluf_(g[5])); w.w = pk2(o[6] * rs * an1[2] * siluf_(g[6]), o[7] * rs * an1[3] * siluf_(g[7]));
                    *(u32x4*)(YC + (size_t)m * DM + c8) = w; } }
            }
        } else {
            const f32x4 lw0 = *(const f32x4*)(p.in[17] + c8), lw1 = *(const f32x4*)(p.in[17] + c8 + 4), lb0 = *(const f32x4*)(p.in[18] + c8), lb1 = *(const f32x4*)(p.in[18] + c8 + 4);
            for (int m0 = gw >> 1; m0 < M; m0 += NWH * 4) {
                u32x4 xy[4], xg[4], xb[4];
#pragma unroll
                for (int u = 0; u < 4; ++u) { const int m = m0 + u * NWH; const size_t i = (size_t)m * 512 + c8; xy[u] = *(const u32x4*)(Vv + i); xg[u] = *(const u32x4*)(Gg + i); xb[u] = *(const u32x4*)(BVG + i); }
#pragma unroll
                for (int u = 0; u < 4; ++u) { const int m = m0 + u * NWH; {
                    const float y[8] = {bflo(xy[u].x), bfhi(xy[u].x), bflo(xy[u].y), bfhi(xy[u].y), bflo(xy[u].z), bfhi(xy[u].z), bflo(xy[u].w), bfhi(xy[u].w)};
                    const float g[8] = {bflo(xg[u].x), bfhi(xg[u].x), bflo(xg[u].y), bfhi(xg[u].y), bflo(xg[u].z), bfhi(xg[u].z), bflo(xg[u].w), bfhi(xg[u].w)};
                    const float bv[8] = {bflo(xb[u].x), bfhi(xb[u].x), bflo(xb[u].y), bfhi(xb[u].y), bflo(xb[u].z), bfhi(xb[u].z), bflo(xb[u].w), bfhi(xb[u].w)};
                    float s1 = 0.f;
#pragma unroll
                    for (int e = 0; e < 8; ++e) s1 += y[e];
                    s1 += dpp_mov<0xB1>(s1); s1 += dpp_mov<0x4E>(s1); s1 += dpp_mov<0x141>(s1);
                    const float mean = s1 * (1.f / 64.f); float s2 = 0.f;
#pragma unroll
                    for (int e = 0; e < 8; ++e) { const float d = y[e] - mean; s2 = fmaf(d, d, s2); }
                    s2 += dpp_mov<0xB1>(s2); s2 += dpp_mov<0x4E>(s2); s2 += dpp_mov<0x141>(s2);
                    const float rs = 1.0f / sqrtf(s2 * (1.f / 64.f) + 64e-5f);
                    float r8[8];
#pragma unroll
                    for (int e = 0; e < 8; ++e) { const float lw = e < 4 ? lw0[e] : lw1[e - 4], lb = e < 4 ? lb0[e] : lb1[e - 4]; r8[e] = ((y[e] - mean) * rs * lw + lb) * g[e] + bv[e]; }
                    u32x4 w; w.x = pk2(r8[0], r8[1]); w.y = pk2(r8[2], r8[3]); w.z = pk2(r8[4], r8[5]); w.w = pk2(r8[6], r8[7]);
                    *(u32x4*)(YC + (size_t)m * DM + 512 + c8) = w; } }
            }
        }
    }
    GSYNC();
    STAMP(5);

    { pg8::Gemm g{YC, (const bf16_t*)(p.ws + WS_OUT0), DM, DM, M, DM, DM}; pg8::StaticOrder S; S.init(M, DM, G, bid);
      pg8::EpiResidual<true, true> E{p.in[0], nullptr, XB, SS1}; pg8::gemm_phase<pg8::EpiResidual<true, true>, pg8::StaticOrder, true, true>(lds, g, S, E); }
    GSYNC();
    STAMP(6);
#define HID U
    { pg8::Gemm g{XB, (const bf16_t*)(p.ws + WS_GU0), DM, DM, M, 2 * FFN, DM}; pg8::StaticOrder S; S.init(M, 2 * FFN, G, bid);
      pg8::EpiSwiGlu E{HID, FFN, SS1}; pg8::gemm_phase<pg8::EpiSwiGlu, pg8::StaticOrder, true, true>(lds, g, S, E); }
    GSYNC();
    STAMP(7);
    { pg8::Gemm g{HID, (const bf16_t*)(p.ws + WS_D0), FFN, FFN, M, DM, FFN}; pg8::StaticOrder S; S.init(M, DM, G, bid);
      pg8::EpiResidual<false, true> E{nullptr, XB, XB, SS2}; pg8::gemm_phase<pg8::EpiResidual<false, true>, pg8::StaticOrder, true, true>(lds, g, S, E); }
    GSYNC();
    STAMP(8);
    { pg8::Gemm g{XB, (const bf16_t*)(p.ws + WS_IN1), DM, DM, M, NP1, DM}; pg8::StaticOrder S; S.init(M, NP1, G, bid);
      pg8::EpiScaleBf16 E{U, LDU1, SS2}; pg8::gemm_phase<pg8::EpiScaleBf16, pg8::StaticOrder, true, true>(lds, g, S, E); }
    GSYNC();
    STAMP(9);

#define Qc ((bf16_t*)(p.ws + WS_YC))
#define Kc ((bf16_t*)(p.ws + WS_MS))
#define gSI ((float*)(p.ws + WS_MS + 48 * MiB))
#define gBI (gSI + (size_t)M * 4)
#define gBT (gSI + (size_t)M * 8)
#define gWL (gSI + (size_t)M * 12)
#define gDP ((float*)(p.ws + WS_MS + 50 * MiB))
#define gDEN ((float*)(p.ws + WS_MS + 51 * MiB))
    {
        PHASE_IDS
        const float* cq = p.in[31]; const float* ck = p.in[32];
        const int gw = bid * 8 + wave, NW = G * 8;
        for (int item = gw; item < (M / 16) * 3; item += NW) {
            const int run = item / 3, m0 = run * 16, c = (item % 3) * 512 + lane * 8; const bool s0 = (m0 & (SEQ - 1)) == 0;
            const bool isk = c >= 768; const int cc = isk ? c - 768 : c; const float* cw = (isk ? ck : cq) + cc; const float sc = isk ? 0.07216878364870322f : 1.f;
            u32x4 x[19];
#pragma unroll
            for (int i = 0; i < 19; ++i) { const int mm = (i < 3 && s0) ? m0 : m0 - 3 + i; x[i] = *(const u32x4*)(U + (size_t)mm * LDU1 + 256 + c); }
            f32x4 w0[4], w1[4];
#pragma unroll
            for (int j = 0; j < 4; ++j) { w0[j] = *(const f32x4*)(cw + j * 768); w1[j] = *(const f32x4*)(cw + j * 768 + 4); }
            if (s0) { const u32x4 z = {0u, 0u, 0u, 0u}; x[0] = z; x[1] = z; x[2] = z; }
            bf16_t* dst = (isk ? Kc : Qc) + (size_t)m0 * 768 + cc;
#pragma unroll
            for (int tk = 0; tk < 16; ++tk) {
                float acc[8];
#pragma unroll
                for (int e = 0; e < 8; ++e) acc[e] = 0.f;
#pragma unroll
                for (int j = 0; j < 4; ++j) { const u32x4 xv = x[tk + j];
                    acc[0] = fmaf(w0[j][0], bflo(xv.x), acc[0]); acc[1] = fmaf(w0[j][1], bfhi(xv.x), acc[1]); acc[2] = fmaf(w0[j][2], bflo(xv.y), acc[2]); acc[3] = fmaf(w0[j][3], bfhi(xv.y), acc[3]);
                    acc[4] = fmaf(w1[j][0], bflo(xv.z), acc[4]); acc[5] = fmaf(w1[j][1], bfhi(xv.z), acc[5]); acc[6] = fmaf(w1[j][2], bflo(xv.w), acc[6]); acc[7] = fmaf(w1[j][3], bfhi(xv.w), acc[7]); }
                u32x4 o; o.x = pk2(siluf_(acc[0]) * sc, siluf_(acc[1]) * sc); o.y = pk2(siluf_(acc[2]) * sc, siluf_(acc[3]) * sc); o.z = pk2(siluf_(acc[4]) * sc, siluf_(acc[5]) * sc); o.w = pk2(siluf_(acc[6]) * sc, siluf_(acc[7]) * sc);
                *(u32x4*)(dst + (size_t)tk * 768) = o; }
        }
        for (int it = gw; it < (M / 64) * 4; it += NW) {
            const int ch = it >> 2, hh = it & 3; const size_t m = (size_t)ch * 64 + lane; const bf16_t* ur = U + m * LDU1;
            const float lf = -softplusf_(-(bf2f(ur[3332 + hh]) + p.in[34][hh]));
            const float li = bf2f(ur[3328 + hh]) + p.in[33][hh];
            float bs = lf;
#pragma unroll
            for (int o = 1; o < 64; o <<= 1) { const float t = __shfl_up(bs, o); if (lane >= o) bs += t; }
            const float bL = __shfl(bs, 63);
            gSI[m * 4 + hh] = __expf(bs); gBI[m * 4 + hh] = li - bs; gBT[m * 4 + hh] = bs; gWL[m * 4 + hh] = __expf(bL - bs + li);
            if (lane == 0) gDP[ch * 4 + hh] = __expf(bL);
        }
    }
    GSYNC();
    STAMP(10);

    if (bid < 192) {
        PHASE_IDS
        const int w = __builtin_amdgcn_readfirstlane(tid >> 6);
        const int grp_ = (bid & 7) * 4 + (bid >> 3) / 6;
        const int vs = (bid >> 3) % 6, h = grp_ & 3, b = grp_ >> 2;
        constexpr int QS = 400, TS = 144;
        constexpr int oQ = 0, oK = 25600, oKT = 51200, oVT = 78848, oVW = 85760, oP = 92672, oCT = 101888, oG = 121088;
        LAS unsigned char* L = lds;
        for (int i = tid; i < 19200 / 4; i += 512) ((LAS unsigned*)(L + oCT))[i] = 0u;
        for (int i = tid; i < 64 * TS / 4; i += 512) ((LAS unsigned*)(L + oP))[i] = 0u;
        for (int i = tid; i < 16 * TS / 4; i += 512) { ((LAS unsigned*)(L + oVT + 32 * TS))[i] = (i < TS / 4) ? 0x3F803F80u : 0u; ((LAS unsigned*)(L + oVW + 32 * TS))[i] = 0u; }
        const size_t tok0 = (size_t)b * SEQ;
        const int fr = lane & 15, fq = lane >> 4;
        u32x4 qa[3], ka[3], va = {0u, 0u, 0u, 0u}; float gsi = 0.f, gbi = 0.f, gbt = 0.f, gwl = 0.f, wlr = 0.f;
        int prow[3], pc8[3];
#pragma unroll
        for (int i = 0; i < 3; ++i) { const int pp = tid + 512 * i; prow[i] = pp / 24; pc8[i] = (pp % 24) * 8; }
        const int vrow = tid & 63, vpart = tid >> 6;
#define MM_FETCH(c_) { const size_t tb_ = tok0 + (size_t)(c_) * 64; _Pragma("unroll") for (int i_ = 0; i_ < 3; ++i_) { const size_t o_ = (tb_ + prow[i_]) * 768 + h * 192 + pc8[i_]; qa[i_] = *(const u32x4*)(Qc + o_); ka[i_] = *(const u32x4*)(Kc + o_); } \
            { va = *(const u32x4*)(U + (tb_ + vrow) * LDU1 + 1792 + h * 192 + vs * 32 + (vpart & 3) * 8); wlr = gWL[(tb_ + vrow) * 4 + h]; } \
            { const size_t g_ = (tb_ + (tid & 63)) * 4 + h; gsi = gSI[g_]; gbi = gBI[g_]; gbt = gBT[g_]; gwl = gWL[g_]; } }
#define MM_H(w_, j_) ((bf16_t)(((j_) & 1) ? ((w_) >> 16) : ((w_) & 0xffffu)))
#define MM_STORE() { _Pragma("unroll") for (int i_ = 0; i_ < 3; ++i_) { *(LAS u32x4*)(L + oQ + prow[i_] * QS + pc8[i_] * 2) = qa[i_]; *(LAS u32x4*)(L + oK + prow[i_] * QS + pc8[i_] * 2) = ka[i_]; \
            } \
            if (tid < 256) { LAS bf16_t* vt_ = (LAS bf16_t*)(L + oVT + (vpart * 8) * TS + vrow * 2); LAS bf16_t* vw_ = (LAS bf16_t*)(L + oVW + (vpart * 8) * TS + vrow * 2); const unsigned vw4_[4] = {va.x, va.y, va.z, va.w}; \
                _Pragma("unroll") for (int j_ = 0; j_ < 8; ++j_) { const bf16_t e_ = MM_H(vw4_[j_ >> 1], j_); vt_[j_ * (TS / 2)] = e_; vw_[j_ * (TS / 2)] = f2bf(bf2f(e_) * wlr); } } \
            if (tid < 64) { ((LAS bf16_t*)(L + oVW + 32 * TS))[tid] = f2bf(gwl); ((LAS float*)(L + oG))[tid] = gsi; ((LAS float*)(L + oG))[64 + tid] = gbi; ((LAS float*)(L + oG))[128 + tid] = gbt; } }
#define MM_TR4(off_) __builtin_amdgcn_ds_read_tr16_b64_v4i16((LAS s16x4*)(ktb + (off_)))
#define MM_TRF(off_) __builtin_shufflevector(MM_TR4(off_), MM_TR4((off_) + 4 * QS), 0, 1, 2, 3, 4, 5, 6, 7)
#define MM_FRAG(off_, row_, stride_, kk_) (*(const LAS bf16x8*)(L + (off_) + ((row_) + fr) * (stride_) + ((kk_) * 32 + 8 * fq) * 2))
        __syncthreads();
        MM_FETCH(0); MM_STORE();
        LBAR();
        f32x4 Cacc[3][2];
#pragma unroll
        for (int i = 0; i < 3; ++i) { Cacc[i][0] = (f32x4){0.f, 0.f, 0.f, 0.f}; Cacc[i][1] = (f32x4){0.f, 0.f, 0.f, 0.f}; }
        const int nvt = (w < 4) ? 1 : 2, vt0 = (w < 4) ? 0 : 1, db0 = 3 * (w & 3);
        const LAS unsigned char* ktb = L + oK + ((lane >> 4) * 8 + ((lane >> 2) & 3)) * QS + (db0 * 16 + (lane & 3) * 4) * 2;
        const LAS float* gSIl = (const LAS float*)(L + oG); const LAS float* gBIl = gSIl + 64; const LAS float* gBTl = gSIl + 128;
        for (int c = 0; c < SEQ / 64; ++c) {
            int fr_o = lane & 15, fq_o = lane >> 4; asm volatile("" : "+v"(fr_o), "+v"(fq_o));
            const int fr = fr_o, fq = fq_o;
            const float dp = gDP[(b * (SEQ / 64) + c) * 4 + h];
            MM_FETCH((c + 1 < SEQ / 64) ? c + 1 : c);
            { const int sb = w >> 1, tb0 = (w & 1) * 2;
              if (sb <= tb0 + 1) {
              const bool two = sb <= tb0;
              bf16x8 kf[6], q0f[6], q1f[6];
#pragma unroll
              for (int kk = 0; kk < 6; ++kk) { kf[kk] = MM_FRAG(oK, sb * 16, QS, kk); q1f[kk] = MM_FRAG(oQ, tb0 * 16 + 16, QS, kk); }
              if (two) {
#pragma unroll
                  for (int kk = 0; kk < 6; ++kk) q0f[kk] = MM_FRAG(oQ, tb0 * 16, QS, kk); }
              const int s0 = sb * 16 + 4 * fq;
              const float bi0 = gBIl[s0], bi1 = gBIl[s0 + 1], bi2 = gBIl[s0 + 2], bi3 = gBIl[s0 + 3];
              const float bt0 = gBTl[tb0 * 16 + fr], bt1 = gBTl[tb0 * 16 + 16 + fr];
              asm volatile("s_waitcnt lgkmcnt(0)" ::: "memory");
              f32x4 a0 = {0.f, 0.f, 0.f, 0.f}, a1 = {0.f, 0.f, 0.f, 0.f};
              if (two) {
#pragma unroll
                  for (int kk = 0; kk < 6; ++kk) { a0 = __builtin_amdgcn_mfma_f32_16x16x32_bf16(kf[kk], q0f[kk], a0, 0, 0, 0); a1 = __builtin_amdgcn_mfma_f32_16x16x32_bf16(kf[kk], q1f[kk], a1, 0, 0, 0); }
              } else {
#pragma unroll
                  for (int kk = 0; kk < 6; ++kk) a1 = __builtin_amdgcn_mfma_f32_16x16x32_bf16(kf[kk], q1f[kk], a1, 0, 0, 0);
              }
#pragma unroll
              for (int j = 0; j < 2; ++j) { if (j == 1 || two) { const int t = (tb0 + j) * 16 + fr; const float bt = j ? bt1 : bt0; const f32x4 a = j ? a1 : a0;
                  const float p0 = (s0 <= t) ? a[0] * __expf(bt + bi0) : 0.f, p1 = (s0 + 1 <= t) ? a[1] * __expf(bt + bi1) : 0.f, p2 = (s0 + 2 <= t) ? a[2] * __expf(bt + bi2) : 0.f, p3 = (s0 + 3 <= t) ? a[3] * __expf(bt + bi3) : 0.f;
                  u32x2 pw; pw.x = pk2(p0, p1); pw.y = pk2(p2, p3); *(LAS u32x2*)(L + oP + t * TS + s0 * 2) = pw; } } } }
            LBAR();
            { const int tb = w & 3;
              const int n2 = (w < 4) ? 2 : 1;
              bf16x8 qf[6], pf[2], vtf[2][2], ctf[2][6];
#pragma unroll
              for (int kk = 0; kk < 6; ++kk) qf[kk] = MM_FRAG(oQ, tb * 16, QS, kk);
#pragma unroll
              for (int kk = 0; kk < 2; ++kk) pf[kk] = MM_FRAG(oP, tb * 16, TS, kk);
#pragma unroll
              for (int j = 0; j < 2; ++j) { if (j < n2) { const int vt = (w < 4) ? j : 2;
#pragma unroll
                  for (int kk = 0; kk < 2; ++kk) vtf[j][kk] = MM_FRAG(oVT, vt * 16, TS, kk);
#pragma unroll
                  for (int kk = 0; kk < 6; ++kk) ctf[j][kk] = MM_FRAG(oCT, vt * 16, QS, kk); } }
              const int t0r = tb * 16 + 4 * fq;
              const float si0 = gSIl[t0r], si1 = gSIl[t0r + 1], si2 = gSIl[t0r + 2], si3 = gSIl[t0r + 3];
              asm volatile("s_waitcnt lgkmcnt(0)" ::: "memory");
              bf16x8 ktf[3][2], vwf[2][2];
#pragma unroll
              for (int i = 0; i < 3; ++i) { ktf[i][0] = MM_TRF(i * 32); ktf[i][1] = MM_TRF(32 * QS + i * 32); }
#pragma unroll
              for (int j = 0; j < 2; ++j) { if (j < nvt) { vwf[j][0] = MM_FRAG(oVW, (vt0 + j) * 16, TS, 0); vwf[j][1] = MM_FRAG(oVW, (vt0 + j) * 16, TS, 1); } }
#pragma unroll
              for (int j = 0; j < 2; ++j) { if (j < n2) { const int vt = (w < 4) ? j : 2;
                  f32x4 d2 = {0.f, 0.f, 0.f, 0.f}, d3 = {0.f, 0.f, 0.f, 0.f};
#pragma unroll
                  for (int kk = 0; kk < 2; ++kk) d2 = __builtin_amdgcn_mfma_f32_16x16x32_bf16(pf[kk], vtf[j][kk], d2, 0, 0, 0);
#pragma unroll
                  for (int kk = 0; kk < 6; ++kk) d3 = __builtin_amdgcn_mfma_f32_16x16x32_bf16(qf[kk], ctf[j][kk], d3, 0, 0, 0);
                  const float o0 = si0 * d3[0] + d2[0], o1 = si1 * d3[1] + d2[1], o2 = si2 * d3[2] + d2[2], o3 = si3 * d3[3] + d2[3];
                  const size_t tg = tok0 + (size_t)c * 64 + t0r;
                  if (w < 4) { bf16_t* op = U + tg * LDU1 + 1792 + h * 192 + vs * 32 + vt * 16 + fr; op[0] = f2bf(o0); op[LDU1] = f2bf(o1); op[2 * LDU1] = f2bf(o2); op[3 * LDU1] = f2bf(o3); }
                  else if (fr == 0 && vs == 0) { float* dn = gDEN + tg * 4 + h; dn[0] = o0; dn[4] = o1; dn[8] = o2; dn[12] = o3; } } }
              asm volatile("s_waitcnt lgkmcnt(0)" ::: "memory");
#pragma unroll
              for (int i = 0; i < 3; ++i)
#pragma unroll
                  for (int j = 0; j < 2; ++j) { if (j < nvt) { f32x4 ca = Cacc[i][j] * dp;
                      ca = __builtin_amdgcn_mfma_f32_16x16x32_bf16(ktf[i][0], vwf[j][0], ca, 0, 0, 0);
                      ca = __builtin_amdgcn_mfma_f32_16x16x32_bf16(ktf[i][1], vwf[j][1], ca, 0, 0, 0); Cacc[i][j] = ca; } } }
            LBAR();
#pragma unroll
            for (int i = 0; i < 3; ++i)
#pragma unroll
                for (int j = 0; j < 2; ++j) { if (j < nvt) { const f32x4 ca = Cacc[i][j]; u32x2 cw; cw.x = pk2(ca[0], ca[1]); cw.y = pk2(ca[2], ca[3]);
                    *(LAS u32x2*)(L + oCT + ((vt0 + j) * 16 + fr) * QS + ((db0 + i) * 16 + 4 * fq) * 2) = cw; } }
            if (c + 1 < SEQ / 64) MM_STORE();
            LBAR();
        }
        STAMP2(18, 0);
#undef MM_FETCH
#undef MM_STORE
#undef MM_FRAG
#undef MM_TR4
#undef MM_TRF
#undef MM_H
    } else {
        PHASE_IDS
        const int w = __builtin_amdgcn_readfirstlane(tid >> 6), wq = w & 3, myc = w >> 2;
        const int fr = lane & 15, fq = lane >> 4;
        constexpr int US = 80, XS = 272, NB = SEQ / 32;
        constexpr int oU = 0, oW1 = 10240, oX = 20480, oH = 37888, oW2 = 55296, oZ = 59648, CH = 61696;
        LAS unsigned char* Lc = lds + myc * CH;
        __syncthreads();
        for (int i = tid; i < 2 * CH / 4; i += 512) ((LAS unsigned*)lds)[i] = 0u;
        __syncthreads();
        for (int i = tid; i < 2 * 128 * 16; i += 512) { const int cc = i >> 11, n = (i >> 4) & 127, k = i & 15; const int g_ = ((bid - 192) * 2 + cc) & 15;
            const float v = (n < 64) ? BBR[(g_ * 64 + n) * 16 + k] : BBI[(g_ * 64 + n - 64) * 16 + k];
            ((LAS bf16_t*)(lds + cc * CH + oW1 + n * US))[k] = f2bf(v); }
        for (int i = tid; i < 2 * 16 * 128; i += 512) { const int cc = i >> 11, hh = (i >> 7) & 15, k = i & 127; const int g_ = ((bid - 192) * 2 + cc) & 15;
            const float v = (k < 64) ? p.in[26][(g_ * 16 + hh) * 64 + k] : -p.in[27][(g_ * 16 + hh) * 64 + k - 64];
            ((LAS bf16_t*)(lds + cc * CH + oW2 + hh * XS))[k] = f2bf(v); }
        const int chain = (bid - 192) * 2 + myc, g = chain & 15, b = chain >> 4;
        bf16_t* gU = U + ((size_t)b * SEQ + (lane >> 1)) * LDU1 + g * 16 + (lane & 1) * 8;
        __syncthreads();
        if (wq == 3) {
            u32x4 sA, sB;
            const int lo = (lane >> 1) * US + (lane & 1) * 16, zo = (lane >> 1) * 32 + (lane & 1) * 16;
#define S5_LD(i_) (*(const u32x4*)(gU + (size_t)(((i_) < NB ? (i_) : NB - 1) * 32) * LDU1))
            sA = S5_LD(0); *(LAS u32x4*)(Lc + oU + 0 * 2560 + lo) = sA; sB = S5_LD(1); *(LAS u32x4*)(Lc + oU + 1 * 2560 + lo) = sB;
            sA = S5_LD(2); sB = S5_LD(3);
            LBAR(); LBAR();
            for (int it = 0; it < NB + 2; it += 2) {
                if (it + 2 < NB) *(LAS u32x4*)(Lc + oU + ((it + 2) & 3) * 2560 + lo) = sA;
                if (it >= 2) *(u32x4*)(gU + (size_t)((it - 2) * 32) * LDU1) = *(const LAS u32x4*)(Lc + oZ + (it & 1) * 1024 + zo);
                sA = S5_LD(it + 4);
                LBAR();
                if (it + 3 < NB) *(LAS u32x4*)(Lc + oU + ((it + 3) & 3) * 2560 + lo) = sB;
                if (it >= 1 && it - 1 < NB) *(u32x4*)(gU + (size_t)((it - 1) * 32) * LDU1) = *(const LAS u32x4*)(Lc + oZ + ((it + 1) & 1) * 1024 + zo);
                sB = S5_LD(it + 5);
                LBAR();
            }
#undef S5_LD
        } else if (wq == 1) {
            bf16x8 w1f[8];
#pragma unroll
            for (int j = 0; j < 8; ++j) w1f[j] = *(const LAS bf16x8*)(Lc + oW1 + (j * 16 + fr) * US + (8 * fq) * 2);
            auto xblk = [&](int blk) {
                const LAS unsigned char* Ut = Lc + oU + (blk & 3) * 2560; LAS unsigned char* Xt = Lc + oX + (blk & 1) * 8704;
                const bf16x8 u0 = *(const LAS bf16x8*)(Ut + fr * US + (8 * fq) * 2), u1 = *(const LAS bf16x8*)(Ut + (16 + fr) * US + (8 * fq) * 2);
                const f32x4 z4 = {0.f, 0.f, 0.f, 0.f};
#pragma unroll
                for (int j = 0; j < 8; ++j) { const f32x4 d0 = __builtin_amdgcn_mfma_f32_16x16x32_bf16(u0, w1f[j], z4, 0, 0, 0), d1 = __builtin_amdgcn_mfma_f32_16x16x32_bf16(u1, w1f[j], z4, 0, 0, 0);
                    LAS bf16_t* xp = (LAS bf16_t*)(Xt + (4 * fq) * XS) + j * 16 + fr;
#pragma unroll
                    for (int r = 0; r < 4; ++r) { xp[r * (XS / 2)] = f2bf(d0[r]); xp[(16 + r) * (XS / 2)] = f2bf(d1[r]); } } };
            LBAR();
            xblk(0);
            LBAR();
            for (int it = 0; it < NB + 2; ++it) { if (it + 1 < NB) xblk(it + 1); LBAR(); }
        } else if (wq == 0) {
            const float ar = LBR[g * 64 + lane], ai = LBI[g * 64 + lane];
            float hr = 0.f, hi = 0.f;
            LBAR(); LBAR();
            for (int it = 0; it < NB + 2; ++it) {
                if (it < NB) { const LAS bf16_t* xp = (const LAS bf16_t*)(Lc + oX + (it & 1) * 8704) + lane; LAS bf16_t* hp = (LAS bf16_t*)(Lc + oH + (it & 1) * 8704) + lane;
                    for (int t8 = 0; t8 < 32; t8 += 8) {
                        bf16_t xr[8], xi[8], or_[8], oi_[8];
#pragma unroll
                        for (int u = 0; u < 8; ++u) { xr[u] = xp[(t8 + u) * (XS / 2)]; xi[u] = xp[(t8 + u) * (XS / 2) + 64]; }
#pragma unroll
                        for (int u = 0; u < 8; ++u) { const float nr = fmaf(ar, hr, fmaf(-ai, hi, bf2f(xr[u]))), ni = fmaf(ar, hi, fmaf(ai, hr, bf2f(xi[u]))); hr = nr; hi = ni; or_[u] = f2bf(hr); oi_[u] = f2bf(hi); }
#pragma unroll
                        for (int u = 0; u < 8; ++u) { hp[(t8 + u) * (XS / 2)] = or_[u]; hp[(t8 + u) * (XS / 2) + 64] = oi_[u]; } } }
                LBAR();
            }
        } else {
            bf16x8 w2f[4];
#pragma unroll
            for (int kk = 0; kk < 4; ++kk) w2f[kk] = *(const LAS bf16x8*)(Lc + oW2 + fr * XS + (kk * 32 + 8 * fq) * 2);
            const float dsk = p.in[28][g * 16 + fr];
            LBAR(); LBAR();
            for (int it = 0; it < NB + 2; ++it) {
                if (it >= 1 && it - 1 < NB) { const int blk = it - 1; const LAS unsigned char* Ht = Lc + oH + (blk & 1) * 8704; const LAS unsigned char* Ut = Lc + oU + (blk & 3) * 2560; LAS unsigned char* Zt = Lc + oZ + (blk & 1) * 1024;
#pragma unroll
                    for (int tb = 0; tb < 2; ++tb) { f32x4 d = {0.f, 0.f, 0.f, 0.f};
#pragma unroll
                        for (int kk = 0; kk < 4; ++kk) d = __builtin_amdgcn_mfma_f32_16x16x32_bf16(*(const LAS bf16x8*)(Ht + (tb * 16 + fr) * XS + (kk * 32 + 8 * fq) * 2), w2f[kk], d, 0, 0, 0);
#pragma unroll
                        for (int r = 0; r < 4; ++r) { const int t = tb * 16 + 4 * fq + r;
                            const float y = d[r] + dsk * bf2f(*(const LAS bf16_t*)(Ut + t * US + fr * 2));
                            const float z = 0.5f * y * (1.f + tanhf_(0.7978845608028654f * (y + 0.044715f * y * y * y)));
                            *(LAS bf16_t*)(Zt + t * 32 + fr * 2) = f2bf(z); } } }
                LBAR();
            }
        }
        STAMP2(19, 192);
    }
    GSYNC();
    STAMP(11);

    {
        PHASE_IDS
        const int w = __builtin_amdgcn_readfirstlane(tid >> 6), fr = lane & 15, fq = lane >> 4;
        constexpr int ZS = 528;
        const bf16_t* WT = (const bf16_t*)(p.ws + WS_GLU);
        bf16x8 wf[2][8];
#pragma unroll
        for (int nt = 0; nt < 2; ++nt)
#pragma unroll
            for (int kk = 0; kk < 8; ++kk) wf[nt][kk] = *(const bf16x8*)(WT + (size_t)(w * 32 + nt * 16 + fr) * 256 + kk * 32 + 8 * fq);
        f32x4 bias4[2];
#pragma unroll
        for (int nt = 0; nt < 2; ++nt) bias4[nt] = *(const f32x4*)(p.in[30] + w * 32 + nt * 16 + 4 * fq);
        for (int m0 = bid * 64; m0 < M; m0 += G * 64) {
            __syncthreads();
#pragma unroll
            for (int i = 0; i < 4; ++i) { const int pp = tid + 512 * i, row = pp >> 5, c8 = (pp & 31) * 8; *(LAS u32x4*)(lds + row * ZS + c8 * 2) = *(const u32x4*)(U + (size_t)(m0 + row) * LDU1 + c8); }
            __syncthreads();
#pragma unroll
            for (int tb = 0; tb < 4; ++tb) { f32x4 d0 = {0.f, 0.f, 0.f, 0.f}, d1 = {0.f, 0.f, 0.f, 0.f};
#pragma unroll
                for (int kk = 0; kk < 8; ++kk) { const bf16x8 zf = *(const LAS bf16x8*)(lds + (tb * 16 + fr) * ZS + (kk * 32 + 8 * fq) * 2);
                    d0 = __builtin_amdgcn_mfma_f32_16x16x32_bf16(wf[0][kk], zf, d0, 0, 0, 0); d1 = __builtin_amdgcn_mfma_f32_16x16x32_bf16(wf[1][kk], zf, d1, 0, 0, 0); }
                const int t = tb * 16 + fr;
#pragma unroll
                for (int nt = 0; nt < 2; ++nt) { const f32x4 a = (nt ? d1 : d0) + bias4[nt]; const int n0 = w * 32 + nt * 16 + 4 * fq;
                    const u32x2 zz = *(const LAS u32x2*)(lds + t * ZS + n0 * 2);
                    u32x2 o; o.x = pk2(bflo(zz.x) * sigmoidf_(a[0]), bfhi(zz.x) * sigmoidf_(a[1])); o.y = pk2(bflo(zz.y) * sigmoidf_(a[2]), bfhi(zz.y) * sigmoidf_(a[3]));
                    *(u32x2*)(YC + (size_t)(m0 + t) * DM + n0) = o; } }
        }
    }
    {
        PHASE_IDS
        const int gw = bid * 8 + wave, NW = G * 8, hh = lane >> 4, c12 = lane * 12;
        f32x4 nw[3];
#pragma unroll
        for (int j = 0; j < 3; ++j) nw[j] = *(const f32x4*)(p.in[35] + c12 + 4 * j);
        for (int m0 = gw; m0 < M; m0 += NW * 4) {
            u32x2 xn[4][3], xo[4][3]; float dn[4];
#pragma unroll
            for (int u = 0; u < 4; ++u) { const int m = m0 + u * NW; const bf16_t* ur = U + (size_t)m * LDU1 + c12; dn[u] = gDEN[(size_t)m * 4 + hh];
#pragma unroll
                for (int j = 0; j < 3; ++j) { xn[u][j] = *(const u32x2*)(ur + 1792 + 4 * j); xo[u][j] = *(const u32x2*)(ur + 2560 + 4 * j); } }
#pragma unroll
            for (int u = 0; u < 4; ++u) { const int m = m0 + u * NW; const float inv = 1.0f / fmaxf(fabsf(dn[u]), 1.0f);
                float hv[12], og[12]; float ss = 0.f;
#pragma unroll
                for (int j = 0; j < 3; ++j) { hv[4 * j] = bflo(xn[u][j].x) * inv; hv[4 * j + 1] = bfhi(xn[u][j].x) * inv; hv[4 * j + 2] = bflo(xn[u][j].y) * inv; hv[4 * j + 3] = bfhi(xn[u][j].y) * inv;
                    og[4 * j] = bflo(xo[u][j].x); og[4 * j + 1] = bfhi(xo[u][j].x); og[4 * j + 2] = bflo(xo[u][j].y); og[4 * j + 3] = bfhi(xo[u][j].y); }
#pragma unroll
                for (int e = 0; e < 12; ++e) ss = fmaf(hv[e], hv[e], ss);
                const float rs = 1.0f / sqrtf(row_sum16(ss) * (1.f / 192.f) + RMS_EPS);
                bf16_t* yo = YC + (size_t)m * DM + 256 + c12;
#pragma unroll
                for (int j = 0; j < 3; ++j) { u32x2 w; w.x = pk2(hv[4 * j] * rs * nw[j][0] * sigmoidf_(og[4 * j]), hv[4 * j + 1] * rs * nw[j][1] * sigmoidf_(og[4 * j + 1]));
                    w.y = pk2(hv[4 * j + 2] * rs * nw[j][2] * sigmoidf_(og[4 * j + 2]), hv[4 * j + 3] * rs * nw[j][3] * sigmoidf_(og[4 * j + 3])); *(u32x2*)(yo + 4 * j) = w; } }
        }
    }
    GSYNC();
    STAMP(12);

    { pg8::Gemm g{YC, (const bf16_t*)(p.ws + WS_OUT1), DM, DM, M, DM, DM}; pg8::StaticOrder S; S.init(M, DM, G, bid);
      pg8::EpiResidual<false, true> E{nullptr, XB, XB, SS3}; pg8::gemm_phase<pg8::EpiResidual<false, true>, pg8::StaticOrder, true, true>(lds, g, S, E); }
    GSYNC();
    STAMP(13);
    { pg8::Gemm g{XB, (const bf16_t*)(p.ws + WS_GU1), DM, DM, M, 2 * FFN, DM}; pg8::StaticOrder S; S.init(M, 2 * FFN, G, bid);
      pg8::EpiSwiGlu E{HID, FFN, SS3}; pg8::gemm_phase<pg8::EpiSwiGlu, pg8::StaticOrder, true, true>(lds, g, S, E); }
    GSYNC();
    STAMP(14);
    { pg8::Gemm g{HID, (const bf16_t*)(p.ws + WS_D1), FFN, FFN, M, DM, FFN}; pg8::StaticOrder S; S.init(M, DM, G, bid);
      pg8::EpiResidual<false, false> E{nullptr, XB, XB, nullptr}; pg8::gemm_phase<pg8::EpiResidual<false, false>, pg8::StaticOrder, true, true>(lds, g, S, E); }
    GSYNC();
    STAMP(15);

    {
        PHASE_IDS
        const f32x4* gg = (const f32x4*)p.in[3] + lane;
        f32x4 gv[4];
#pragma unroll
        for (int j = 0; j < 4; ++j) gv[j] = gg[64 * j];
        for (int row = bid * 8 + wave; row < M; row += G * 32) {
            u32x2 w[4][4];
#pragma unroll
            for (int r = 0; r < 4; ++r)
#pragma unroll
                for (int j = 0; j < 4; ++j) w[r][j] = ((const u32x2*)(XB + (size_t)(row + r * G * 8) * DM))[64 * j + lane];
#pragma unroll
            for (int r = 0; r < 4; ++r) { f32x4 v[4]; float s = 0.f;
#pragma unroll
                for (int j = 0; j < 4; ++j) { v[j] = (f32x4){bflo(w[r][j].x), bfhi(w[r][j].x), bflo(w[r][j].y), bfhi(w[r][j].y)}; s += (v[j][0] * v[j][0] + v[j][1] * v[j][1]) + (v[j][2] * v[j][2] + v[j][3] * v[j][3]); }
                const float rs = 1.0f / sqrtf(wave_sum(s) * (1.f / DM) + RMS_EPS);
                f32x4* xr = (f32x4*)(p.out + (size_t)(row + r * G * 8) * DM) + lane;
#pragma unroll
                for (int j = 0; j < 4; ++j) xr[64 * j] = v[j] * rs * gv[j]; }
        }
    }
    STAMP(16);
#if PROBE
    if (bid == 0 && threadIdx.x == 0) {
        const unsigned long long* ts = (const unsigned long long*)(p.ws + CTL_TS);
        const int order[18] = {0, 1, 2, 3, 17, 4, 5, 6, 7, 8, 9, 10, 11, 12, 13, 14, 15, 16};
        unsigned long long extra = 0;
        for (int j = 0; j < 17; ++j) if ((PROBE_MASK >> j) & 1) extra += __hip_atomic_load(ts + order[j + 1], __ATOMIC_RELAXED, __HIP_MEMORY_SCOPE_AGENT) - __hip_atomic_load(ts + order[j], __ATOMIC_RELAXED, __HIP_MEMORY_SCOPE_AGENT);
#ifdef PROBE_A
        extra += __hip_atomic_load(ts + PROBE_B, __ATOMIC_RELAXED, __HIP_MEMORY_SCOPE_AGENT) - __hip_atomic_load(ts + PROBE_A, __ATOMIC_RELAXED, __HIP_MEMORY_SCOPE_AGENT);
#endif
        const unsigned long long t0 = __builtin_amdgcn_s_memrealtime();
        while (__builtin_amdgcn_s_memrealtime() - t0 < extra) __builtin_amdgcn_s_sleep(8);
    }
#endif
}

extern "C" void kernel_launch(void* const* d_in, const int* in_sizes, int n_in, void* d_out, int out_size, void* d_ws, size_t ws_size, hipStream_t stream) {
    static int ready = 0;
    if (!ready) {
        if (n_in != 39 || out_size != M * DM || ws_size < WS_END) { fprintf(stderr, "kernel_launch: unexpected problem shape (n_in %d out %d ws %zu)\n", n_in, out_size, ws_size); ready = -1; return; }
        if (hipFuncSetAttribute((const void*)mega, hipFuncAttributeMaxDynamicSharedMemorySize, LDS_BYTES) != hipSuccess) { fprintf(stderr, "kernel_launch: hipFuncSetAttribute failed\n"); ready = -1; return; }
        int per_cu = 0; (void)hipOccupancyMaxActiveBlocksPerMultiprocessor(&per_cu, (const void*)mega, 512, LDS_BYTES);
        if (per_cu < 1) fprintf(stderr, "kernel_launch: occupancy query says %d blocks per CU\n", per_cu);
        (void)hipGetLastError();
        ready = 1;
    }
    if (ready < 0) return;
    (void)hipMemsetAsync((char*)d_ws + WS_CTL, 0, CTL_BYTES, stream);
    Params p{};
    for (int i = 0; i < 39; ++i) p.in[i] = (const float*)d_in[i];
    p.out = (float*)d_out; p.ws = (unsigned char*)d_ws;
    void* args[] = {&p};
    hipError_t e = hipLaunchCooperativeKernel((const void*)mega, dim3(256), dim3(512), args, LDS_BYTES, stream);
    if (e != hipSuccess) fprintf(stderr, "kernel_launch: cooperative launch failed: %s\n", hipGetErrorString(e));
}
```

```cpp
#include <hip/hip_runtime.h>
#include <hip/hip_cooperative_groups.h>
#include <cstdio>
#include <cstdint>
#include <cmath>
namespace cg = cooperative_groups;

#define LAS __attribute__((address_space(3)))
typedef unsigned short bf16_t;
typedef short bf16x8 __attribute__((ext_vector_type(8)));
typedef short s16x4 __attribute__((ext_vector_type(4)));
typedef float f32x4 __attribute__((ext_vector_type(4)));
typedef unsigned u32x4 __attribute__((ext_vector_type(4)));
typedef unsigned u32x2 __attribute__((ext_vector_type(2)));

constexpr int SEQ = 4096, BATCH = 8, DM = 1024, M = BATCH * SEQ;
constexpr int EVEN_IN = 3744, LDU0 = 3840, ODD_IN = 3336, NP1 = 3584, LDU1 = 3712, FFN = 2816;
constexpr float RMS_EPS = 1e-6f;

constexpr size_t MiB = 1u << 20;
constexpr size_t WS_CTL = 0, CTL_BYTES = 1 * MiB;
constexpr size_t CTL_SS1 = 128 * 1024, CTL_SS2 = 256 * 1024, CTL_SS3 = 384 * 1024, CTL_SS0 = 512 * 1024;
constexpr size_t CTL_TS = 800 * 1024;
constexpr size_t CTL_LB = 640 * 1024, CTL_LBR = 644 * 1024, CTL_LBI = 648 * 1024, CTL_BBR = 656 * 1024, CTL_BBI = 720 * 1024;
constexpr size_t WS_IN0 = 1 * MiB, WS_OUT0 = WS_IN0 + (size_t)LDU0 * DM * 2, WS_GU0 = WS_OUT0 + 2 * MiB, WS_D0 = WS_GU0 + 11 * MiB;
constexpr size_t WS_IN1 = WS_D0 + (size_t)DM * FFN * 2, WS_OUT1 = WS_IN1 + (size_t)NP1 * DM * 2, WS_GU1 = WS_OUT1 + 2 * MiB, WS_D1 = WS_GU1 + 11 * MiB;
constexpr size_t WS_GLU = WS_D1 + (size_t)DM * FFN * 2;
constexpr size_t WS_LORA = WS_GLU + 256 * 256 * 2;
constexpr size_t WS_XB = 53 * MiB, WS_YC = 117 * MiB, WS_U = 181 * MiB, WS_MS = 421 * MiB, WS_END = 512 * MiB;
constexpr size_t WS_SSQ = WS_MS + 70 * MiB;
static_assert(WS_LORA + 512 * 160 * 2 <= WS_XB, "weights fit");
static_assert(WS_U + (size_t)M * LDU0 * 2 <= WS_MS, "U fits");

__device__ __forceinline__ float bf2f(bf16_t h) { return __uint_as_float(((unsigned)h) << 16); }
__device__ __forceinline__ float bflo(unsigned w) { return __uint_as_float(w << 16); }
__device__ __forceinline__ unsigned long long ss_fix(float s) { return (unsigned long long)(s * 1048576.0f); }
__device__ __forceinline__ float ss_flt(unsigned long long q) { return ((float)(unsigned)(q >> 32) * 4294967296.0f + (float)(unsigned)q) * (1.0f / 1048576.0f); }
__device__ __forceinline__ float bfhi(unsigned w) { return __uint_as_float(w & 0xffff0000u); }
typedef __bf16 bf16x2_t __attribute__((ext_vector_type(2)));
typedef float f32x2c_t __attribute__((ext_vector_type(2)));
__device__ __forceinline__ unsigned pk2(float lo, float hi) { const bf16x2_t v = __builtin_convertvector((f32x2c_t){lo, hi}, bf16x2_t); return __builtin_bit_cast(unsigned, v); }
__device__ __forceinline__ bf16_t f2bf(float f) { const __bf16 b = (__bf16)f; return __builtin_bit_cast(bf16_t, b); }
__device__ __forceinline__ float sigmoidf_(float x) { return __builtin_amdgcn_rcpf(1.f + __expf(-x)); }
__device__ __forceinline__ float rsqrtf_(float x) { return __builtin_amdgcn_rsqf(x); }
__device__ __forceinline__ float siluf_(float x) { return x * sigmoidf_(x); }
__device__ __forceinline__ float softplusf_(float x) { return fmaxf(x, 0.f) + __logf(1.f + __expf(-fabsf(x))); }
__device__ __forceinline__ float tanhf_(float x) { const float e = __expf(-2.f * fabsf(x)); const float t = (1.f - e) * __builtin_amdgcn_rcpf(1.f + e); return x < 0.f ? -t : t; }
template <int CTRL> __device__ __forceinline__ float dpp_mov(float x) { return __int_as_float(__builtin_amdgcn_update_dpp(0, __float_as_int(x), CTRL, 0xf, 0xf, true)); }
__device__ __forceinline__ float row_sum16(float v) { v += dpp_mov<0xB1>(v); v += dpp_mov<0x4E>(v); v += dpp_mov<0x141>(v); v += dpp_mov<0x140>(v); return v; }
__device__ __forceinline__ float xrow16(float v) { const auto r = __builtin_amdgcn_permlane16_swap(__float_as_uint(v), __float_as_uint(v), false, false); return __uint_as_float(r[0]) + __uint_as_float(r[1]); }
__device__ __forceinline__ float xrow32(float v) { const auto r = __builtin_amdgcn_permlane32_swap(__float_as_uint(v), __float_as_uint(v), false, false); return __uint_as_float(r[0]) + __uint_as_float(r[1]); }
__device__ __forceinline__ float half_sum(float v) { return xrow16(row_sum16(v)); }
__device__ __forceinline__ float wave_sum(float v) { return xrow32(half_sum(v)); }

typedef float f32x2 __attribute__((ext_vector_type(2)));
__device__ __forceinline__ void half_reduce8(const float (&p)[8], int lane, float& o0, float& o1) {
    const bool b0 = (lane & 1) != 0, b1 = (lane & 2) != 0;
    float r[4];
#pragma unroll
    for (int i = 0; i < 4; ++i) { const float keep = b0 ? p[2 * i + 1] : p[2 * i], send = b0 ? p[2 * i] : p[2 * i + 1]; r[i] = keep + dpp_mov<0xB1>(send); }
    float q0, q1;
    { const float keep = b1 ? r[1] : r[0], send = b1 ? r[0] : r[1]; q0 = keep + dpp_mov<0x4E>(send); }
    { const float keep = b1 ? r[3] : r[2], send = b1 ? r[2] : r[3]; q1 = keep + dpp_mov<0x4E>(send); }
    q0 += dpp_mov<0x124>(q0); q0 += dpp_mov<0x128>(q0);
    q1 += dpp_mov<0x124>(q1); q1 += dpp_mov<0x128>(q1);
    o0 = xrow16(q0); o1 = xrow16(q1);
}

#define LBAR() do { asm volatile("s_waitcnt lgkmcnt(0)" ::: "memory"); __builtin_amdgcn_s_barrier(); asm volatile("" ::: "memory"); } while (0)
namespace pg8 {
constexpr int BM = 256, BK = 64, HALF = 128, HTB = HALF * BK * 2, STAGE_BYTES = 8 * HTB, NXCD = 8, WGM = 8;
__device__ __forceinline__ int lds_byte(int r, int c) { const int st = (r >> 4) * 2 + (c >> 5), rr = r & 15, cc = c & 31, ob = rr * 64 + cc * 2; return st * 1024 + (ob ^ (((ob >> 9) & 1) << 5)); }
__device__ __forceinline__ void stage_rc(int b, int& R, int& C) { const int st = b / 1024, sb = b % 1024, swz = sb ^ (((sb >> 9) & 1) << 5); R = (st >> 1) * 16 + swz / 64; C = (st & 1) * 32 + (swz % 64) / 2; }
__device__ __forceinline__ int perm32(int rho) { const int n = rho >> 4, i = rho & 15; return 8 * (i >> 2) + 4 * n + (i & 3); }
struct Unit { int pm, pn; };
struct Gemm { const bf16_t* A; const bf16_t* Bt; int lda, ldb, M, N, K; };
struct StaticOrder {
    int nM, nN, nwg, G, c;
    __device__ void init(int M_, int N_, int G_, int c_) { nM = M_ / BM; nN = N_ / BM; nwg = nM * nN; G = G_; c = c_; }
    __device__ bool next(int i, Unit& u) const {
        const long L = (long)i * G + c; if (L >= nwg) return false;
        int wgid = (int)L; { const int q = nwg / NXCD, r = nwg % NXCD, xcd = wgid % NXCD, off = wgid / NXCD; wgid = (xcd < r ? xcd * (q + 1) : r * (q + 1) + (xcd - r) * q) + off; }
        const int nig = WGM * nN, gid = wgid / nig, fm = gid * WGM, gsz = (nM - fm) < WGM ? (nM - fm) : WGM;
        u.pm = fm + ((wgid % nig) % gsz); u.pn = (wgid % nig) / gsz; return true;
    }
};

struct EpiScaleBf16 {
    static constexpr bool PERM = true;
    bf16_t* O; int ldc; const unsigned long long* ss;
    __device__ __forceinline__ void operator()(const f32x4 (&acc)[2][2][4][2], const Unit& u, int wr, int wc, int fr, int fq) const {
        const int row0 = u.pm * BM + wr * 64 + fr, col0 = u.pn * BM + wc * 32 + 8 * fq;
#pragma unroll
        for (int ai = 0; ai < 2; ++ai)
#pragma unroll
            for (int m = 0; m < 4; ++m) { const int row = row0 + ai * HALF + m * 16; const float rs = rsqrtf_(ss_flt(ss[row]) * (1.f / DM) + RMS_EPS);
                bf16_t* rowp = O + (size_t)row * ldc + col0;
#pragma unroll
                for (int bj = 0; bj < 2; ++bj) { const f32x4 v0 = acc[ai][bj][m][0] * rs, v1 = acc[ai][bj][m][1] * rs;
                    u32x4 w; w.x = pk2(v0[0], v0[1]); w.y = pk2(v0[2], v0[3]); w.z = pk2(v1[0], v1[1]); w.w = pk2(v1[2], v1[3]);
                    *(u32x4*)(rowp + bj * HALF) = w; } }
    }
};
struct EpiSwiGlu {
    static constexpr bool PERM = true;
    bf16_t* O; int ldc; const unsigned long long* ss;
    __device__ __forceinline__ void operator()(const f32x4 (&acc)[2][2][4][2], const Unit& u, int wr, int wc, int fr, int fq) const {
        const int row0 = u.pm * BM + wr * 64 + fr, col0 = u.pn * HALF + wc * 32 + 8 * fq;
#pragma unroll
        for (int ai = 0; ai < 2; ++ai)
#pragma unroll
            for (int m = 0; m < 4; ++m) { const int row = row0 + ai * HALF + m * 16; const float rs = rsqrtf_(ss_flt(ss[row]) * (1.f / DM) + RMS_EPS);
                f32x4 h[2];
#pragma unroll
                for (int n = 0; n < 2; ++n) { const f32x4 g = acc[ai][0][m][n] * rs, up = acc[ai][1][m][n] * rs;
#pragma unroll
                    for (int e = 0; e < 4; ++e) h[n][e] = siluf_(g[e]) * up[e]; }
                u32x4 w; w.x = pk2(h[0][0], h[0][1]); w.y = pk2(h[0][2], h[0][3]); w.z = pk2(h[1][0], h[1][1]); w.w = pk2(h[1][2], h[1][3]);
                *(u32x4*)(O + (size_t)row * ldc + col0) = w; }
    }
};
template <bool BASE_F32, bool WITH_SS> struct EpiResidual {
    static constexpr bool PERM = true;
    const float* base32; const bf16_t* base16; bf16_t* xb; unsigned long long* ss;
    __device__ __forceinline__ void operator()(const f32x4 (&acc)[2][2][4][2], const Unit& u, int wr, int wc, int fr, int fq) const {
        const int row0 = u.pm * BM + wr * 64 + fr, col0 = u.pn * BM + wc * 32 + 8 * fq;
#pragma unroll
        for (int ai = 0; ai < 2; ++ai)
#pragma unroll
            for (int m = 0; m < 4; ++m) { const int row = row0 + ai * HALF + m * 16; const size_t off = (size_t)row * DM + col0; float s = 0.f;
#pragma unroll
                for (int bj = 0; bj < 2; ++bj) { const size_t o = off + bj * HALF; f32x4 r0, r1;
                    if (BASE_F32) { r0 = *(const f32x4*)(base32 + o); r1 = *(const f32x4*)(base32 + o + 4); }
                    else { const u32x4 rb = *(const u32x4*)(base16 + o); r0 = (f32x4){bflo(rb.x), bfhi(rb.x), bflo(rb.y), bfhi(rb.y)}; r1 = (f32x4){bflo(rb.z), bfhi(rb.z), bflo(rb.w), bfhi(rb.w)}; }
                    const f32x4 v0 = r0 + acc[ai][bj][m][0], v1 = r1 + acc[ai][bj][m][1];
                    u32x4 w; w.x = pk2(v0[0], v0[1]); w.y = pk2(v0[2], v0[3]); w.z = pk2(v1[0], v1[1]); w.w = pk2(v1[2], v1[3]); *(u32x4*)(xb + o) = w;
                    s += ((v0[0] * v0[0] + v0[1] * v0[1]) + (v0[2] * v0[2] + v0[3] * v0[3])) + ((v1[0] * v1[0] + v1[1] * v1[1]) + (v1[2] * v1[2] + v1[3] * v1[3])); }
                if (WITH_SS) { s = xrow32(xrow16(s)); if (fq == 0) atomicAdd(ss + row, ss_fix(s)); } }
    }
};

template <class Epi, class Sched, bool ALIGN_EPI, bool SP2>
__device__ __forceinline__ void gemm_phase(LAS unsigned char* lds, const Gemm g, const Sched& S, const Epi& E) {
    int tid_ = threadIdx.x; asm volatile("" : "+v"(tid_));
    const int tid = tid_, wid = __builtin_amdgcn_readfirstlane(tid >> 6), lane = tid & 63, wr = wid >> 2, wc = wid & 3, fr = lane & 15, fq = lane >> 4;
    const int K = g.K, nt = K / BK;
    unsigned voffA[2], voffB[2];
#pragma unroll
    for (int i = 0; i < 2; ++i) { int R, C; stage_rc(tid * 16 + i * 8192, R, C); const int Rb = Epi::PERM ? ((R & ~31) + perm32(R & 31)) : R;
        voffA[i] = (unsigned)(R * g.lda + C) * 2u; voffB[i] = (unsigned)(Rb * g.ldb + C) * 2u; }
    const size_t kstep = (size_t)(BK * 2);
    const size_t hstepA = (size_t)HALF * g.lda * 2, hstepB = (size_t)HALF * g.ldb * 2;
    const size_t tstepA = 2 * hstepA, tstepB = 2 * hstepB;
    const unsigned ldsw = (unsigned)wid * 1024u;
    const int aoff = lds_byte(wr * 64 + fr, fq * 8), boff = lds_byte(wc * 32 + fr, fq * 8);
#define PG8_SA(b, h) (((b) * 2 + (h)) * HTB)
#define PG8_SB(b, h) ((4 + (b) * 2 + (h)) * HTB)
#define PG8_STAGE(bufoff, gbase, voff) do { _Pragma("unroll") for (int _i = 0; _i < 2; ++_i) \
        __builtin_amdgcn_global_load_lds((const unsigned*)((const char*)(gbase) + (voff)[_i]), (LAS unsigned*)(lds + (bufoff) + ldsw + _i * 8192), 16, 0, 0); } while (0)
#define PG8_LDA(dst, b, h) do { _Pragma("unroll") for (int m = 0; m < 4; ++m) _Pragma("unroll") for (int k = 0; k < 2; ++k) dst[m][k] = *(const LAS bf16x8*)(lds + PG8_SA(b, h) + aoff + m * 2048 + k * 1024); } while (0)
#define PG8_LDB(dst, b, h) do { _Pragma("unroll") for (int n = 0; n < 2; ++n) _Pragma("unroll") for (int k = 0; k < 2; ++k) dst[n][k] = *(const LAS bf16x8*)(lds + PG8_SB(b, h) + boff + n * 2048 + k * 1024); } while (0)
#define PG8_MMA(ai, bj, At, Bt) do { __builtin_amdgcn_s_setprio(1); _Pragma("unroll") for (int m = 0; m < 4; ++m) _Pragma("unroll") for (int n = 0; n < 2; ++n) _Pragma("unroll") for (int k = 0; k < 2; ++k) \
        acc[ai][bj][m][n] = __builtin_amdgcn_mfma_f32_16x16x32_bf16(Bt[n][k], At[m][k], acc[ai][bj][m][n], 0, 0, 0); __builtin_amdgcn_s_setprio(0); } while (0)
#define PG8_WAIT_V(n) asm volatile("s_waitcnt vmcnt(" #n ")" ::: "memory")
#define PG8_WAIT_L(n) asm volatile("s_waitcnt lgkmcnt(" #n ")" ::: "memory")
#define PG8_BAR __builtin_amdgcn_s_barrier()
#define PG8_SCHED __builtin_amdgcn_sched_barrier(0)
    Unit cur, nxt; int ui = 0;
    if (!S.next(0, cur)) return;
    f32x4 acc[2][2][4][2];
#pragma unroll
    for (int a = 0; a < 2; ++a)
#pragma unroll
        for (int b = 0; b < 2; ++b)
#pragma unroll
            for (int m = 0; m < 4; ++m)
#pragma unroll
                for (int n = 0; n < 2; ++n) acc[a][b][m][n] = (f32x4){0.f, 0.f, 0.f, 0.f};
    bf16x8 At[4][2], B0[2][2], B1[2][2];
    const char* cA = (const char*)g.A + (size_t)cur.pm * tstepA; const char* cB = (const char*)g.Bt + (size_t)cur.pn * tstepB;
    if constexpr (SP2) {
        PG8_STAGE(PG8_SB(0, 0), cB, voffB); PG8_STAGE(PG8_SB(0, 1), cB + hstepB, voffB); PG8_STAGE(PG8_SA(0, 0), cA, voffA); PG8_STAGE(PG8_SA(0, 1), cA + hstepA, voffA);
        if (wr == 1) PG8_BAR;
        PG8_WAIT_V(2); PG8_BAR;
        PG8_STAGE(PG8_SB(1, 0), cB + kstep, voffB); PG8_STAGE(PG8_SA(1, 0), cA + kstep, voffA); PG8_STAGE(PG8_SB(1, 1), cB + hstepB + kstep, voffB);
        PG8_WAIT_V(6); PG8_BAR;
    } else {
        PG8_STAGE(PG8_SB(0, 0), cB, voffB); PG8_STAGE(PG8_SA(0, 0), cA, voffA); PG8_STAGE(PG8_SB(0, 1), cB + hstepB, voffB); PG8_STAGE(PG8_SA(0, 1), cA + hstepA, voffA);
        if (wr == 1) PG8_BAR;
        PG8_WAIT_V(4); PG8_BAR;
        PG8_STAGE(PG8_SB(1, 0), cB + kstep, voffB); PG8_STAGE(PG8_SA(1, 0), cA + kstep, voffA); PG8_STAGE(PG8_SB(1, 1), cB + hstepB + kstep, voffB);
        PG8_WAIT_V(6); PG8_BAR;
    }
    for (;;) {
        const bool has_next = S.next(ui + 1, nxt);
        const char* nA = has_next ? (const char*)g.A + (size_t)nxt.pm * tstepA : cA; const char* nB = has_next ? (const char*)g.Bt + (size_t)nxt.pn * tstepB : cB;
        for (int t = 0; t < nt; t += 2) {
            const bool last = (t == nt - 2);
            const char* a1 = cA + (size_t)(t + 1) * kstep;
            const char* a2 = last ? nA : cA + (size_t)(t + 2) * kstep; const char* b2 = last ? nB : cB + (size_t)(t + 2) * kstep;
            const char* a3 = a2 + kstep; const char* b3 = b2 + kstep;
            if constexpr (SP2) {
            PG8_LDB(B0, 0, 0); PG8_LDB(B1, 0, 1); PG8_SCHED; PG8_LDA(At, 0, 0); PG8_STAGE(PG8_SA(1, 1), a1 + hstepA, voffA);
            PG8_WAIT_V(8); PG8_WAIT_L(0); PG8_BAR; PG8_MMA(0, 0, At, B0); PG8_MMA(0, 1, At, B1); PG8_BAR; PG8_SCHED;
            PG8_LDA(At, 0, 1); PG8_STAGE(PG8_SB(0, 0), b2, voffB); PG8_STAGE(PG8_SB(0, 1), b2 + hstepB, voffB); PG8_STAGE(PG8_SA(0, 0), a2, voffA);
            PG8_WAIT_V(8); PG8_WAIT_L(0); PG8_BAR; PG8_MMA(1, 0, At, B0); PG8_MMA(1, 1, At, B1); PG8_BAR; PG8_SCHED;
            PG8_LDB(B0, 1, 0); PG8_LDB(B1, 1, 1); PG8_SCHED; PG8_LDA(At, 1, 0); PG8_STAGE(PG8_SA(0, 1), a2 + hstepA, voffA);
            PG8_WAIT_V(8); PG8_WAIT_L(0); PG8_BAR; PG8_MMA(0, 0, At, B0); PG8_MMA(0, 1, At, B1); PG8_BAR; PG8_SCHED;
            PG8_LDA(At, 1, 1); PG8_STAGE(PG8_SB(1, 0), b3, voffB); PG8_STAGE(PG8_SB(1, 1), b3 + hstepB, voffB); PG8_STAGE(PG8_SA(1, 0), a3, voffA);
            PG8_WAIT_V(8); PG8_WAIT_L(0); PG8_BAR; PG8_MMA(1, 0, At, B0); PG8_MMA(1, 1, At, B1); PG8_BAR; PG8_SCHED;
            } else {
            PG8_LDB(B0, 0, 0); PG8_SCHED; PG8_LDA(At, 0, 0); PG8_STAGE(PG8_SA(1, 1), a1 + hstepA, voffA);
            PG8_WAIT_L(8); PG8_BAR; PG8_WAIT_L(0); PG8_MMA(0, 0, At, B0); PG8_BAR; PG8_SCHED;
            PG8_LDB(B1, 0, 1); PG8_STAGE(PG8_SB(0, 0), b2, voffB);
            PG8_BAR; PG8_WAIT_L(0); PG8_MMA(0, 1, At, B1); PG8_BAR;
            PG8_LDA(At, 0, 1); PG8_STAGE(PG8_SA(0, 0), a2, voffA);
            PG8_BAR; PG8_WAIT_L(0); PG8_MMA(1, 0, At, B0); PG8_BAR; PG8_SCHED;
            PG8_STAGE(PG8_SB(0, 1), b2 + hstepB, voffB);
            PG8_WAIT_V(6); PG8_BAR; PG8_MMA(1, 1, At, B1); PG8_BAR;
            PG8_LDB(B0, 1, 0); PG8_SCHED; PG8_LDA(At, 1, 0); PG8_STAGE(PG8_SA(0, 1), a2 + hstepA, voffA);
            PG8_WAIT_L(8); PG8_BAR; PG8_WAIT_L(0); PG8_MMA(0, 0, At, B0); PG8_BAR; PG8_SCHED;
            PG8_LDB(B1, 1, 1); PG8_STAGE(PG8_SB(1, 0), b3, voffB);
            PG8_BAR; PG8_WAIT_L(0); PG8_MMA(0, 1, At, B1); PG8_BAR;
            PG8_LDA(At, 1, 1); PG8_STAGE(PG8_SA(1, 0), a3, voffA);
            PG8_BAR; PG8_WAIT_L(0); PG8_MMA(1, 0, At, B0); PG8_BAR; PG8_SCHED;
            PG8_STAGE(PG8_SB(1, 1), b3 + hstepB, voffB);
            PG8_WAIT_V(6); PG8_BAR; PG8_MMA(1, 1, At, B1); PG8_BAR;
            }
        }
        if constexpr (ALIGN_EPI) { if (wr == 0) PG8_BAR; }
        E(acc, cur, wr, wc, fr, fq);
        if (!has_next) break;
#pragma unroll
        for (int a = 0; a < 2; ++a)
#pragma unroll
            for (int b = 0; b < 2; ++b)
#pragma unroll
                for (int m = 0; m < 4; ++m)
#pragma unroll
                    for (int n = 0; n < 2; ++n) acc[a][b][m][n] = (f32x4){0.f, 0.f, 0.f, 0.f};
        cur = nxt; cA = nA; cB = nB; ++ui;
        if constexpr (ALIGN_EPI) { if (wr == 1) PG8_BAR; }
    }
    PG8_WAIT_V(0);
    if constexpr (!ALIGN_EPI) { if (wr == 0) PG8_BAR; }
    PG8_BAR;
#undef PG8_SA
#undef PG8_SB
#undef PG8_STAGE
#undef PG8_LDA
#undef PG8_LDB
#undef PG8_MMA
#undef PG8_WAIT_V
#undef PG8_WAIT_L
#undef PG8_BAR
#undef PG8_SCHED
}
}

#define XB_TMO      128
#define XB_XCNT(j)  (256  + 64 * (j))
#define XB_XSUB(j)  (1280 + 64 * (j))
#define XB_XGEN(j)  (2304 + 64 * (j))
#define XB_TOP      3328
#define XB_TOPGEN   3392
#define XCD_BAR_WORDS 3456
#define XB_SPIN_CAP (1u << 18)
__device__ __forceinline__ unsigned xb_ld(unsigned* p)              { return __hip_atomic_load(p, __ATOMIC_RELAXED, __HIP_MEMORY_SCOPE_AGENT); }
__device__ __forceinline__ unsigned xb_add(unsigned* p, unsigned v) { return __hip_atomic_fetch_add(p, v, __ATOMIC_RELAXED, __HIP_MEMORY_SCOPE_AGENT); }
__device__ __forceinline__ unsigned xb_xcc_id() { return (unsigned)__builtin_amdgcn_s_getreg((3 << 11) | 20) & 0xFu; }
#define XB_SPIN(cond, bar) do { unsigned _sp = 0; while (cond) { __builtin_amdgcn_s_sleep(1); \
    if ((++_sp & 255u) == 0u) { if (xb_ld(&(bar)[XB_TMO])) break; if (_sp > XB_SPIN_CAP) { atomicAdd(&(bar)[XB_TMO], 1u); break; } } } } while (0)
struct XcdBarrier { unsigned* bar; unsigned x; volatile LAS unsigned* st; };
__device__ __forceinline__ XcdBarrier xcd_barrier_post(unsigned* bar, volatile LAS unsigned* st) {
    XcdBarrier b; b.bar = bar; b.x = xb_xcc_id(); b.st = st;
    if (threadIdx.x == 0) (void)xb_add(&bar[XB_XCNT(b.x)], 1u);
    return b;
}
__device__ __forceinline__ void xcd_barrier_complete(unsigned* bar, unsigned x, unsigned& nloc, unsigned& nx) {
    const unsigned G = gridDim.x * gridDim.y * gridDim.z;
    unsigned sum, cnt, mine, sp = 0u;
    for (;;) {
        sum = 0u; cnt = 0u; mine = 0u;
#pragma unroll
        for (unsigned j = 0; j < 16; ++j) { const unsigned c = xb_ld(&bar[XB_XCNT(j)]); sum += c; cnt += (c > 0u) ? 1u : 0u; mine = (j == x) ? c : mine; }
        if (sum == G) break;
        __builtin_amdgcn_s_sleep(1);
        if ((++sp & 255u) == 0u) { if (xb_ld(&bar[XB_TMO])) break; if (sp > XB_SPIN_CAP) { atomicAdd(&bar[XB_TMO], 1u); break; } }
    }
    nloc = mine > 0u ? mine : 1u; nx = cnt > 0u ? cnt : 1u;
}
__device__ __forceinline__ void xcd_barrier(const XcdBarrier& b, const int tid0) {
    asm volatile("s_waitcnt vmcnt(0)" ::: "memory");
    __syncthreads();
    if (tid0 == 0) {
        unsigned* bar = b.bar;
        __builtin_amdgcn_s_waitcnt(0);
        unsigned nloc = b.st[0], nx = b.st[1];
        if (nloc == 0u) { xcd_barrier_complete(bar, b.x, nloc, nx); b.st[0] = nloc; b.st[1] = nx; }
        const unsigned old = xb_add(&bar[XB_XSUB(b.x)], 1u);
        const unsigned gen = old / nloc;
        if (old + 1u == (gen + 1u) * nloc) {
            __builtin_amdgcn_fence(__ATOMIC_RELEASE, "agent");
            asm volatile("s_waitcnt vmcnt(0)" ::: "memory");
            const unsigned og = xb_add(&bar[XB_TOP], 1u);
            const unsigned tg = og / nx;
            if (og + 1u == (tg + 1u) * nx) xb_add(&bar[XB_TOPGEN], 1u);
            else XB_SPIN(xb_ld(&bar[XB_TOPGEN]) == tg, bar);
            __builtin_amdgcn_fence(__ATOMIC_ACQUIRE, "agent");
            xb_add(&bar[XB_XGEN(b.x)], 1u);
            asm volatile("s_waitcnt vmcnt(0)" ::: "memory");
        } else {
            XB_SPIN(xb_ld(&bar[XB_XGEN(b.x)]) == gen, bar);
            __builtin_amdgcn_fence(__ATOMIC_ACQUIRE, "agent");
            asm volatile("s_waitcnt vmcnt(0)" ::: "memory");
        }
    }
    __syncthreads();
}

constexpr int LDS_BYTES = 147456;
struct Params { const float* in[39]; float* out; unsigned char* ws; };

struct TrTile { const float* W; const float* gain; bf16_t* dst; int N, Npad, ldb, mode, k0, n0; };
__device__ __forceinline__ void tr_load(const TrTile& t, int tid, f32x4 (&v)[8], float (&gv)[8]) {
    const float* gp = t.gain ? t.gain : t.W;
#pragma unroll
    for (int i = 0; i < 8; ++i) { const int pp = tid + 512 * i, kk = pp >> 6, n = t.n0 + (pp & 63) * 4; const bool inb = n + 3 < t.N;
        v[i] = *(const f32x4*)(t.W + (size_t)(t.k0 + kk) * t.N + (inb ? n : 0)); gv[i] = gp[t.k0 + kk]; }
}
__device__ __forceinline__ void tr_to_lds(const TrTile& t, int tid, const f32x4 (&v)[8], const float (&gv)[8], LAS unsigned char* l) {
#pragma unroll
    for (int i = 0; i < 8; ++i) { const int pp = tid + 512 * i, kk = pp >> 6, n4 = (pp & 63) * 4; const bool inb = t.n0 + n4 + 3 < t.N;
        const float g = t.gain ? gv[i] : 1.f; const f32x4 x = inb ? v[i] * g : (f32x4){0.f, 0.f, 0.f, 0.f};
        u32x2 w; w.x = pk2(x[0], x[1]); w.y = pk2(x[2], x[3]); *(LAS u32x2*)(l + kk * 528 + n4 * 2) = w; }
}
__device__ __forceinline__ void tr_store(const TrTile& t, int tid, const LAS unsigned char* l) {
#pragma unroll
    for (int i = 0; i < 4; ++i) { const int pp = tid + 512 * i, n = pp >> 3, c = pp & 7; const int jn = t.n0 + n;
        if (jn < t.Npad) { const LAS bf16_t* s = (const LAS bf16_t*)(l + (8 * c) * 528) + n;
            const int drow = t.mode == 0 ? jn : ((jn >> 7) * 256 + (jn & 127) + (t.mode == 2 ? 128 : 0));
            u32x4 o; o.x = (unsigned)s[0] | ((unsigned)s[264] << 16); o.y = (unsigned)s[2 * 264] | ((unsigned)s[3 * 264] << 16); o.z = (unsigned)s[4 * 264] | ((unsigned)s[5 * 264] << 16); o.w = (unsigned)s[6 * 264] | ((unsigned)s[7 * 264] << 16);
            *(u32x4*)(t.dst + (size_t)drow * t.ldb + t.k0 + 8 * c) = o; } }
}

__global__ void __launch_bounds__(512, 2) mega(Params p) {
    extern __shared__ __attribute__((aligned(16))) unsigned char lds_raw[];
    LAS unsigned char* lds = (LAS unsigned char*)lds_raw;
    cg::grid_group grid = cg::this_grid();
    const int G = gridDim.x, bid = blockIdx.x;
#define PHASE_IDS int tid_o = threadIdx.x; asm volatile("" : "+v"(tid_o)); const int tid = tid_o, lane = tid & 63, wave = tid >> 6; (void)lane; (void)wave;
#define SS0 ((unsigned long long*)(p.ws + WS_SSQ))
#define SS1 (SS0 + M)
#define SS2 (SS0 + 2 * M)
#define SS3 (SS0 + 3 * M)
#define LBT ((float*)(p.ws + CTL_LB))
#define LBR ((float*)(p.ws + CTL_LBR))
#define LBI ((float*)(p.ws + CTL_LBI))
#define BBR ((float*)(p.ws + CTL_BBR))
#define BBI ((float*)(p.ws + CTL_BBI))
#define XB ((bf16_t*)(p.ws + WS_XB))
#define YC ((bf16_t*)(p.ws + WS_YC))
#define U ((bf16_t*)(p.ws + WS_U))
    { volatile LAS unsigned* st0 = (volatile LAS unsigned*)(lds + LDS_BYTES - 64); if (threadIdx.x < 16) st0[threadIdx.x] = 0u; }
    __syncthreads();
    (void)xcd_barrier_post((unsigned*)(p.ws + WS_CTL), (volatile LAS unsigned*)(lds + LDS_BYTES - 64));
#ifndef PROBE
#define PROBE 0
#endif
#ifndef PROBE_MASK
#define PROBE_MASK 0
#endif
#define STAMP(k) do { if (PROBE && bid == 0 && threadIdx.x == 0) ((unsigned long long*)(p.ws + CTL_TS))[k] = __builtin_amdgcn_s_memrealtime(); } while (0)
#define STAMP2(k, blk) do { if (PROBE && bid == (blk) && threadIdx.x == 0) ((unsigned long long*)(p.ws + CTL_TS))[k] = __builtin_amdgcn_s_memrealtime(); } while (0)
    STAMP(0);
#define GSYNC() do { XcdBarrier xb_; xb_.bar = (unsigned*)(p.ws + WS_CTL); xb_.x = xb_xcc_id(); xb_.st = (volatile LAS unsigned*)(lds + LDS_BYTES - 64); xcd_barrier(xb_, (int)threadIdx.x); } while (0)

    {
        PHASE_IDS
        constexpr int T_IN0 = 16 * 15, T_SQ = 16 * 4, T_GU = 16 * 11, T_DN = 44 * 4, T_IN1 = 16 * 14, T_GL = 4 * 1;
        constexpr int NT = T_IN0 + T_SQ + 2 * T_GU + T_DN + T_IN1 + T_SQ + 2 * T_GU + T_DN + T_GL;
#define P0_DECODE(T_, it_) { int r = (it_); const float* W; const float* gain; bf16_t* dst; int N, Npad, nNt, ldb, mode; \
            if (r < T_IN0) { W = p.in[4]; gain = p.in[1]; dst = (bf16_t*)(p.ws + WS_IN0); N = EVEN_IN; Npad = LDU0; nNt = 15; ldb = DM; mode = 0; } \
            else if ((r -= T_IN0) < T_SQ) { W = p.in[5]; gain = nullptr; dst = (bf16_t*)(p.ws + WS_OUT0); N = DM; Npad = DM; nNt = 4; ldb = DM; mode = 0; } \
            else if ((r -= T_SQ) < T_GU) { W = p.in[36]; gain = p.in[2]; dst = (bf16_t*)(p.ws + WS_GU0); N = FFN; Npad = FFN; nNt = 11; ldb = DM; mode = 1; } \
            else if ((r -= T_GU) < T_GU) { W = p.in[37]; gain = p.in[2]; dst = (bf16_t*)(p.ws + WS_GU0); N = FFN; Npad = FFN; nNt = 11; ldb = DM; mode = 2; } \
            else if ((r -= T_GU) < T_DN) { W = p.in[38]; gain = nullptr; dst = (bf16_t*)(p.ws + WS_D0); N = DM; Npad = DM; nNt = 4; ldb = FFN; mode = 0; } \
            else if ((r -= T_DN) < T_IN1) { W = p.in[19]; gain = p.in[1] + DM; dst = (bf16_t*)(p.ws + WS_IN1); N = ODD_IN; Npad = NP1; nNt = 14; ldb = DM; mode = 0; } \
            else if ((r -= T_IN1) < T_SQ) { W = p.in[20]; gain = nullptr; dst = (bf16_t*)(p.ws + WS_OUT1); N = DM; Npad = DM; nNt = 4; ldb = DM; mode = 0; } \
            else if ((r -= T_SQ) < T_GU) { W = p.in[36] + (size_t)DM * FFN; gain = p.in[2] + DM; dst = (bf16_t*)(p.ws + WS_GU1); N = FFN; Npad = FFN; nNt = 11; ldb = DM; mode = 1; } \
            else if ((r -= T_GU) < T_GU) { W = p.in[37] + (size_t)DM * FFN; gain = p.in[2] + DM; dst = (bf16_t*)(p.ws + WS_GU1); N = FFN; Npad = FFN; nNt = 11; ldb = DM; mode = 2; } \
            else if ((r -= T_GU) < T_DN) { W = p.in[38] + (size_t)FFN * DM; gain = nullptr; dst = (bf16_t*)(p.ws + WS_D1); N = DM; Npad = DM; nNt = 4; ldb = FFN; mode = 0; } \
            else { r -= T_DN; W = p.in[29]; gain = nullptr; dst = (bf16_t*)(p.ws + WS_GLU); N = 256; Npad = 256; nNt = 1; ldb = 256; mode = 0; } \
            T_.W = W; T_.gain = gain; T_.dst = dst; T_.N = N; T_.Npad = Npad; T_.ldb = ldb; T_.mode = mode; T_.k0 = (r / nNt) * 64; T_.n0 = (r % nNt) * 256; }
        if (bid < NT) {
            TrTile cur, nxt; f32x4 tv[8]; float tg[8];
            P0_DECODE(cur, bid); tr_load(cur, tid, tv, tg);
            for (int it = bid; it < NT; it += G) {
                const int itn = (it + G < NT) ? it + G : it; P0_DECODE(nxt, itn);
                __syncthreads();
                tr_to_lds(cur, tid, tv, tg, lds);
                tr_load(nxt, tid, tv, tg);
                __syncthreads();
                tr_store(cur, tid, lds);
                cur = nxt;
            }
        }
#undef P0_DECODE
        const float* x = p.in[0];
        for (int row = bid * 8 + wave; row < M; row += G * 16) {
            const int row2 = row + G * 8; const bool has2 = row2 < M;
            const f32x4* xr = (const f32x4*)(x + (size_t)row * DM) + lane; const f32x4* xr2 = (const f32x4*)(x + (size_t)(has2 ? row2 : row) * DM) + lane; f32x4 v[4], v2[4]; float s = 0.f, s2 = 0.f;
#pragma unroll
            for (int j = 0; j < 4; ++j) { v[j] = xr[64 * j]; v2[j] = xr2[64 * j]; }
#pragma unroll
            for (int j = 0; j < 4; ++j) { s += (v[j][0] * v[j][0] + v[j][1] * v[j][1]) + (v[j][2] * v[j][2] + v[j][3] * v[j][3]); s2 += (v2[j][0] * v2[j][0] + v2[j][1] * v2[j][1]) + (v2[j][2] * v2[j][2] + v2[j][3] * v2[j][3]); }
            s = wave_sum(s); s2 = wave_sum(s2); if (lane == 0) { SS0[row] = ss_fix(s); if (has2) SS0[row2] = ss_fix(s2); }
            u32x2* o = (u32x2*)(XB + (size_t)row * DM) + lane; u32x2* o2 = (u32x2*)(XB + (size_t)row2 * DM) + lane;
#pragma unroll
            for (int j = 0; j < 4; ++j) { u32x2 w; w.x = pk2(v[j][0], v[j][1]); w.y = pk2(v[j][2], v[j][3]); o[64 * j] = w; if (has2) { u32x2 w2; w2.x = pk2(v2[j][0], v2[j][1]); w2.y = pk2(v2[j][2], v2[j][3]); o2[64 * j] = w2; } }
        }
        for (int i = bid * 512 + tid; i < 3 * M; i += G * 512) SS1[i] = 0ull;
        for (int i = bid * 512 + tid; i < 512 * 160; i += G * 512) { const int c = i / 160, k = i % 160;
            const float v = (k < 32) ? p.in[10][k * 512 + c] : (k < 64) ? p.in[12][(k - 32) * 512 + c] : p.in[13][(k - 64) * 512 + c]; ((bf16_t*)(p.ws + WS_LORA))[i] = f2bf(v); }
        { const int gt = bid * 512 + tid;
          if (gt < 512) { const float* lt = p.in[6]; const float l0 = lt[gt], l1 = lt[512 + gt], l2 = lt[1024 + gt]; const float mx = fmaxf(l0, fmaxf(l1, l2));
              const float e0 = expf(l0 - mx), e1 = expf(l1 - mx), e2 = expf(l2 - mx); LBT[gt] = e0 / (e0 + e1 + e2); }
          const int i = gt - 512;
          if (i >= 0 && i < 16384) { const int gp = i >> 4, h = i & 15, g = gp >> 6; const float step = expf(p.in[23][g]); const float lr = p.in[21][gp], li = p.in[22][gp];
              const float mag = expf(lr * step); const float br = mag * cosf(li * step), bi = mag * sinf(li * step);
              if (h == 0) { LBR[gp] = br; LBI[gp] = bi; }
              const float den = lr * lr + li * li, nr = br - 1.f, ni = bi; const float cr = (nr * lr + ni * li) / den, ci = (ni * lr - nr * li) / den;
              const float xr2 = p.in[24][gp * 16 + h], xi2 = p.in[25][gp * 16 + h]; BBR[gp * 16 + h] = cr * xr2 - ci * xi2; BBI[gp * 16 + h] = cr * xi2 + ci * xr2; } }
    }
    grid.sync();
    STAMP(1);

    { pg8::Gemm g{XB, (const bf16_t*)(p.ws + WS_IN0), DM, DM, M, LDU0, DM}; pg8::StaticOrder S; S.init(M, LDU0, G, bid);
      pg8::EpiScaleBf16 E{U, LDU0, SS0}; pg8::gemm_phase<pg8::EpiScaleBf16, pg8::StaticOrder, true, true>(lds, g, S, E); }
    GSYNC();
    STAMP(2);

#define Rt ((bf16_t*)p.out)
#define At (Rt + (size_t)M * 512)
#define Bh (Rt + (size_t)M * 1024)
#define Kh (Rt + (size_t)M * 1536)
#define Vv XB
#define BVG (XB + (size_t)M * 512)
#define Gg ((bf16_t*)(p.ws + WS_MS))
#define GLc ((float*)(p.ws + WS_MS + 32 * MiB))
#define HEM ((float*)(p.ws + WS_MS + 64 * MiB))
#define HEL ((float*)(p.ws + WS_MS + 65 * MiB))
#define HELM ((float*)(p.ws + WS_MS + 66 * MiB))

    {
        PHASE_IDS
        const int hd = __builtin_amdgcn_readfirstlane(tid >> 6), fr = lane & 15, fq = lane >> 4;
        constexpr int SLS = 336;
        const bf16_t* LT = (const bf16_t*)(p.ws + WS_LORA);
        float mu_r[4], mu_k[4], mu_v[4], w0c[4], a0c[4], kkc[4], kac[4], rkc[4];
#pragma unroll
        for (int nt = 0; nt < 4; ++nt) { const int c = hd * 64 + 4 * fr + nt; mu_r[nt] = p.in[8][c]; mu_k[nt] = p.in[8][512 + c]; mu_v[nt] = p.in[8][1024 + c];
            w0c[nt] = p.in[9][c]; a0c[nt] = p.in[11][c]; kkc[nt] = p.in[14][c]; kac[nt] = p.in[15][c]; rkc[nt] = p.in[16][c]; }
        bf16_t sa_c[5], sa_p[5];
        const unsigned char* zsrc = p.ws + WS_CTL + 128 * 1024;
#define P2_FETCH(cidx_, RAWn_) { const int m0_ = (cidx_) * 16; const bool sq_ = (m0_ & (SEQ - 1)) == 0; \
            _Pragma("unroll") for (int i_ = 0; i_ < 5; ++i_) { const int id_ = tid + 512 * i_, t_ = id_ / 160, j_ = id_ % 160; const bf16_t* ur_ = U + (size_t)(m0_ + t_) * LDU0 + 3584 + j_; sa_c[i_] = ur_[0]; sa_p[i_] = ur_[-LDU0]; } \
            _Pragma("unroll") for (int i_ = 0; i_ < 7; ++i_) { const int q_ = hd + 8 * i_; if (q_ < 51) { const int row_ = q_ / 3, th_ = q_ % 3; \
                const unsigned char* g_ = (row_ == 0 && sq_) ? zsrc + th_ * 1024 + lane * 16 : (const unsigned char*)(U + ((size_t)m0_ + row_) * LDU0 - LDU0 + 2048 + th_ * 512 + lane * 8); \
                __builtin_amdgcn_global_load_lds((const unsigned*)g_, (LAS unsigned*)((RAWn_) + row_ * 3088 + th_ * 1024), 16, 0, 0); } } }
        P2_FETCH(bid, lds + 12288);
        int it = 0;
        for (int cidx = bid; cidx < M / 16; cidx += G, ++it) {
            const int m0 = cidx * 16; const bool seq0 = (m0 & (SEQ - 1)) == 0;
            LAS unsigned char* SL = lds + (it & 1) * (16 * SLS);
            LAS unsigned char* RAW = lds + 12288 + (it & 1) * 52496;
#pragma unroll
            for (int i = 0; i < 5; ++i) { const int id = tid + 512 * i, t = id / 160, j = id % 160;
                const float cur = bf2f(sa_c[i]); const float prev = (t == 0 && seq0) ? 0.f : bf2f(sa_p[i]); const float v = cur + (prev - cur) * p.in[8][1536 + j];
                *(LAS bf16_t*)(SL + t * SLS + j * 2) = f2bf((j < 32) ? tanhf_(v) : (j < 64 ? v : sigmoidf_(v))); }
            asm volatile("s_waitcnt vmcnt(0)" ::: "memory");
            __syncthreads();
            f32x4 dw[4], da[4], dg[4];
            { bf16x8 sf[5];
#pragma unroll
              for (int kk = 0; kk < 5; ++kk) sf[kk] = *(const LAS bf16x8*)(SL + fr * SLS + (kk * 32 + 8 * fq) * 2);
              const f32x4 z4 = {0.f, 0.f, 0.f, 0.f};
#pragma unroll
              for (int nt = 0; nt < 4; ++nt) { const bf16_t* lr = LT + (size_t)(hd * 64 + 4 * fr + nt) * 160 + 8 * fq;
                  const bf16x8 wf = *(const bf16x8*)lr, af = *(const bf16x8*)(lr + 32), g0 = *(const bf16x8*)(lr + 64), g1 = *(const bf16x8*)(lr + 96), g2 = *(const bf16x8*)(lr + 128);
                  dw[nt] = __builtin_amdgcn_mfma_f32_16x16x32_bf16(sf[0], wf, z4, 0, 0, 0); da[nt] = __builtin_amdgcn_mfma_f32_16x16x32_bf16(sf[1], af, z4, 0, 0, 0);
                  f32x4 g = __builtin_amdgcn_mfma_f32_16x16x32_bf16(sf[2], g0, z4, 0, 0, 0); g = __builtin_amdgcn_mfma_f32_16x16x32_bf16(sf[3], g1, g, 0, 0, 0); dg[nt] = __builtin_amdgcn_mfma_f32_16x16x32_bf16(sf[4], g2, g, 0, 0, 0); } }
            { const int cn = (cidx + G < M / 16) ? cidx + G : cidx; P2_FETCH(cn, lds + 12288 + ((it + 1) & 1) * 52496); }
            float as_[4][4], wd_[4][4];
            float ssq[4] = {0.f, 0.f, 0.f, 0.f}, bon[4] = {0.f, 0.f, 0.f, 0.f};
#pragma unroll
            for (int nt = 0; nt < 4; ++nt)
#pragma unroll
                for (int r = 0; r < 4; ++r) { const LAS bf16_t* rw = (const LAS bf16_t*)(RAW + (4 * fq + r) * 3088) + hd * 64 + 4 * fr + nt;
                    const float c0 = bf2f(rw[1544]), c1 = bf2f(rw[1544 + 512]);
                    const float p0 = bf2f(rw[0]), p1 = bf2f(rw[512]);
                    const float rv = c0 + (p0 - c0) * mu_r[nt], kv = c1 + (p1 - c1) * mu_k[nt];
                    const float wlog = -softplusf_(-(w0c[nt] + dw[nt][r])) - 0.5f;
                    wd_[nt][r] = __expf(-__expf(wlog));
                    const float a = sigmoidf_(a0c[nt] + da[nt][r]); as_[nt][r] = a;
                    const float kkv = kv * kkc[nt]; ssq[r] = fmaf(kkv, kkv, ssq[r]);
                    bon[r] = fmaf(rv * kv * (1.f + (a - 1.f) * kac[nt]), rkc[nt], bon[r]); }
#pragma unroll
            for (int r = 0; r < 4; ++r) { ssq[r] = 1.0f / fmaxf(sqrtf(row_sum16(ssq[r])), 1e-12f); bon[r] = row_sum16(bon[r]); }
            float gam[4][5];
#pragma unroll
            for (int nt = 0; nt < 4; ++nt) {
                const float q1 = wd_[nt][0], q2 = q1 * wd_[nt][1], q3 = q2 * wd_[nt][2], q4 = q3 * wd_[nt][3];
                const float t0 = __shfl(q4, fr), t1 = __shfl(q4, fr + 16), t2 = __shfl(q4, fr + 32);
                const float pre = (fq == 0) ? 1.f : (fq == 1) ? t0 : (fq == 2) ? t0 * t1 : t0 * t1 * t2;
                gam[nt][0] = pre; gam[nt][1] = pre * q1; gam[nt][2] = pre * q2; gam[nt][3] = pre * q3; gam[nt][4] = pre * q4; }
#pragma unroll
            for (int r = 0; r < 4; ++r) { const size_t o = (size_t)(m0 + 4 * fq + r) * 512 + hd * 64 + 4 * fr; const LAS bf16_t* rw = (const LAS bf16_t*)(RAW + (4 * fq + r) * 3088) + hd * 64 + 4 * fr;
                float oa[4], orr[4], ob[4], okk[4], ov[4], og[4], obv[4];
#pragma unroll
                for (int nt = 0; nt < 4; ++nt) {
                    const float c0 = bf2f(rw[1544 + nt]), c1 = bf2f(rw[1544 + 512 + nt]), c2 = bf2f(rw[1544 + 1024 + nt]);
                    const float p0 = bf2f(rw[nt]), p1 = bf2f(rw[512 + nt]), p2 = bf2f(rw[1024 + nt]);
                    const float rv = c0 + (p0 - c0) * mu_r[nt], kv = c1 + (p1 - c1) * mu_k[nt], vv = c2 + (p2 - c2) * mu_v[nt];
                    const float a = as_[nt][r], kk = kv * kkc[nt] * ssq[r], kp = kv * (1.f + (a - 1.f) * kac[nt]), ig = __builtin_amdgcn_rcpf(gam[nt][r + 1]), g = dg[nt][r];
                    oa[nt] = -kk * gam[nt][r]; orr[nt] = rv * gam[nt][r + 1]; ob[nt] = kk * a * ig; okk[nt] = kp * ig; ov[nt] = vv; og[nt] = g; obv[nt] = bon[r] * vv * g; }
                u32x2 w;
                w.x = pk2(oa[0], oa[1]); w.y = pk2(oa[2], oa[3]); *(u32x2*)(At + o) = w;
                w.x = pk2(orr[0], orr[1]); w.y = pk2(orr[2], orr[3]); *(u32x2*)(Rt + o) = w;
                w.x = pk2(ob[0], ob[1]); w.y = pk2(ob[2], ob[3]); *(u32x2*)(Bh + o) = w;
                w.x = pk2(okk[0], okk[1]); w.y = pk2(okk[2], okk[3]); *(u32x2*)(Kh + o) = w;
                w.x = pk2(ov[0], ov[1]); w.y = pk2(ov[2], ov[3]); *(u32x2*)(Vv + o) = w;
                w.x = pk2(og[0], og[1]); w.y = pk2(og[2], og[3]); *(u32x2*)(Gg + o) = w;
                w.x = pk2(obv[0], obv[1]); w.y = pk2(obv[2], obv[3]); *(u32x2*)(BVG + o) = w; }
            if (fq == 3) *(f32x4*)(GLc + (size_t)cidx * 512 + hd * 64 + 4 * fr) = (f32x4){gam[0][4], gam[1][4], gam[2][4], gam[3][4]};
        }
#undef P2_FETCH
        STAMP2(20, 0);
        {
            constexpr int HS = 272;
            LAS unsigned char* LQ = lds; LAS unsigned char* LF = lds + 64 * HS;
            int prow[2], pc8[2];
#pragma unroll
            for (int i = 0; i < 2; ++i) { const int pp = tid + 512 * i; prow[i] = pp >> 4; pc8[i] = (pp & 15) * 8; }
            u32x4 rq[2], rf[2]; f32x4 lbn[2][2];
#define HP_FETCH(t_) { const int ch_ = (t_) >> 2, hh_ = (t_) & 3; _Pragma("unroll") for (int i_ = 0; i_ < 2; ++i_) { const bf16_t* r_ = U + ((size_t)ch_ * 64 + prow[i_]) * LDU0 + hh_ * 128 + pc8[i_]; rq[i_] = *(const u32x4*)r_; rf[i_] = *(const u32x4*)(r_ + 512); \
                const float* l_ = LBT + hh_ * 128 + (wave + 8 * i_) * 8; lbn[i_][0] = *(const f32x4*)l_; lbn[i_][1] = *(const f32x4*)(l_ + 4); } }
            asm volatile("s_waitcnt vmcnt(0)" ::: "memory");
            __syncthreads();
            HP_FETCH(bid);
            for (int tl = bid; tl < (M / 64) * 4; tl += G) {
                const int ch = tl >> 2, hh = tl & 3;
#pragma unroll
                for (int i = 0; i < 2; ++i) { *(LAS u32x4*)(LQ + prow[i] * HS + pc8[i] * 2) = rq[i]; *(LAS u32x4*)(LF + prow[i] * HS + pc8[i] * 2) = rf[i]; }
                const float lbv[2][8] = {{lbn[0][0][0], lbn[0][0][1], lbn[0][0][2], lbn[0][0][3], lbn[0][1][0], lbn[0][1][1], lbn[0][1][2], lbn[0][1][3]}, {lbn[1][0][0], lbn[1][0][1], lbn[1][0][2], lbn[1][0][3], lbn[1][1][0], lbn[1][1][1], lbn[1][1][2], lbn[1][1][3]}};
                __syncthreads();
                { const int tn = (tl + G < (M / 64) * 4) ? tl + G : tl; HP_FETCH(tn); }
#pragma unroll
                for (int gi = 0; gi < 2; ++gi) { const int cg = wave + 8 * gi, c0 = hh * 128 + cg * 8;
                    LAS u32x4* lq = (LAS u32x4*)(LQ + lane * HS + cg * 16); LAS u32x4* lf = (LAS u32x4*)(LF + lane * HS + cg * 16);
                    const u32x4 wq = *lq, wf = *lf;
                    const unsigned wqa[4] = {wq.x, wq.y, wq.z, wq.w}, wfa[4] = {wf.x, wf.y, wf.z, wf.w};
                    unsigned oq[4], ok[4];
#pragma unroll
                    for (int j = 0; j < 8; ++j) { const float aq = (j & 1) ? bfhi(wqa[j >> 1]) : bflo(wqa[j >> 1]), af = (j & 1) ? bfhi(wfa[j >> 1]) : bflo(wfa[j >> 1]);
                        const float kv = (1.f - lbv[gi][j]) * sigmoidf_(-af);
                        float bs = __logf(1.f - kv);
                        bs += __int_as_float(__builtin_amdgcn_update_dpp(0, __float_as_int(bs), 0x111, 0xf, 0xf, true)); bs += __int_as_float(__builtin_amdgcn_update_dpp(0, __float_as_int(bs), 0x112, 0xf, 0xf, true));
                        bs += __int_as_float(__builtin_amdgcn_update_dpp(0, __float_as_int(bs), 0x114, 0xf, 0xf, true)); bs += __int_as_float(__builtin_amdgcn_update_dpp(0, __float_as_int(bs), 0x118, 0xf, 0xf, true));
                        bs += __int_as_float(__builtin_amdgcn_update_dpp(0, __float_as_int(bs), 0x142, 0xa, 0xf, false)); bs += __int_as_float(__builtin_amdgcn_update_dpp(0, __float_as_int(bs), 0x143, 0xc, 0xf, false));
                        const float bm = __int_as_float(__builtin_amdgcn_readlane(__float_as_int(bs), 31)), bL = __int_as_float(__builtin_amdgcn_readlane(__float_as_int(bs), 63));
                        const float qt = siluf_(aq) * __expf(bs - bm), kt = kv * __expf(bm - bs);
                        if (j & 1) { oq[j >> 1] = pk2(__uint_as_float(oq[j >> 1]), qt); ok[j >> 1] = pk2(__uint_as_float(ok[j >> 1]), kt); } else { oq[j >> 1] = __float_as_uint(qt); ok[j >> 1] = __float_as_uint(kt); }
                        if (lane == 0) { const size_t vo = (size_t)ch * 512 + c0 + j; HEM[vo] = __expf(bm); HEL[vo] = __expf(bL); HELM[vo] = __expf(bL - bm); } }
                    u32x4 w; w.x = oq[0]; w.y = oq[1]; w.z = oq[2]; w.w = oq[3]; *lq = w;
                    w.x = ok[0]; w.y = ok[1]; w.z = ok[2]; w.w = ok[3]; *lf = w; }
                __syncthreads();
#pragma unroll
                for (int i = 0; i < 2; ++i) { bf16_t* r = U + ((size_t)ch * 64 + prow[i]) * LDU0 + hh * 128 + pc8[i];
                    *(u32x4*)r = *(const LAS u32x4*)(LQ + prow[i] * HS + pc8[i] * 2); *(u32x4*)(r + 512) = *(const LAS u32x4*)(LF + prow[i] * HS + pc8[i] * 2); }
            }
#undef HP_FETCH
        }
    }
    GSYNC();
    STAMP(3);

    for (int item = bid; item < 256; item += G) {
        PHASE_IDS
        const int w = __builtin_amdgcn_readfirstlane(tid >> 6), fr = lane & 15, fq = lane >> 4;
        const int grp_ = (item & 7) * 8 + (item >> 5), vt = (item >> 3) & 3, h = grp_ & 7, b = grp_ >> 3;
        constexpr int BUF = 20992, oRt = 0, oAt = 2304, oBh = 4608, oKh = 6912, oBT = 9216, oKT = 14336, oVT = 19456, oGL = 20736;
        constexpr int oMS = 4 * BUF, MSET = 3840, oAf = oMS + 3 * MSET, oTT = oAf + 2 * 1024, oWT = oTT + 2 * 1280, oUT = oWT + 1280, oST = oUT + 1280, LTOT = oST + 2304;
        constexpr int NCH = SEQ / 16;
        LAS unsigned char* L = lds;
        __syncthreads();
        for (int i = tid; i < LTOT / 4; i += 512) ((LAS unsigned*)L)[i] = 0u;
        __syncthreads();
        const size_t tok0 = (size_t)b * SEQ; const size_t colb = (size_t)h * 64;
#define RC_F144(B_, off_, kk_) (*(const LAS bf16x8*)((B_) + (off_) + fr * 144 + ((kk_) * 32 + 8 * fq) * 2))
#define RC_F80(base_, row0_) (*(const LAS bf16x8*)((base_) + ((row0_) + fr) * 80 + (8 * fq) * 2))
        if (w >= 3) {
            const int lt = tid - 192;
            const bf16_t* arr[4] = {Rt, At, Bh, Kh};
            const int q0 = lt, q1 = lt + 320;
            const int kind1 = (q1 < 512) ? 0 : (q1 < 544) ? 1 : (q1 < 560) ? 2 : 3;
            const char* gp0 = (const char*)(arr[q0 >> 7] + (tok0 + ((q0 >> 3) & 15)) * 512 + colb + (q0 & 7) * 8);
            const char* gp1 = kind1 == 0 ? (const char*)(arr[(q1 >> 7) & 3] + (tok0 + ((q1 >> 3) & 15)) * 512 + colb + (q1 & 7) * 8)
                            : kind1 == 1 ? (const char*)(Vv + (tok0 + ((q1 - 512) >> 1)) * 512 + colb + vt * 16 + ((q1 - 512) & 1) * 8)
                            : kind1 == 2 ? (const char*)(GLc + ((size_t)b * NCH) * 512 + colb + (q1 - 544) * 4) : gp0;
            const size_t st1 = (kind1 == 2) ? (size_t)512 * 4 : (size_t)16 * 512 * 2;
            u32x4 d0[2], d1[2], d2[2], d3[2];
#define RP_H(w_, j_) ((bf16_t)(((j_) & 1) ? ((w_) >> 16) : ((w_) & 0xffffu)))
#define RP_FETCH(D_, c_) { const size_t cc_ = (size_t)((c_) < NCH ? (c_) : NCH - 1); D_[0] = *(const u32x4*)(gp0 + cc_ * (size_t)(16 * 512 * 2)); D_[1] = *(const u32x4*)(gp1 + cc_ * st1); }
#define RP_TILE(B_, q_, D_) { const int tl_ = (q_) >> 7, t_ = ((q_) >> 3) & 15, k_ = ((q_) & 7) * 8; const unsigned w4_[4] = {D_.x, D_.y, D_.z, D_.w}; *(LAS u32x4*)((B_) + tl_ * 2304 + t_ * 144 + k_ * 2) = D_; \
                if (tl_ >= 2) { LAS bf16_t* x_ = (LAS bf16_t*)((B_) + (tl_ == 2 ? oBT : oKT) + k_ * 80 + t_ * 2); const int g_ = (q_) & 7; \
                    _Pragma("unroll") for (int j_ = 0; j_ < 8; ++j_) { const int jj_ = (j_ + g_) & 7; const unsigned ww_ = (jj_ >> 1) == 0 ? w4_[0] : (jj_ >> 1) == 1 ? w4_[1] : (jj_ >> 1) == 2 ? w4_[2] : w4_[3]; x_[jj_ * 40] = (bf16_t)(ww_ >> ((jj_ & 1) * 16)); } } }
#define RP_STORE(D_, buf_) { LAS unsigned char* B_ = L + (buf_) * BUF; RP_TILE(B_, q0, D_[0]); \
                if (kind1 == 0) { RP_TILE(B_, q1, D_[1]); } \
                else if (kind1 == 1) { const int vq_ = q1 - 512; const unsigned w4_[4] = {D_[1].x, D_[1].y, D_[1].z, D_[1].w}; LAS bf16_t* x_ = (LAS bf16_t*)(B_ + oVT + ((vq_ & 1) * 8) * 80 + (vq_ >> 1) * 2); _Pragma("unroll") for (int j_ = 0; j_ < 8; ++j_) x_[j_ * 40] = RP_H(w4_[j_ >> 1], j_); } \
                else if (kind1 == 2) *(LAS u32x4*)(B_ + oGL + (q1 - 544) * 16) = D_[1]; }
            RP_FETCH(d0, 0); RP_STORE(d0, 0); RP_FETCH(d0, 1); RP_STORE(d0, 1); RP_FETCH(d0, 2); RP_STORE(d0, 2);
            RP_FETCH(d3, 3); RP_FETCH(d0, 4); RP_FETCH(d1, 5); RP_FETCH(d2, 6);
            LBAR(); LBAR(); LBAR();
            for (int i = 0; i < NCH; i += 4) {
                if (i + 3 < NCH) RP_STORE(d3, (i + 3) & 3);
                RP_FETCH(d3, i + 7);
                LBAR();
                if (i + 4 < NCH) RP_STORE(d0, (i + 4) & 3);
                RP_FETCH(d0, i + 8);
                LBAR();
                if (i + 5 < NCH) RP_STORE(d1, (i + 5) & 3);
                RP_FETCH(d1, i + 9);
                LBAR();
                if (i + 6 < NCH) RP_STORE(d2, (i + 6) & 3);
                RP_FETCH(d2, i + 10);
                LBAR();
            }
#undef RP_TILE
#undef RP_FETCH
#undef RP_H
#undef RP_STORE
        } else if (w == 1) {
            auto amats = [&](int cc) {
                const LAS unsigned char* B_ = L + (cc & 3) * BUF; LAS unsigned char* Ms = L + oMS + (cc % 3) * MSET; LAS unsigned char* Af = L + oAf + (cc & 1) * 1024;
                const bf16x8 a0 = RC_F144(B_, oAt, 0), a1 = RC_F144(B_, oAt, 1), r0 = RC_F144(B_, oRt, 0), r1 = RC_F144(B_, oRt, 1), b0 = RC_F144(B_, oBh, 0), b1 = RC_F144(B_, oBh, 1), k0 = RC_F144(B_, oKh, 0), k1 = RC_F144(B_, oKh, 1);
                const f32x4 z4 = {0.f, 0.f, 0.f, 0.f};
                f32x4 dab = __builtin_amdgcn_mfma_f32_16x16x32_bf16(a0, b0, z4, 0, 0, 0); dab = __builtin_amdgcn_mfma_f32_16x16x32_bf16(a1, b1, dab, 0, 0, 0);
                f32x4 dak = __builtin_amdgcn_mfma_f32_16x16x32_bf16(a0, k0, z4, 0, 0, 0); dak = __builtin_amdgcn_mfma_f32_16x16x32_bf16(a1, k1, dak, 0, 0, 0);
                f32x4 drb = __builtin_amdgcn_mfma_f32_16x16x32_bf16(r0, b0, z4, 0, 0, 0); drb = __builtin_amdgcn_mfma_f32_16x16x32_bf16(r1, b1, drb, 0, 0, 0);
                f32x4 drk = __builtin_amdgcn_mfma_f32_16x16x32_bf16(r0, k0, z4, 0, 0, 0); drk = __builtin_amdgcn_mfma_f32_16x16x32_bf16(r1, k1, drk, 0, 0, 0);
#pragma unroll
                for (int r = 0; r < 4; ++r) { const int t = 4 * fq + r; const bool st = fr < t, le = fr <= t;
                    *(LAS float*)(Af + t * 64 + fr * 4) = st ? dab[r] : 0.f;
                    *(LAS bf16_t*)(Ms + t * 80 + fr * 2) = f2bf(st ? dak[r] : 0.f);
                    *(LAS bf16_t*)(Ms + 1280 + t * 80 + fr * 2) = f2bf(le ? drb[r] : 0.f);
                    *(LAS bf16_t*)(Ms + 2560 + t * 80 + fr * 2) = f2bf(le ? drk[r] : 0.f); } };
            LBAR();
            amats(0);
            LBAR();
            amats(1);
            LBAR();
            for (int i = 0; i < NCH; ++i) { if (i + 2 < NCH) amats(i + 2); LBAR(); }
        } else if (w == 2) {
            auto tinv = [&](int cc) {
                const LAS unsigned char* Af = L + oAf + (cc & 1) * 1024; LAS unsigned char* Tt = L + oTT + (cc & 1) * 1280;
                f32x4 am[16][4];
#pragma unroll
                for (int t = 1; t < 16; ++t)
#pragma unroll
                    for (int sq = 0; sq < 4; ++sq) if (4 * sq < t) am[t][sq] = *(const LAS f32x4*)(Af + t * 64 + sq * 16);
                asm volatile("s_waitcnt lgkmcnt(0)" ::: "memory");
                float x[16];
#pragma unroll
                for (int t = 0; t < 16; ++t) {
                    float acc0 = (t == fr) ? 1.f : 0.f, acc1 = 0.f;
#pragma unroll
                    for (int sq = 0; sq < 4; ++sq) { if (4 * sq < t) {
#pragma unroll
                        for (int e = 0; e < 4; ++e) { const int s = 4 * sq + e; if (s < t) { if (s & 1) acc1 = fmaf(am[t][sq][e], x[s], acc1); else acc0 = fmaf(am[t][sq][e], x[s], acc0); } } } }
                    x[t] = acc0 + acc1; }
                if (fq == 0) {
#pragma unroll
                    for (int t = 0; t < 16; ++t) *(LAS bf16_t*)(Tt + t * 80 + fr * 2) = f2bf(x[t]); } };
            LBAR(); LBAR();
            tinv(0);
            LBAR();
            for (int i = 0; i < NCH; ++i) { if (i + 1 < NCH) tinv(i + 1); LBAR(); }
        } else {
#define RC_R8(p_) (*(const LAS s16x4*)(p_))
#define RC_CAT(x_, y_) __builtin_shufflevector((x_), (y_), 0, 1, 2, 3, 4, 5, 6, 7)
#define RC_PK4(v_) __builtin_bit_cast(s16x4, (u32x2){pk2((v_)[0], (v_)[1]), pk2((v_)[2], (v_)[3])})
            f32x4 Sacc[4]; s16x4 sp[4];
#pragma unroll
            for (int kt = 0; kt < 4; ++kt) { Sacc[kt] = (f32x4){0.f, 0.f, 0.f, 0.f}; sp[kt] = (s16x4){0, 0, 0, 0}; }
            bf16_t* yg = Vv + tok0 * 512 + colb + vt * 16 + fr;
            LBAR(); LBAR(); LBAR();
            for (int i = 0; i < NCH; ++i) {
                const LAS unsigned char* B_ = L + (i & 3) * BUF; const LAS unsigned char* Ms = L + oMS + (i % 3) * MSET; const LAS unsigned char* Tt = L + oTT + (i & 1) * 1280;
                const LAS unsigned char* ap = B_ + oAt + fr * 144 + (4 * fq) * 2; const LAS unsigned char* rp = B_ + oRt + fr * 144 + (4 * fq) * 2;
                const bf16x8 a0 = RC_CAT(RC_R8(ap), RC_R8(ap + 32)), a1 = RC_CAT(RC_R8(ap + 64), RC_R8(ap + 96)), r0 = RC_CAT(RC_R8(rp), RC_R8(rp + 32)), r1 = RC_CAT(RC_R8(rp + 64), RC_R8(rp + 96));
                const bf16x8 vtf = RC_F80(B_ + oVT, 0), makf = RC_F80(Ms, 0), mrkf = RC_F80(Ms + 2560, 0);
                const s16x4 tt4 = RC_R8(Tt + fr * 80 + (4 * fq) * 2), mrb4 = RC_R8(Ms + 1280 + fr * 80 + (4 * fq) * 2);
                bf16x8 ktf[4]; s16x4 bt4[4]; f32x4 glv[4];
#pragma unroll
                for (int kt = 0; kt < 4; ++kt) { bt4[kt] = RC_R8(B_ + oBT + (kt * 16 + fr) * 80 + (4 * fq) * 2); ktf[kt] = RC_F80(B_ + oKT, kt * 16); glv[kt] = *(const LAS f32x4*)(B_ + oGL + (kt * 16 + 4 * fq) * 4); }
                asm volatile("s_waitcnt lgkmcnt(0)" ::: "memory");
                const f32x4 z4 = {0.f, 0.f, 0.f, 0.f};
                const bf16x8 sb0 = RC_CAT(sp[0], sp[1]), sb1 = RC_CAT(sp[2], sp[3]);
                f32x4 dw = __builtin_amdgcn_mfma_f32_16x16x32_bf16(a0, sb0, z4, 0, 0, 0); dw = __builtin_amdgcn_mfma_f32_16x16x32_bf16(a1, sb1, dw, 0, 0, 0);
                dw = __builtin_amdgcn_mfma_f32_16x16x32_bf16(makf, vtf, dw, 0, 0, 0);
                f32x4 dy = __builtin_amdgcn_mfma_f32_16x16x32_bf16(r0, sb0, z4, 0, 0, 0); dy = __builtin_amdgcn_mfma_f32_16x16x32_bf16(r1, sb1, dy, 0, 0, 0);
                dy = __builtin_amdgcn_mfma_f32_16x16x32_bf16(mrkf, vtf, dy, 0, 0, 0);
                f32x4 sk[4];
#pragma unroll
                for (int kt = 0; kt < 4; ++kt) sk[kt] = __builtin_amdgcn_mfma_f32_16x16x32_bf16(ktf[kt], vtf, Sacc[kt], 0, 0, 0);
                const f32x4 du = __builtin_amdgcn_mfma_f32_16x16x16bf16_1k(tt4, RC_PK4(dw), z4, 0, 0, 0);
                const s16x4 u4 = RC_PK4(du);
                dy = __builtin_amdgcn_mfma_f32_16x16x16bf16_1k(mrb4, u4, dy, 0, 0, 0);
#pragma unroll
                for (int kt = 0; kt < 4; ++kt) {
                    f32x4 sa = __builtin_amdgcn_mfma_f32_16x16x16bf16_1k(bt4[kt], u4, sk[kt], 0, 0, 0);
                    sa = sa * glv[kt]; Sacc[kt] = sa; sp[kt] = RC_PK4(sa); }
                { bf16_t* yo = yg + (size_t)(i * 16 + 4 * fq) * 512; yo[0] = f2bf(dy[0]); yo[512] = f2bf(dy[1]); yo[1024] = f2bf(dy[2]); yo[1536] = f2bf(dy[3]); }
                LBAR();
            }
#undef RC_R8
#undef RC_CAT
#undef RC_PK4
        }
#undef RC_F144
#undef RC_F80
    }
    STAMP(17);
    for (int item = bid; item < 256; item += G) {
        PHASE_IDS
        const int w = __builtin_amdgcn_readfirstlane(tid >> 6), fr = lane & 15, fq = lane >> 4;
        const int grp_ = (item & 7) * 4 + (item >> 6), vs = (item >> 3) & 7, h = grp_ & 3, b = grp_ >> 2;
        constexpr int QS = 272, TS = 144;
        constexpr int BUFB = 38656, oQ = 0, oK = 17408, oVT = 34816, oV = 37120, oP = 2 * BUFB, oCT = oP + 9216;
        LAS unsigned char* L = lds;
        const size_t tok0 = (size_t)b * SEQ;
        int prow[2], pc8[2];
#pragma unroll
        for (int i = 0; i < 2; ++i) { const int pp = tid + 512 * i; prow[i] = pp >> 4; pc8[i] = (pp & 15) * 8; }
        const int vrow = tid & 63, vpart = (tid >> 6) & 1;
        u32x4 qa[2], ka[2], va = {0u, 0u, 0u, 0u}; float vem = 0.f, vel = 0.f, velm = 0.f;
#define HM_FETCH(c_) { const size_t tb_ = tok0 + (size_t)(c_) * 64; _Pragma("unroll") for (int i_ = 0; i_ < 2; ++i_) { const bf16_t* r_ = U + (tb_ + prow[i_]) * LDU0 + h * 128 + pc8[i_]; qa[i_] = *(const u32x4*)r_; ka[i_] = *(const u32x4*)(r_ + 512); } \
            { va = *(const u32x4*)(U + (tb_ + vrow) * LDU0 + 1024 + h * 128 + vs * 16 + vpart * 8); const size_t vo_ = ((size_t)b * (SEQ / 64) + (c_)) * 512 + h * 128 + (tid & 127); vem = HEM[vo_]; vel = HEL[vo_]; velm = HELM[vo_]; } }
#define HM_H(w_, j_) ((bf16_t)(((j_) & 1) ? ((w_) >> 16) : ((w_) & 0xffffu)))
#define HM_STORE(bo_) { _Pragma("unroll") for (int i_ = 0; i_ < 2; ++i_) { *(LAS u32x4*)(L + (bo_) + oQ + prow[i_] * QS + pc8[i_] * 2) = qa[i_]; *(LAS u32x4*)(L + (bo_) + oK + prow[i_] * QS + pc8[i_] * 2) = ka[i_]; } \
            if (tid < 128) { LAS bf16_t* vt_ = (LAS bf16_t*)(L + (bo_) + oVT + (vpart * 8) * TS + vrow * 2); const unsigned vw4_[4] = {va.x, va.y, va.z, va.w}; \
                _Pragma("unroll") for (int j_ = 0; j_ < 8; ++j_) vt_[j_ * (TS / 2)] = HM_H(vw4_[j_ >> 1], j_); \
                ((LAS float*)(L + (bo_) + oV))[tid] = vem; ((LAS float*)(L + (bo_) + oV))[128 + tid] = vel; ((LAS float*)(L + (bo_) + oV))[256 + tid] = velm; } }
#define HM_FRAG(off_, row_, stride_, kk_) (*(const LAS bf16x8*)(L + (off_) + ((row_) + fr) * (stride_) + ((kk_) * 32 + 8 * fq) * 2))
#define HM_TR4(p_) __builtin_amdgcn_ds_read_tr16_b64_v4i16((LAS s16x4*)(p_))
        __syncthreads();
        for (int i = tid; i < (9216 + 4352) / 4; i += 512) ((LAS unsigned*)(L + oP))[i] = 0u;
        HM_FETCH(0); HM_STORE(0); HM_FETCH(1);
        LBAR();
        f32x4 Cacc = {0.f, 0.f, 0.f, 0.f};
        const int ktoff = oK + ((lane >> 4) * 8 + ((lane >> 2) & 3)) * QS + (w * 16 + (lane & 3) * 4) * 2;
        for (int c = 0; c < SEQ / 64; ++c) {
            const int bo = (c & 1) * BUFB, bn = BUFB - bo;
            { const int k0 = w * 16 + 4 * fq; const LAS float* vEM = (const LAS float*)(L + bo + oV);
              u32x2 cw; cw.x = pk2(Cacc[0] * vEM[k0], Cacc[1] * vEM[k0 + 1]); cw.y = pk2(Cacc[2] * vEM[k0 + 2], Cacc[3] * vEM[k0 + 3]);
              *(LAS u32x2*)(L + oCT + fr * QS + k0 * 2) = cw; }
            { const int sb = w >> 1, tb0 = (w & 1) * 2;
              if (sb <= tb0 + 1) { const bool two = sb <= tb0;
                  bf16x8 kf[4], q0f[4], q1f[4];
#pragma unroll
                  for (int kk = 0; kk < 4; ++kk) { kf[kk] = HM_FRAG(bo + oK, sb * 16, QS, kk); q1f[kk] = HM_FRAG(bo + oQ, tb0 * 16 + 16, QS, kk); }
                  if (two) {
#pragma unroll
                      for (int kk = 0; kk < 4; ++kk) q0f[kk] = HM_FRAG(bo + oQ, tb0 * 16, QS, kk); }
                  f32x4 a0 = {0.f, 0.f, 0.f, 0.f}, a1 = {0.f, 0.f, 0.f, 0.f};
                  if (two) {
#pragma unroll
                      for (int kk = 0; kk < 4; ++kk) { a0 = __builtin_amdgcn_mfma_f32_16x16x32_bf16(kf[kk], q0f[kk], a0, 0, 0, 0); a1 = __builtin_amdgcn_mfma_f32_16x16x32_bf16(kf[kk], q1f[kk], a1, 0, 0, 0); }
                  } else {
#pragma unroll
                      for (int kk = 0; kk < 4; ++kk) a1 = __builtin_amdgcn_mfma_f32_16x16x32_bf16(kf[kk], q1f[kk], a1, 0, 0, 0);
                  }
                  const int s0 = sb * 16 + 4 * fq;
#pragma unroll
                  for (int j = 0; j < 2; ++j) { if (j == 1 || two) { const int t = (tb0 + j) * 16 + fr; const f32x4 a = j ? a1 : a0;
                      u32x2 pw; pw.x = pk2((s0 <= t) ? a[0] : 0.f, (s0 + 1 <= t) ? a[1] : 0.f); pw.y = pk2((s0 + 2 <= t) ? a[2] : 0.f, (s0 + 3 <= t) ? a[3] : 0.f);
                      *(LAS u32x2*)(L + oP + t * TS + s0 * 2) = pw; } } } }
            LBAR();
            if (c + 1 < SEQ / 64) HM_STORE(bn);
            HM_FETCH((c + 2 < SEQ / 64) ? c + 2 : c);
            if (w < 4) { f32x4 d = {0.f, 0.f, 0.f, 0.f};
#pragma unroll
                for (int kk = 0; kk < 2; ++kk) d = __builtin_amdgcn_mfma_f32_16x16x32_bf16(HM_FRAG(oP, w * 16, TS, kk), HM_FRAG(bo + oVT, 0, TS, kk), d, 0, 0, 0);
#pragma unroll
                for (int kk = 0; kk < 4; ++kk) d = __builtin_amdgcn_mfma_f32_16x16x32_bf16(HM_FRAG(bo + oQ, w * 16, QS, kk), HM_FRAG(oCT, 0, QS, kk), d, 0, 0, 0);
                bf16_t* op = U + (tok0 + (size_t)c * 64 + w * 16 + 4 * fq) * LDU0 + 1024 + h * 128 + vs * 16 + fr;
                op[0] = f2bf(d[0]); op[LDU0] = f2bf(d[1]); op[2 * LDU0] = f2bf(d[2]); op[3 * LDU0] = f2bf(d[3]); }
            { f32x4 tmp = {0.f, 0.f, 0.f, 0.f};
              const LAS unsigned char* kt = L + bo + ktoff;
#pragma unroll
              for (int kk = 0; kk < 2; ++kk) { const bf16x8 ktf = __builtin_shufflevector(HM_TR4(kt + kk * 32 * QS), HM_TR4(kt + kk * 32 * QS + 4 * QS), 0, 1, 2, 3, 4, 5, 6, 7);
                  tmp = __builtin_amdgcn_mfma_f32_16x16x32_bf16(ktf, HM_FRAG(bo + oVT, 0, TS, kk), tmp, 0, 0, 0); }
              const int k0 = w * 16 + 4 * fq; const LAS float* vEL = (const LAS float*)(L + bo + oV) + 128; const LAS float* vELM = vEL + 128;
#pragma unroll
              for (int r = 0; r < 4; ++r) Cacc[r] = Cacc[r] * vEL[k0 + r] + tmp[r] * vELM[k0 + r]; }
            LBAR();
        }
#undef HM_TR4
#undef HM_FETCH
#undef HM_STORE
#undef HM_FRAG
#undef HM_H
    }
    GSYNC();
    STAMP(4);

    {
        PHASE_IDS
        const int gw = bid * 8 + wave, NWH = G * 4;
        const int c8 = lane * 8;
        if ((gw & 1) == 0) {
            const f32x4 an0 = *(const f32x4*)(p.in[7] + c8), an1 = *(const f32x4*)(p.in[7] + c8 + 4);
            for (int m0 = gw >> 1; m0 < M; m0 += NWH * 4) {
                u32x4 xo[4], xg[4];
#pragma unroll
                for (int u = 0; u < 4; ++u) { const int m = m0 + u * NWH; const bf16_t* ur = U + (size_t)m * LDU0 + c8; xo[u] = *(const u32x4*)(ur + 1024); xg[u] = *(const u32x4*)(ur + 1536); }
#pragma unroll
                for (int u = 0; u < 4; ++u) { const int m = m0 + u * NWH; {
                    const float o[8] = {bflo(xo[u].x), bfhi(xo[u].x), bflo(xo[u].y), bfhi(xo[u].y), bflo(xo[u].z), bfhi(xo[u].z), bflo(xo[u].w), bfhi(xo[u].w)};
                    const float g[8] = {bflo(xg[u].x), bfhi(xg[u].x), bflo(xg[u].y), bfhi(xg[u].y), bflo(xg[u].z), bfhi(xg[u].z), bflo(xg[u].w), bfhi(xg[u].w)};
                    float ss = 0.f;
#pragma unroll
                    for (int e = 0; e < 8; ++e) ss = fmaf(o[e], o[e], ss);
                    const float rs = 1.0f / sqrtf(row_sum16(ss) * (1.f / 128.f) + RMS_EPS);
                    u32x4 w; w.x = pk2(o[0] * rs * an0[0] * siluf_(g[0]), o[1] * rs * an0[1] * siluf_(g[1])); w.y = pk2(o[2] * rs * an0[2] * siluf_(g[2]), o[3] * rs * an0[3] * siluf_(g[3]));
                    w.z = pk2(o[4] * rs * an1[0] * siluf_(g[4]), o[5] * rs * an1[1] * siluf_(g[5])); w.w = pk2(o[6] * rs * an1[2] * siluf_(g[6]), o[7] * rs * an1[3] * siluf_(g[7]));
                    *(u32x4*)(YC + (size_t)m * DM + c8) = w; } }
            }
        } else {
            const f32x4 lw0 = *(const f32x4*)(p.in[17] + c8), lw1 = *(const f32x4*)(p.in[17] + c8 + 4), lb0 = *(const f32x4*)(p.in[18] + c8), lb1 = *(const f32x4*)(p.in[18] + c8 + 4);
            for (int m0 = gw >> 1; m0 < M; m0 += NWH * 4) {
                u32x4 xy[4], xg[4], xb[4];
#pragma unroll
                for (int u = 0; u < 4; ++u) { const int m = m0 + u * NWH; const size_t i = (size_t)m * 512 + c8; xy[u] = *(const u32x4*)(Vv + i); xg[u] = *(const u32x4*)(Gg + i); xb[u] = *(const u32x4*)(BVG + i); }
#pragma unroll
                for (int u = 0; u < 4; ++u) { const int m = m0 + u * NWH; {
                    const float y[8] = {bflo(xy[u].x), bfhi(xy[u].x), bflo(xy[u].y), bfhi(xy[u].y), bflo(xy[u].z), bfhi(xy[u].z), bflo(xy[u].w), bfhi(xy[u].w)};
                    const float g[8] = {bflo(xg[u].x), bfhi(xg[u].x), bflo(xg[u].y), bfhi(xg[u].y), bflo(xg[u].z), bfhi(xg[u].z), bflo(xg[u].w), bfhi(xg[u].w)};
                    const float bv[8] = {bflo(xb[u].x), bfhi(xb[u].x), bflo(xb[u].y), bfhi(xb[u].y), bflo(xb[u].z), bfhi(xb[u].z), bflo(xb[u].w), bfhi(xb[u].w)};
                    float s1 = 0.f;
#pragma unroll
                    for (int e = 0; e < 8; ++e) s1 += y[e];
                    s1 += dpp_mov<0xB1>(s1); s1 += dpp_mov<0x4E>(s1); s1 += dpp_mov<0x141>(s1);
                    const float mean = s1 * (1.f / 64.f); float s2 = 0.f;
#pragma unroll
                    for (int e = 0; e < 8; ++e) { const float d = y[e] - mean; s2 = fmaf(d, d, s2); }
                    s2 += dpp_mov<0xB1>(s2); s2 += dpp_mov<0x4E>(s2); s2 += dpp_mov<0x141>(s2);
                    const float rs = 1.0f / sqrtf(s2 * (1.f / 64.f) + 64e-5f);
                    float r8[8];
#pragma unroll
                    for (int e = 0; e < 8; ++e) { const float lw = e < 4 ? lw0[e] : lw1[e - 4], lb = e < 4 ? lb0[e] : lb1[e - 4]; r8[e] = ((y[e] - mean) * rs * lw + lb) * g[e] + bv[e]; }
                    u32x4 w; w.x = pk2(r8[0], r8[1]); w.y = pk2(r8[2], r8[3]); w.z = pk2(r8[4], r8[5]); w.w = pk2(r8[6], r8[7]);
                    *(u32x4*)(YC + (size_t)m * DM + 512 + c8) = w; } }
            }
        }
    }
    GSYNC();
    STAMP(5);

    { pg8::Gemm g{YC, (const bf16_t*)(p.ws + WS_OUT0), DM, DM, M, DM, DM}; pg8::StaticOrder S; S.init(M, DM, G, bid);
      pg8::EpiResidual<true, true> E{p.in[0], nullptr, XB, SS1}; pg8::gemm_phase<pg8::EpiResidual<true, true>, pg8::StaticOrder, true, true>(lds, g, S, E); }
    GSYNC();
    STAMP(6);
#define HID U
    { pg8::Gemm g{XB, (const bf16_t*)(p.ws + WS_GU0), DM, DM, M, 2 * FFN, DM}; pg8::StaticOrder S; S.init(M, 2 * FFN, G, bid);
      pg8::EpiSwiGlu E{HID, FFN, SS1}; pg8::gemm_phase<pg8::EpiSwiGlu, pg8::StaticOrder, true, true>(lds, g, S, E); }
    GSYNC();
    STAMP(7);
    { pg8::Gemm g{HID, (const bf16_t*)(p.ws + WS_D0), FFN, FFN, M, DM, FFN}; pg8::StaticOrder S; S.init(M, DM, G, bid);
      pg8::EpiResidual<false, true> E{nullptr, XB, XB, SS2}; pg8::gemm_phase<pg8::EpiResidual<false, true>, pg8::StaticOrder, true, true>(lds, g, S, E); }
    GSYNC();
    STAMP(8);
    { pg8::Gemm g{XB, (const bf16_t*)(p.ws + WS_IN1), DM, DM, M, NP1, DM}; pg8::StaticOrder S; S.init(M, NP1, G, bid);
      pg8::EpiScaleBf16 E{U, LDU1, SS2}; pg8::gemm_phase<pg8::EpiScaleBf16, pg8::StaticOrder, true, true>(lds, g, S, E); }
    GSYNC();
    STAMP(9);

#define Qc ((bf16_t*)(p.ws + WS_YC))
#define Kc ((bf16_t*)(p.ws + WS_MS))
#define gSI ((float*)(p.ws + WS_MS + 48 * MiB))
#define gBI (gSI + (size_t)M * 4)
#define gBT (gSI + (size_t)M * 8)
#define gWL (gSI + (size_t)M * 12)
#define gDP ((float*)(p.ws + WS_MS + 50 * MiB))
#define gDEN ((float*)(p.ws + WS_MS + 51 * MiB))
    {
        PHASE_IDS
        const float* cq = p.in[31]; const float* ck = p.in[32];
        const int gw = bid * 8 + wave, NW = G * 8;
        for (int item = gw; item < (M / 16) * 3; item += NW) {
            const int run = item / 3, m0 = run * 16, c = (item % 3) * 512 + lane * 8; const bool s0 = (m0 & (SEQ - 1)) == 0;
            const bool isk = c >= 768; const int cc = isk ? c - 768 : c; const float* cw = (isk ? ck : cq) + cc; const float sc = isk ? 0.07216878364870322f : 1.f;
            u32x4 x[19];
#pragma unroll
            for (int i = 0; i < 19; ++i) { const int mm = (i < 3 && s0) ? m0 : m0 - 3 + i; x[i] = *(const u32x4*)(U + (size_t)mm * LDU1 + 256 + c); }
            f32x4 w0[4], w1[4];
#pragma unroll
            for (int j = 0; j < 4; ++j) { w0[j] = *(const f32x4*)(cw + j * 768); w1[j] = *(const f32x4*)(cw + j * 768 + 4); }
            if (s0) { const u32x4 z = {0u, 0u, 0u, 0u}; x[0] = z; x[1] = z; x[2] = z; }
            bf16_t* dst = (isk ? Kc : Qc) + (size_t)m0 * 768 + cc;
#pragma unroll
            for (int tk = 0; tk < 16; ++tk) {
                float acc[8];
#pragma unroll
                for (int e = 0; e < 8; ++e) acc[e] = 0.f;
#pragma unroll
                for (int j = 0; j < 4; ++j) { const u32x4 xv = x[tk + j];
                    acc[0] = fmaf(w0[j][0], bflo(xv.x), acc[0]); acc[1] = fmaf(w0[j][1], bfhi(xv.x), acc[1]); acc[2] = fmaf(w0[j][2], bflo(xv.y), acc[2]); acc[3] = fmaf(w0[j][3], bfhi(xv.y), acc[3]);
                    acc[4] = fmaf(w1[j][0], bflo(xv.z), acc[4]); acc[5] = fmaf(w1[j][1], bfhi(xv.z), acc[5]); acc[6] = fmaf(w1[j][2], bflo(xv.w), acc[6]); acc[7] = fmaf(w1[j][3], bfhi(xv.w), acc[7]); }
                u32x4 o; o.x = pk2(siluf_(acc[0]) * sc, siluf_(acc[1]) * sc); o.y = pk2(siluf_(acc[2]) * sc, siluf_(acc[3]) * sc); o.z = pk2(siluf_(acc[4]) * sc, siluf_(acc[5]) * sc); o.w = pk2(siluf_(acc[6]) * sc, siluf_(acc[7]) * sc);
                *(u32x4*)(dst + (size_t)tk * 768) = o; }
        }
        for (int it = gw; it < (M / 64) * 4; it += NW) {
            const int ch = it >> 2, hh = it & 3; const size_t m = (size_t)ch * 64 + lane; const bf16_t* ur = U + m * LDU1;
            const float lf = -softplusf_(-(bf2f(ur[3332 + hh]) + p.in[34][hh]));
            const float li = bf2f(ur[3328 + hh]) + p.in[33][hh];
            float bs = lf;
#pragma unroll
            for (int o = 1; o < 64; o <<= 1) { const float t = __shfl_up(bs, o); if (lane >= o) bs += t; }
            const float bL = __shfl(bs, 63);
            gSI[m * 4 + hh] = __expf(bs); gBI[m * 4 + hh] = li - bs; gBT[m * 4 + hh] = bs; gWL[m * 4 + hh] = __expf(bL - bs + li);
            if (lane == 0) gDP[ch * 4 + hh] = __expf(bL);
        }
    }
    GSYNC();
    STAMP(10);

    if (bid < 192) {
        PHASE_IDS
        const int w = __builtin_amdgcn_readfirstlane(tid >> 6);
        const int grp_ = (bid & 7) * 4 + (bid >> 3) / 6;
        const int vs = (bid >> 3) % 6, h = grp_ & 3, b = grp_ >> 2;
        constexpr int QS = 400, TS = 144;
        constexpr int oQ = 0, oK = 25600, oKT = 51200, oVT = 78848, oVW = 85760, oP = 92672, oCT = 101888, oG = 121088;
        LAS unsigned char* L = lds;
        for (int i = tid; i < 19200 / 4; i += 512) ((LAS unsigned*)(L + oCT))[i] = 0u;
        for (int i = tid; i < 64 * TS / 4; i += 512) ((LAS unsigned*)(L + oP))[i] = 0u;
        for (int i = tid; i < 16 * TS / 4; i += 512) { ((LAS unsigned*)(L + oVT + 32 * TS))[i] = (i < TS / 4) ? 0x3F803F80u : 0u; ((LAS unsigned*)(L + oVW + 32 * TS))[i] = 0u; }
        const size_t tok0 = (size_t)b * SEQ;
        const int fr = lane & 15, fq = lane >> 4;
        u32x4 qa[3], ka[3], va = {0u, 0u, 0u, 0u}; float gsi = 0.f, gbi = 0.f, gbt = 0.f, gwl = 0.f, wlr = 0.f;
        int prow[3], pc8[3];
#pragma unroll
        for (int i = 0; i < 3; ++i) { const int pp = tid + 512 * i; prow[i] = pp / 24; pc8[i] = (pp % 24) * 8; }
        const int vrow = tid & 63, vpart = tid >> 6;
#define MM_FETCH(c_) { const size_t tb_ = tok0 + (size_t)(c_) * 64; _Pragma("unroll") for (int i_ = 0; i_ < 3; ++i_) { const size_t o_ = (tb_ + prow[i_]) * 768 + h * 192 + pc8[i_]; qa[i_] = *(const u32x4*)(Qc + o_); ka[i_] = *(const u32x4*)(Kc + o_); } \
            { va = *(const u32x4*)(U + (tb_ + vrow) * LDU1 + 1792 + h * 192 + vs * 32 + (vpart & 3) * 8); wlr = gWL[(tb_ + vrow) * 4 + h]; } \
            { const size_t g_ = (tb_ + (tid & 63)) * 4 + h; gsi = gSI[g_]; gbi = gBI[g_]; gbt = gBT[g_]; gwl = gWL[g_]; } }
#define MM_H(w_, j_) ((bf16_t)(((j_) & 1) ? ((w_) >> 16) : ((w_) & 0xffffu)))
#define MM_STORE() { _Pragma("unroll") for (int i_ = 0; i_ < 3; ++i_) { *(LAS u32x4*)(L + oQ + prow[i_] * QS + pc8[i_] * 2) = qa[i_]; *(LAS u32x4*)(L + oK + prow[i_] * QS + pc8[i_] * 2) = ka[i_]; \
            } \
            if (tid < 256) { LAS bf16_t* vt_ = (LAS bf16_t*)(L + oVT + (vpart * 8) * TS + vrow * 2); LAS bf16_t* vw_ = (LAS bf16_t*)(L + oVW + (vpart * 8) * TS + vrow * 2); const unsigned vw4_[4] = {va.x, va.y, va.z, va.w}; \
                _Pragma("unroll") for (int j_ = 0; j_ < 8; ++j_) { const bf16_t e_ = MM_H(vw4_[j_ >> 1], j_); vt_[j_ * (TS / 2)] = e_; vw_[j_ * (TS / 2)] = f2bf(bf2f(e_) * wlr); } } \
            if (tid < 64) { ((LAS bf16_t*)(L + oVW + 32 * TS))[tid] = f2bf(gwl); ((LAS float*)(L + oG))[tid] = gsi; ((LAS float*)(L + oG))[64 + tid] = gbi; ((LAS float*)(L + oG))[128 + tid] = gbt; } }
#define MM_TR4(off_) __builtin_amdgcn_ds_read_tr16_b64_v4i16((LAS s16x4*)(ktb + (off_)))
#define MM_TRF(off_) __builtin_shufflevector(MM_TR4(off_), MM_TR4((off_) + 4 * QS), 0, 1, 2, 3, 4, 5, 6, 7)
#define MM_FRAG(off_, row_, stride_, kk_) (*(const LAS bf16x8*)(L + (off_) + ((row_) + fr) * (stride_) + ((kk_) * 32 + 8 * fq) * 2))
        __syncthreads();
        MM_FETCH(0); MM_STORE();
        LBAR();
        f32x4 Cacc[3][2];
#pragma unroll
        for (int i = 0; i < 3; ++i) { Cacc[i][0] = (f32x4){0.f, 0.f, 0.f, 0.f}; Cacc[i][1] = (f32x4){0.f, 0.f, 0.f, 0.f}; }
        const int nvt = (w < 4) ? 1 : 2, vt0 = (w < 4) ? 0 : 1, db0 = 3 * (w & 3);
        const LAS unsigned char* ktb = L + oK + ((lane >> 4) * 8 + ((lane >> 2) & 3)) * QS + (db0 * 16 + (lane & 3) * 4) * 2;
        const LAS float* gSIl = (const LAS float*)(L + oG); const LAS float* gBIl = gSIl + 64; const LAS float* gBTl = gSIl + 128;
        for (int c = 0; c < SEQ / 64; ++c) {
            int fr_o = lane & 15, fq_o = lane >> 4; asm volatile("" : "+v"(fr_o), "+v"(fq_o));
            const int fr = fr_o, fq = fq_o;
            const float dp = gDP[(b * (SEQ / 64) + c) * 4 + h];
            MM_FETCH((c + 1 < SEQ / 64) ? c + 1 : c);
            { const int sb = w >> 1, tb0 = (w & 1) * 2;
              if (sb <= tb0 + 1) {
              const bool two = sb <= tb0;
              bf16x8 kf[6], q0f[6], q1f[6];
#pragma unroll
              for (int kk = 0; kk < 6; ++kk) { kf[kk] = MM_FRAG(oK, sb * 16, QS, kk); q1f[kk] = MM_FRAG(oQ, tb0 * 16 + 16, QS, kk); }
              if (two) {
#pragma unroll
                  for (int kk = 0; kk < 6; ++kk) q0f[kk] = MM_FRAG(oQ, tb0 * 16, QS, kk); }
              const int s0 = sb * 16 + 4 * fq;
              const float bi0 = gBIl[s0], bi1 = gBIl[s0 + 1], bi2 = gBIl[s0 + 2], bi3 = gBIl[s0 + 3];
              const float bt0 = gBTl[tb0 * 16 + fr], bt1 = gBTl[tb0 * 16 + 16 + fr];
              asm volatile("s_waitcnt lgkmcnt(0)" ::: "memory");
              f32x4 a0 = {0.f, 0.f, 0.f, 0.f}, a1 = {0.f, 0.f, 0.f, 0.f};
              if (two) {
#pragma unroll
                  for (int kk = 0; kk < 6; ++kk) { a0 = __builtin_amdgcn_mfma_f32_16x16x32_bf16(kf[kk], q0f[kk], a0, 0, 0, 0); a1 = __builtin_amdgcn_mfma_f32_16x16x32_bf16(kf[kk], q1f[kk], a1, 0, 0, 0); }
              } else {
#pragma unroll
                  for (int kk = 0; kk < 6; ++kk) a1 = __builtin_amdgcn_mfma_f32_16x16x32_bf16(kf[kk], q1f[kk], a1, 0, 0, 0);
              }
#pragma unroll
              for (int j = 0; j < 2; ++j) { if (j == 1 || two) { const int t = (tb0 + j) * 16 + fr; const float bt = j ? bt1 : bt0; const f32x4 a = j ? a1 : a0;
                  const float p0 = (s0 <= t) ? a[0] * __expf(bt + bi0) : 0.f, p1 = (s0 + 1 <= t) ? a[1] * __expf(bt + bi1) : 0.f, p2 = (s0 + 2 <= t) ? a[2] * __expf(bt + bi2) : 0.f, p3 = (s0 + 3 <= t) ? a[3] * __expf(bt + bi3) : 0.f;
                  u32x2 pw; pw.x = pk2(p0, p1); pw.y = pk2(p2, p3); *(LAS u32x2*)(L + oP + t * TS + s0 * 2) = pw; } } } }
            LBAR();
            { const int tb = w & 3;
              const int n2 = (w < 4) ? 2 : 1;
              bf16x8 qf[6], pf[2], vtf[2][2], ctf[2][6];
#pragma unroll
              for (int kk = 0; kk < 6; ++kk) qf[kk] = MM_FRAG(oQ, tb * 16, QS, kk);
#pragma unroll
              for (int kk = 0; kk < 2; ++kk) pf[kk] = MM_FRAG(oP, tb * 16, TS, kk);
#pragma unroll
              for (int j = 0; j < 2; ++j) { if (j < n2) { const int vt = (w < 4) ? j : 2;
#pragma unroll
                  for (int kk = 0; kk < 2; ++kk) vtf[j][kk] = MM_FRAG(oVT, vt * 16, TS, kk);
#pragma unroll
                  for (int kk = 0; kk < 6; ++kk) ctf[j][kk] = MM_FRAG(oCT, vt * 16, QS, kk); } }
              const int t0r = tb * 16 + 4 * fq;
              const float si0 = gSIl[t0r], si1 = gSIl[t0r + 1], si2 = gSIl[t0r + 2], si3 = gSIl[t0r + 3];
              asm volatile("s_waitcnt lgkmcnt(0)" ::: "memory");
              bf16x8 ktf[3][2], vwf[2][2];
#pragma unroll
              for (int i = 0; i < 3; ++i) { ktf[i][0] = MM_TRF(i * 32); ktf[i][1] = MM_TRF(32 * QS + i * 32); }
#pragma unroll
              for (int j = 0; j < 2; ++j) { if (j < nvt) { vwf[j][0] = MM_FRAG(oVW, (vt0 + j) * 16, TS, 0); vwf[j][1] = MM_FRAG(oVW, (vt0 + j) * 16, TS, 1); } }
#pragma unroll
              for (int j = 0; j < 2; ++j) { if (j < n2) { const int vt = (w < 4) ? j : 2;
                  f32x4 d2 = {0.f, 0.f, 0.f, 0.f}, d3 = {0.f, 0.f, 0.f, 0.f};
#pragma unroll
                  for (int kk = 0; kk < 2; ++kk) d2 = __builtin_amdgcn_mfma_f32_16x16x32_bf16(pf[kk], vtf[j][kk], d2, 0, 0, 0);
#pragma unroll
                  for (int kk = 0; kk < 6; ++kk) d3 = __builtin_amdgcn_mfma_f32_16x16x32_bf16(qf[kk], ctf[j][kk], d3, 0, 0, 0);
                  const float o0 = si0 * d3[0] + d2[0], o1 = si1 * d3[1] + d2[1], o2 = si2 * d3[2] + d2[2], o3 = si3 * d3[3] + d2[3];
                  const size_t tg = tok0 + (size_t)c * 64 + t0r;
                  if (w < 4) { bf16_t* op = U + tg * LDU1 + 1792 + h * 192 + vs * 32 + vt * 16 + fr; op[0] = f2bf(o0); op[LDU1] = f2bf(o1); op[2 * LDU1] = f2bf(o2); op[3 * LDU1] = f2bf(o3); }
                  else if (fr == 0 && vs == 0) { float* dn = gDEN + tg * 4 + h; dn[0] = o0; dn[4] = o1; dn[8] = o2; dn[12] = o3; } } }
              asm volatile("s_waitcnt lgkmcnt(0)" ::: "memory");
#pragma unroll
              for (int i = 0; i < 3; ++i)
#pragma unroll
                  for (int j = 0; j < 2; ++j) { if (j < nvt) { f32x4 ca = Cacc[i][j] * dp;
                      ca = __builtin_amdgcn_mfma_f32_16x16x32_bf16(ktf[i][0], vwf[j][0], ca, 0, 0, 0);
                      ca = __builtin_amdgcn_mfma_f32_16x16x32_bf16(ktf[i][1], vwf[j][1], ca, 0, 0, 0); Cacc[i][j] = ca; } } }
            LBAR();
#pragma unroll
            for (int i = 0; i < 3; ++i)
#pragma unroll
                for (int j = 0; j < 2; ++j) { if (j < nvt) { const f32x4 ca = Cacc[i][j]; u32x2 cw; cw.x = pk2(ca[0], ca[1]); cw.y = pk2(ca[2], ca[3]);
                    *(LAS u32x2*)(L + oCT + ((vt0 + j) * 16 + fr) * QS + ((db0 + i) * 16 + 4 * fq) * 2) = cw; } }
            if (c + 1 < SEQ / 64) MM_STORE();
            LBAR();
        }
        STAMP2(18, 0);
#undef MM_FETCH
#undef MM_STORE
#undef MM_FRAG
#undef MM_TR4
#undef MM_TRF
#undef MM_H
    } else {
        PHASE_IDS
        const int w = __builtin_amdgcn_readfirstlane(tid >> 6), wq = w & 3, myc = w >> 2;
        const int fr = lane & 15, fq = lane >> 4;
        constexpr int US = 80, XS = 272, NB = SEQ / 32;
        constexpr int oU = 0, oW1 = 10240, oX = 20480, oH = 37888, oW2 = 55296, oZ = 59648, CH = 61696;
        LAS unsigned char* Lc = lds + myc * CH;
        __syncthreads();
        for (int i = tid; i < 2 * CH / 4; i += 512) ((LAS unsigned*)lds)[i] = 0u;
        __syncthreads();
        for (int i = tid; i < 2 * 128 * 16; i += 512) { const int cc = i >> 11, n = (i >> 4) & 127, k = i & 15; const int g_ = ((bid - 192) * 2 + cc) & 15;
            const float v = (n < 64) ? BBR[(g_ * 64 + n) * 16 + k] : BBI[(g_ * 64 + n - 64) * 16 + k];
            ((LAS bf16_t*)(lds + cc * CH + oW1 + n * US))[k] = f2bf(v); }
        for (int i = tid; i < 2 * 16 * 128; i += 512) { const int cc = i >> 11, hh = (i >> 7) & 15, k = i & 127; const int g_ = ((bid - 192) * 2 + cc) & 15;
            const float v = (k < 64) ? p.in[26][(g_ * 16 + hh) * 64 + k] : -p.in[27][(g_ * 16 + hh) * 64 + k - 64];
            ((LAS bf16_t*)(lds + cc * CH + oW2 + hh * XS))[k] = f2bf(v); }
        const int chain = (bid - 192) * 2 + myc, g = chain & 15, b = chain >> 4;
        bf16_t* gU = U + ((size_t)b * SEQ + (lane >> 1)) * LDU1 + g * 16 + (lane & 1) * 8;
        __syncthreads();
        if (wq == 3) {
            u32x4 sA, sB;
            const int lo = (lane >> 1) * US + (lane & 1) * 16, zo = (lane >> 1) * 32 + (lane & 1) * 16;
#define S5_LD(i_) (*(const u32x4*)(gU + (size_t)(((i_) < NB ? (i_) : NB - 1) * 32) * LDU1))
            sA = S5_LD(0); *(LAS u32x4*)(Lc + oU + 0 * 2560 + lo) = sA; sB = S5_LD(1); *(LAS u32x4*)(Lc + oU + 1 * 2560 + lo) = sB;
            sA = S5_LD(2); sB = S5_LD(3);
            LBAR(); LBAR();
            for (int it = 0; it < NB + 2; it += 2) {
                if (it + 2 < NB) *(LAS u32x4*)(Lc + oU + ((it + 2) & 3) * 2560 + lo) = sA;
                if (it >= 2) *(u32x4*)(gU + (size_t)((it - 2) * 32) * LDU1) = *(const LAS u32x4*)(Lc + oZ + (it & 1) * 1024 + zo);
                sA = S5_LD(it + 4);
                LBAR();
                if (it + 3 < NB) *(LAS u32x4*)(Lc + oU + ((it + 3) & 3) * 2560 + lo) = sB;
                if (it >= 1 && it - 1 < NB) *(u32x4*)(gU + (size_t)((it - 1) * 32) * LDU1) = *(const LAS u32x4*)(Lc + oZ + ((it + 1) & 1) * 1024 + zo);
                sB = S5_LD(it + 5);
                LBAR();
            }
#undef S5_LD
        } else if (wq == 1) {
            bf16x8 w1f[8];
#pragma unroll
            for (int j = 0; j < 8; ++j) w1f[j] = *(const LAS bf16x8*)(Lc + oW1 + (j * 16 + fr) * US + (8 * fq) * 2);
            auto xblk = [&](int blk) {
                const LAS unsigned char* Ut = Lc + oU + (blk & 3) * 2560; LAS unsigned char* Xt = Lc + oX + (blk & 1) * 8704;
                const bf16x8 u0 = *(const LAS bf16x8*)(Ut + fr * US + (8 * fq) * 2), u1 = *(const LAS bf16x8*)(Ut + (16 + fr) * US + (8 * fq) * 2);
                const f32x4 z4 = {0.f, 0.f, 0.f, 0.f};
#pragma unroll
                for (int j = 0; j < 8; ++j) { const f32x4 d0 = __builtin_amdgcn_mfma_f32_16x16x32_bf16(u0, w1f[j], z4, 0, 0, 0), d1 = __builtin_amdgcn_mfma_f32_16x16x32_bf16(u1, w1f[j], z4, 0, 0, 0);
                    LAS bf16_t* xp = (LAS bf16_t*)(Xt + (4 * fq) * XS) + j * 16 + fr;
#pragma unroll
                    for (int r = 0; r < 4; ++r) { xp[r * (XS / 2)] = f2bf(d0[r]); xp[(16 + r) * (XS / 2)] = f2bf(d1[r]); } } };
            LBAR();
            xblk(0);
            LBAR();
            for (int it = 0; it < NB + 2; ++it) { if (it + 1 < NB) xblk(it + 1); LBAR(); }
        } else if (wq == 0) {
            const float ar = LBR[g * 64 + lane], ai = LBI[g * 64 + lane];
            float hr = 0.f, hi = 0.f;
            LBAR(); LBAR();
            for (int it = 0; it < NB + 2; ++it) {
                if (it < NB) { const LAS bf16_t* xp = (const LAS bf16_t*)(Lc + oX + (it & 1) * 8704) + lane; LAS bf16_t* hp = (LAS bf16_t*)(Lc + oH + (it & 1) * 8704) + lane;
                    for (int t8 = 0; t8 < 32; t8 += 8) {
                        bf16_t xr[8], xi[8], or_[8], oi_[8];
#pragma unroll
                        for (int u = 0; u < 8; ++u) { xr[u] = xp[(t8 + u) * (XS / 2)]; xi[u] = xp[(t8 + u) * (XS / 2) + 64]; }
#pragma unroll
                        for (int u = 0; u < 8; ++u) { const float nr = fmaf(ar, hr, fmaf(-ai, hi, bf2f(xr[u]))), ni = fmaf(ar, hi, fmaf(ai, hr, bf2f(xi[u]))); hr = nr; hi = ni; or_[u] = f2bf(hr); oi_[u] = f2bf(hi); }
#pragma unroll
                        for (int u = 0; u < 8; ++u) { hp[(t8 + u) * (XS / 2)] = or_[u]; hp[(t8 + u) * (XS / 2) + 64] = oi_[u]; } } }
                LBAR();
            }
        } else {
            bf16x8 w2f[4];
#pragma unroll
            for (int kk = 0; kk < 4; ++kk) w2f[kk] = *(const LAS bf16x8*)(Lc + oW2 + fr * XS + (kk * 32 + 8 * fq) * 2);
            const float dsk = p.in[28][g * 16 + fr];
            LBAR(); LBAR();
            for (int it = 0; it < NB + 2; ++it) {
                if (it >= 1 && it - 1 < NB) { const int blk = it - 1; const LAS unsigned char* Ht = Lc + oH + (blk & 1) * 8704; const LAS unsigned char* Ut = Lc + oU + (blk & 3) * 2560; LAS unsigned char* Zt = Lc + oZ + (blk & 1) * 1024;
#pragma unroll
                    for (int tb = 0; tb < 2; ++tb) { f32x4 d = {0.f, 0.f, 0.f, 0.f};
#pragma unroll
                        for (int kk = 0; kk < 4; ++kk) d = __builtin_amdgcn_mfma_f32_16x16x32_bf16(*(const LAS bf16x8*)(Ht + (tb * 16 + fr) * XS + (kk * 32 + 8 * fq) * 2), w2f[kk], d, 0, 0, 0);
#pragma unroll
                        for (int r = 0; r < 4; ++r) { const int t = tb * 16 + 4 * fq + r;
                            const float y = d[r] + dsk * bf2f(*(const LAS bf16_t*)(Ut + t * US + fr * 2));
                            const float z = 0.5f * y * (1.f + tanhf_(0.7978845608028654f * (y + 0.044715f * y * y * y)));
                            *(LAS bf16_t*)(Zt + t * 32 + fr * 2) = f2bf(z); } } }
                LBAR();
            }
        }
        STAMP2(19, 192);
    }
    GSYNC();
    STAMP(11);

    {
        PHASE_IDS
        const int w = __builtin_amdgcn_readfirstlane(tid >> 6), fr = lane & 15, fq = lane >> 4;
        constexpr int ZS = 528;
        const bf16_t* WT = (const bf16_t*)(p.ws + WS_GLU);
        bf16x8 wf[2][8];
#pragma unroll
        for (int nt = 0; nt < 2; ++nt)
#pragma unroll
            for (int kk = 0; kk < 8; ++kk) wf[nt][kk] = *(const bf16x8*)(WT + (size_t)(w * 32 + nt * 16 + fr) * 256 + kk * 32 + 8 * fq);
        f32x4 bias4[2];
#pragma unroll
        for (int nt = 0; nt < 2; ++nt) bias4[nt] = *(const f32x4*)(p.in[30] + w * 32 + nt * 16 + 4 * fq);
        for (int m0 = bid * 64; m0 < M; m0 += G * 64) {
            __syncthreads();
#pragma unroll
            for (int i = 0; i < 4; ++i) { const int pp = tid + 512 * i, row = pp >> 5, c8 = (pp & 31) * 8; *(LAS u32x4*)(lds + row * ZS + c8 * 2) = *(const u32x4*)(U + (size_t)(m0 + row) * LDU1 + c8); }
            __syncthreads();
#pragma unroll
            for (int tb = 0; tb < 4; ++tb) { f32x4 d0 = {0.f, 0.f, 0.f, 0.f}, d1 = {0.f, 0.f, 0.f, 0.f};
#pragma unroll
                for (int kk = 0; kk < 8; ++kk) { const bf16x8 zf = *(const LAS bf16x8*)(lds + (tb * 16 + fr) * ZS + (kk * 32 + 8 * fq) * 2);
                    d0 = __builtin_amdgcn_mfma_f32_16x16x32_bf16(wf[0][kk], zf, d0, 0, 0, 0); d1 = __builtin_amdgcn_mfma_f32_16x16x32_bf16(wf[1][kk], zf, d1, 0, 0, 0); }
                const int t = tb * 16 + fr;
#pragma unroll
                for (int nt = 0; nt < 2; ++nt) { const f32x4 a = (nt ? d1 : d0) + bias4[nt]; const int n0 = w * 32 + nt * 16 + 4 * fq;
                    const u32x2 zz = *(const LAS u32x2*)(lds + t * ZS + n0 * 2);
                    u32x2 o; o.x = pk2(bflo(zz.x) * sigmoidf_(a[0]), bfhi(zz.x) * sigmoidf_(a[1])); o.y = pk2(bflo(zz.y) * sigmoidf_(a[2]), bfhi(zz.y) * sigmoidf_(a[3]));
                    *(u32x2*)(YC + (size_t)(m0 + t) * DM + n0) = o; } }
        }
    }
    {
        PHASE_IDS
        const int gw = bid * 8 + wave, NW = G * 8, hh = lane >> 4, c12 = lane * 12;
        f32x4 nw[3];
#pragma unroll
        for (int j = 0; j < 3; ++j) nw[j] = *(const f32x4*)(p.in[35] + c12 + 4 * j);
        for (int m0 = gw; m0 < M; m0 += NW * 4) {
            u32x2 xn[4][3], xo[4][3]; float dn[4];
#pragma unroll
            for (int u = 0; u < 4; ++u) { const int m = m0 + u * NW; const bf16_t* ur = U + (size_t)m * LDU1 + c12; dn[u] = gDEN[(size_t)m * 4 + hh];
#pragma unroll
                for (int j = 0; j < 3; ++j) { xn[u][j] = *(const u32x2*)(ur + 1792 + 4 * j); xo[u][j] = *(const u32x2*)(ur + 2560 + 4 * j); } }
#pragma unroll
            for (int u = 0; u < 4; ++u) { const int m = m0 + u * NW; const float inv = 1.0f / fmaxf(fabsf(dn[u]), 1.0f);
                float hv[12], og[12]; float ss = 0.f;
#pragma unroll
                for (int j = 0; j < 3; ++j) { hv[4 * j] = bflo(xn[u][j].x) * inv; hv[4 * j + 1] = bfhi(xn[u][j].x) * inv; hv[4 * j + 2] = bflo(xn[u][j].y) * inv; hv[4 * j + 3] = bfhi(xn[u][j].y) * inv;
                    og[4 * j] = bflo(xo[u][j].x); og[4 * j + 1] = bfhi(xo[u][j].x); og[4 * j + 2] = bflo(xo[u][j].y); og[4 * j + 3] = bfhi(xo[u][j].y); }
#pragma unroll
                for (int e = 0; e < 12; ++e) ss = fmaf(hv[e], hv[e], ss);
                const float rs = 1.0f / sqrtf(row_sum16(ss) * (1.f / 192.f) + RMS_EPS);
                bf16_t* yo = YC + (size_t)m * DM + 256 + c12;
#pragma unroll
                for (int j = 0; j < 3; ++j) { u32x2 w; w.x = pk2(hv[4 * j] * rs * nw[j][0] * sigmoidf_(og[4 * j]), hv[4 * j + 1] * rs * nw[j][1] * sigmoidf_(og[4 * j + 1]));
                    w.y = pk2(hv[4 * j + 2] * rs * nw[j][2] * sigmoidf_(og[4 * j + 2]), hv[4 * j + 3] * rs * nw[j][3] * sigmoidf_(og[4 * j + 3])); *(u32x2*)(yo + 4 * j) = w; } }
        }
    }
    GSYNC();
    STAMP(12);

    { pg8::Gemm g{YC, (const bf16_t*)(p.ws + WS_OUT1), DM, DM, M, DM, DM}; pg8::StaticOrder S; S.init(M, DM, G, bid);
      pg8::EpiResidual<false, true> E{nullptr, XB, XB, SS3}; pg8::gemm_phase<pg8::EpiResidual<false, true>, pg8::StaticOrder, true, true>(lds, g, S, E); }
    GSYNC();
    STAMP(13);
    { pg8::Gemm g{XB, (const bf16_t*)(p.ws + WS_GU1), DM, DM, M, 2 * FFN, DM}; pg8::StaticOrder S; S.init(M, 2 * FFN, G, bid);
      pg8::EpiSwiGlu E{HID, FFN, SS3}; pg8::gemm_phase<pg8::EpiSwiGlu, pg8::StaticOrder, true, true>(lds, g, S, E); }
    GSYNC();
    STAMP(14);
    { pg8::Gemm g{HID, (const bf16_t*)(p.ws + WS_D1), FFN, FFN, M, DM, FFN}; pg8::StaticOrder S; S.init(M, DM, G, bid);
      pg8::EpiResidual<false, false> E{nullptr, XB, XB, nullptr}; pg8::gemm_phase<pg8::EpiResidual<false, false>, pg8::StaticOrder, true, true>(lds, g, S, E); }
    GSYNC();
    STAMP(15);

    {
        PHASE_IDS
        const f32x4* gg = (const f32x4*)p.in[3] + lane;
        f32x4 gv[4];
#pragma unroll
        for (int j = 0; j < 4; ++j) gv[j] = gg[64 * j];
        for (int row = bid * 8 + wave; row < M; row += G * 32) {
            u32x2 w[4][4];
#pragma unroll
            for (int r = 0; r < 4; ++r)
#pragma unroll
                for (int j = 0; j < 4; ++j) w[r][j] = ((const u32x2*)(XB + (size_t)(row + r * G * 8) * DM))[64 * j + lane];
#pragma unroll
            for (int r = 0; r < 4; ++r) { f32x4 v[4]; float s = 0.f;
#pragma unroll
                for (int j = 0; j < 4; ++j) { v[j] = (f32x4){bflo(w[r][j].x), bfhi(w[r][j].x), bflo(w[r][j].y), bfhi(w[r][j].y)}; s += (v[j][0] * v[j][0] + v[j][1] * v[j][1]) + (v[j][2] * v[j][2] + v[j][3] * v[j][3]); }
                const float rs = 1.0f / sqrtf(wave_sum(s) * (1.f / DM) + RMS_EPS);
                f32x4* xr = (f32x4*)(p.out + (size_t)(row + r * G * 8) * DM) + lane;
#pragma unroll
                for (int j = 0; j < 4; ++j) xr[64 * j] = v[j] * rs * gv[j]; }
        }
    }
    STAMP(16);
#if PROBE
    if (bid == 0 && threadIdx.x == 0) {
        const unsigned long long* ts = (const unsigned long long*)(p.ws + CTL_TS);
        const int order[18] = {0, 1, 2, 3, 17, 4, 5, 6, 7, 8, 9, 10, 11, 12, 13, 14, 15, 16};
        unsigned long long extra = 0;
        for (int j = 0; j < 17; ++j) if ((PROBE_MASK >> j) & 1) extra += __hip_atomic_load(ts + order[j + 1], __ATOMIC_RELAXED, __HIP_MEMORY_SCOPE_AGENT) - __hip_atomic_load(ts + order[j], __ATOMIC_RELAXED, __HIP_MEMORY_SCOPE_AGENT);
#ifdef PROBE_A
        extra += __hip_atomic_load(ts + PROBE_B, __ATOMIC_RELAXED, __HIP_MEMORY_SCOPE_AGENT) - __hip_atomic_load(ts + PROBE_A, __ATOMIC_RELAXED, __HIP_MEMORY_SCOPE_AGENT);
#endif
        const unsigned long long t0 = __builtin_amdgcn_s_memrealtime();
        while (__builtin_amdgcn_s_memrealtime() - t0 < extra) __builtin_amdgcn_s_sleep(8);
    }
#endif
}

extern "C" void kernel_launch(void* const* d_in, const int* in_sizes, int n_in, void* d_out, int out_size, void* d_ws, size_t ws_size, hipStream_t stream) {
    static int ready = 0;
    if (!ready) {
        if (n_in != 39 || out_size != M * DM || ws_size < WS_END) { fprintf(stderr, "kernel_launch: unexpected problem shape (n_in %d out %d ws %zu)\n", n_in, out_size, ws_size); ready = -1; return; }
        if (hipFuncSetAttribute((const void*)mega, hipFuncAttributeMaxDynamicSharedMemorySize, LDS_BYTES) != hipSuccess) { fprintf(stderr, "kernel_launch: hipFuncSetAttribute failed\n"); ready = -1; return; }
        int per_cu = 0; (void)hipOccupancyMaxActiveBlocksPerMultiprocessor(&per_cu, (const void*)mega, 512, LDS_BYTES);
        if (per_cu < 1) fprintf(stderr, "kernel_launch: occupancy query says %d blocks per CU\n", per_cu);
        (void)hipGetLastError();
        ready = 1;
    }
    if (ready < 0) return;
    (void)hipMemsetAsync((char*)d_ws + WS_CTL, 0, CTL_BYTES, stream);
    Params p{};
    for (int i = 0; i < 39; ++i) p.in[i] = (const float*)d_in[i];
    p.out = (float*)d_out; p.ws = (unsigned char*)d_ws;
    void* args[] = {&p};
    hipError_t e = hipLaunchCooperativeKernel((const void*)mega, dim3(256), dim3(512), args, LDS_BYTES, stream);
    if (e != hipSuccess) fprintf(stderr, "kernel_launch: cooperative launch failed: %s\n", hipGetErrorString(e));
}
```

```cpp
#include <hip/hip_runtime.h>
#include <hip/hip_cooperative_groups.h>
#include <cstdio>
#include <cstdint>
#include <cmath>
namespace cg = cooperative_groups;

#define LAS __attribute__((address_space(3)))
typedef unsigned short bf16_t;
typedef short bf16x8 __attribute__((ext_vector_type(8)));
typedef short s16x4 __attribute__((ext_vector_type(4)));
typedef float f32x4 __attribute__((ext_vector_type(4)));
typedef unsigned u32x4 __attribute__((ext_vector_type(4)));
typedef unsigned u32x2 __attribute__((ext_vector_type(2)));

constexpr int SEQ = 4096, BATCH = 8, DM = 1024, M = BATCH * SEQ;
constexpr int EVEN_IN = 3744, LDU0 = 3840, ODD_IN = 3336, NP1 = 3584, LDU1 = 3712, FFN = 2816;
constexpr float RMS_EPS = 1e-6f;

constexpr size_t MiB = 1u << 20;
constexpr size_t WS_CTL = 0, CTL_BYTES = 1 * MiB;
constexpr size_t CTL_SS1 = 128 * 1024, CTL_SS2 = 256 * 1024, CTL_SS3 = 384 * 1024, CTL_SS0 = 512 * 1024;
constexpr size_t CTL_TS = 800 * 1024;
constexpr size_t CTL_LB = 640 * 1024, CTL_LBR = 644 * 1024, CTL_LBI = 648 * 1024, CTL_BBR = 656 * 1024, CTL_BBI = 720 * 1024;
constexpr size_t WS_IN0 = 1 * MiB, WS_OUT0 = WS_IN0 + (size_t)LDU0 * DM * 2, WS_GU0 = WS_OUT0 + 2 * MiB, WS_D0 = WS_GU0 + 11 * MiB;
constexpr size_t WS_IN1 = WS_D0 + (size_t)DM * FFN * 2, WS_OUT1 = WS_IN1 + (size_t)NP1 * DM * 2, WS_GU1 = WS_OUT1 + 2 * MiB, WS_D1 = WS_GU1 + 11 * MiB;
constexpr size_t WS_GLU = WS_D1 + (size_t)DM * FFN * 2;
constexpr size_t WS_LORA = WS_GLU + 256 * 256 * 2;
constexpr size_t WS_XB = 53 * MiB, WS_YC = 117 * MiB, WS_U = 181 * MiB, WS_MS = 421 * MiB, WS_END = 512 * MiB;
constexpr size_t WS_SSQ = WS_MS + 70 * MiB;
static_assert(WS_LORA + 512 * 160 * 2 <= WS_XB, "weights fit");
static_assert(WS_U + (size_t)M * LDU0 * 2 <= WS_MS, "U fits");

__device__ __forceinline__ float bf2f(bf16_t h) { return __uint_as_float(((unsigned)h) << 16); }
__device__ __forceinline__ float bflo(unsigned w) { return __uint_as_float(w << 16); }
__device__ __forceinline__ unsigned long long ss_fix(float s) { return (unsigned long long)(s * 1048576.0f); }
__device__ __forceinline__ float ss_flt(unsigned long long q) { return ((float)(unsigned)(q >> 32) * 4294967296.0f + (float)(unsigned)q) * (1.0f / 1048576.0f); }
__device__ __forceinline__ float bfhi(unsigned w) { return __uint_as_float(w & 0xffff0000u); }
typedef __bf16 bf16x2_t __attribute__((ext_vector_type(2)));
typedef float f32x2c_t __attribute__((ext_vector_type(2)));
__device__ __forceinline__ unsigned pk2(float lo, float hi) { const bf16x2_t v = __builtin_convertvector((f32x2c_t){lo, hi}, bf16x2_t); return __builtin_bit_cast(unsigned, v); }
__device__ __forceinline__ bf16_t f2bf(float f) { const __bf16 b = (__bf16)f; return __builtin_bit_cast(bf16_t, b); }
__device__ __forceinline__ float sigmoidf_(float x) { return __builtin_amdgcn_rcpf(1.f + __expf(-x)); }
__device__ __forceinline__ float rsqrtf_(float x) { return __builtin_amdgcn_rsqf(x); }
__device__ __forceinline__ float siluf_(float x) { return x * sigmoidf_(x); }
__device__ __forceinline__ float softplusf_(float x) { return fmaxf(x, 0.f) + __logf(1.f + __expf(-fabsf(x))); }
__device__ __forceinline__ float tanhf_(float x) { const float e = __expf(-2.f * fabsf(x)); const float t = (1.f - e) * __builtin_amdgcn_rcpf(1.f + e); return x < 0.f ? -t : t; }
template <int CTRL> __device__ __forceinline__ float dpp_mov(float x) { return __int_as_float(__builtin_amdgcn_update_dpp(0, __float_as_int(x), CTRL, 0xf, 0xf, true)); }
__device__ __forceinline__ float row_sum16(float v) { v += dpp_mov<0xB1>(v); v += dpp_mov<0x4E>(v); v += dpp_mov<0x141>(v); v += dpp_mov<0x140>(v); return v; }
__device__ __forceinline__ float xrow16(float v) { const auto r = __builtin_amdgcn_permlane16_swap(__float_as_uint(v), __float_as_uint(v), false, false); return __uint_as_float(r[0]) + __uint_as_float(r[1]); }
__device__ __forceinline__ float xrow32(float v) { const auto r = __builtin_amdgcn_permlane32_swap(__float_as_uint(v), __float_as_uint(v), false, false); return __uint_as_float(r[0]) + __uint_as_float(r[1]); }
__device__ __forceinline__ float half_sum(float v) { return xrow16(row_sum16(v)); }
__device__ __forceinline__ float wave_sum(float v) { return xrow32(half_sum(v)); }

typedef float f32x2 __attribute__((ext_vector_type(2)));
__device__ __forceinline__ void half_reduce8(const float (&p)[8], int lane, float& o0, float& o1) {
    const bool b0 = (lane & 1) != 0, b1 = (lane & 2) != 0;
    float r[4];
#pragma unroll
    for (int i = 0; i < 4; ++i) { const float keep = b0 ? p[2 * i + 1] : p[2 * i], send = b0 ? p[2 * i] : p[2 * i + 1]; r[i] = keep + dpp_mov<0xB1>(send); }
    float q0, q1;
    { const float keep = b1 ? r[1] : r[0], send = b1 ? r[0] : r[1]; q0 = keep + dpp_mov<0x4E>(send); }
    { const float keep = b1 ? r[3] : r[2], send = b1 ? r[2] : r[3]; q1 = keep + dpp_mov<0x4E>(send); }
    q0 += dpp_mov<0x124>(q0); q0 += dpp_mov<0x128>(q0);
    q1 += dpp_mov<0x124>(q1); q1 += dpp_mov<0x128>(q1);
    o0 = xrow16(q0); o1 = xrow16(q1);
}

#define LBAR() do { asm volatile("s_waitcnt lgkmcnt(0)" ::: "memory"); __builtin_amdgcn_s_barrier(); asm volatile("" ::: "memory"); } while (0)
namespace pg8 {
constexpr int BM = 256, BK = 64, HALF = 128, HTB = HALF * BK * 2, STAGE_BYTES = 8 * HTB, NXCD = 8, WGM = 8;
__device__ __forceinline__ int lds_byte(int r, int c) { const int st = (r >> 4) * 2 + (c >> 5), rr = r & 15, cc = c & 31, ob = rr * 64 + cc * 2; return st * 1024 + (ob ^ (((ob >> 9) & 1) << 5)); }
__device__ __forceinline__ void stage_rc(int b, int& R, int& C) { const int st = b / 1024, sb = b % 1024, swz = sb ^ (((sb >> 9) & 1) << 5); R = (st >> 1) * 16 + swz / 64; C = (st & 1) * 32 + (swz % 64) / 2; }
__device__ __forceinline__ int perm32(int rho) { const int n = rho >> 4, i = rho & 15; return 8 * (i >> 2) + 4 * n + (i & 3); }
struct Unit { int pm, pn; };
struct Gemm { const bf16_t* A; const bf16_t* Bt; int lda, ldb, M, N, K; };
struct StaticOrder {
    int nM, nN, nwg, G, c;
    __device__ void init(int M_, int N_, int G_, int c_) { nM = M_ / BM; nN = N_ / BM; nwg = nM * nN; G = G_; c = c_; }
    __device__ bool next(int i, Unit& u) const {
        const long L = (long)i * G + c; if (L >= nwg) return false;
        int wgid = (int)L; { const int q = nwg / NXCD, r = nwg % NXCD, xcd = wgid % NXCD, off = wgid / NXCD; wgid = (xcd < r ? xcd * (q + 1) : r * (q + 1) + (xcd - r) * q) + off; }
        const int nig = WGM * nN, gid = wgid / nig, fm = gid * WGM, gsz = (nM - fm) < WGM ? (nM - fm) : WGM;
        u.pm = fm + ((wgid % nig) % gsz); u.pn = (wgid % nig) / gsz; return true;
    }
};

struct EpiScaleBf16 {
    static constexpr bool PERM = true;
    bf16_t* O; int ldc; const unsigned long long* ss;
    __device__ __forceinline__ void operator()(const f32x4 (&acc)[2][2][4][2], const Unit& u, int wr, int wc, int fr, int fq) const {
        const int row0 = u.pm * BM + wr * 64 + fr, col0 = u.pn * BM + wc * 32 + 8 * fq;
#pragma unroll
        for (int ai = 0; ai < 2; ++ai)
#pragma unroll
            for (int m = 0; m < 4; ++m) { const int row = row0 + ai * HALF + m * 16; const float rs = rsqrtf_(ss_flt(ss[row]) * (1.f / DM) + RMS_EPS);
                bf16_t* rowp = O + (size_t)row * ldc + col0;
#pragma unroll
                for (int bj = 0; bj < 2; ++bj) { const f32x4 v0 = acc[ai][bj][m][0] * rs, v1 = acc[ai][bj][m][1] * rs;
                    u32x4 w; w.x = pk2(v0[0], v0[1]); w.y = pk2(v0[2], v0[3]); w.z = pk2(v1[0], v1[1]); w.w = pk2(v1[2], v1[3]);
                    *(u32x4*)(rowp + bj * HALF) = w; } }
    }
};
struct EpiSwiGlu {
    static constexpr bool PERM = true;
    bf16_t* O; int ldc; const unsigned long long* ss;
    __device__ __forceinline__ void operator()(const f32x4 (&acc)[2][2][4][2], const Unit& u, int wr, int wc, int fr, int fq) const {
        const int row0 = u.pm * BM + wr * 64 + fr, col0 = u.pn * HALF + wc * 32 + 8 * fq;
#pragma unroll
        for (int ai = 0; ai < 2; ++ai)
#pragma unroll
            for (int m = 0; m < 4; ++m) { const int row = row0 + ai * HALF + m * 16; const float rs = rsqrtf_(ss_flt(ss[row]) * (1.f / DM) + RMS_EPS);
                f32x4 h[2];
#pragma unroll
                for (int n = 0; n < 2; ++n) { const f32x4 g = acc[ai][0][m][n] * rs, up = acc[ai][1][m][n] * rs;
#pragma unroll
                    for (int e = 0; e < 4; ++e) h[n][e] = siluf_(g[e]) * up[e]; }
                u32x4 w; w.x = pk2(h[0][0], h[0][1]); w.y = pk2(h[0][2], h[0][3]); w.z = pk2(h[1][0], h[1][1]); w.w = pk2(h[1][2], h[1][3]);
                *(u32x4*)(O + (size_t)row * ldc + col0) = w; }
    }
};
template <bool BASE_F32, bool WITH_SS> struct EpiResidual {
    static constexpr bool PERM = true;
    const float* base32; const bf16_t* base16; bf16_t* xb; unsigned long long* ss;
    __device__ __forceinline__ void operator()(const f32x4 (&acc)[2][2][4][2], const Unit& u, int wr, int wc, int fr, int fq) const {
        const int row0 = u.pm * BM + wr * 64 + fr, col0 = u.pn * BM + wc * 32 + 8 * fq;
#pragma unroll
        for (int ai = 0; ai < 2; ++ai)
#pragma unroll
            for (int m = 0; m < 4; ++m) { const int row = row0 + ai * HALF + m * 16; const size_t off = (size_t)row * DM + col0; float s = 0.f;
#pragma unroll
                for (int bj = 0; bj < 2; ++bj) { const size_t o = off + bj * HALF; f32x4 r0, r1;
                    if (BASE_F32) { r0 = *(const f32x4*)(base32 + o); r1 = *(const f32x4*)(base32 + o + 4); }
                    else { const u32x4 rb = *(const u32x4*)(base16 + o); r0 = (f32x4){bflo(rb.x), bfhi(rb.x), bflo(rb.y), bfhi(rb.y)}; r1 = (f32x4){bflo(rb.z), bfhi(rb.z), bflo(rb.w), bfhi(rb.w)}; }
                    const f32x4 v0 = r0 + acc[ai][bj][m][0], v1 = r1 + acc[ai][bj][m][1];
                    u32x4 w; w.x = pk2(v0[0], v0[1]); w.y = pk2(v0[2], v0[3]); w.z = pk2(v1[0], v1[1]); w.w = pk2(v1[2], v1[3]); *(u32x4*)(xb + o) = w;
                    s += ((v0[0] * v0[0] + v0[1] * v0[1]) + (v0[2] * v0[2] + v0[3] * v0[3])) + ((v1[0] * v1[0] + v1[1] * v1[1]) + (v1[2] * v1[2] + v1[3] * v1[3])); }
                if (WITH_SS) { s = xrow32(xrow16(s)); if (fq == 0) atomicAdd(ss + row, ss_fix(s)); } }
    }
};

template <class Epi, class Sched, bool ALIGN_EPI, bool SP2>
__device__ __forceinline__ void gemm_phase(LAS unsigned char* lds, const Gemm g, const Sched& S, const Epi& E) {
    int tid_ = threadIdx.x; asm volatile("" : "+v"(tid_));
    const int tid = tid_, wid = __builtin_amdgcn_readfirstlane(tid >> 6), lane = tid & 63, wr = wid >> 2, wc = wid & 3, fr = lane & 15, fq = lane >> 4;
    const int K = g.K, nt = K / BK;
    unsigned voffA[2], voffB[2];
#pragma unroll
    for (int i = 0; i < 2; ++i) { int R, C; stage_rc(tid * 16 + i * 8192, R, C); const int Rb = Epi::PERM ? ((R & ~31) + perm32(R & 31)) : R;
        voffA[i] = (unsigned)(R * g.lda + C) * 2u; voffB[i] = (unsigned)(Rb * g.ldb + C) * 2u; }
    const size_t kstep = (size_t)(BK * 2);
    const size_t hstepA = (size_t)HALF * g.lda * 2, hstepB = (size_t)HALF * g.ldb * 2;
    const size_t tstepA = 2 * hstepA, tstepB = 2 * hstepB;
    const unsigned ldsw = (unsigned)wid * 1024u;
    const int aoff = lds_byte(wr * 64 + fr, fq * 8), boff = lds_byte(wc * 32 + fr, fq * 8);
#define PG8_SA(b, h) (((b) * 2 + (h)) * HTB)
#define PG8_SB(b, h) ((4 + (b) * 2 + (h)) * HTB)
#define PG8_STAGE(bufoff, gbase, voff) do { _Pragma("unroll") for (int _i = 0; _i < 2; ++_i) \
        __builtin_amdgcn_global_load_lds((const unsigned*)((const char*)(gbase) + (voff)[_i]), (LAS unsigned*)(lds + (bufoff) + ldsw + _i * 8192), 16, 0, 0); } while (0)
#define PG8_LDA(dst, b, h) do { _Pragma("unroll") for (int m = 0; m < 4; ++m) _Pragma("unroll") for (int k = 0; k < 2; ++k) dst[m][k] = *(const LAS bf16x8*)(lds + PG8_SA(b, h) + aoff + m * 2048 + k * 1024); } while (0)
#define PG8_LDB(dst, b, h) do { _Pragma("unroll") for (int n = 0; n < 2; ++n) _Pragma("unroll") for (int k = 0; k < 2; ++k) dst[n][k] = *(const LAS bf16x8*)(lds + PG8_SB(b, h) + boff + n * 2048 + k * 1024); } while (0)
#define PG8_MMA(ai, bj, At, Bt) do { __builtin_amdgcn_s_setprio(1); _Pragma("unroll") for (int m = 0; m < 4; ++m) _Pragma("unroll") for (int n = 0; n < 2; ++n) _Pragma("unroll") for (int k = 0; k < 2; ++k) \
        acc[ai][bj][m][n] = __builtin_amdgcn_mfma_f32_16x16x32_bf16(Bt[n][k], At[m][k], acc[ai][bj][m][n], 0, 0, 0); __builtin_amdgcn_s_setprio(0); } while (0)
#define PG8_WAIT_V(n) asm volatile("s_waitcnt vmcnt(" #n ")" ::: "memory")
#define PG8_WAIT_L(n) asm volatile("s_waitcnt lgkmcnt(" #n ")" ::: "memory")
#define PG8_BAR __builtin_amdgcn_s_barrier()
#define PG8_SCHED __builtin_amdgcn_sched_barrier(0)
    Unit cur, nxt; int ui = 0;
    if (!S.next(0, cur)) return;
    f32x4 acc[2][2][4][2];
#pragma unroll
    for (int a = 0; a < 2; ++a)
#pragma unroll
        for (int b = 0; b < 2; ++b)
#pragma unroll
            for (int m = 0; m < 4; ++m)
#pragma unroll
                for (int n = 0; n < 2; ++n) acc[a][b][m][n] = (f32x4){0.f, 0.f, 0.f, 0.f};
    bf16x8 At[4][2], B0[2][2], B1[2][2];
    const char* cA = (const char*)g.A + (size_t)cur.pm * tstepA; const char* cB = (const char*)g.Bt + (size_t)cur.pn * tstepB;
    if constexpr (SP2) {
        PG8_STAGE(PG8_SB(0, 0), cB, voffB); PG8_STAGE(PG8_SB(0, 1), cB + hstepB, voffB); PG8_STAGE(PG8_SA(0, 0), cA, voffA); PG8_STAGE(PG8_SA(0, 1), cA + hstepA, voffA);
        if (wr == 1) PG8_BAR;
        PG8_WAIT_V(2); PG8_BAR;
        PG8_STAGE(PG8_SB(1, 0), cB + kstep, voffB); PG8_STAGE(PG8_SA(1, 0), cA + kstep, voffA); PG8_STAGE(PG8_SB(1, 1), cB + hstepB + kstep, voffB);
        PG8_WAIT_V(6); PG8_BAR;
    } else {
        PG8_STAGE(PG8_SB(0, 0), cB, voffB); PG8_STAGE(PG8_SA(0, 0), cA, voffA); PG8_STAGE(PG8_SB(0, 1), cB + hstepB, voffB); PG8_STAGE(PG8_SA(0, 1), cA + hstepA, voffA);
        if (wr == 1) PG8_BAR;
        PG8_WAIT_V(4); PG8_BAR;
        PG8_STAGE(PG8_SB(1, 0), cB + kstep, voffB); PG8_STAGE(PG8_SA(1, 0), cA + kstep, voffA); PG8_STAGE(PG8_SB(1, 1), cB + hstepB + kstep, voffB);
        PG8_WAIT_V(6); PG8_BAR;
    }
    for (;;) {
        const bool has_next = S.next(ui + 1, nxt);
        const char* nA = has_next ? (const char*)g.A + (size_t)nxt.pm * tstepA : cA; const char* nB = has_next ? (const char*)g.Bt + (size_t)nxt.pn * tstepB : cB;
        for (int t = 0; t < nt; t += 2) {
            const bool last = (t == nt - 2);
            const char* a1 = cA + (size_t)(t + 1) * kstep;
            const char* a2 = last ? nA : cA + (size_t)(t + 2) * kstep; const char* b2 = last ? nB : cB + (size_t)(t + 2) * kstep;
            const char* a3 = a2 + kstep; const char* b3 = b2 + kstep;
            if constexpr (SP2) {
            PG8_LDB(B0, 0, 0); PG8_LDB(B1, 0, 1); PG8_SCHED; PG8_LDA(At, 0, 0); PG8_STAGE(PG8_SA(1, 1), a1 + hstepA, voffA);
            PG8_WAIT_V(8); PG8_WAIT_L(0); PG8_BAR; PG8_MMA(0, 0, At, B0); PG8_MMA(0, 1, At, B1); PG8_BAR; PG8_SCHED;
            PG8_LDA(At, 0, 1); PG8_STAGE(PG8_SB(0, 0), b2, voffB); PG8_STAGE(PG8_SB(0, 1), b2 + hstepB, voffB); PG8_STAGE(PG8_SA(0, 0), a2, voffA);
            PG8_WAIT_V(8); PG8_WAIT_L(0); PG8_BAR; PG8_MMA(1, 0, At, B0); PG8_MMA(1, 1, At, B1); PG8_BAR; PG8_SCHED;
            PG8_LDB(B0, 1, 0); PG8_LDB(B1, 1, 1); PG8_SCHED; PG8_LDA(At, 1, 0); PG8_STAGE(PG8_SA(0, 1), a2 + hstepA, voffA);
            PG8_WAIT_V(8); PG8_WAIT_L(0); PG8_BAR; PG8_MMA(0, 0, At, B0); PG8_MMA(0, 1, At, B1); PG8_BAR; PG8_SCHED;
            PG8_LDA(At, 1, 1); PG8_STAGE(PG8_SB(1, 0), b3, voffB); PG8_STAGE(PG8_SB(1, 1), b3 + hstepB, voffB); PG8_STAGE(PG8_SA(1, 0), a3, voffA);
            PG8_WAIT_V(8); PG8_WAIT_L(0); PG8_BAR; PG8_MMA(1, 0, At, B0); PG8_MMA(1, 1, At, B1); PG8_BAR; PG8_SCHED;
            } else {
            PG8_LDB(B0, 0, 0); PG8_SCHED; PG8_LDA(At, 0, 0); PG8_STAGE(PG8_SA(1, 1), a1 + hstepA, voffA);
            PG8_WAIT_L(8); PG8_BAR; PG8_WAIT_L(0); PG8_MMA(0, 0, At, B0); PG8_BAR; PG8_SCHED;
            PG8_LDB(B1, 0, 1); PG8_STAGE(PG8_SB(0, 0), b2, voffB);
            PG8_BAR; PG8_WAIT_L(0); PG8_MMA(0, 1, At, B1); PG8_BAR;
            PG8_LDA(At, 0, 1); PG8_STAGE(PG8_SA(0, 0), a2, voffA);
            PG8_BAR; PG8_WAIT_L(0); PG8_MMA(1, 0, At, B0); PG8_BAR; PG8_SCHED;
            PG8_STAGE(PG8_SB(0, 1), b2 + hstepB, voffB);
            PG8_WAIT_V(6); PG8_BAR; PG8_MMA(1, 1, At, B1); PG8_BAR;
            PG8_LDB(B0, 1, 0); PG8_SCHED; PG8_LDA(At, 1, 0); PG8_STAGE(PG8_SA(0, 1), a2 + hstepA, voffA);
            PG8_WAIT_L(8); PG8_BAR; PG8_WAIT_L(0); PG8_MMA(0, 0, At, B0); PG8_BAR; PG8_SCHED;
            PG8_LDB(B1, 1, 1); PG8_STAGE(PG8_SB(1, 0), b3, voffB);
            PG8_BAR; PG8_WAIT_L(0); PG8_MMA(0, 1, At, B1); PG8_BAR;
            PG8_LDA(At, 1, 1); PG8_STAGE(PG8_SA(1, 0), a3, voffA);
            PG8_BAR; PG8_WAIT_L(0); PG8_MMA(1, 0, At, B0); PG8_BAR; PG8_SCHED;
            PG8_STAGE(PG8_SB(1, 1), b3 + hstepB, voffB);
            PG8_WAIT_V(6); PG8_BAR; PG8_MMA(1, 1, At, B1); PG8_BAR;
            }
        }
        if constexpr (ALIGN_EPI) { if (wr == 0) PG8_BAR; }
        E(acc, cur, wr, wc, fr, fq);
        if (!has_next) break;
#pragma unroll
        for (int a = 0; a < 2; ++a)
#pragma unroll
            for (int b = 0; b < 2; ++b)
#pragma unroll
                for (int m = 0; m < 4; ++m)
#pragma unroll
                    for (int n = 0; n < 2; ++n) acc[a][b][m][n] = (f32x4){0.f, 0.f, 0.f, 0.f};
        cur = nxt; cA = nA; cB = nB; ++ui;
        if constexpr (ALIGN_EPI) { if (wr == 1) PG8_BAR; }
    }
    PG8_WAIT_V(0);
    if constexpr (!ALIGN_EPI) { if (wr == 0) PG8_BAR; }
    PG8_BAR;
#undef PG8_SA
#undef PG8_SB
#undef PG8_STAGE
#undef PG8_LDA
#undef PG8_LDB
#undef PG8_MMA
#undef PG8_WAIT_V
#undef PG8_WAIT_L
#undef PG8_BAR
#undef PG8_SCHED
}
}

#define XB_TMO      128
#define XB_XCNT(j)  (256  + 64 * (j))
#define XB_XSUB(j)  (1280 + 64 * (j))
#define XB_XGEN(j)  (2304 + 64 * (j))
#define XB_TOP      3328
#define XB_TOPGEN   3392
#define XCD_BAR_WORDS 3456
#define XB_SPIN_CAP (1u << 18)
__device__ __forceinline__ unsigned xb_ld(unsigned* p)              { return __hip_atomic_load(p, __ATOMIC_RELAXED, __HIP_MEMORY_SCOPE_AGENT); }
__device__ __forceinline__ unsigned xb_add(unsigned* p, unsigned v) { return __hip_atomic_fetch_add(p, v, __ATOMIC_RELAXED, __HIP_MEMORY_SCOPE_AGENT); }
__device__ __forceinline__ unsigned xb_xcc_id() { return (unsigned)__builtin_amdgcn_s_getreg((3 << 11) | 20) & 0xFu; }
#define XB_SPIN(cond, bar) do { unsigned _sp = 0; while (cond) { __builtin_amdgcn_s_sleep(1); \
    if ((++_sp & 255u) == 0u) { if (xb_ld(&(bar)[XB_TMO])) break; if (_sp > XB_SPIN_CAP) { atomicAdd(&(bar)[XB_TMO], 1u); break; } } } } while (0)
struct XcdBarrier { unsigned* bar; unsigned x; volatile LAS unsigned* st; };
__device__ __forceinline__ XcdBarrier xcd_barrier_post(unsigned* bar, volatile LAS unsigned* st) {
    XcdBarrier b; b.bar = bar; b.x = xb_xcc_id(); b.st = st;
    if (threadIdx.x == 0) (void)xb_add(&bar[XB_XCNT(b.x)], 1u);
    return b;
}
__device__ __forceinline__ void xcd_barrier_complete(unsigned* bar, unsigned x, unsigned& nloc, unsigned& nx) {
    const unsigned G = gridDim.x * gridDim.y * gridDim.z;
    unsigned sum, cnt, mine, sp = 0u;
    for (;;) {
        sum = 0u; cnt = 0u; mine = 0u;
#pragma unroll
        for (unsigned j = 0; j < 16; ++j) { const unsigned c = xb_ld(&bar[XB_XCNT(j)]); sum += c; cnt += (c > 0u) ? 1u : 0u; mine = (j == x) ? c : mine; }
        if (sum == G) break;
        __builtin_amdgcn_s_sleep(1);
        if ((++sp & 255u) == 0u) { if (xb_ld(&bar[XB_TMO])) break; if (sp > XB_SPIN_CAP) { atomicAdd(&bar[XB_TMO], 1u); break; } }
    }
    nloc = mine > 0u ? mine : 1u; nx = cnt > 0u ? cnt : 1u;
}
__device__ __forceinline__ void xcd_barrier(const XcdBarrier& b, const int tid0) {
    asm volatile("s_waitcnt vmcnt(0)" ::: "memory");
    __syncthreads();
    if (tid0 == 0) {
        unsigned* bar = b.bar;
        __builtin_amdgcn_s_waitcnt(0);
        unsigned nloc = b.st[0], nx = b.st[1];
        if (nloc == 0u) { xcd_barrier_complete(bar, b.x, nloc, nx); b.st[0] = nloc; b.st[1] = nx; }
        const unsigned old = xb_add(&bar[XB_XSUB(b.x)], 1u);
        const unsigned gen = old / nloc;
        if (old + 1u == (gen + 1u) * nloc) {
            __builtin_amdgcn_fence(__ATOMIC_RELEASE, "agent");
            asm volatile("s_waitcnt vmcnt(0)" ::: "memory");
            const unsigned og = xb_add(&bar[XB_TOP], 1u);
            const unsigned tg = og / nx;
            if (og + 1u == (tg + 1u) * nx) xb_add(&bar[XB_TOPGEN], 1u);
            else XB_SPIN(xb_ld(&bar[XB_TOPGEN]) == tg, bar);
            __builtin_amdgcn_fence(__ATOMIC_ACQUIRE, "agent");
            xb_add(&bar[XB_XGEN(b.x)], 1u);
            asm volatile("s_waitcnt vmcnt(0)" ::: "memory");
        } else {
            XB_SPIN(xb_ld(&bar[XB_XGEN(b.x)]) == gen, bar);
            __builtin_amdgcn_fence(__ATOMIC_ACQUIRE, "agent");
            asm volatile("s_waitcnt vmcnt(0)" ::: "memory");
        }
    }
    __syncthreads();
}

constexpr int LDS_BYTES = 147456;
struct Params { const float* in[39]; float* out; unsigned char* ws; };

struct TrTile { const float* W; const float* gain; bf16_t* dst; int N, Npad, ldb, mode, k0, n0; };
__device__ __forceinline__ void tr_load(const TrTile& t, int tid, f32x4 (&v)[8], float (&gv)[8]) {
    const float* gp = t.gain ? t.gain : t.W;
#pragma unroll
    for (int i = 0; i < 8; ++i) { const int pp = tid + 512 * i, kk = pp >> 6, n = t.n0 + (pp & 63) * 4; const bool inb = n + 3 < t.N;
        v[i] = *(const f32x4*)(t.W + (size_t)(t.k0 + kk) * t.N + (inb ? n : 0)); gv[i] = gp[t.k0 + kk]; }
}
__device__ __forceinline__ void tr_to_lds(const TrTile& t, int tid, const f32x4 (&v)[8], const float (&gv)[8], LAS unsigned char* l) {
#pragma unroll
    for (int i = 0; i < 8; ++i) { const int pp = tid + 512 * i, kk = pp >> 6, n4 = (pp & 63) * 4; const bool inb = t.n0 + n4 + 3 < t.N;
        const float g = t.gain ? gv[i] : 1.f; const f32x4 x = inb ? v[i] * g : (f32x4){0.f, 0.f, 0.f, 0.f};
        u32x2 w; w.x = pk2(x[0], x[1]); w.y = pk2(x[2], x[3]); *(LAS u32x2*)(l + kk * 528 + n4 * 2) = w; }
}
__device__ __forceinline__ void tr_store(const TrTile& t, int tid, const LAS unsigned char* l) {
#pragma unroll
    for (int i = 0; i < 4; ++i) { const int pp = tid + 512 * i, n = pp >> 3, c = pp & 7; const int jn = t.n0 + n;
        if (jn < t.Npad) { const LAS bf16_t* s = (const LAS bf16_t*)(l + (8 * c) * 528) + n;
            const int drow = t.mode == 0 ? jn : ((jn >> 7) * 256 + (jn & 127) + (t.mode == 2 ? 128 : 0));
            u32x4 o; o.x = (unsigned)s[0] | ((unsigned)s[264] << 16); o.y = (unsigned)s[2 * 264] | ((unsigned)s[3 * 264] << 16); o.z = (unsigned)s[4 * 264] | ((unsigned)s[5 * 264] << 16); o.w = (unsigned)s[6 * 264] | ((unsigned)s[7 * 264] << 16);
            *(u32x4*)(t.dst + (size_t)drow * t.ldb + t.k0 + 8 * c) = o; } }
}

__global__ void __launch_bounds__(512, 2) mega(Params p) {
    extern __shared__ __attribute__((aligned(16))) unsigned char lds_raw[];
    LAS unsigned char* lds = (LAS unsigned char*)lds_raw;
    cg::grid_group grid = cg::this_grid();
    const int G = gridDim.x, bid = blockIdx.x;
#define PHASE_IDS int tid_o = threadIdx.x; asm volatile("" : "+v"(tid_o)); const int tid = tid_o, lane = tid & 63, wave = tid >> 6; (void)lane; (void)wave;
#define SS0 ((unsigned long long*)(p.ws + WS_SSQ))
#define SS1 (SS0 + M)
#define SS2 (SS0 + 2 * M)
#define SS3 (SS0 + 3 * M)
#define LBT ((float*)(p.ws + CTL_LB))
#define LBR ((float*)(p.ws + CTL_LBR))
#define LBI ((float*)(p.ws + CTL_LBI))
#define BBR ((float*)(p.ws + CTL_BBR))
#define BBI ((float*)(p.ws + CTL_BBI))
#define XB ((bf16_t*)(p.ws + WS_XB))
#define YC ((bf16_t*)(p.ws + WS_YC))
#define U ((bf16_t*)(p.ws + WS_U))
    { volatile LAS unsigned* st0 = (volatile LAS unsigned*)(lds + LDS_BYTES - 64); if (threadIdx.x < 16) st0[threadIdx.x] = 0u; }
    __syncthreads();
    (void)xcd_barrier_post((unsigned*)(p.ws + WS_CTL), (volatile LAS unsigned*)(lds + LDS_BYTES - 64));
#ifndef PROBE
#define PROBE 0
#endif
#ifndef PROBE_MASK
#define PROBE_MASK 0
#endif
#define STAMP(k) do { if (PROBE && bid == 0 && threadIdx.x == 0) ((unsigned long long*)(p.ws + CTL_TS))[k] = __builtin_amdgcn_s_memrealtime(); } while (0)
#define STAMP2(k, blk) do { if (PROBE && bid == (blk) && threadIdx.x == 0) ((unsigned long long*)(p.ws + CTL_TS))[k] = __builtin_amdgcn_s_memrealtime(); } while (0)
    STAMP(0);
#define GSYNC() do { XcdBarrier xb_; xb_.bar = (unsigned*)(p.ws + WS_CTL); xb_.x = xb_xcc_id(); xb_.st = (volatile LAS unsigned*)(lds + LDS_BYTES - 64); xcd_barrier(xb_, (int)threadIdx.x); } while (0)

    {
        PHASE_IDS
        constexpr int T_IN0 = 16 * 15, T_SQ = 16 * 4, T_GU = 16 * 11, T_DN = 44 * 4, T_IN1 = 16 * 14, T_GL = 4 * 1;
        constexpr int NT = T_IN0 + T_SQ + 2 * T_GU + T_DN + T_IN1 + T_SQ + 2 * T_GU + T_DN + T_GL;
#define P0_DECODE(T_, it_) { int r = (it_); const float* W; const float* gain; bf16_t* dst; int N, Npad, nNt, ldb, mode; \
            if (r < T_IN0) { W = p.in[4]; gain = p.in[1]; dst = (bf16_t*)(p.ws + WS_IN0); N = EVEN_IN; Npad = LDU0; nNt = 15; ldb = DM; mode = 0; } \
            else if ((r -= T_IN0) < T_SQ) { W = p.in[5]; gain = nullptr; dst = (bf16_t*)(p.ws + WS_OUT0); N = DM; Npad = DM; nNt = 4; ldb = DM; mode = 0; } \
            else if ((r -= T_SQ) < T_GU) { W = p.in[36]; gain = p.in[2]; dst = (bf16_t*)(p.ws + WS_GU0); N = FFN; Npad = FFN; nNt = 11; ldb = DM; mode = 1; } \
            else if ((r -= T_GU) < T_GU) { W = p.in[37]; gain = p.in[2]; dst = (bf16_t*)(p.ws + WS_GU0); N = FFN; Npad = FFN; nNt = 11; ldb = DM; mode = 2; } \
            else if ((r -= T_GU) < T_DN) { W = p.in[38]; gain = nullptr; dst = (bf16_t*)(p.ws + WS_D0); N = DM; Npad = DM; nNt = 4; ldb = FFN; mode = 0; } \
            else if ((r -= T_DN) < T_IN1) { W = p.in[19]; gain = p.in[1] + DM; dst = (bf16_t*)(p.ws + WS_IN1); N = ODD_IN; Npad = NP1; nNt = 14; ldb = DM; mode = 0; } \
            else if ((r -= T_IN1) < T_SQ) { W = p.in[20]; gain = nullptr; dst = (bf16_t*)(p.ws + WS_OUT1); N = DM; Npad = DM; nNt = 4; ldb = DM; mode = 0; } \
            else if ((r -= T_SQ) < T_GU) { W = p.in[36] + (size_t)DM * FFN; gain = p.in[2] + DM; dst = (bf16_t*)(p.ws + WS_GU1); N = FFN; Npad = FFN; nNt = 11; ldb = DM; mode = 1; } \
            else if ((r -= T_GU) < T_GU) { W = p.in[37] + (size_t)DM * FFN; gain = p.in[2] + DM; dst = (bf16_t*)(p.ws + WS_GU1); N = FFN; Npad = FFN; nNt = 11; ldb = DM; mode = 2; } \
            else if ((r -= T_GU) < T_DN) { W = p.in[38] + (size_t)FFN * DM; gain = nullptr; dst = (bf16_t*)(p.ws + WS_D1); N = DM; Npad = DM; nNt = 4; ldb = FFN; mode = 0; } \
            else { r -= T_DN; W = p.in[29]; gain = nullptr; dst = (bf16_t*)(p.ws + WS_GLU); N = 256; Npad = 256; nNt = 1; ldb = 256; mode = 0; } \
            T_.W = W; T_.gain = gain; T_.dst = dst; T_.N = N; T_.Npad = Npad; T_.ldb = ldb; T_.mode = mode; T_.k0 = (r / nNt) * 64; T_.n0 = (r % nNt) * 256; }
        if (bid < NT) {
            TrTile cur, nxt; f32x4 tv[8]; float tg[8];
            P0_DECODE(cur, bid); tr_load(cur, tid, tv, tg);
            for (int it = bid; it < NT; it += G) {
                const int itn = (it + G < NT) ? it + G : it; P0_DECODE(nxt, itn);
                __syncthreads();
                tr_to_lds(cur, tid, tv, tg, lds);
                tr_load(nxt, tid, tv, tg);
                __syncthreads();
                tr_store(cur, tid, lds);
                cur = nxt;
            }
        }
#undef P0_DECODE
        const float* x = p.in[0];
        for (int row = bid * 8 + wave; row < M; row += G * 16) {
            const int row2 = row + G * 8; const bool has2 = row2 < M;
            const f32x4* xr = (const f32x4*)(x + (size_t)row * DM) + lane; const f32x4* xr2 = (const f32x4*)(x + (size_t)(has2 ? row2 : row) * DM) + lane; f32x4 v[4], v2[4]; float s = 0.f, s2 = 0.f;
#pragma unroll
            for (int j = 0; j < 4; ++j) { v[j] = xr[64 * j]; v2[j] = xr2[64 * j]; }
#pragma unroll
            for (int j = 0; j < 4; ++j) { s += (v[j][0] * v[j][0] + v[j][1] * v[j][1]) + (v[j][2] * v[j][2] + v[j][3] * v[j][3]); s2 += (v2[j][0] * v2[j][0] + v2[j][1] * v2[j][1]) + (v2[j][2] * v2[j][2] + v2[j][3] * v2[j][3]); }
            s = wave_sum(s); s2 = wave_sum(s2); if (lane == 0) { SS0[row] = ss_fix(s); if (has2) SS0[row2] = ss_fix(s2); }
            u32x2* o = (u32x2*)(XB + (size_t)row * DM) + lane; u32x2* o2 = (u32x2*)(XB + (size_t)row2 * DM) + lane;
#pragma unroll
            for (int j = 0; j < 4; ++j) { u32x2 w; w.x = pk2(v[j][0], v[j][1]); w.y = pk2(v[j][2], v[j][3]); o[64 * j] = w; if (has2) { u32x2 w2; w2.x = pk2(v2[j][0], v2[j][1]); w2.y = pk2(v2[j][2], v2[j][3]); o2[64 * j] = w2; } }
        }
        for (int i = bid * 512 + tid; i < 3 * M; i += G * 512) SS1[i] = 0ull;
        for (int i = bid * 512 + tid; i < 512 * 160; i += G * 512) { const int c = i / 160, k = i % 160;
            const float v = (k < 32) ? p.in[10][k * 512 + c] : (k < 64) ? p.in[12][(k - 32) * 512 + c] : p.in[13][(k - 64) * 512 + c]; ((bf16_t*)(p.ws + WS_LORA))[i] = f2bf(v); }
        { const int gt = bid * 512 + tid;
          if (gt < 512) { const float* lt = p.in[6]; const float l0 = lt[gt], l1 = lt[512 + gt], l2 = lt[1024 + gt]; const float mx = fmaxf(l0, fmaxf(l1, l2));
              const float e0 = expf(l0 - mx), e1 = expf(l1 - mx), e2 = expf(l2 - mx); LBT[gt] = e0 / (e0 + e1 + e2); }
          const int i = gt - 512;
          if (i >= 0 && i < 16384) { const int gp = i >> 4, h = i & 15, g = gp >> 6; const float step = expf(p.in[23][g]); const float lr = p.in[21][gp], li = p.in[22][gp];
              const float mag = expf(lr * step); const float br = mag * cosf(li * step), bi = mag * sinf(li * step);
              if (h == 0) { LBR[gp] = br; LBI[gp] = bi; }
              const float den = lr * lr + li * li, nr = br - 1.f, ni = bi; const float cr = (nr * lr + ni * li) / den, ci = (ni * lr - nr * li) / den;
              const float xr2 = p.in[24][gp * 16 + h], xi2 = p.in[25][gp * 16 + h]; BBR[gp * 16 + h] = cr * xr2 - ci * xi2; BBI[gp * 16 + h] = cr * xi2 + ci * xr2; } }
    }
    grid.sync();
    STAMP(1);

    { pg8::Gemm g{XB, (const bf16_t*)(p.ws + WS_IN0), DM, DM, M, LDU0, DM}; pg8::StaticOrder S; S.init(M, LDU0, G, bid);
      pg8::EpiScaleBf16 E{U, LDU0, SS0}; pg8::gemm_phase<pg8::EpiScaleBf16, pg8::StaticOrder, true, true>(lds, g, S, E); }
    GSYNC();
    STAMP(2);

#define Rt ((bf16_t*)p.out)
#define At (Rt + (size_t)M * 512)
#define Bh (Rt + (size_t)M * 1024)
#define Kh (Rt + (size_t)M * 1536)
#define Vv XB
#define BVG (XB + (size_t)M * 512)
#define Gg ((bf16_t*)(p.ws + WS_MS))
#define GLc ((float*)(p.ws + WS_MS + 32 * MiB))
#define HEM ((float*)(p.ws + WS_MS + 64 * MiB))
#define HEL ((float*)(p.ws + WS_MS + 65 * MiB))
#define HELM ((float*)(p.ws + WS_MS + 66 * MiB))

    {
        PHASE_IDS
        const int hd = __builtin_amdgcn_readfirstlane(tid >> 6), fr = lane & 15, fq = lane >> 4;
        constexpr int SLS = 336;
        const bf16_t* LT = (const bf16_t*)(p.ws + WS_LORA);
        float mu_r[4], mu_k[4], mu_v[4], w0c[4], a0c[4], kkc[4], kac[4], rkc[4];
#pragma unroll
        for (int nt = 0; nt < 4; ++nt) { const int c = hd * 64 + 4 * fr + nt; mu_r[nt] = p.in[8][c]; mu_k[nt] = p.in[8][512 + c]; mu_v[nt] = p.in[8][1024 + c];
            w0c[nt] = p.in[9][c]; a0c[nt] = p.in[11][c]; kkc[nt] = p.in[14][c]; kac[nt] = p.in[15][c]; rkc[nt] = p.in[16][c]; }
        bf16_t sa_c[5], sa_p[5];
        const unsigned char* zsrc = p.ws + WS_CTL + 128 * 1024;
#define P2_FETCH(cidx_, RAWn_) { const int m0_ = (cidx_) * 16; const bool sq_ = (m0_ & (SEQ - 1)) == 0; \
            _Pragma("unroll") for (int i_ = 0; i_ < 5; ++i_) { const int id_ = tid + 512 * i_, t_ = id_ / 160, j_ = id_ % 160; const bf16_t* ur_ = U + (size_t)(m0_ + t_) * LDU0 + 3584 + j_; sa_c[i_] = ur_[0]; sa_p[i_] = ur_[-LDU0]; } \
            _Pragma("unroll") for (int i_ = 0; i_ < 7; ++i_) { const int q_ = hd + 8 * i_; if (q_ < 51) { const int row_ = q_ / 3, th_ = q_ % 3; \
                const unsigned char* g_ = (row_ == 0 && sq_) ? zsrc + th_ * 1024 + lane * 16 : (const unsigned char*)(U + ((size_t)m0_ + row_) * LDU0 - LDU0 + 2048 + th_ * 512 + lane * 8); \
                __builtin_amdgcn_global_load_lds((const unsigned*)g_, (LAS unsigned*)((RAWn_) + row_ * 3088 + th_ * 1024), 16, 0, 0); } } }
        P2_FETCH(bid, lds + 12288);
        int it = 0;
        for (int cidx = bid; cidx < M / 16; cidx += G, ++it) {
            const int m0 = cidx * 16; const bool seq0 = (m0 & (SEQ - 1)) == 0;
            LAS unsigned char* SL = lds + (it & 1) * (16 * SLS);
            LAS unsigned char* RAW = lds + 12288 + (it & 1) * 52496;
#pragma unroll
            for (int i = 0; i < 5; ++i) { const int id = tid + 512 * i, t = id / 160, j = id % 160;
                const float cur = bf2f(sa_c[i]); const float prev = (t == 0 && seq0) ? 0.f : bf2f(sa_p[i]); const float v = cur + (prev - cur) * p.in[8][1536 + j];
                *(LAS bf16_t*)(SL + t * SLS + j * 2) = f2bf((j < 32) ? tanhf_(v) : (j < 64 ? v : sigmoidf_(v))); }
            asm volatile("s_waitcnt vmcnt(0)" ::: "memory");
            __syncthreads();
            f32x4 dw[4], da[4], dg[4];
            { bf16x8 sf[5];
#pragma unroll
              for (int kk = 0; kk < 5; ++kk) sf[kk] = *(const LAS bf16x8*)(SL + fr * SLS + (kk * 32 + 8 * fq) * 2);
              const f32x4 z4 = {0.f, 0.f, 0.f, 0.f};
#pragma unroll
              for (int nt = 0; nt < 4; ++nt) { const bf16_t* lr = LT + (size_t)(hd * 64 + 4 * fr + nt) * 160 + 8 * fq;
                  const bf16x8 wf = *(const bf16x8*)lr, af = *(const bf16x8*)(lr + 32), g0 = *(const bf16x8*)(lr + 64), g1 = *(const bf16x8*)(lr + 96), g2 = *(const bf16x8*)(lr + 128);
                  dw[nt] = __builtin_amdgcn_mfma_f32_16x16x32_bf16(sf[0], wf, z4, 0, 0, 0); da[nt] = __builtin_amdgcn_mfma_f32_16x16x32_bf16(sf[1], af, z4, 0, 0, 0);
                  f32x4 g = __builtin_amdgcn_mfma_f32_16x16x32_bf16(sf[2], g0, z4, 0, 0, 0); g = __builtin_amdgcn_mfma_f32_16x16x32_bf16(sf[3], g1, g, 0, 0, 0); dg[nt] = __builtin_amdgcn_mfma_f32_16x16x32_bf16(sf[4], g2, g, 0, 0, 0); } }
            { const int cn = (cidx + G < M / 16) ? cidx + G : cidx; P2_FETCH(cn, lds + 12288 + ((it + 1) & 1) * 52496); }
            float as_[4][4], wd_[4][4];
            float ssq[4] = {0.f, 0.f, 0.f, 0.f}, bon[4] = {0.f, 0.f, 0.f, 0.f};
#pragma unroll
            for (int nt = 0; nt < 4; ++nt)
#pragma unroll
                for (int r = 0; r < 4; ++r) { const LAS bf16_t* rw = (const LAS bf16_t*)(RAW + (4 * fq + r) * 3088) + hd * 64 + 4 * fr + nt;
                    const float c0 = bf2f(rw[1544]), c1 = bf2f(rw[1544 + 512]);
                    const float p0 = bf2f(rw[0]), p1 = bf2f(rw[512]);
                    const float rv = c0 + (p0 - c0) * mu_r[nt], kv = c1 + (p1 - c1) * mu_k[nt];
                    const float wlog = -softplusf_(-(w0c[nt] + dw[nt][r])) - 0.5f;
                    wd_[nt][r] = __expf(-__expf(wlog));
                    const float a = sigmoidf_(a0c[nt] + da[nt][r]); as_[nt][r] = a;
                    const float kkv = kv * kkc[nt]; ssq[r] = fmaf(kkv, kkv, ssq[r]);
                    bon[r] = fmaf(rv * kv * (1.f + (a - 1.f) * kac[nt]), rkc[nt], bon[r]); }
#pragma unroll
            for (int r = 0; r < 4; ++r) { ssq[r] = 1.0f / fmaxf(sqrtf(row_sum16(ssq[r])), 1e-12f); bon[r] = row_sum16(bon[r]); }
            float gam[4][5];
#pragma unroll
            for (int nt = 0; nt < 4; ++nt) {
                const float q1 = wd_[nt][0], q2 = q1 * wd_[nt][1], q3 = q2 * wd_[nt][2], q4 = q3 * wd_[nt][3];
                const float t0 = __shfl(q4, fr), t1 = __shfl(q4, fr + 16), t2 = __shfl(q4, fr + 32);
                const float pre = (fq == 0) ? 1.f : (fq == 1) ? t0 : (fq == 2) ? t0 * t1 : t0 * t1 * t2;
                gam[nt][0] = pre; gam[nt][1] = pre * q1; gam[nt][2] = pre * q2; gam[nt][3] = pre * q3; gam[nt][4] = pre * q4; }
#pragma unroll
            for (int r = 0; r < 4; ++r) { const size_t o = (size_t)(m0 + 4 * fq + r) * 512 + hd * 64 + 4 * fr; const LAS bf16_t* rw = (const LAS bf16_t*)(RAW + (4 * fq + r) * 3088) + hd * 64 + 4 * fr;
                float oa[4], orr[4], ob[4], okk[4], ov[4], og[4], obv[4];
#pragma unroll
                for (int nt = 0; nt < 4; ++nt) {
                    const float c0 = bf2f(rw[1544 + nt]), c1 = bf2f(rw[1544 + 512 + nt]), c2 = bf2f(rw[1544 + 1024 + nt]);
                    const float p0 = bf2f(rw[nt]), p1 = bf2f(rw[512 + nt]), p2 = bf2f(rw[1024 + nt]);
                    const float rv = c0 + (p0 - c0) * mu_r[nt], kv = c1 + (p1 - c1) * mu_k[nt], vv = c2 + (p2 - c2) * mu_v[nt];
                    const float a = as_[nt][r], kk = kv * kkc[nt] * ssq[r], kp = kv * (1.f + (a - 1.f) * kac[nt]), ig = __builtin_amdgcn_rcpf(gam[nt][r + 1]), g = dg[nt][r];
                    oa[nt] = -kk * gam[nt][r]; orr[nt] = rv * gam[nt][r + 1]; ob[nt] = kk * a * ig; okk[nt] = kp * ig; ov[nt] = vv; og[nt] = g; obv[nt] = bon[r] * vv * g; }
                u32x2 w;
                w.x = pk2(oa[0], oa[1]); w.y = pk2(oa[2], oa[3]); *(u32x2*)(At + o) = w;
                w.x = pk2(orr[0], orr[1]); w.y = pk2(orr[2], orr[3]); *(u32x2*)(Rt + o) = w;
                w.x = pk2(ob[0], ob[1]); w.y = pk2(ob[2], ob[3]); *(u32x2*)(Bh + o) = w;
                w.x = pk2(okk[0], okk[1]); w.y = pk2(okk[2], okk[3]); *(u32x2*)(Kh + o) = w;
                w.x = pk2(ov[0], ov[1]); w.y = pk2(ov[2], ov[3]); *(u32x2*)(Vv + o) = w;
                w.x = pk2(og[0], og[1]); w.y = pk2(og[2], og[3]); *(u32x2*)(Gg + o) = w;
                w.x = pk2(obv[0], obv[1]); w.y = pk2(obv[2], obv[3]); *(u32x2*)(BVG + o) = w; }
            if (fq == 3) *(f32x4*)(GLc + (size_t)cidx * 512 + hd * 64 + 4 * fr) = (f32x4){gam[0][4], gam[1][4], gam[2][4], gam[3][4]};
        }
#undef P2_FETCH
        STAMP2(20, 0);
        {
            constexpr int HS = 272;
            LAS unsigned char* LQ = lds; LAS unsigned char* LF = lds + 64 * HS;
            int prow[2], pc8[2];
#pragma unroll
            for (int i = 0; i < 2; ++i) { const int pp = tid + 512 * i; prow[i] = pp >> 4; pc8[i] = (pp & 15) * 8; }
            u32x4 rq[2], rf[2]; f32x4 lbn[2][2];
#define HP_FETCH(t_) { const int ch_ = (t_) >> 2, hh_ = (t_) & 3; _Pragma("unroll") for (int i_ = 0; i_ < 2; ++i_) { const bf16_t* r_ = U + ((size_t)ch_ * 64 + prow[i_]) * LDU0 + hh_ * 128 + pc8[i_]; rq[i_] = *(const u32x4*)r_; rf[i_] = *(const u32x4*)(r_ + 512); \
                const float* l_ = LBT + hh_ * 128 + (wave + 8 * i_) * 8; lbn[i_][0] = *(const f32x4*)l_; lbn[i_][1] = *(const f32x4*)(l_ + 4); } }
            asm volatile("s_waitcnt vmcnt(0)" ::: "memory");
            __syncthreads();
            HP_FETCH(bid);
            for (int tl = bid; tl < (M / 64) * 4; tl += G) {
                const int ch = tl >> 2, hh = tl & 3;
#pragma unroll
                for (int i = 0; i < 2; ++i) { *(LAS u32x4*)(LQ + prow[i] * HS + pc8[i] * 2) = rq[i]; *(LAS u32x4*)(LF + prow[i] * HS + pc8[i] * 2) = rf[i]; }
                const float lbv[2][8] = {{lbn[0][0][0], lbn[0][0][1], lbn[0][0][2], lbn[0][0][3], lbn[0][1][0], lbn[0][1][1], lbn[0][1][2], lbn[0][1][3]}, {lbn[1][0][0], lbn[1][0][1], lbn[1][0][2], lbn[1][0][3], lbn[1][1][0], lbn[1][1][1], lbn[1][1][2], lbn[1][1][3]}};
                __syncthreads();
                { const int tn = (tl + G < (M / 64) * 4) ? tl + G : tl; HP_FETCH(tn); }
#pragma unroll
                for (int gi = 0; gi < 2; ++gi) { const int cg = wave + 8 * gi, c0 = hh * 128 + cg * 8;
                    LAS u32x4* lq = (LAS u32x4*)(LQ + lane * HS + cg * 16); LAS u32x4* lf = (LAS u32x4*)(LF + lane * HS + cg * 16);
                    const u32x4 wq = *lq, wf = *lf;
                    const unsigned wqa[4] = {wq.x, wq.y, wq.z, wq.w}, wfa[4] = {wf.x, wf.y, wf.z, wf.w};
                    unsigned oq[4], ok[4];
#pragma unroll
                    for (int j = 0; j < 8; ++j) { const float aq = (j & 1) ? bfhi(wqa[j >> 1]) : bflo(wqa[j >> 1]), af = (j & 1) ? bfhi(wfa[j >> 1]) : bflo(wfa[j >> 1]);
                        const float kv = (1.f - lbv[gi][j]) * sigmoidf_(-af);
                        float bs = __logf(1.f - kv);
                        bs += __int_as_float(__builtin_amdgcn_update_dpp(0, __float_as_int(bs), 0x111, 0xf, 0xf, true)); bs += __int_as_float(__builtin_amdgcn_update_dpp(0, __float_as_int(bs), 0x112, 0xf, 0xf, true));
                        bs += __int_as_float(__builtin_amdgcn_update_dpp(0, __float_as_int(bs), 0x114, 0xf, 0xf, true)); bs += __int_as_float(__builtin_amdgcn_update_dpp(0, __float_as_int(bs), 0x118, 0xf, 0xf, true));
                        bs += __int_as_float(__builtin_amdgcn_update_dpp(0, __float_as_int(bs), 0x142, 0xa, 0xf, false)); bs += __int_as_float(__builtin_amdgcn_update_dpp(0, __float_as_int(bs), 0x143, 0xc, 0xf, false));
                        const float bm = __int_as_float(__builtin_amdgcn_readlane(__float_as_int(bs), 31)), bL = __int_as_float(__builtin_amdgcn_readlane(__float_as_int(bs), 63));
                        const float qt = siluf_(aq) * __expf(bs - bm), kt = kv * __expf(bm - bs);
                        if (j & 1) { oq[j >> 1] = pk2(__uint_as_float(oq[j >> 1]), qt); ok[j >> 1] = pk2(__uint_as_float(ok[j >> 1]), kt); } else { oq[j >> 1] = __float_as_uint(qt); ok[j >> 1] = __float_as_uint(kt); }
                        if (lane == 0) { const size_t vo = (size_t)ch * 512 + c0 + j; HEM[vo] = __expf(bm); HEL[vo] = __expf(bL); HELM[vo] = __expf(bL - bm); } }
                    u32x4 w; w.x = oq[0]; w.y = oq[1]; w.z = oq[2]; w.w = oq[3]; *lq = w;
                    w.x = ok[0]; w.y = ok[1]; w.z = ok[2]; w.w = ok[3]; *lf = w; }
                __syncthreads();
#pragma unroll
                for (int i = 0; i < 2; ++i) { bf16_t* r = U + ((size_t)ch * 64 + prow[i]) * LDU0 + hh * 128 + pc8[i];
                    *(u32x4*)r = *(const LAS u32x4*)(LQ + prow[i] * HS + pc8[i] * 2); *(u32x4*)(r + 512) = *(const LAS u32x4*)(LF + prow[i] * HS + pc8[i] * 2); }
            }
#undef HP_FETCH
        }
    }
    GSYNC();
    STAMP(3);

    for (int item = bid; item < 256; item += G) {
        PHASE_IDS
        const int w = __builtin_amdgcn_readfirstlane(tid >> 6), fr = lane & 15, fq = lane >> 4;
        const int grp_ = (item & 7) * 8 + (item >> 5), vt = (item >> 3) & 3, h = grp_ & 7, b = grp_ >> 3;
        constexpr int BUF = 20992, oRt = 0, oAt = 2304, oBh = 4608, oKh = 6912, oBT = 9216, oKT = 14336, oVT = 19456, oGL = 20736;
        constexpr int oMS = 4 * BUF, MSET = 3840, oAf = oMS + 3 * MSET, oTT = oAf + 2 * 1024, oWT = oTT + 2 * 1280, oUT = oWT + 1280, oST = oUT + 1280, LTOT = oST + 2304;
        constexpr int NCH = SEQ / 16;
        LAS unsigned char* L = lds;
        __syncthreads();
        for (int i = tid; i < LTOT / 4; i += 512) ((LAS unsigned*)L)[i] = 0u;
        __syncthreads();
        const size_t tok0 = (size_t)b * SEQ; const size_t colb = (size_t)h * 64;
#define RC_F144(B_, off_, kk_) (*(const LAS bf16x8*)((B_) + (off_) + fr * 144 + ((kk_) * 32 + 8 * fq) * 2))
#define RC_F80(base_, row0_) (*(const LAS bf16x8*)((base_) + ((row0_) + fr) * 80 + (8 * fq) * 2))
        if (w >= 3) {
            const int lt = tid - 192;
            const bf16_t* arr[4] = {Rt, At, Bh, Kh};
            const int q0 = lt, q1 = lt + 320;
            const int kind1 = (q1 < 512) ? 0 : (q1 < 544) ? 1 : (q1 < 560) ? 2 : 3;
            const char* gp0 = (const char*)(arr[q0 >> 7] + (tok0 + ((q0 >> 3) & 15)) * 512 + colb + (q0 & 7) * 8);
            const char* gp1 = kind1 == 0 ? (const char*)(arr[(q1 >> 7) & 3] + (tok0 + ((q1 >> 3) & 15)) * 512 + colb + (q1 & 7) * 8)
                            : kind1 == 1 ? (const char*)(Vv + (tok0 + ((q1 - 512) >> 1)) * 512 + colb + vt * 16 + ((q1 - 512) & 1) * 8)
                            : kind1 == 2 ? (const char*)(GLc + ((size_t)b * NCH) * 512 + colb + (q1 - 544) * 4) : gp0;
            const size_t st1 = (kind1 == 2) ? (size_t)512 * 4 : (size_t)16 * 512 * 2;
            u32x4 d0[2], d1[2], d2[2], d3[2];
#define RP_H(w_, j_) ((bf16_t)(((j_) & 1) ? ((w_) >> 16) : ((w_) & 0xffffu)))
#define RP_FETCH(D_, c_) { const size_t cc_ = (size_t)((c_) < NCH ? (c_) : NCH - 1); D_[0] = *(const u32x4*)(gp0 + cc_ * (size_t)(16 * 512 * 2)); D_[1] = *(const u32x4*)(gp1 + cc_ * st1); }
#define RP_TILE(B_, q_, D_) { const int tl_ = (q_) >> 7, t_ = ((q_) >> 3) & 15, k_ = ((q_) & 7) * 8; const unsigned w4_[4] = {D_.x, D_.y, D_.z, D_.w}; *(LAS u32x4*)((B_) + tl_ * 2304 + t_ * 144 + k_ * 2) = D_; \
                if (tl_ >= 2) { LAS bf16_t* x_ = (LAS bf16_t*)((B_) + (tl_ == 2 ? oBT : oKT) + k_ * 80 + t_ * 2); const int g_ = (q_) & 7; \
                    _Pragma("unroll") for (int j_ = 0; j_ < 8; ++j_) { const int jj_ = (j_ + g_) & 7; const unsigned ww_ = (jj_ >> 1) == 0 ? w4_[0] : (jj_ >> 1) == 1 ? w4_[1] : (jj_ >> 1) == 2 ? w4_[2] : w4_[3]; x_[jj_ * 40] = (bf16_t)(ww_ >> ((jj_ & 1) * 16)); } } }
#define RP_STORE(D_, buf_) { LAS unsigned char* B_ = L + (buf_) * BUF; RP_TILE(B_, q0, D_[0]); \
                if (kind1 == 0) { RP_TILE(B_, q1, D_[1]); } \
                else if (kind1 == 1) { const int vq_ = q1 - 512; const unsigned w4_[4] = {D_[1].x, D_[1].y, D_[1].z, D_[1].w}; LAS bf16_t* x_ = (LAS bf16_t*)(B_ + oVT + ((vq_ & 1) * 8) * 80 + (vq_ >> 1) * 2); _Pragma("unroll") for (int j_ = 0; j_ < 8; ++j_) x_[j_ * 40] = RP_H(w4_[j_ >> 1], j_); } \
                else if (kind1 == 2) *(LAS u32x4*)(B_ + oGL + (q1 - 544) * 16) = D_[1]; }
            RP_FETCH(d0, 0); RP_STORE(d0, 0); RP_FETCH(d0, 1); RP_STORE(d0, 1); RP_FETCH(d0, 2); RP_STORE(d0, 2);
            RP_FETCH(d3, 3); RP_FETCH(d0, 4); RP_FETCH(d1, 5); RP_FETCH(d2, 6);
            LBAR(); LBAR(); LBAR();
            unsigned long long twl_ = 0;
            for (int i = 0; i < NCH; i += 4) {
                const unsigned long long t0l_ = PROBE ? __builtin_amdgcn_s_memrealtime() : 0ull;
                if (i + 3 < NCH) RP_STORE(d3, (i + 3) & 3);
                RP_FETCH(d3, i + 7);
                asm volatile("s_waitcnt lgkmcnt(0)" ::: "memory"); if (PROBE) twl_ += __builtin_amdgcn_s_memrealtime() - t0l_;
                LBAR();
                if (i + 4 < NCH) RP_STORE(d0, (i + 4) & 3);
                RP_FETCH(d0, i + 8);
                LBAR();
                if (i + 5 < NCH) RP_STORE(d1, (i + 5) & 3);
                RP_FETCH(d1, i + 9);
                LBAR();
                if (i + 6 < NCH) RP_STORE(d2, (i + 6) & 3);
                RP_FETCH(d2, i + 10);
                LBAR();
            }
            if (PROBE && bid == 0 && w == 3 && lane == 0) { unsigned long long* ts_ = (unsigned long long*)(p.ws + CTL_TS); ts_[33] = twl_ * 4; }
#undef RP_TILE
#undef RP_FETCH
#undef RP_H
#undef RP_STORE
        } else if (w == 1) {
            auto amats = [&](int cc) {
                const LAS unsigned char* B_ = L + (cc & 3) * BUF; LAS unsigned char* Ms = L + oMS + (cc % 3) * MSET; LAS unsigned char* Af = L + oAf + (cc & 1) * 1024;
                const bf16x8 a0 = RC_F144(B_, oAt, 0), a1 = RC_F144(B_, oAt, 1), r0 = RC_F144(B_, oRt, 0), r1 = RC_F144(B_, oRt, 1), b0 = RC_F144(B_, oBh, 0), b1 = RC_F144(B_, oBh, 1), k0 = RC_F144(B_, oKh, 0), k1 = RC_F144(B_, oKh, 1);
                const f32x4 z4 = {0.f, 0.f, 0.f, 0.f};
                f32x4 dab = __builtin_amdgcn_mfma_f32_16x16x32_bf16(a0, b0, z4, 0, 0, 0); dab = __builtin_amdgcn_mfma_f32_16x16x32_bf16(a1, b1, dab, 0, 0, 0);
                f32x4 dak = __builtin_amdgcn_mfma_f32_16x16x32_bf16(a0, k0, z4, 0, 0, 0); dak = __builtin_amdgcn_mfma_f32_16x16x32_bf16(a1, k1, dak, 0, 0, 0);
                f32x4 drb = __builtin_amdgcn_mfma_f32_16x16x32_bf16(r0, b0, z4, 0, 0, 0); drb = __builtin_amdgcn_mfma_f32_16x16x32_bf16(r1, b1, drb, 0, 0, 0);
                f32x4 drk = __builtin_amdgcn_mfma_f32_16x16x32_bf16(r0, k0, z4, 0, 0, 0); drk = __builtin_amdgcn_mfma_f32_16x16x32_bf16(r1, k1, drk, 0, 0, 0);
#pragma unroll
                for (int r = 0; r < 4; ++r) { const int t = 4 * fq + r; const bool st = fr < t, le = fr <= t;
                    *(LAS float*)(Af + t * 64 + fr * 4) = st ? dab[r] : 0.f;
                    *(LAS bf16_t*)(Ms + t * 80 + fr * 2) = f2bf(st ? dak[r] : 0.f);
                    *(LAS bf16_t*)(Ms + 1280 + t * 80 + fr * 2) = f2bf(le ? drb[r] : 0.f);
                    *(LAS bf16_t*)(Ms + 2560 + t * 80 + fr * 2) = f2bf(le ? drk[r] : 0.f); } };
            LBAR();
            amats(0);
            LBAR();
            amats(1);
            LBAR();
            { unsigned long long tw_ = 0; for (int i = 0; i < NCH; ++i) { const unsigned long long t0_ = PROBE ? __builtin_amdgcn_s_memrealtime() : 0ull; if (i + 2 < NCH) amats(i + 2); asm volatile("s_waitcnt lgkmcnt(0)" ::: "memory"); if (PROBE) tw_ += __builtin_amdgcn_s_memrealtime() - t0_; LBAR(); }
              if (PROBE && bid == 0 && lane == 0) { unsigned long long* ts_ = (unsigned long long*)(p.ws + CTL_TS); ts_[30] = tw_; } }
        } else if (w == 2) {
            auto tinv = [&](int cc) {
                const LAS unsigned char* Af = L + oAf + (cc & 1) * 1024; LAS unsigned char* Tt = L + oTT + (cc & 1) * 1280;
                const f32x4 y1 = *(const LAS f32x4*)(Af + fr * 64 + (4 * fq) * 4);
                f32x4 x1;
#pragma unroll
                for (int r = 0; r < 4; ++r) x1[r] = *(const LAS float*)(Af + (4 * fq + r) * 64 + fr * 4);
                asm volatile("s_waitcnt lgkmcnt(0)" ::: "memory");
#define TI_PK4(v_) __builtin_bit_cast(s16x4, (u32x2){pk2((v_)[0], (v_)[1]), pk2((v_)[2], (v_)[3])})
                const f32x4 z4 = {0.f, 0.f, 0.f, 0.f};
                const s16x4 X1 = TI_PK4(x1), Y1 = TI_PK4(y1);
                const f32x4 x2 = __builtin_amdgcn_mfma_f32_16x16x16bf16_1k(Y1, X1, z4, 0, 0, 0), y2 = __builtin_amdgcn_mfma_f32_16x16x16bf16_1k(X1, Y1, z4, 0, 0, 0);
                const s16x4 X2 = TI_PK4(x2), Y2 = TI_PK4(y2);
                const f32x4 x4 = __builtin_amdgcn_mfma_f32_16x16x16bf16_1k(Y2, X2, z4, 0, 0, 0), y4 = __builtin_amdgcn_mfma_f32_16x16x16bf16_1k(X2, Y2, z4, 0, 0, 0);
                const s16x4 X4 = TI_PK4(x4), Y4 = TI_PK4(y4);
                const f32x4 x8 = __builtin_amdgcn_mfma_f32_16x16x16bf16_1k(Y4, X4, z4, 0, 0, 0);
                const s16x4 X8 = TI_PK4(x8);
                f32x4 q0;
#pragma unroll
                for (int r = 0; r < 4; ++r) q0[r] = y1[r] + ((4 * fq + r == fr) ? 1.f : 0.f);
                const f32x4 q1 = __builtin_amdgcn_mfma_f32_16x16x16bf16_1k(X2, TI_PK4(q0), q0, 0, 0, 0);
                const f32x4 q2 = __builtin_amdgcn_mfma_f32_16x16x16bf16_1k(X4, TI_PK4(q1), q1, 0, 0, 0);
                const f32x4 tt = __builtin_amdgcn_mfma_f32_16x16x16bf16_1k(X8, TI_PK4(q2), q2, 0, 0, 0);
                { u32x2 tw; tw.x = pk2(tt[0], tt[1]); tw.y = pk2(tt[2], tt[3]); *(LAS u32x2*)(Tt + fr * 80 + (4 * fq) * 2) = tw; }
#undef TI_PK4
            };
            LBAR(); LBAR();
            tinv(0);
            LBAR();
            { unsigned long long tw_ = 0; for (int i = 0; i < NCH; ++i) { const unsigned long long t0_ = PROBE ? __builtin_amdgcn_s_memrealtime() : 0ull; if (i + 1 < NCH) tinv(i + 1); asm volatile("s_waitcnt lgkmcnt(0)" ::: "memory"); if (PROBE) tw_ += __builtin_amdgcn_s_memrealtime() - t0_; LBAR(); }
              if (PROBE && bid == 0 && lane == 0) { unsigned long long* ts_ = (unsigned long long*)(p.ws + CTL_TS); ts_[31] = tw_; } }
        } else {
#define RC_R8(p_) (*(const LAS s16x4*)(p_))
#define RC_CAT(x_, y_) __builtin_shufflevector((x_), (y_), 0, 1, 2, 3, 4, 5, 6, 7)
#define RC_PK4(v_) __builtin_bit_cast(s16x4, (u32x2){pk2((v_)[0], (v_)[1]), pk2((v_)[2], (v_)[3])})
            f32x4 Sacc[4]; s16x4 sp[4];
#pragma unroll
            for (int kt = 0; kt < 4; ++kt) { Sacc[kt] = (f32x4){0.f, 0.f, 0.f, 0.f}; sp[kt] = (s16x4){0, 0, 0, 0}; }
            bf16_t* yg = Vv + tok0 * 512 + colb + vt * 16 + fr;
            LBAR(); LBAR(); LBAR();
            unsigned long long twc_ = 0;
            for (int i = 0; i < NCH; ++i) {
                const unsigned long long t0c_ = PROBE ? __builtin_amdgcn_s_memrealtime() : 0ull;
                const LAS unsigned char* B_ = L + (i & 3) * BUF; const LAS unsigned char* Ms = L + oMS + (i % 3) * MSET; const LAS unsigned char* Tt = L + oTT + (i & 1) * 1280;
                const LAS unsigned char* ap = B_ + oAt + fr * 144 + (4 * fq) * 2; const LAS unsigned char* rp = B_ + oRt + fr * 144 + (4 * fq) * 2;
                const bf16x8 a0 = RC_CAT(RC_R8(ap), RC_R8(ap + 32)), a1 = RC_CAT(RC_R8(ap + 64), RC_R8(ap + 96)), r0 = RC_CAT(RC_R8(rp), RC_R8(rp + 32)), r1 = RC_CAT(RC_R8(rp + 64), RC_R8(rp + 96));
                const bf16x8 vtf = RC_F80(B_ + oVT, 0), makf = RC_F80(Ms, 0), mrkf = RC_F80(Ms + 2560, 0);
                const s16x4 tt4 = RC_R8(Tt + fr * 80 + (4 * fq) * 2), mrb4 = RC_R8(Ms + 1280 + fr * 80 + (4 * fq) * 2);
                bf16x8 ktf[4]; s16x4 bt4[4]; f32x4 glv[4];
#pragma unroll
                for (int kt = 0; kt < 4; ++kt) { bt4[kt] = RC_R8(B_ + oBT + (kt * 16 + fr) * 80 + (4 * fq) * 2); ktf[kt] = RC_F80(B_ + oKT, kt * 16); glv[kt] = *(const LAS f32x4*)(B_ + oGL + (kt * 16 + 4 * fq) * 4); }
                asm volatile("s_waitcnt lgkmcnt(0)" ::: "memory");
                const f32x4 z4 = {0.f, 0.f, 0.f, 0.f};
                const bf16x8 sb0 = RC_CAT(sp[0], sp[1]), sb1 = RC_CAT(sp[2], sp[3]);
                f32x4 dw = __builtin_amdgcn_mfma_f32_16x16x32_bf16(a0, sb0, z4, 0, 0, 0); dw = __builtin_amdgcn_mfma_f32_16x16x32_bf16(a1, sb1, dw, 0, 0, 0);
                dw = __builtin_amdgcn_mfma_f32_16x16x32_bf16(makf, vtf, dw, 0, 0, 0);
                f32x4 dy = __builtin_amdgcn_mfma_f32_16x16x32_bf16(r0, sb0, z4, 0, 0, 0); dy = __builtin_amdgcn_mfma_f32_16x16x32_bf16(r1, sb1, dy, 0, 0, 0);
                dy = __builtin_amdgcn_mfma_f32_16x16x32_bf16(mrkf, vtf, dy, 0, 0, 0);
                f32x4 sk[4];
#pragma unroll
                for (int kt = 0; kt < 4; ++kt) sk[kt] = __builtin_amdgcn_mfma_f32_16x16x32_bf16(ktf[kt], vtf, Sacc[kt], 0, 0, 0);
                const f32x4 du = __builtin_amdgcn_mfma_f32_16x16x16bf16_1k(tt4, RC_PK4(dw), z4, 0, 0, 0);
                const s16x4 u4 = RC_PK4(du);
                dy = __builtin_amdgcn_mfma_f32_16x16x16bf16_1k(mrb4, u4, dy, 0, 0, 0);
#pragma unroll
                for (int kt = 0; kt < 4; ++kt) {
                    f32x4 sa = __builtin_amdgcn_mfma_f32_16x16x16bf16_1k(bt4[kt], u4, sk[kt], 0, 0, 0);
                    sa = sa * glv[kt]; Sacc[kt] = sa; sp[kt] = RC_PK4(sa); }
                { bf16_t* yo = yg + (size_t)(i * 16 + 4 * fq) * 512; yo[0] = f2bf(dy[0]); yo[512] = f2bf(dy[1]); yo[1024] = f2bf(dy[2]); yo[1536] = f2bf(dy[3]); }
                if (PROBE) twc_ += __builtin_amdgcn_s_memrealtime() - t0c_;
                LBAR();
            }
            if (PROBE && bid == 0 && lane == 0) { unsigned long long* ts_ = (unsigned long long*)(p.ws + CTL_TS); ts_[32] = twc_; ts_[29] = 0; }
#undef RC_R8
#undef RC_CAT
#undef RC_PK4
        }
#undef RC_F144
#undef RC_F80
    }
    STAMP(17);
    for (int item = bid; item < 256; item += G) {
        PHASE_IDS
        const int w = __builtin_amdgcn_readfirstlane(tid >> 6), fr = lane & 15, fq = lane >> 4;
        const int grp_ = (item & 7) * 4 + (item >> 6), vs = (item >> 3) & 7, h = grp_ & 3, b = grp_ >> 2;
        constexpr int QS = 272, TS = 144;
        constexpr int BUFB = 38656, oQ = 0, oK = 17408, oVT = 34816, oV = 37120, oP = 2 * BUFB, oCT = oP + 9216;
        LAS unsigned char* L = lds;
        const size_t tok0 = (size_t)b * SEQ;
        int prow[2], pc8[2];
#pragma unroll
        for (int i = 0; i < 2; ++i) { const int pp = tid + 512 * i; prow[i] = pp >> 4; pc8[i] = (pp & 15) * 8; }
        const int vrow = tid & 63, vpart = (tid >> 6) & 1;
        u32x4 qa[2], ka[2], va = {0u, 0u, 0u, 0u}; float vem = 0.f, vel = 0.f, velm = 0.f;
#define HM_FETCH(c_) { const size_t tb_ = tok0 + (size_t)(c_) * 64; _Pragma("unroll") for (int i_ = 0; i_ < 2; ++i_) { const bf16_t* r_ = U + (tb_ + prow[i_]) * LDU0 + h * 128 + pc8[i_]; qa[i_] = *(const u32x4*)r_; ka[i_] = *(const u32x4*)(r_ + 512); } \
            { va = *(const u32x4*)(U + (tb_ + vrow) * LDU0 + 1024 + h * 128 + vs * 16 + vpart * 8); const size_t vo_ = ((size_t)b * (SEQ / 64) + (c_)) * 512 + h * 128 + (tid & 127); vem = HEM[vo_]; vel = HEL[vo_]; velm = HELM[vo_]; } }
#define HM_H(w_, j_) ((bf16_t)(((j_) & 1) ? ((w_) >> 16) : ((w_) & 0xffffu)))
#define HM_STORE(bo_) { _Pragma("unroll") for (int i_ = 0; i_ < 2; ++i_) { *(LAS u32x4*)(L + (bo_) + oQ + prow[i_] * QS + pc8[i_] * 2) = qa[i_]; *(LAS u32x4*)(L + (bo_) + oK + prow[i_] * QS + pc8[i_] * 2) = ka[i_]; } \
            if (tid < 128) { LAS bf16_t* vt_ = (LAS bf16_t*)(L + (bo_) + oVT + (vpart * 8) * TS + vrow * 2); const unsigned vw4_[4] = {va.x, va.y, va.z, va.w}; \
                _Pragma("unroll") for (int j_ = 0; j_ < 8; ++j_) vt_[j_ * (TS / 2)] = HM_H(vw4_[j_ >> 1], j_); \
                ((LAS float*)(L + (bo_) + oV))[tid] = vem; ((LAS float*)(L + (bo_) + oV))[128 + tid] = vel; ((LAS float*)(L + (bo_) + oV))[256 + tid] = velm; } }
#define HM_FRAG(off_, row_, stride_, kk_) (*(const LAS bf16x8*)(L + (off_) + ((row_) + fr) * (stride_) + ((kk_) * 32 + 8 * fq) * 2))
#define HM_TR4(p_) __builtin_amdgcn_ds_read_tr16_b64_v4i16((LAS s16x4*)(p_))
        __syncthreads();
        for (int i = tid; i < (9216 + 4352) / 4; i += 512) ((LAS unsigned*)(L + oP))[i] = 0u;
        HM_FETCH(0); HM_STORE(0); HM_FETCH(1);
        LBAR();
        f32x4 Cacc = {0.f, 0.f, 0.f, 0.f};
        const int ktoff = oK + ((lane >> 4) * 8 + ((lane >> 2) & 3)) * QS + (w * 16 + (lane & 3) * 4) * 2;
        for (int c = 0; c < SEQ / 64; ++c) {
            const int bo = (c & 1) * BUFB, bn = BUFB - bo;
            { const int k0 = w * 16 + 4 * fq; const LAS float* vEM = (const LAS float*)(L + bo + oV);
              u32x2 cw; cw.x = pk2(Cacc[0] * vEM[k0], Cacc[1] * vEM[k0 + 1]); cw.y = pk2(Cacc[2] * vEM[k0 + 2], Cacc[3] * vEM[k0 + 3]);
              *(LAS u32x2*)(L + oCT + fr * QS + k0 * 2) = cw; }
            { const int sb = w >> 1, tb0 = (w & 1) * 2;
              if (sb <= tb0 + 1) { const bool two = sb <= tb0;
                  bf16x8 kf[4], q0f[4], q1f[4];
#pragma unroll
                  for (int kk = 0; kk < 4; ++kk) { kf[kk] = HM_FRAG(bo + oK, sb * 16, QS, kk); q1f[kk] = HM_FRAG(bo + oQ, tb0 * 16 + 16, QS, kk); }
                  if (two) {
#pragma unroll
                      for (int kk = 0; kk < 4; ++kk) q0f[kk] = HM_FRAG(bo + oQ, tb0 * 16, QS, kk); }
                  f32x4 a0 = {0.f, 0.f, 0.f, 0.f}, a1 = {0.f, 0.f, 0.f, 0.f};
                  if (two) {
#pragma unroll
                      for (int kk = 0; kk < 4; ++kk) { a0 = __builtin_amdgcn_mfma_f32_16x16x32_bf16(kf[kk], q0f[kk], a0, 0, 0, 0); a1 = __builtin_amdgcn_mfma_f32_16x16x32_bf16(kf[kk], q1f[kk], a1, 0, 0, 0); }
                  } else {
#pragma unroll
                      for (int kk = 0; kk < 4; ++kk) a1 = __builtin_amdgcn_mfma_f32_16x16x32_bf16(kf[kk], q1f[kk], a1, 0, 0, 0);
                  }
                  const int s0 = sb * 16 + 4 * fq;
#pragma unroll
                  for (int j = 0; j < 2; ++j) { if (j == 1 || two) { const int t = (tb0 + j) * 16 + fr; const f32x4 a = j ? a1 : a0;
                      u32x2 pw; pw.x = pk2((s0 <= t) ? a[0] : 0.f, (s0 + 1 <= t) ? a[1] : 0.f); pw.y = pk2((s0 + 2 <= t) ? a[2] : 0.f, (s0 + 3 <= t) ? a[3] : 0.f);
                      *(LAS u32x2*)(L + oP + t * TS + s0 * 2) = pw; } } } }
            LBAR();
            if (c + 1 < SEQ / 64) HM_STORE(bn);
            HM_FETCH((c + 2 < SEQ / 64) ? c + 2 : c);
            if (w < 4) { f32x4 d = {0.f, 0.f, 0.f, 0.f};
#pragma unroll
                for (int kk = 0; kk < 2; ++kk) d = __builtin_amdgcn_mfma_f32_16x16x32_bf16(HM_FRAG(oP, w * 16, TS, kk), HM_FRAG(bo + oVT, 0, TS, kk), d, 0, 0, 0);
#pragma unroll
                for (int kk = 0; kk < 4; ++kk) d = __builtin_amdgcn_mfma_f32_16x16x32_bf16(HM_FRAG(bo + oQ, w * 16, QS, kk), HM_FRAG(oCT, 0, QS, kk), d, 0, 0, 0);
                bf16_t* op = U + (tok0 + (size_t)c * 64 + w * 16 + 4 * fq) * LDU0 + 1024 + h * 128 + vs * 16 + fr;
                op[0] = f2bf(d[0]); op[LDU0] = f2bf(d[1]); op[2 * LDU0] = f2bf(d[2]); op[3 * LDU0] = f2bf(d[3]); }
            { f32x4 tmp = {0.f, 0.f, 0.f, 0.f};
              const LAS unsigned char* kt = L + bo + ktoff;
#pragma unroll
              for (int kk = 0; kk < 2; ++kk) { const bf16x8 ktf = __builtin_shufflevector(HM_TR4(kt + kk * 32 * QS), HM_TR4(kt + kk * 32 * QS + 4 * QS), 0, 1, 2, 3, 4, 5, 6, 7);
                  tmp = __builtin_amdgcn_mfma_f32_16x16x32_bf16(ktf, HM_FRAG(bo + oVT, 0, TS, kk), tmp, 0, 0, 0); }
              const int k0 = w * 16 + 4 * fq; const LAS float* vEL = (const LAS float*)(L + bo + oV) + 128; const LAS float* vELM = vEL + 128;
#pragma unroll
              for (int r = 0; r < 4; ++r) Cacc[r] = Cacc[r] * vEL[k0 + r] + tmp[r] * vELM[k0 + r]; }
            LBAR();
        }
#undef HM_TR4
#undef HM_FETCH
#undef HM_STORE
#undef HM_FRAG
#undef HM_H
    }
    GSYNC();
    STAMP(4);

    {
        PHASE_IDS
        const int gw = bid * 8 + wave, NWH = G * 4;
        const int c8 = lane * 8;
        if ((gw & 1) == 0) {
            const f32x4 an0 = *(const f32x4*)(p.in[7] + c8), an1 = *(const f32x4*)(p.in[7] + c8 + 4);
            for (int m0 = gw >> 1; m0 < M; m0 += NWH * 4) {
                u32x4 xo[4], xg[4];
#pragma unroll
                for (int u = 0; u < 4; ++u) { const int m = m0 + u * NWH; const bf16_t* ur = U + (size_t)m * LDU0 + c8; xo[u] = *(const u32x4*)(ur + 1024); xg[u] = *(const u32x4*)(ur + 1536); }
#pragma unroll
                for (int u = 0; u < 4; ++u) { const int m = m0 + u * NWH; {
                    const float o[8] = {bflo(xo[u].x), bfhi(xo[u].x), bflo(xo[u].y), bfhi(xo[u].y), bflo(xo[u].z), bfhi(xo[u].z), bflo(xo[u].w), bfhi(xo[u].w)};
                    const float g[8] = {bflo(xg[u].x), bfhi(xg[u].x), bflo(xg[u].y), bfhi(xg[u].y), bflo(xg[u].z), bfhi(xg[u].z), bflo(xg[u].w), bfhi(xg[u].w)};
                    float ss = 0.f;
#pragma unroll
                    for (int e = 0; e < 8; ++e) ss = fmaf(o[e], o[e], ss);
                    const float rs = 1.0f / sqrtf(row_sum16(ss) * (1.f / 128.f) + RMS_EPS);
                    u32x4 w; w.x = pk2(o[0] * rs * an0[0] * siluf_(g[0]), o[1] * rs * an0[1] * siluf_(g[1])); w.y = pk2(o[2] * rs * an0[2] * siluf_(g[2]), o[3] * rs * an0[3] * siluf_(g[3]));
                    w.z = pk2(o[4] * rs * an1[0] * siluf_(g[4]), o[5] * rs * an1[1] * siluf_(g[5])); w.w = pk2(o[6] * rs * an1[2] * siluf_(g[6]), o[7] * rs * an1[3] * siluf_(g[7]));
                    *(u32x4*)(YC + (size_t)m * DM + c8) = w; } }
            }
        } else {
            const f32x4 lw0 = *(const f32x4*)(p.in[17] + c8), lw1 = *(const f32x4*)(p.in[17] + c8 + 4), lb0 = *(const f32x4*)(p.in[18] + c8), lb1 = *(const f32x4*)(p.in[18] + c8 + 4);
            for (int m0 = gw >> 1; m0 < M; m0 += NWH * 4) {
                u32x4 xy[4], xg[4], xb[4];
#pragma unroll
                for (int u = 0; u < 4; ++u) { const int m = m0 + u * NWH; const size_t i = (size_t)m * 512 + c8; xy[u] = *(const u32x4*)(Vv + i); xg[u] = *(const u32x4*)(Gg + i); xb[u] = *(const u32x4*)(BVG + i); }
#pragma unroll
                for (int u = 0; u < 4; ++u) { const int m = m0 + u * NWH; {
                    const float y[8] = {bflo(xy[u].x), bfhi(xy[u].x), bflo(xy[u].y), bfhi(xy[u].y), bflo(xy[u].z), bfhi(xy[u].z), bflo(xy[u].w), bfhi(xy[u].w)};
                    const float g[8] = {bflo(xg[u].x), bfhi(xg[u].x), bflo(xg[u].y), bfhi(xg[u].y), bflo(xg[u].z), bfhi(xg[u].z), bflo(xg[u].w), bfhi(xg[u].w)};
                    const float bv[8] = {bflo(xb[u].x), bfhi(xb[u].x), bflo(xb[u].y), bfhi(xb[u].y), bflo(xb[u].z), bfhi(xb[u].z), bflo(xb[u].w), bfhi(xb[u].w)};
                    float s1 = 0.f;
#pragma unroll
                    for (int e = 0; e < 8; ++e) s1 += y[e];
                    s1 += dpp_mov<0xB1>(s1); s1 += dpp_mov<0x4E>(s1); s1 += dpp_mov<0x141>(s1);
                    const float mean = s1 * (1.f / 64.f); float s2 = 0.f;
#pragma unroll
                    for (int e = 0; e < 8; ++e) { const float d = y[e] - mean; s2 = fmaf(d, d, s2); }
                    s2 += dpp_mov<0xB1>(s2); s2 += dpp_mov<0x4E>(s2); s2 += dpp_mov<0x141>(s2);
                    const float rs = 1.0f / sqrtf(s2 * (1.f / 64.f) + 64e-5f);
                    float r8[8];
#pragma unroll
                    for (int e = 0; e < 8; ++e) { const float lw = e < 4 ? lw0[e] : lw1[e - 4], lb = e < 4 ? lb0[e] : lb1[e - 4]; r8[e] = ((y[e] - mean) * rs * lw + lb) * g[e] + bv[e]; }
                    u32x4 w; w.x = pk2(r8[0], r8[1]); w.y = pk2(r8[2], r8[3]); w.z = pk2(r8[4], r8[5]); w.w = pk2(r8[6], r8[7]);
                    *(u32x4*)(YC + (size_t)m * DM + 512 + c8) = w; } }
            }
        }
    }
    GSYNC();
    STAMP(5);

    { pg8::Gemm g{YC, (const bf16_t*)(p.ws + WS_OUT0), DM, DM, M, DM, DM}; pg8::StaticOrder S; S.init(M, DM, G, bid);
      pg8::EpiResidual<true, true> E{p.in[0], nullptr, XB, SS1}; pg8::gemm_phase<pg8::EpiResidual<true, true>, pg8::StaticOrder, true, true>(lds, g, S, E); }
    GSYNC();
    STAMP(6);
#define HID U
    { pg8::Gemm g{XB, (const bf16_t*)(p.ws + WS_GU0), DM, DM, M, 2 * FFN, DM}; pg8::StaticOrder S; S.init(M, 2 * FFN, G, bid);
      pg8::EpiSwiGlu E{HID, FFN, SS1}; pg8::gemm_phase<pg8::EpiSwiGlu, pg8::StaticOrder, true, true>(lds, g, S, E); }
    GSYNC();
    STAMP(7);
    { pg8::Gemm g{HID, (const bf16_t*)(p.ws + WS_D0), FFN, FFN, M, DM, FFN}; pg8::StaticOrder S; S.init(M, DM, G, bid);
      pg8::EpiResidual<false, true> E{nullptr, XB, XB, SS2}; pg8::gemm_phase<pg8::EpiResidual<false, true>, pg8::StaticOrder, true, true>(lds, g, S, E); }
    GSYNC();
    STAMP(8);
    { pg8::Gemm g{XB, (const bf16_t*)(p.ws + WS_IN1), DM, DM, M, NP1, DM}; pg8::StaticOrder S; S.init(M, NP1, G, bid);
      pg8::EpiScaleBf16 E{U, LDU1, SS2}; pg8::gemm_phase<pg8::EpiScaleBf16, pg8::StaticOrder, true, true>(lds, g, S, E); }
    GSYNC();
    STAMP(9);

#define Qc ((bf16_t*)(p.ws + WS_YC))
#define Kc ((bf16_t*)(p.ws + WS_MS))
#define gSI ((float*)(p.ws + WS_MS + 48 * MiB))
#define gBI (gSI + (size_t)M * 4)
#define gBT (gSI + (size_t)M * 8)
#define gWL (gSI + (size_t)M * 12)
#define gDP ((float*)(p.ws + WS_MS + 50 * MiB))
#define gDEN ((float*)(p.ws + WS_MS + 51 * MiB))
    {
        PHASE_IDS
        const float* cq = p.in[31]; const float* ck = p.in[32];
        const int gw = bid * 8 + wave, NW = G * 8;
        for (int item = gw; item < (M / 16) * 3; item += NW) {
            const int run = item / 3, m0 = run * 16, c = (item % 3) * 512 + lane * 8; const bool s0 = (m0 & (SEQ - 1)) == 0;
            const bool isk = c >= 768; const int cc = isk ? c - 768 : c; const float* cw = (isk ? ck : cq) + cc; const float sc = isk ? 0.07216878364870322f : 1.f;
            u32x4 x[19];
#pragma unroll
            for (int i = 0; i < 19; ++i) { const int mm = (i < 3 && s0) ? m0 : m0 - 3 + i; x[i] = *(const u32x4*)(U + (size_t)mm * LDU1 + 256 + c); }
            f32x4 w0[4], w1[4];
#pragma unroll
            for (int j = 0; j < 4; ++j) { w0[j] = *(const f32x4*)(cw + j * 768); w1[j] = *(const f32x4*)(cw + j * 768 + 4); }
            if (s0) { const u32x4 z = {0u, 0u, 0u, 0u}; x[0] = z; x[1] = z; x[2] = z; }
            bf16_t* dst = (isk ? Kc : Qc) + (size_t)m0 * 768 + cc;
#pragma unroll
            for (int tk = 0; tk < 16; ++tk) {
                float acc[8];
#pragma unroll
                for (int e = 0; e < 8; ++e) acc[e] = 0.f;
#pragma unroll
                for (int j = 0; j < 4; ++j) { const u32x4 xv = x[tk + j];
                    acc[0] = fmaf(w0[j][0], bflo(xv.x), acc[0]); acc[1] = fmaf(w0[j][1], bfhi(xv.x), acc[1]); acc[2] = fmaf(w0[j][2], bflo(xv.y), acc[2]); acc[3] = fmaf(w0[j][3], bfhi(xv.y), acc[3]);
                    acc[4] = fmaf(w1[j][0], bflo(xv.z), acc[4]); acc[5] = fmaf(w1[j][1], bfhi(xv.z), acc[5]); acc[6] = fmaf(w1[j][2], bflo(xv.w), acc[6]); acc[7] = fmaf(w1[j][3], bfhi(xv.w), acc[7]); }
                u32x4 o; o.x = pk2(siluf_(acc[0]) * sc, siluf_(acc[1]) * sc); o.y = pk2(siluf_(acc[2]) * sc, siluf_(acc[3]) * sc); o.z = pk2(siluf_(acc[4]) * sc, siluf_(acc[5]) * sc); o.w = pk2(siluf_(acc[6]) * sc, siluf_(acc[7]) * sc);
                *(u32x4*)(dst + (size_t)tk * 768) = o; }
        }
        for (int it = gw; it < (M / 64) * 4; it += NW) {
            const int ch = it >> 2, hh = it & 3; const size_t m = (size_t)ch * 64 + lane; const bf16_t* ur = U + m * LDU1;
            const float lf = -softplusf_(-(bf2f(ur[3332 + hh]) + p.in[34][hh]));
            const float li = bf2f(ur[3328 + hh]) + p.in[33][hh];
            float bs = lf;
#pragma unroll
            for (int o = 1; o < 64; o <<= 1) { const float t = __shfl_up(bs, o); if (lane >= o) bs += t; }
            const float bL = __shfl(bs, 63);
            gSI[m * 4 + hh] = __expf(bs); gBI[m * 4 + hh] = li - bs; gBT[m * 4 + hh] = bs; gWL[m * 4 + hh] = __expf(bL - bs + li);
            if (lane == 0) gDP[ch * 4 + hh] = __expf(bL);
        }
    }
    GSYNC();
    STAMP(10);

    if (bid < 192) {
        PHASE_IDS
        const int w = __builtin_amdgcn_readfirstlane(tid >> 6);
        const int grp_ = (bid & 7) * 4 + (bid >> 3) / 6;
        const int vs = (bid >> 3) % 6, h = grp_ & 3, b = grp_ >> 2;
        constexpr int QS = 400, TS = 144;
        constexpr int oQ = 0, oK = 25600, oKT = 51200, oVT = 78848, oVW = 85760, oP = 92672, oCT = 101888, oG = 121088;
        LAS unsigned char* L = lds;
        for (int i = tid; i < 19200 / 4; i += 512) ((LAS unsigned*)(L + oCT))[i] = 0u;
        for (int i = tid; i < 64 * TS / 4; i += 512) ((LAS unsigned*)(L + oP))[i] = 0u;
        for (int i = tid; i < 16 * TS / 4; i += 512) { ((LAS unsigned*)(L + oVT + 32 * TS))[i] = (i < TS / 4) ? 0x3F803F80u : 0u; ((LAS unsigned*)(L + oVW + 32 * TS))[i] = 0u; }
        const size_t tok0 = (size_t)b * SEQ;
        const int fr = lane & 15, fq = lane >> 4;
        u32x4 qa[3], ka[3], va = {0u, 0u, 0u, 0u}; float gsi = 0.f, gbi = 0.f, gbt = 0.f, gwl = 0.f, wlr = 0.f;
        int prow[3], pc8[3];
#pragma unroll
        for (int i = 0; i < 3; ++i) { const int pp = tid + 512 * i; prow[i] = pp / 24; pc8[i] = (pp % 24) * 8; }
        const int vrow = tid & 63, vpart = tid >> 6;
#define MM_FETCH(c_) { const size_t tb_ = tok0 + (size_t)(c_) * 64; _Pragma("unroll") for (int i_ = 0; i_ < 3; ++i_) { const size_t o_ = (tb_ + prow[i_]) * 768 + h * 192 + pc8[i_]; qa[i_] = *(const u32x4*)(Qc + o_); ka[i_] = *(const u32x4*)(Kc + o_); } \
            { va = *(const u32x4*)(U + (tb_ + vrow) * LDU1 + 1792 + h * 192 + vs * 32 + (vpart & 3) * 8); wlr = gWL[(tb_ + vrow) * 4 + h]; } \
            { const size_t g_ = (tb_ + (tid & 63)) * 4 + h; gsi = gSI[g_]; gbi = gBI[g_]; gbt = gBT[g_]; gwl = gWL[g_]; } }
#define MM_H(w_, j_) ((bf16_t)(((j_) & 1) ? ((w_) >> 16) : ((w_) & 0xffffu)))
#define MM_STORE() { _Pragma("unroll") for (int i_ = 0; i_ < 3; ++i_) { *(LAS u32x4*)(L + oQ + prow[i_] * QS + pc8[i_] * 2) = qa[i_]; *(LAS u32x4*)(L + oK + prow[i_] * QS + pc8[i_] * 2) = ka[i_]; \
            } \
            if (tid < 256) { LAS bf16_t* vt_ = (LAS bf16_t*)(L + oVT + (vpart * 8) * TS + vrow * 2); LAS bf16_t* vw_ = (LAS bf16_t*)(L + oVW + (vpart * 8) * TS + vrow * 2); const unsigned vw4_[4] = {va.x, va.y, va.z, va.w}; \
                _Pragma("unroll") for (int j_ = 0; j_ < 8; ++j_) { const bf16_t e_ = MM_H(vw4_[j_ >> 1], j_); vt_[j_ * (TS / 2)] = e_; vw_[j_ * (TS / 2)] = f2bf(bf2f(e_) * wlr); } } \
            if (tid < 64) { ((LAS bf16_t*)(L + oVW + 32 * TS))[tid] = f2bf(gwl); ((LAS float*)(L + oG))[tid] = gsi; ((LAS float*)(L + oG))[64 + tid] = gbi; ((LAS float*)(L + oG))[128 + tid] = gbt; } }
#define MM_TR4(off_) __builtin_amdgcn_ds_read_tr16_b64_v4i16((LAS s16x4*)(ktb + (off_)))
#define MM_TRF(off_) __builtin_shufflevector(MM_TR4(off_), MM_TR4((off_) + 4 * QS), 0, 1, 2, 3, 4, 5, 6, 7)
#define MM_FRAG(off_, row_, stride_, kk_) (*(const LAS bf16x8*)(L + (off_) + ((row_) + fr) * (stride_) + ((kk_) * 32 + 8 * fq) * 2))
        __syncthreads();
        MM_FETCH(0); MM_STORE();
        LBAR();
        f32x4 Cacc[3][2];
#pragma unroll
        for (int i = 0; i < 3; ++i) { Cacc[i][0] = (f32x4){0.f, 0.f, 0.f, 0.f}; Cacc[i][1] = (f32x4){0.f, 0.f, 0.f, 0.f}; }
        const int nvt = (w < 4) ? 1 : 2, vt0 = (w < 4) ? 0 : 1, db0 = 3 * (w & 3);
        const LAS unsigned char* ktb = L + oK + ((lane >> 4) * 8 + ((lane >> 2) & 3)) * QS + (db0 * 16 + (lane & 3) * 4) * 2;
        const LAS float* gSIl = (const LAS float*)(L + oG); const LAS float* gBIl = gSIl + 64; const LAS float* gBTl = gSIl + 128;
        for (int c = 0; c < SEQ / 64; ++c) {
            int fr_o = lane & 15, fq_o = lane >> 4; asm volatile("" : "+v"(fr_o), "+v"(fq_o));
            const int fr = fr_o, fq = fq_o;
            const float dp = gDP[(b * (SEQ / 64) + c) * 4 + h];
            MM_FETCH((c + 1 < SEQ / 64) ? c + 1 : c);
            { const int sb = w >> 1, tb0 = (w & 1) * 2;
              if (sb <= tb0 + 1) {
              const bool two = sb <= tb0;
              bf16x8 kf[6], q0f[6], q1f[6];
#pragma unroll
              for (int kk = 0; kk < 6; ++kk) { kf[kk] = MM_FRAG(oK, sb * 16, QS, kk); q1f[kk] = MM_FRAG(oQ, tb0 * 16 + 16, QS, kk); }
              if (two) {
#pragma unroll
                  for (int kk = 0; kk < 6; ++kk) q0f[kk] = MM_FRAG(oQ, tb0 * 16, QS, kk); }
              const int s0 = sb * 16 + 4 * fq;
              const float bi0 = gBIl[s0], bi1 = gBIl[s0 + 1], bi2 = gBIl[s0 + 2], bi3 = gBIl[s0 + 3];
              const float bt0 = gBTl[tb0 * 16 + fr], bt1 = gBTl[tb0 * 16 + 16 + fr];
              asm volatile("s_waitcnt lgkmcnt(0)" ::: "memory");
              f32x4 a0 = {0.f, 0.f, 0.f, 0.f}, a1 = {0.f, 0.f, 0.f, 0.f};
              if (two) {
#pragma unroll
                  for (int kk = 0; kk < 6; ++kk) { a0 = __builtin_amdgcn_mfma_f32_16x16x32_bf16(kf[kk], q0f[kk], a0, 0, 0, 0); a1 = __builtin_amdgcn_mfma_f32_16x16x32_bf16(kf[kk], q1f[kk], a1, 0, 0, 0); }
              } else {
#pragma unroll
                  for (int kk = 0; kk < 6; ++kk) a1 = __builtin_amdgcn_mfma_f32_16x16x32_bf16(kf[kk], q1f[kk], a1, 0, 0, 0);
              }
#pragma unroll
              for (int j = 0; j < 2; ++j) { if (j == 1 || two) { const int t = (tb0 + j) * 16 + fr; const float bt = j ? bt1 : bt0; const f32x4 a = j ? a1 : a0;
                  const float p0 = (s0 <= t) ? a[0] * __expf(bt + bi0) : 0.f, p1 = (s0 + 1 <= t) ? a[1] * __expf(bt + bi1) : 0.f, p2 = (s0 + 2 <= t) ? a[2] * __expf(bt + bi2) : 0.f, p3 = (s0 + 3 <= t) ? a[3] * __expf(bt + bi3) : 0.f;
                  u32x2 pw; pw.x = pk2(p0, p1); pw.y = pk2(p2, p3); *(LAS u32x2*)(L + oP + t * TS + s0 * 2) = pw; } } } }
            LBAR();
            { const int tb = w & 3;
              const int n2 = (w < 4) ? 2 : 1;
              bf16x8 qf[6], pf[2], vtf[2][2], ctf[2][6];
#pragma unroll
              for (int kk = 0; kk < 6; ++kk) qf[kk] = MM_FRAG(oQ, tb * 16, QS, kk);
#pragma unroll
              for (int kk = 0; kk < 2; ++kk) pf[kk] = MM_FRAG(oP, tb * 16, TS, kk);
#pragma unroll
              for (int j = 0; j < 2; ++j) { if (j < n2) { const int vt = (w < 4) ? j : 2;
#pragma unroll
                  for (int kk = 0; kk < 2; ++kk) vtf[j][kk] = MM_FRAG(oVT, vt * 16, TS, kk);
#pragma unroll
                  for (int kk = 0; kk < 6; ++kk) ctf[j][kk] = MM_FRAG(oCT, vt * 16, QS, kk); } }
              const int t0r = tb * 16 + 4 * fq;
              const float si0 = gSIl[t0r], si1 = gSIl[t0r + 1], si2 = gSIl[t0r + 2], si3 = gSIl[t0r + 3];
              asm volatile("s_waitcnt lgkmcnt(0)" ::: "memory");
              bf16x8 ktf[3][2], vwf[2][2];
#pragma unroll
              for (int i = 0; i < 3; ++i) { ktf[i][0] = MM_TRF(i * 32); ktf[i][1] = MM_TRF(32 * QS + i * 32); }
#pragma unroll
              for (int j = 0; j < 2; ++j) { if (j < nvt) { vwf[j][0] = MM_FRAG(oVW, (vt0 + j) * 16, TS, 0); vwf[j][1] = MM_FRAG(oVW, (vt0 + j) * 16, TS, 1); } }
#pragma unroll
              for (int j = 0; j < 2; ++j) { if (j < n2) { const int vt = (w < 4) ? j : 2;
                  f32x4 d2 = {0.f, 0.f, 0.f, 0.f}, d3 = {0.f, 0.f, 0.f, 0.f};
#pragma unroll
                  for (int kk = 0; kk < 2; ++kk) d2 = __builtin_amdgcn_mfma_f32_16x16x32_bf16(pf[kk], vtf[j][kk], d2, 0, 0, 0);
#pragma unroll
                  for (int kk = 0; kk < 6; ++kk) d3 = __builtin_amdgcn_mfma_f32_16x16x32_bf16(qf[kk], ctf[j][kk], d3, 0, 0, 0);
                  const float o0 = si0 * d3[0] + d2[0], o1 = si1 * d3[1] + d2[1], o2 = si2 * d3[2] + d2[2], o3 = si3 * d3[3] + d2[3];
                  const size_t tg = tok0 + (size_t)c * 64 + t0r;
                  if (w < 4) { bf16_t* op = U + tg * LDU1 + 1792 + h * 192 + vs * 32 + vt * 16 + fr; op[0] = f2bf(o0); op[LDU1] = f2bf(o1); op[2 * LDU1] = f2bf(o2); op[3 * LDU1] = f2bf(o3); }
                  else if (fr == 0 && vs == 0) { float* dn = gDEN + tg * 4 + h; dn[0] = o0; dn[4] = o1; dn[8] = o2; dn[12] = o3; } } }
              asm volatile("s_waitcnt lgkmcnt(0)" ::: "memory");
#pragma unroll
              for (int i = 0; i < 3; ++i)
#pragma unroll
                  for (int j = 0; j < 2; ++j) { if (j < nvt) { f32x4 ca = Cacc[i][j] * dp;
                      ca = __builtin_amdgcn_mfma_f32_16x16x32_bf16(ktf[i][0], vwf[j][0], ca, 0, 0, 0);
                      ca = __builtin_amdgcn_mfma_f32_16x16x32_bf16(ktf[i][1], vwf[j][1], ca, 0, 0, 0); Cacc[i][j] = ca; } } }
            LBAR();
#pragma unroll
            for (int i = 0; i < 3; ++i)
#pragma unroll
                for (int j = 0; j < 2; ++j) { if (j < nvt) { const f32x4 ca = Cacc[i][j]; u32x2 cw; cw.x = pk2(ca[0], ca[1]); cw.y = pk2(ca[2], ca[3]);
                    *(LAS u32x2*)(L + oCT + ((vt0 + j) * 16 + fr) * QS + ((db0 + i) * 16 + 4 * fq) * 2) = cw; } }
            if (c + 1 < SEQ / 64) MM_STORE();
            LBAR();
        }
        STAMP2(18, 0);
#undef MM_FETCH
#undef MM_STORE
#undef MM_FRAG
#undef MM_TR4
#undef MM_TRF
#undef MM_H
    } else {
        PHASE_IDS
        const int w = __builtin_amdgcn_readfirstlane(tid >> 6), wq = w & 3, myc = w >> 2;
        const int fr = lane & 15, fq = lane >> 4;
        constexpr int US = 80, XS = 272, NB = SEQ / 32;
        constexpr int oU = 0, oW1 = 10240, oX = 20480, oH = 37888, oW2 = 55296, oZ = 59648, CH = 61696;
        LAS unsigned char* Lc = lds + myc * CH;
        __syncthreads();
        for (int i = tid; i < 2 * CH / 4; i += 512) ((LAS unsigned*)lds)[i] = 0u;
        __syncthreads();
        for (int i = tid; i < 2 * 128 * 16; i += 512) { const int cc = i >> 11, n = (i >> 4) & 127, k = i & 15; const int g_ = ((bid - 192) * 2 + cc) & 15;
            const float v = (n < 64) ? BBR[(g_ * 64 + n) * 16 + k] : BBI[(g_ * 64 + n - 64) * 16 + k];
            ((LAS bf16_t*)(lds + cc * CH + oW1 + n * US))[k] = f2bf(v); }
        for (int i = tid; i < 2 * 16 * 128; i += 512) { const int cc = i >> 11, hh = (i >> 7) & 15, k = i & 127; const int g_ = ((bid - 192) * 2 + cc) & 15;
            const float v = (k < 64) ? p.in[26][(g_ * 16 + hh) * 64 + k] : -p.in[27][(g_ * 16 + hh) * 64 + k - 64];
            ((LAS bf16_t*)(lds + cc * CH + oW2 + hh * XS))[k] = f2bf(v); }
        const int chain = (bid - 192) * 2 + myc, g = chain & 15, b = chain >> 4;
        bf16_t* gU = U + ((size_t)b * SEQ + (lane >> 1)) * LDU1 + g * 16 + (lane & 1) * 8;
        __syncthreads();
        if (wq == 3) {
            u32x4 sA, sB;
            const int lo = (lane >> 1) * US + (lane & 1) * 16, zo = (lane >> 1) * 32 + (lane & 1) * 16;
#define S5_LD(i_) (*(const u32x4*)(gU + (size_t)(((i_) < NB ? (i_) : NB - 1) * 32) * LDU1))
            sA = S5_LD(0); *(LAS u32x4*)(Lc + oU + 0 * 2560 + lo) = sA; sB = S5_LD(1); *(LAS u32x4*)(Lc + oU + 1 * 2560 + lo) = sB;
            sA = S5_LD(2); sB = S5_LD(3);
            LBAR(); LBAR();
            for (int it = 0; it < NB + 2; it += 2) {
                if (it + 2 < NB) *(LAS u32x4*)(Lc + oU + ((it + 2) & 3) * 2560 + lo) = sA;
                if (it >= 2) *(u32x4*)(gU + (size_t)((it - 2) * 32) * LDU1) = *(const LAS u32x4*)(Lc + oZ + (it & 1) * 1024 + zo);
                sA = S5_LD(it + 4);
                LBAR();
                if (it + 3 < NB) *(LAS u32x4*)(Lc + oU + ((it + 3) & 3) * 2560 + lo) = sB;
                if (it >= 1 && it - 1 < NB) *(u32x4*)(gU + (size_t)((it - 1) * 32) * LDU1) = *(const LAS u32x4*)(Lc + oZ + ((it + 1) & 1) * 1024 + zo);
                sB = S5_LD(it + 5);
                LBAR();
            }
#undef S5_LD
        } else if (wq == 1) {
            bf16x8 w1f[8];
#pragma unroll
            for (int j = 0; j < 8; ++j) w1f[j] = *(const LAS bf16x8*)(Lc + oW1 + (j * 16 + fr) * US + (8 * fq) * 2);
            auto xblk = [&](int blk) {
                const LAS unsigned char* Ut = Lc + oU + (blk & 3) * 2560; LAS unsigned char* Xt = Lc + oX + (blk & 1) * 8704;
                const bf16x8 u0 = *(const LAS bf16x8*)(Ut + fr * US + (8 * fq) * 2), u1 = *(const LAS bf16x8*)(Ut + (16 + fr) * US + (8 * fq) * 2);
                const f32x4 z4 = {0.f, 0.f, 0.f, 0.f};
#pragma unroll
                for (int j = 0; j < 8; ++j) { const f32x4 d0 = __builtin_amdgcn_mfma_f32_16x16x32_bf16(u0, w1f[j], z4, 0, 0, 0), d1 = __builtin_amdgcn_mfma_f32_16x16x32_bf16(u1, w1f[j], z4, 0, 0, 0);
                    LAS bf16_t* xp = (LAS bf16_t*)(Xt + (4 * fq) * XS) + j * 16 + fr;
#pragma unroll
                    for (int r = 0; r < 4; ++r) { xp[r * (XS / 2)] = f2bf(d0[r]); xp[(16 + r) * (XS / 2)] = f2bf(d1[r]); } } };
            LBAR();
            xblk(0);
            LBAR();
            for (int it = 0; it < NB + 2; ++it) { if (it + 1 < NB) xblk(it + 1); LBAR(); }
        } else if (wq == 0) {
            const float ar = LBR[g * 64 + lane], ai = LBI[g * 64 + lane];
            float hr = 0.f, hi = 0.f;
            LBAR(); LBAR();
            for (int it = 0; it < NB + 2; ++it) {
                if (it < NB) { const LAS bf16_t* xp = (const LAS bf16_t*)(Lc + oX + (it & 1) * 8704) + lane; LAS bf16_t* hp = (LAS bf16_t*)(Lc + oH + (it & 1) * 8704) + lane;
                    for (int t8 = 0; t8 < 32; t8 += 8) {
                        bf16_t xr[8], xi[8], or_[8], oi_[8];
#pragma unroll
                        for (int u = 0; u < 8; ++u) { xr[u] = xp[(t8 + u) * (XS / 2)]; xi[u] = xp[(t8 + u) * (XS / 2) + 64]; }
#pragma unroll
                        for (int u = 0; u < 8; ++u) { const float nr = fmaf(ar, hr, fmaf(-ai, hi, bf2f(xr[u]))), ni = fmaf(ar, hi, fmaf(ai, hr, bf2f(xi[u]))); hr = nr; hi = ni; or_[u] = f2bf(hr); oi_[u] = f2bf(hi); }
#pragma unroll
                        for (int u = 0; u < 8; ++u) { hp[(t8 + u) * (XS / 2)] = or_[u]; hp[(t8 + u) * (XS / 2) + 64] = oi_[u]; } } }
                LBAR();
            }
        } else {
            bf16x8 w2f[4];
#pragma unroll
            for (int kk = 0; kk < 4; ++kk) w2f[kk] = *(const LAS bf16x8*)(Lc + oW2 + fr * XS + (kk * 32 + 8 * fq) * 2);
            const float dsk = p.in[28][g * 16 + fr];
            LBAR(); LBAR();
            for (int it = 0; it < NB + 2; ++it) {
                if (it >= 1 && it - 1 < NB) { const int blk = it - 1; const LAS unsigned char* Ht = Lc + oH + (blk & 1) * 8704; const LAS unsigned char* Ut = Lc + oU + (blk & 3) * 2560; LAS unsigned char* Zt = Lc + oZ + (blk & 1) * 1024;
#pragma unroll
                    for (int tb = 0; tb < 2; ++tb) { f32x4 d = {0.f, 0.f, 0.f, 0.f};
#pragma unroll
                        for (int kk = 0; kk < 4; ++kk) d = __builtin_amdgcn_mfma_f32_16x16x32_bf16(*(const LAS bf16x8*)(Ht + (tb * 16 + fr) * XS + (kk * 32 + 8 * fq) * 2), w2f[kk], d, 0, 0, 0);
#pragma unroll
                        for (int r = 0; r < 4; ++r) { const int t = tb * 16 + 4 * fq + r;
                            const float y = d[r] + dsk * bf2f(*(const LAS bf16_t*)(Ut + t * US + fr * 2));
                            const float z = 0.5f * y * (1.f + tanhf_(0.7978845608028654f * (y + 0.044715f * y * y * y)));
                            *(LAS bf16_t*)(Zt + t * 32 + fr * 2) = f2bf(z); } } }
                LBAR();
            }
        }
        STAMP2(19, 192);
    }
    GSYNC();
    STAMP(11);

    {
        PHASE_IDS
        const int w = __builtin_amdgcn_readfirstlane(tid >> 6), fr = lane & 15, fq = lane >> 4;
        constexpr int ZS = 528;
        const bf16_t* WT = (const bf16_t*)(p.ws + WS_GLU);
        bf16x8 wf[2][8];
#pragma unroll
        for (int nt = 0; nt < 2; ++nt)
#pragma unroll
            for (int kk = 0; kk < 8; ++kk) wf[nt][kk] = *(const bf16x8*)(WT + (size_t)(w * 32 + nt * 16 + fr) * 256 + kk * 32 + 8 * fq);
        f32x4 bias4[2];
#pragma unroll
        for (int nt = 0; nt < 2; ++nt) bias4[nt] = *(const f32x4*)(p.in[30] + w * 32 + nt * 16 + 4 * fq);
        for (int m0 = bid * 64; m0 < M; m0 += G * 64) {
            __syncthreads();
#pragma unroll
            for (int i = 0; i < 4; ++i) { const int pp = tid + 512 * i, row = pp >> 5, c8 = (pp & 31) * 8; *(LAS u32x4*)(lds + row * ZS + c8 * 2) = *(const u32x4*)(U + (size_t)(m0 + row) * LDU1 + c8); }
            __syncthreads();
#pragma unroll
            for (int tb = 0; tb < 4; ++tb) { f32x4 d0 = {0.f, 0.f, 0.f, 0.f}, d1 = {0.f, 0.f, 0.f, 0.f};
#pragma unroll
                for (int kk = 0; kk < 8; ++kk) { const bf16x8 zf = *(const LAS bf16x8*)(lds + (tb * 16 + fr) * ZS + (kk * 32 + 8 * fq) * 2);
                    d0 = __builtin_amdgcn_mfma_f32_16x16x32_bf16(wf[0][kk], zf, d0, 0, 0, 0); d1 = __builtin_amdgcn_mfma_f32_16x16x32_bf16(wf[1][kk], zf, d1, 0, 0, 0); }
                const int t = tb * 16 + fr;
#pragma unroll
                for (int nt = 0; nt < 2; ++nt) { const f32x4 a = (nt ? d1 : d0) + bias4[nt]; const int n0 = w * 32 + nt * 16 + 4 * fq;
                    const u32x2 zz = *(const LAS u32x2*)(lds + t * ZS + n0 * 2);
                    u32x2 o; o.x = pk2(bflo(zz.x) * sigmoidf_(a[0]), bfhi(zz.x) * sigmoidf_(a[1])); o.y = pk2(bflo(zz.y) * sigmoidf_(a[2]), bfhi(zz.y) * sigmoidf_(a[3]));
                    *(u32x2*)(YC + (size_t)(m0 + t) * DM + n0) = o; } }
        }
    }
    {
        PHASE_IDS
        const int gw = bid * 8 + wave, NW = G * 8, hh = lane >> 4, c12 = lane * 12;
        f32x4 nw[3];
#pragma unroll
        for (int j = 0; j < 3; ++j) nw[j] = *(const f32x4*)(p.in[35] + c12 + 4 * j);
        for (int m0 = gw; m0 < M; m0 += NW * 4) {
            u32x2 xn[4][3], xo[4][3]; float dn[4];
#pragma unroll
            for (int u = 0; u < 4; ++u) { const int m = m0 + u * NW; const bf16_t* ur = U + (size_t)m * LDU1 + c12; dn[u] = gDEN[(size_t)m * 4 + hh];
#pragma unroll
                for (int j = 0; j < 3; ++j) { xn[u][j] = *(const u32x2*)(ur + 1792 + 4 * j); xo[u][j] = *(const u32x2*)(ur + 2560 + 4 * j); } }
#pragma unroll
            for (int u = 0; u < 4; ++u) { const int m = m0 + u * NW; const float inv = 1.0f / fmaxf(fabsf(dn[u]), 1.0f);
                float hv[12], og[12]; float ss = 0.f;
#pragma unroll
                for (int j = 0; j < 3; ++j) { hv[4 * j] = bflo(xn[u][j].x) * inv; hv[4 * j + 1] = bfhi(xn[u][j].x) * inv; hv[4 * j + 2] = bflo(xn[u][j].y) * inv; hv[4 * j + 3] = bfhi(xn[u][j].y) * inv;
                    og[4 * j] = bflo(xo[u][j].x); og[4 * j + 1] = bfhi(xo[u][j].x); og[4 * j + 2] = bflo(xo[u][j].y); og[4 * j + 3] = bfhi(xo[u][j].y); }
#pragma unroll
                for (int e = 0; e < 12; ++e) ss = fmaf(hv[e], hv[e], ss);
                const float rs = 1.0f / sqrtf(row_sum16(ss) * (1.f / 192.f) + RMS_EPS);
                bf16_t* yo = YC + (size_t)m * DM + 256 + c12;
#pragma unroll
                for (int j = 0; j < 3; ++j) { u32x2 w; w.x = pk2(hv[4 * j] * rs * nw[j][0] * sigmoidf_(og[4 * j]), hv[4 * j + 1] * rs * nw[j][1] * sigmoidf_(og[4 * j + 1]));
                    w.y = pk2(hv[4 * j + 2] * rs * nw[j][2] * sigmoidf_(og[4 * j + 2]), hv[4 * j + 3] * rs * nw[j][3] * sigmoidf_(og[4 * j + 3])); *(u32x2*)(yo + 4 * j) = w; } }
        }
    }
    GSYNC();
    STAMP(12);

    { pg8::Gemm g{YC, (const bf16_t*)(p.ws + WS_OUT1), DM, DM, M, DM, DM}; pg8::StaticOrder S; S.init(M, DM, G, bid);
      pg8::EpiResidual<false, true> E{nullptr, XB, XB, SS3}; pg8::gemm_phase<pg8::EpiResidual<false, true>, pg8::StaticOrder, true, true>(lds, g, S, E); }
    GSYNC();
    STAMP(13);
    { pg8::Gemm g{XB, (const bf16_t*)(p.ws + WS_GU1), DM, DM, M, 2 * FFN, DM}; pg8::StaticOrder S; S.init(M, 2 * FFN, G, bid);
      pg8::EpiSwiGlu E{HID, FFN, SS3}; pg8::gemm_phase<pg8::EpiSwiGlu, pg8::StaticOrder, true, true>(lds, g, S, E); }
    GSYNC();
    STAMP(14);
    { pg8::Gemm g{HID, (const bf16_t*)(p.ws + WS_D1), FFN, FFN, M, DM, FFN}; pg8::StaticOrder S; S.init(M, DM, G, bid);
      pg8::EpiResidual<false, false> E{nullptr, XB, XB, nullptr}; pg8::gemm_phase<pg8::EpiResidual<false, false>, pg8::StaticOrder, true, true>(lds, g, S, E); }
    GSYNC();
    STAMP(15);

    {
        PHASE_IDS
        const f32x4* gg = (const f32x4*)p.in[3] + lane;
        f32x4 gv[4];
#pragma unroll
        for (int j = 0; j < 4; ++j) gv[j] = gg[64 * j];
        for (int row = bid * 8 + wave; row < M; row += G * 32) {
            u32x2 w[4][4];
#pragma unroll
            for (int r = 0; r < 4; ++r)
#pragma unroll
                for (int j = 0; j < 4; ++j) w[r][j] = ((const u32x2*)(XB + (size_t)(row + r * G * 8) * DM))[64 * j + lane];
#pragma unroll
            for (int r = 0; r < 4; ++r) { f32x4 v[4]; float s = 0.f;
#pragma unroll
                for (int j = 0; j < 4; ++j) { v[j] = (f32x4){bflo(w[r][j].x), bfhi(w[r][j].x), bflo(w[r][j].y), bfhi(w[r][j].y)}; s += (v[j][0] * v[j][0] + v[j][1] * v[j][1]) + (v[j][2] * v[j][2] + v[j][3] * v[j][3]); }
                const float rs = 1.0f / sqrtf(wave_sum(s) * (1.f / DM) + RMS_EPS);
                f32x4* xr = (f32x4*)(p.out + (size_t)(row + r * G * 8) * DM) + lane;
#pragma unroll
                for (int j = 0; j < 4; ++j) xr[64 * j] = v[j] * rs * gv[j]; }
        }
    }
    STAMP(16);
#if PROBE
    if (bid == 0 && threadIdx.x == 0) {
        const unsigned long long* ts = (const unsigned long long*)(p.ws + CTL_TS);
        const int order[18] = {0, 1, 2, 3, 17, 4, 5, 6, 7, 8, 9, 10, 11, 12, 13, 14, 15, 16};
        unsigned long long extra = 0;
        for (int j = 0; j < 17; ++j) if ((PROBE_MASK >> j) & 1) extra += __hip_atomic_load(ts + order[j + 1], __ATOMIC_RELAXED, __HIP_MEMORY_SCOPE_AGENT) - __hip_atomic_load(ts + order[j], __ATOMIC_RELAXED, __HIP_MEMORY_SCOPE_AGENT);
#ifdef PROBE_A
        extra += __hip_atomic_load(ts + PROBE_B, __ATOMIC_RELAXED, __HIP_MEMORY_SCOPE_AGENT) - __hip_atomic_load(ts + PROBE_A, __ATOMIC_RELAXED, __HIP_MEMORY_SCOPE_AGENT);
#endif
        const unsigned long long t0 = __builtin_amdgcn_s_memrealtime();
        while (__builtin_amdgcn_s_memrealtime() - t0 < extra) __builtin_amdgcn_s_sleep(8);
    }
#endif
}

extern "C" void kernel_launch(void* const* d_in, const int* in_sizes, int n_in, void* d_out, int out_size, void* d_ws, size_t ws_size, hipStream_t stream) {
    static int ready = 0;
    if (!ready) {
        if (n_in != 39 || out_size != M * DM || ws_size < WS_END) { fprintf(stderr, "kernel_launch: unexpected problem shape (n_in %d out %d ws %zu)\n", n_in, out_size, ws_size); ready = -1; return; }
        if (hipFuncSetAttribute((const void*)mega, hipFuncAttributeMaxDynamicSharedMemorySize, LDS_BYTES) != hipSuccess) { fprintf(stderr, "kernel_launch: hipFuncSetAttribute failed\n"); ready = -1; return; }
        int per_cu = 0; (void)hipOccupancyMaxActiveBlocksPerMultiprocessor(&per_cu, (const void*)mega, 512, LDS_BYTES);
        if (per_cu < 1) fprintf(stderr, "kernel_launch: occupancy query says %d blocks per CU\n", per_cu);
        (void)hipGetLastError();
        ready = 1;
    }
    if (ready < 0) return;
    (void)hipMemsetAsync((char*)d_ws + WS_CTL, 0, CTL_BYTES, stream);
    Params p{};
    for (int i = 0; i < 39; ++i) p.in[i] = (const float*)d_in[i];
    p.out = (float*)d_out; p.ws = (unsigned char*)d_ws;
    void* args[] = {&p};
    hipError_t e = hipLaunchCooperativeKernel((const void*)mega, dim3(256), dim3(512), args, LDS_BYTES, stream);
    if (e != hipSuccess) fprintf(stderr, "kernel_launch: cooperative launch failed: %s\n", hipGetErrorString(e));
}
```

```cpp
#include <hip/hip_runtime.h>
#include <hip/hip_cooperative_groups.h>
#include <cstdio>
#include <cstdint>
#include <cmath>
namespace cg = cooperative_groups;

#define LAS __attribute__((address_space(3)))
typedef unsigned short bf16_t;
typedef short bf16x8 __attribute__((ext_vector_type(8)));
typedef short s16x4 __attribute__((ext_vector_type(4)));
typedef float f32x4 __attribute__((ext_vector_type(4)));
typedef unsigned u32x4 __attribute__((ext_vector_type(4)));
typedef unsigned u32x2 __attribute__((ext_vector_type(2)));

constexpr int SEQ = 4096, BATCH = 8, DM = 1024, M = BATCH * SEQ;
constexpr int EVEN_IN = 3744, LDU0 = 3840, ODD_IN = 3336, NP1 = 3584, LDU1 = 3712, FFN = 2816;
constexpr float RMS_EPS = 1e-6f;

constexpr size_t MiB = 1u << 20;
constexpr size_t WS_CTL = 0, CTL_BYTES = 1 * MiB;
constexpr size_t CTL_SS1 = 128 * 1024, CTL_SS2 = 256 * 1024, CTL_SS3 = 384 * 1024, CTL_SS0 = 512 * 1024;
constexpr size_t CTL_TS = 800 * 1024;
constexpr size_t CTL_LB = 640 * 1024, CTL_LBR = 644 * 1024, CTL_LBI = 648 * 1024, CTL_BBR = 656 * 1024, CTL_BBI = 720 * 1024;
constexpr size_t WS_IN0 = 1 * MiB, WS_OUT0 = WS_IN0 + (size_t)LDU0 * DM * 2, WS_GU0 = WS_OUT0 + 2 * MiB, WS_D0 = WS_GU0 + 11 * MiB;
constexpr size_t WS_IN1 = WS_D0 + (size_t)DM * FFN * 2, WS_OUT1 = WS_IN1 + (size_t)NP1 * DM * 2, WS_GU1 = WS_OUT1 + 2 * MiB, WS_D1 = WS_GU1 + 11 * MiB;
constexpr size_t WS_GLU = WS_D1 + (size_t)DM * FFN * 2;
constexpr size_t WS_LORA = WS_GLU + 256 * 256 * 2;
constexpr size_t WS_XB = 53 * MiB, WS_YC = 117 * MiB, WS_U = 181 * MiB, WS_MS = 421 * MiB, WS_END = 512 * MiB;
constexpr size_t WS_SSQ = WS_MS + 70 * MiB;
static_assert(WS_LORA + 512 * 160 * 2 <= WS_XB, "weights fit");
static_assert(WS_U + (size_t)M * LDU0 * 2 <= WS_MS, "U fits");

__device__ __forceinline__ float bf2f(bf16_t h) { return __uint_as_float(((unsigned)h) << 16); }
__device__ __forceinline__ float bflo(unsigned w) { return __uint_as_float(w << 16); }
__device__ __forceinline__ unsigned long long ss_fix(float s) { return (unsigned long long)(s * 1048576.0f); }
__device__ __forceinline__ float ss_flt(unsigned long long q) { return ((float)(unsigned)(q >> 32) * 4294967296.0f + (float)(unsigned)q) * (1.0f / 1048576.0f); }
__device__ __forceinline__ float bfhi(unsigned w) { return __uint_as_float(w & 0xffff0000u); }
typedef __bf16 bf16x2_t __attribute__((ext_vector_type(2)));
typedef float f32x2c_t __attribute__((ext_vector_type(2)));
__device__ __forceinline__ unsigned pk2(float lo, float hi) { const bf16x2_t v = __builtin_convertvector((f32x2c_t){lo, hi}, bf16x2_t); return __builtin_bit_cast(unsigned, v); }
__device__ __forceinline__ bf16_t f2bf(float f) { const __bf16 b = (__bf16)f; return __builtin_bit_cast(bf16_t, b); }
__device__ __forceinline__ float sigmoidf_(float x) { return __builtin_amdgcn_rcpf(1.f + __expf(-x)); }
__device__ __forceinline__ float rsqrtf_(float x) { return __builtin_amdgcn_rsqf(x); }
__device__ __forceinline__ float siluf_(float x) { return x * sigmoidf_(x); }
__device__ __forceinline__ float softplusf_(float x) { return fmaxf(x, 0.f) + __logf(1.f + __expf(-fabsf(x))); }
__device__ __forceinline__ float tanhf_(float x) { const float e = __expf(-2.f * fabsf(x)); const float t = (1.f - e) * __builtin_amdgcn_rcpf(1.f + e); return x < 0.f ? -t : t; }
template <int CTRL> __device__ __forceinline__ float dpp_mov(float x) { return __int_as_float(__builtin_amdgcn_update_dpp(0, __float_as_int(x), CTRL, 0xf, 0xf, true)); }
__device__ __forceinline__ float row_sum16(float v) { v += dpp_mov<0xB1>(v); v += dpp_mov<0x4E>(v); v += dpp_mov<0x141>(v); v += dpp_mov<0x140>(v); return v; }
__device__ __forceinline__ float xrow16(float v) { const auto r = __builtin_amdgcn_permlane16_swap(__float_as_uint(v), __float_as_uint(v), false, false); return __uint_as_float(r[0]) + __uint_as_float(r[1]); }
__device__ __forceinline__ float xrow32(float v) { const auto r = __builtin_amdgcn_permlane32_swap(__float_as_uint(v), __float_as_uint(v), false, false); return __uint_as_float(r[0]) + __uint_as_float(r[1]); }
__device__ __forceinline__ float half_sum(float v) { return xrow16(row_sum16(v)); }
__device__ __forceinline__ float wave_sum(float v) { return xrow32(half_sum(v)); }

typedef float f32x2 __attribute__((ext_vector_type(2)));
__device__ __forceinline__ void half_reduce8(const float (&p)[8], int lane, float& o0, float& o1) {
    const bool b0 = (lane & 1) != 0, b1 = (lane & 2) != 0;
    float r[4];
#pragma unroll
    for (int i = 0; i < 4; ++i) { const float keep = b0 ? p[2 * i + 1] : p[2 * i], send = b0 ? p[2 * i] : p[2 * i + 1]; r[i] = keep + dpp_mov<0xB1>(send); }
    float q0, q1;
    { const float keep = b1 ? r[1] : r[0], send = b1 ? r[0] : r[1]; q0 = keep + dpp_mov<0x4E>(send); }
    { const float keep = b1 ? r[3] : r[2], send = b1 ? r[2] : r[3]; q1 = keep + dpp_mov<0x4E>(send); }
    q0 += dpp_mov<0x124>(q0); q0 += dpp_mov<0x128>(q0);
    q1 += dpp_mov<0x124>(q1); q1 += dpp_mov<0x128>(q1);
    o0 = xrow16(q0); o1 = xrow16(q1);
}

#define LBAR() do { asm volatile("s_waitcnt lgkmcnt(0)" ::: "memory"); __builtin_amdgcn_s_barrier(); asm volatile("" ::: "memory"); } while (0)
namespace pg8 {
constexpr int BM = 256, BK = 64, HALF = 128, HTB = HALF * BK * 2, STAGE_BYTES = 8 * HTB, NXCD = 8, WGM = 4;
__device__ __forceinline__ int lds_byte(int r, int c) { const int st = (r >> 4) * 2 + (c >> 5), rr = r & 15, cc = c & 31, ob = rr * 64 + cc * 2; return st * 1024 + (ob ^ (((ob >> 9) & 1) << 5)); }
__device__ __forceinline__ void stage_rc(int b, int& R, int& C) { const int st = b / 1024, sb = b % 1024, swz = sb ^ (((sb >> 9) & 1) << 5); R = (st >> 1) * 16 + swz / 64; C = (st & 1) * 32 + (swz % 64) / 2; }
__device__ __forceinline__ int perm32(int rho) { const int n = rho >> 4, i = rho & 15; return 8 * (i >> 2) + 4 * n + (i & 3); }
struct Unit { int pm, pn; };
struct Gemm { const bf16_t* A; const bf16_t* Bt; int lda, ldb, M, N, K; };
struct StaticOrder {
    int nM, nN, nwg, G, c;
    __device__ void init(int M_, int N_, int G_, int c_) { nM = M_ / BM; nN = N_ / BM; nwg = nM * nN; G = G_; c = c_; }
    __device__ bool next(int i, Unit& u) const {
        const long L = (long)i * G + c; if (L >= nwg) return false;
        int wgid = (int)L; { const int q = nwg / NXCD, r = nwg % NXCD, xcd = wgid % NXCD, off = wgid / NXCD; wgid = (xcd < r ? xcd * (q + 1) : r * (q + 1) + (xcd - r) * q) + off; }
        const int nig = WGM * nN, gid = wgid / nig, fm = gid * WGM, gsz = (nM - fm) < WGM ? (nM - fm) : WGM;
        u.pm = fm + ((wgid % nig) % gsz); u.pn = (wgid % nig) / gsz; return true;
    }
};

struct EpiScaleBf16 {
    static constexpr bool PERM = true;
    bf16_t* O; int ldc; const unsigned long long* ss;
    __device__ __forceinline__ void operator()(const f32x4 (&acc)[2][2][4][2], const Unit& u, int wr, int wc, int fr, int fq) const {
        const int row0 = u.pm * BM + wr * 64 + fr, col0 = u.pn * BM + wc * 32 + 8 * fq;
#pragma unroll
        for (int ai = 0; ai < 2; ++ai)
#pragma unroll
            for (int m = 0; m < 4; ++m) { const int row = row0 + ai * HALF + m * 16; const float rs = rsqrtf_(ss_flt(ss[row]) * (1.f / DM) + RMS_EPS);
                bf16_t* rowp = O + (size_t)row * ldc + col0;
#pragma unroll
                for (int bj = 0; bj < 2; ++bj) { const f32x4 v0 = acc[ai][bj][m][0] * rs, v1 = acc[ai][bj][m][1] * rs;
                    u32x4 w; w.x = pk2(v0[0], v0[1]); w.y = pk2(v0[2], v0[3]); w.z = pk2(v1[0], v1[1]); w.w = pk2(v1[2], v1[3]);
                    *(u32x4*)(rowp + bj * HALF) = w; } }
    }
};
struct EpiSwiGlu {
    static constexpr bool PERM = true;
    bf16_t* O; int ldc; const unsigned long long* ss;
    __device__ __forceinline__ void operator()(const f32x4 (&acc)[2][2][4][2], const Unit& u, int wr, int wc, int fr, int fq) const {
        const int row0 = u.pm * BM + wr * 64 + fr, col0 = u.pn * HALF + wc * 32 + 8 * fq;
#pragma unroll
        for (int ai = 0; ai < 2; ++ai)
#pragma unroll
            for (int m = 0; m < 4; ++m) { const int row = row0 + ai * HALF + m * 16; const float rs = rsqrtf_(ss_flt(ss[row]) * (1.f / DM) + RMS_EPS);
                f32x4 h[2];
#pragma unroll
                for (int n = 0; n < 2; ++n) { const f32x4 g = acc[ai][0][m][n] * rs, up = acc[ai][1][m][n] * rs;
#pragma unroll
                    for (int e = 0; e < 4; ++e) h[n][e] = siluf_(g[e]) * up[e]; }
                u32x4 w; w.x = pk2(h[0][0], h[0][1]); w.y = pk2(h[0][2], h[0][3]); w.z = pk2(h[1][0], h[1][1]); w.w = pk2(h[1][2], h[1][3]);
                *(u32x4*)(O + (size_t)row * ldc + col0) = w; }
    }
};
template <bool BASE_F32, bool WITH_SS> struct EpiResidual {
    static constexpr bool PERM = true;
    const float* base32; const bf16_t* base16; bf16_t* xb; unsigned long long* ss;
    __device__ __forceinline__ void operator()(const f32x4 (&acc)[2][2][4][2], const Unit& u, int wr, int wc, int fr, int fq) const {
        const int row0 = u.pm * BM + wr * 64 + fr, col0 = u.pn * BM + wc * 32 + 8 * fq;
#pragma unroll
        for (int ai = 0; ai < 2; ++ai)
#pragma unroll
            for (int m = 0; m < 4; ++m) { const int row = row0 + ai * HALF + m * 16; const size_t off = (size_t)row * DM + col0; float s = 0.f;
#pragma unroll
                for (int bj = 0; bj < 2; ++bj) { const size_t o = off + bj * HALF; f32x4 r0, r1;
                    if (BASE_F32) { r0 = *(const f32x4*)(base32 + o); r1 = *(const f32x4*)(base32 + o + 4); }
                    else { const u32x4 rb = *(const u32x4*)(base16 + o); r0 = (f32x4){bflo(rb.x), bfhi(rb.x), bflo(rb.y), bfhi(rb.y)}; r1 = (f32x4){bflo(rb.z), bfhi(rb.z), bflo(rb.w), bfhi(rb.w)}; }
                    const f32x4 v0 = r0 + acc[ai][bj][m][0], v1 = r1 + acc[ai][bj][m][1];
                    u32x4 w; w.x = pk2(v0[0], v0[1]); w.y = pk2(v0[2], v0[3]); w.z = pk2(v1[0], v1[1]); w.w = pk2(v1[2], v1[3]); *(u32x4*)(xb + o) = w;
                    s += ((v0[0] * v0[0] + v0[1] * v0[1]) + (v0[2] * v0[2] + v0[3] * v0[3])) + ((v1[0] * v1[0] + v1[1] * v1[1]) + (v1[2] * v1[2] + v1[3] * v1[3])); }
                if (WITH_SS) { s = xrow32(xrow16(s)); if (fq == 0) atomicAdd(ss + row, ss_fix(s)); } }
    }
};

template <class Epi, class Sched, bool ALIGN_EPI, bool SP2>
__device__ __forceinline__ void gemm_phase(LAS unsigned char* lds, const Gemm g, const Sched& S, const Epi& E) {
    int tid_ = threadIdx.x; asm volatile("" : "+v"(tid_));
    const int tid = tid_, wid = __builtin_amdgcn_readfirstlane(tid >> 6), lane = tid & 63, wr = wid >> 2, wc = wid & 3, fr = lane & 15, fq = lane >> 4;
    const int K = g.K, nt = K / BK;
    unsigned voffA[2], voffB[2];
#pragma unroll
    for (int i = 0; i < 2; ++i) { int R, C; stage_rc(tid * 16 + i * 8192, R, C); const int Rb = Epi::PERM ? ((R & ~31) + perm32(R & 31)) : R;
        voffA[i] = (unsigned)(R * g.lda + C) * 2u; voffB[i] = (unsigned)(Rb * g.ldb + C) * 2u; }
    const size_t kstep = (size_t)(BK * 2);
    const size_t hstepA = (size_t)HALF * g.lda * 2, hstepB = (size_t)HALF * g.ldb * 2;
    const size_t tstepA = 2 * hstepA, tstepB = 2 * hstepB;
    const unsigned ldsw = (unsigned)wid * 1024u;
    const int aoff = lds_byte(wr * 64 + fr, fq * 8), boff = lds_byte(wc * 32 + fr, fq * 8);
#define PG8_SA(b, h) (((b) * 2 + (h)) * HTB)
#define PG8_SB(b, h) ((4 + (b) * 2 + (h)) * HTB)
#define PG8_STAGE(bufoff, gbase, voff) do { _Pragma("unroll") for (int _i = 0; _i < 2; ++_i) \
        __builtin_amdgcn_global_load_lds((const unsigned*)((const char*)(gbase) + (voff)[_i]), (LAS unsigned*)(lds + (bufoff) + ldsw + _i * 8192), 16, 0, 0); } while (0)
#define PG8_LDA(dst, b, h) do { _Pragma("unroll") for (int m = 0; m < 4; ++m) _Pragma("unroll") for (int k = 0; k < 2; ++k) dst[m][k] = *(const LAS bf16x8*)(lds + PG8_SA(b, h) + aoff + m * 2048 + k * 1024); } while (0)
#define PG8_LDB(dst, b, h) do { _Pragma("unroll") for (int n = 0; n < 2; ++n) _Pragma("unroll") for (int k = 0; k < 2; ++k) dst[n][k] = *(const LAS bf16x8*)(lds + PG8_SB(b, h) + boff + n * 2048 + k * 1024); } while (0)
#define PG8_MMA(ai, bj, At, Bt) do { __builtin_amdgcn_s_setprio(1); _Pragma("unroll") for (int m = 0; m < 4; ++m) _Pragma("unroll") for (int n = 0; n < 2; ++n) _Pragma("unroll") for (int k = 0; k < 2; ++k) \
        acc[ai][bj][m][n] = __builtin_amdgcn_mfma_f32_16x16x32_bf16(Bt[n][k], At[m][k], acc[ai][bj][m][n], 0, 0, 0); __builtin_amdgcn_s_setprio(0); } while (0)
#define PG8_WAIT_V(n) asm volatile("s_waitcnt vmcnt(" #n ")" ::: "memory")
#define PG8_WAIT_L(n) asm volatile("s_waitcnt lgkmcnt(" #n ")" ::: "memory")
#define PG8_BAR __builtin_amdgcn_s_barrier()
#define PG8_SCHED __builtin_amdgcn_sched_barrier(0)
    Unit cur, nxt; int ui = 0;
    if (!S.next(0, cur)) return;
    f32x4 acc[2][2][4][2];
#pragma unroll
    for (int a = 0; a < 2; ++a)
#pragma unroll
        for (int b = 0; b < 2; ++b)
#pragma unroll
            for (int m = 0; m < 4; ++m)
#pragma unroll
                for (int n = 0; n < 2; ++n) acc[a][b][m][n] = (f32x4){0.f, 0.f, 0.f, 0.f};
    bf16x8 At[4][2], B0[2][2], B1[2][2];
    const char* cA = (const char*)g.A + (size_t)cur.pm * tstepA; const char* cB = (const char*)g.Bt + (size_t)cur.pn * tstepB;
    if constexpr (SP2) {
        PG8_STAGE(PG8_SB(0, 0), cB, voffB); PG8_STAGE(PG8_SB(0, 1), cB + hstepB, voffB); PG8_STAGE(PG8_SA(0, 0), cA, voffA); PG8_STAGE(PG8_SA(0, 1), cA + hstepA, voffA);
        if (wr == 1) PG8_BAR;
        PG8_WAIT_V(2); PG8_BAR;
        PG8_STAGE(PG8_SB(1, 0), cB + kstep, voffB); PG8_STAGE(PG8_SA(1, 0), cA + kstep, voffA); PG8_STAGE(PG8_SB(1, 1), cB + hstepB + kstep, voffB);
        PG8_WAIT_V(6); PG8_BAR;
    } else {
        PG8_STAGE(PG8_SB(0, 0), cB, voffB); PG8_STAGE(PG8_SA(0, 0), cA, voffA); PG8_STAGE(PG8_SB(0, 1), cB + hstepB, voffB); PG8_STAGE(PG8_SA(0, 1), cA + hstepA, voffA);
        if (wr == 1) PG8_BAR;
        PG8_WAIT_V(4); PG8_BAR;
        PG8_STAGE(PG8_SB(1, 0), cB + kstep, voffB); PG8_STAGE(PG8_SA(1, 0), cA + kstep, voffA); PG8_STAGE(PG8_SB(1, 1), cB + hstepB + kstep, voffB);
        PG8_WAIT_V(6); PG8_BAR;
    }
    for (;;) {
        const bool has_next = S.next(ui + 1, nxt);
        const char* nA = has_next ? (const char*)g.A + (size_t)nxt.pm * tstepA : cA; const char* nB = has_next ? (const char*)g.Bt + (size_t)nxt.pn * tstepB : cB;
        for (int t = 0; t < nt; t += 2) {
            const bool last = (t == nt - 2);
            const char* a1 = cA + (size_t)(t + 1) * kstep;
            const char* a2 = last ? nA : cA + (size_t)(t + 2) * kstep; const char* b2 = last ? nB : cB + (size_t)(t + 2) * kstep;
            const char* a3 = a2 + kstep; const char* b3 = b2 + kstep;
            if constexpr (SP2) {
            PG8_LDB(B0, 0, 0); PG8_LDB(B1, 0, 1); PG8_SCHED; PG8_LDA(At, 0, 0); PG8_STAGE(PG8_SA(1, 1), a1 + hstepA, voffA);
            PG8_WAIT_V(8); PG8_WAIT_L(0); PG8_BAR; PG8_MMA(0, 0, At, B0); PG8_MMA(0, 1, At, B1); PG8_BAR; PG8_SCHED;
            PG8_LDA(At, 0, 1); PG8_STAGE(PG8_SB(0, 0), b2, voffB); PG8_STAGE(PG8_SB(0, 1), b2 + hstepB, voffB); PG8_STAGE(PG8_SA(0, 0), a2, voffA);
            PG8_WAIT_V(8); PG8_WAIT_L(0); PG8_BAR; PG8_MMA(1, 0, At, B0); PG8_MMA(1, 1, At, B1); PG8_BAR; PG8_SCHED;
            PG8_LDB(B0, 1, 0); PG8_LDB(B1, 1, 1); PG8_SCHED; PG8_LDA(At, 1, 0); PG8_STAGE(PG8_SA(0, 1), a2 + hstepA, voffA);
            PG8_WAIT_V(8); PG8_WAIT_L(0); PG8_BAR; PG8_MMA(0, 0, At, B0); PG8_MMA(0, 1, At, B1); PG8_BAR; PG8_SCHED;
            PG8_LDA(At, 1, 1); PG8_STAGE(PG8_SB(1, 0), b3, voffB); PG8_STAGE(PG8_SB(1, 1), b3 + hstepB, voffB); PG8_STAGE(PG8_SA(1, 0), a3, voffA);
            PG8_WAIT_V(8); PG8_WAIT_L(0); PG8_BAR; PG8_MMA(1, 0, At, B0); PG8_MMA(1, 1, At, B1); PG8_BAR; PG8_SCHED;
            } else {
            PG8_LDB(B0, 0, 0); PG8_SCHED; PG8_LDA(At, 0, 0); PG8_STAGE(PG8_SA(1, 1), a1 + hstepA, voffA);
            PG8_WAIT_L(8); PG8_BAR; PG8_WAIT_L(0); PG8_MMA(0, 0, At, B0); PG8_BAR; PG8_SCHED;
            PG8_LDB(B1, 0, 1); PG8_STAGE(PG8_SB(0, 0), b2, voffB);
            PG8_BAR; PG8_WAIT_L(0); PG8_MMA(0, 1, At, B1); PG8_BAR;
            PG8_LDA(At, 0, 1); PG8_STAGE(PG8_SA(0, 0), a2, voffA);
            PG8_BAR; PG8_WAIT_L(0); PG8_MMA(1, 0, At, B0); PG8_BAR; PG8_SCHED;
            PG8_STAGE(PG8_SB(0, 1), b2 + hstepB, voffB);
            PG8_WAIT_V(6); PG8_BAR; PG8_MMA(1, 1, At, B1); PG8_BAR;
            PG8_LDB(B0, 1, 0); PG8_SCHED; PG8_LDA(At, 1, 0); PG8_STAGE(PG8_SA(0, 1), a2 + hstepA, voffA);
            PG8_WAIT_L(8); PG8_BAR; PG8_WAIT_L(0); PG8_MMA(0, 0, At, B0); PG8_BAR; PG8_SCHED;
            PG8_LDB(B1, 1, 1); PG8_STAGE(PG8_SB(1, 0), b3, voffB);
            PG8_BAR; PG8_WAIT_L(0); PG8_MMA(0, 1, At, B1); PG8_BAR;
            PG8_LDA(At, 1, 1); PG8_STAGE(PG8_SA(1, 0), a3, voffA);
            PG8_BAR; PG8_WAIT_L(0); PG8_MMA(1, 0, At, B0); PG8_BAR; PG8_SCHED;
            PG8_STAGE(PG8_SB(1, 1), b3 + hstepB, voffB);
            PG8_WAIT_V(6); PG8_BAR; PG8_MMA(1, 1, At, B1); PG8_BAR;
            }
        }
        if constexpr (ALIGN_EPI) { if (wr == 0) PG8_BAR; }
        E(acc, cur, wr, wc, fr, fq);
        if (!has_next) break;
#pragma unroll
        for (int a = 0; a < 2; ++a)
#pragma unroll
            for (int b = 0; b < 2; ++b)
#pragma unroll
                for (int m = 0; m < 4; ++m)
#pragma unroll
                    for (int n = 0; n < 2; ++n) acc[a][b][m][n] = (f32x4){0.f, 0.f, 0.f, 0.f};
        cur = nxt; cA = nA; cB = nB; ++ui;
        if constexpr (ALIGN_EPI) { if (wr == 1) PG8_BAR; }
    }
    PG8_WAIT_V(0);
    if constexpr (!ALIGN_EPI) { if (wr == 0) PG8_BAR; }
    PG8_BAR;
#undef PG8_SA
#undef PG8_SB
#undef PG8_STAGE
#undef PG8_LDA
#undef PG8_LDB
#undef PG8_MMA
#undef PG8_WAIT_V
#undef PG8_WAIT_L
#undef PG8_BAR
#undef PG8_SCHED
}
}

#define XB_TMO      128
#define XB_XCNT(j)  (256  + 64 * (j))
#define XB_XSUB(j)  (1280 + 64 * (j))
#define XB_XGEN(j)  (2304 + 64 * (j))
#define XB_TOP      3328
#define XB_TOPGEN   3392
#define XCD_BAR_WORDS 3456
#define XB_SPIN_CAP (1u << 18)
__device__ __forceinline__ unsigned xb_ld(unsigned* p)              { return __hip_atomic_load(p, __ATOMIC_RELAXED, __HIP_MEMORY_SCOPE_AGENT); }
__device__ __forceinline__ unsigned xb_add(unsigned* p, unsigned v) { return __hip_atomic_fetch_add(p, v, __ATOMIC_RELAXED, __HIP_MEMORY_SCOPE_AGENT); }
__device__ __forceinline__ unsigned xb_xcc_id() { return (unsigned)__builtin_amdgcn_s_getreg((3 << 11) | 20) & 0xFu; }
#define XB_SPIN(cond, bar) do { unsigned _sp = 0; while (cond) { __builtin_amdgcn_s_sleep(1); \
    if ((++_sp & 255u) == 0u) { if (xb_ld(&(bar)[XB_TMO])) break; if (_sp > XB_SPIN_CAP) { atomicAdd(&(bar)[XB_TMO], 1u); break; } } } } while (0)
struct XcdBarrier { unsigned* bar; unsigned x; volatile LAS unsigned* st; };
__device__ __forceinline__ XcdBarrier xcd_barrier_post(unsigned* bar, volatile LAS unsigned* st) {
    XcdBarrier b; b.bar = bar; b.x = xb_xcc_id(); b.st = st;
    if (threadIdx.x == 0) (void)xb_add(&bar[XB_XCNT(b.x)], 1u);
    return b;
}
__device__ __forceinline__ void xcd_barrier_complete(unsigned* bar, unsigned x, unsigned& nloc, unsigned& nx) {
    const unsigned G = gridDim.x * gridDim.y * gridDim.z;
    unsigned sum, cnt, mine, sp = 0u;
    for (;;) {
        sum = 0u; cnt = 0u; mine = 0u;
#pragma unroll
        for (unsigned j = 0; j < 16; ++j) { const unsigned c = xb_ld(&bar[XB_XCNT(j)]); sum += c; cnt += (c > 0u) ? 1u : 0u; mine = (j == x) ? c : mine; }
        if (sum == G) break;
        __builtin_amdgcn_s_sleep(1);
        if ((++sp & 255u) == 0u) { if (xb_ld(&bar[XB_TMO])) break; if (sp > XB_SPIN_CAP) { atomicAdd(&bar[XB_TMO], 1u); break; } }
    }
    nloc = mine > 0u ? mine : 1u; nx = cnt > 0u ? cnt : 1u;
}
__device__ __forceinline__ void xcd_barrier(const XcdBarrier& b, const int tid0) {
    asm volatile("s_waitcnt vmcnt(0)" ::: "memory");
    __syncthreads();
    if (tid0 == 0) {
        unsigned* bar = b.bar;
        __builtin_amdgcn_s_waitcnt(0);
        unsigned nloc = b.st[0], nx = b.st[1];
        if (nloc == 0u) { xcd_barrier_complete(bar, b.x, nloc, nx); b.st[0] = nloc; b.st[1] = nx; }
        const unsigned old = xb_add(&bar[XB_XSUB(b.x)], 1u);
        const unsigned gen = old / nloc;
        if (old + 1u == (gen + 1u) * nloc) {
            __builtin_amdgcn_fence(__ATOMIC_RELEASE, "agent");
            asm volatile("s_waitcnt vmcnt(0)" ::: "memory");
            const unsigned og = xb_add(&bar[XB_TOP], 1u);
            const unsigned tg = og / nx;
            if (og + 1u != (tg + 1u) * nx) XB_SPIN(xb_ld(&bar[XB_TOP]) < (tg + 1u) * nx, bar);
            __builtin_amdgcn_fence(__ATOMIC_ACQUIRE, "agent");
            xb_add(&bar[XB_XGEN(b.x)], 1u);
            asm volatile("s_waitcnt vmcnt(0)" ::: "memory");
        } else {
            XB_SPIN(xb_ld(&bar[XB_XGEN(b.x)]) == gen, bar);
            __builtin_amdgcn_fence(__ATOMIC_ACQUIRE, "agent");
            asm volatile("s_waitcnt vmcnt(0)" ::: "memory");
        }
    }
    __syncthreads();
}

constexpr int LDS_BYTES = 147456;
struct Params { const float* in[39]; float* out; unsigned char* ws; };

struct TrTile { const float* W; const float* gain; bf16_t* dst; int N, Npad, ldb, mode, k0, n0; };
__device__ __forceinline__ void tr_load(const TrTile& t, int tid, f32x4 (&v)[8], float (&gv)[8]) {
    const float* gp = t.gain ? t.gain : t.W;
#pragma unroll
    for (int i = 0; i < 8; ++i) { const int pp = tid + 512 * i, kk = pp >> 6, n = t.n0 + (pp & 63) * 4; const bool inb = n + 3 < t.N;
        v[i] = *(const f32x4*)(t.W + (size_t)(t.k0 + kk) * t.N + (inb ? n : 0)); gv[i] = gp[t.k0 + kk]; }
}
__device__ __forceinline__ void tr_to_lds(const TrTile& t, int tid, const f32x4 (&v)[8], const float (&gv)[8], LAS unsigned char* l) {
#pragma unroll
    for (int i = 0; i < 8; ++i) { const int pp = tid + 512 * i, kk = pp >> 6, n4 = (pp & 63) * 4; const bool inb = t.n0 + n4 + 3 < t.N;
        const float g = t.gain ? gv[i] : 1.f; const f32x4 x = inb ? v[i] * g : (f32x4){0.f, 0.f, 0.f, 0.f};
        u32x2 w; w.x = pk2(x[0], x[1]); w.y = pk2(x[2], x[3]); *(LAS u32x2*)(l + kk * 528 + n4 * 2) = w; }
}
__device__ __forceinline__ void tr_store(const TrTile& t, int tid, const LAS unsigned char* l) {
#pragma unroll
    for (int i = 0; i < 4; ++i) { const int pp = tid + 512 * i, n = pp >> 3, c = pp & 7; const int jn = t.n0 + n;
        if (jn < t.Npad) { const LAS bf16_t* s = (const LAS bf16_t*)(l + (8 * c) * 528) + n;
            const int drow = t.mode == 0 ? jn : ((jn >> 7) * 256 + (jn & 127) + (t.mode == 2 ? 128 : 0));
            u32x4 o; o.x = (unsigned)s[0] | ((unsigned)s[264] << 16); o.y = (unsigned)s[2 * 264] | ((unsigned)s[3 * 264] << 16); o.z = (unsigned)s[4 * 264] | ((unsigned)s[5 * 264] << 16); o.w = (unsigned)s[6 * 264] | ((unsigned)s[7 * 264] << 16);
            *(u32x4*)(t.dst + (size_t)drow * t.ldb + t.k0 + 8 * c) = o; } }
}

__global__ void __launch_bounds__(512, 2) mega(Params p) {
    extern __shared__ __attribute__((aligned(16))) unsigned char lds_raw[];
    LAS unsigned char* lds = (LAS unsigned char*)lds_raw;
    const int G = gridDim.x, bid = blockIdx.x;
#define PHASE_IDS int tid_o = threadIdx.x; asm volatile("" : "+v"(tid_o)); const int tid = tid_o, lane = tid & 63, wave = tid >> 6; (void)lane; (void)wave;
#define SS0 ((unsigned long long*)(p.ws + WS_SSQ))
#define SS1 (SS0 + M)
#define SS2 (SS0 + 2 * M)
#define SS3 (SS0 + 3 * M)
#define LBT ((float*)(p.ws + CTL_LB))
#define LBR ((float*)(p.ws + CTL_LBR))
#define LBI ((float*)(p.ws + CTL_LBI))
#define BBR ((float*)(p.ws + CTL_BBR))
#define BBI ((float*)(p.ws + CTL_BBI))
#define XB ((bf16_t*)(p.ws + WS_XB))
#define YC ((bf16_t*)(p.ws + WS_YC))
#define U ((bf16_t*)(p.ws + WS_U))
    { volatile LAS unsigned* st0 = (volatile LAS unsigned*)(lds + LDS_BYTES - 64); if (threadIdx.x < 16) st0[threadIdx.x] = 0u; }
    __syncthreads();
    (void)xcd_barrier_post((unsigned*)(p.ws + WS_CTL), (volatile LAS unsigned*)(lds + LDS_BYTES - 64));
#ifndef PROBE
#define PROBE 0
#endif
#ifndef PROBE_MASK
#define PROBE_MASK 0
#endif
#define STAMP(k) do { if (PROBE && bid == 0 && threadIdx.x == 0) ((unsigned long long*)(p.ws + CTL_TS))[k] = __builtin_amdgcn_s_memrealtime(); } while (0)
#define STAMP2(k, blk) do { if (PROBE && bid == (blk) && threadIdx.x == 0) ((unsigned long long*)(p.ws + CTL_TS))[k] = __builtin_amdgcn_s_memrealtime(); } while (0)
    STAMP(0);
#define GSYNC() do { XcdBarrier xb_; xb_.bar = (unsigned*)(p.ws + WS_CTL); xb_.x = xb_xcc_id(); xb_.st = (volatile LAS unsigned*)(lds + LDS_BYTES - 64); xcd_barrier(xb_, (int)threadIdx.x); } while (0)

    constexpr int T_IN0 = 16 * 15, T_SQ = 16 * 4, T_GU = 16 * 11, T_DN = 44 * 4, T_IN1 = 16 * 14, T_GL = 4 * 1;
    constexpr int NTA = T_IN0, NT0 = T_IN0 + 448, NT = T_IN0 + T_SQ + 2 * T_GU + T_DN + T_IN1 + T_SQ + 2 * T_GU + T_DN + T_GL;
    {
        PHASE_IDS
#define P0_DECODE(T_, it_) { int r = (it_); const float* W; const float* gain; bf16_t* dst; int N, Npad, nNt, ldb, mode; \
            if (r < T_IN0) { W = p.in[4]; gain = p.in[1]; dst = (bf16_t*)(p.ws + WS_IN0); N = EVEN_IN; Npad = LDU0; nNt = 15; ldb = DM; mode = 0; } \
            else if ((r -= T_IN0) < T_SQ) { W = p.in[5]; gain = nullptr; dst = (bf16_t*)(p.ws + WS_OUT0); N = DM; Npad = DM; nNt = 4; ldb = DM; mode = 0; } \
            else if ((r -= T_SQ) < T_GU) { W = p.in[36]; gain = p.in[2]; dst = (bf16_t*)(p.ws + WS_GU0); N = FFN; Npad = FFN; nNt = 11; ldb = DM; mode = 1; } \
            else if ((r -= T_GU) < T_GU) { W = p.in[37]; gain = p.in[2]; dst = (bf16_t*)(p.ws + WS_GU0); N = FFN; Npad = FFN; nNt = 11; ldb = DM; mode = 2; } \
            else if ((r -= T_GU) < T_DN) { W = p.in[38]; gain = nullptr; dst = (bf16_t*)(p.ws + WS_D0); N = DM; Npad = DM; nNt = 4; ldb = FFN; mode = 0; } \
            else if ((r -= T_DN) < T_IN1) { W = p.in[19]; gain = p.in[1] + DM; dst = (bf16_t*)(p.ws + WS_IN1); N = ODD_IN; Npad = NP1; nNt = 14; ldb = DM; mode = 0; } \
            else if ((r -= T_IN1) < T_SQ) { W = p.in[20]; gain = nullptr; dst = (bf16_t*)(p.ws + WS_OUT1); N = DM; Npad = DM; nNt = 4; ldb = DM; mode = 0; } \
            else if ((r -= T_SQ) < T_GU) { W = p.in[36] + (size_t)DM * FFN; gain = p.in[2] + DM; dst = (bf16_t*)(p.ws + WS_GU1); N = FFN; Npad = FFN; nNt = 11; ldb = DM; mode = 1; } \
            else if ((r -= T_GU) < T_GU) { W = p.in[37] + (size_t)DM * FFN; gain = p.in[2] + DM; dst = (bf16_t*)(p.ws + WS_GU1); N = FFN; Npad = FFN; nNt = 11; ldb = DM; mode = 2; } \
            else if ((r -= T_GU) < T_DN) { W = p.in[38] + (size_t)FFN * DM; gain = nullptr; dst = (bf16_t*)(p.ws + WS_D1); N = DM; Npad = DM; nNt = 4; ldb = FFN; mode = 0; } \
            else { r -= T_DN; W = p.in[29]; gain = nullptr; dst = (bf16_t*)(p.ws + WS_GLU); N = 256; Npad = 256; nNt = 1; ldb = 256; mode = 0; } \
            T_.W = W; T_.gain = gain; T_.dst = dst; T_.N = N; T_.Npad = Npad; T_.ldb = ldb; T_.mode = mode; T_.k0 = (r / nNt) * 64; T_.n0 = (r % nNt) * 256; }
        const float* x = p.in[0];
        int xrow = bid * 8 + wave;
#define P0_XSTEP() { if (xrow < M) { const int row = xrow, row2 = row + G * 8; const bool has2 = row2 < M; \
            const f32x4* xr = (const f32x4*)(x + (size_t)row * DM) + lane; const f32x4* xr2 = (const f32x4*)(x + (size_t)(has2 ? row2 : row) * DM) + lane; f32x4 v[4], v2[4]; float s = 0.f, s2 = 0.f; \
            _Pragma("unroll") for (int j = 0; j < 4; ++j) { v[j] = xr[64 * j]; v2[j] = xr2[64 * j]; } \
            _Pragma("unroll") for (int j = 0; j < 4; ++j) { s += (v[j][0] * v[j][0] + v[j][1] * v[j][1]) + (v[j][2] * v[j][2] + v[j][3] * v[j][3]); s2 += (v2[j][0] * v2[j][0] + v2[j][1] * v2[j][1]) + (v2[j][2] * v2[j][2] + v2[j][3] * v2[j][3]); } \
            s = wave_sum(s); s2 = wave_sum(s2); if (lane == 0) { SS0[row] = ss_fix(s); if (has2) SS0[row2] = ss_fix(s2); } \
            u32x2* o = (u32x2*)(XB + (size_t)row * DM) + lane; u32x2* o2 = (u32x2*)(XB + (size_t)row2 * DM) + lane; \
            _Pragma("unroll") for (int j = 0; j < 4; ++j) { u32x2 w; w.x = pk2(v[j][0], v[j][1]); w.y = pk2(v[j][2], v[j][3]); o[64 * j] = w; if (has2) { u32x2 w2; w2.x = pk2(v2[j][0], v2[j][1]); w2.y = pk2(v2[j][2], v2[j][3]); o2[64 * j] = w2; } } \
            xrow += G * 16; } }
        for (int it = bid; it < NTA; it += G) {
            TrTile cur; f32x4 tv[8]; float tg[8];
            P0_DECODE(cur, it); tr_load(cur, tid, tv, tg);
            P0_XSTEP();
            __syncthreads();
            tr_to_lds(cur, tid, tv, tg, lds);
            __syncthreads();
            tr_store(cur, tid, lds);
            P0_XSTEP();
        }
        while (xrow < M) P0_XSTEP();
#undef P0_XSTEP
        for (int i = bid * 512 + tid; i < 3 * M; i += G * 512) SS1[i] = 0ull;
        for (int i = bid * 512 + tid; i < 512 * 160; i += G * 512) { const int c = i / 160, k = i % 160;
            const float v = (k < 32) ? p.in[10][k * 512 + c] : (k < 64) ? p.in[12][(k - 32) * 512 + c] : p.in[13][(k - 64) * 512 + c]; ((bf16_t*)(p.ws + WS_LORA))[i] = f2bf(v); }
        { const int gt = bid * 512 + tid;
          if (gt < 512) { const float* lt = p.in[6]; const float l0 = lt[gt], l1 = lt[512 + gt], l2 = lt[1024 + gt]; const float mx = fmaxf(l0, fmaxf(l1, l2));
              const float e0 = expf(l0 - mx), e1 = expf(l1 - mx), e2 = expf(l2 - mx); LBT[gt] = e0 / (e0 + e1 + e2); }
          const int i = gt - 512;
          if (i >= 0 && i < 16384) { const int gp = i >> 4, h = i & 15, g = gp >> 6; const float step = expf(p.in[23][g]); const float lr = p.in[21][gp], li = p.in[22][gp];
              const float mag = expf(lr * step); const float br = mag * cosf(li * step), bi = mag * sinf(li * step);
              if (h == 0) { LBR[gp] = br; LBI[gp] = bi; }
              const float den = lr * lr + li * li, nr = br - 1.f, ni = bi; const float cr = (nr * lr + ni * li) / den, ci = (ni * lr - nr * li) / den;
              const float xr2 = p.in[24][gp * 16 + h], xi2 = p.in[25][gp * 16 + h]; BBR[gp * 16 + h] = cr * xr2 - ci * xi2; BBI[gp * 16 + h] = cr * xi2 + ci * xr2; } }
    }
    GSYNC();
    STAMP(1);

    { pg8::Gemm g{XB, (const bf16_t*)(p.ws + WS_IN0), DM, DM, M, LDU0, DM}; pg8::StaticOrder S; S.init(M, LDU0, G, bid);
      pg8::EpiScaleBf16 E{U, LDU0, SS0}; pg8::gemm_phase<pg8::EpiScaleBf16, pg8::StaticOrder, true, true>(lds, g, S, E); }
    if (bid >= 128) {
        PHASE_IDS
        int it = NTA + (bid - 128);
        if (it < NT0) {
            TrTile cur, nxt; f32x4 tv[8]; float tg[8];
            P0_DECODE(cur, it); tr_load(cur, tid, tv, tg);
            for (; it < NT0; it += 128) {
                const int itn = (it + 128 < NT0) ? it + 128 : it; P0_DECODE(nxt, itn);
                LBAR();
                tr_to_lds(cur, tid, tv, tg, lds);
                tr_load(nxt, tid, tv, tg);
                LBAR();
                tr_store(cur, tid, lds);
                cur = nxt;
            }
        }
    }
    GSYNC();
    STAMP(2);

#define Rt ((bf16_t*)p.out)
#define At (Rt + (size_t)M * 512)
#define Bh (Rt + (size_t)M * 1024)
#define Kh (Rt + (size_t)M * 1536)
#define Vv XB
#define BVG (XB + (size_t)M * 512)
#define Gg ((bf16_t*)(p.ws + WS_MS))
#define GLc ((float*)(p.ws + WS_MS + 32 * MiB))
#define HEM ((float*)(p.ws + WS_MS + 64 * MiB))
#define HEL ((float*)(p.ws + WS_MS + 65 * MiB))
#define HELM ((float*)(p.ws + WS_MS + 66 * MiB))
#define Pg2 ((bf16_t*)(p.ws + WS_YC))

    {
        PHASE_IDS
        const int hd = __builtin_amdgcn_readfirstlane(tid >> 6), fr = lane & 15, fq = lane >> 4;
        constexpr int SLS = 336;
        const bf16_t* LT = (const bf16_t*)(p.ws + WS_LORA);
        float mu_r[4], mu_k[4], mu_v[4], w0c[4], a0c[4], kkc[4], kac[4], rkc[4];
#pragma unroll
        for (int nt = 0; nt < 4; ++nt) { const int c = hd * 64 + 4 * fr + nt; mu_r[nt] = p.in[8][c]; mu_k[nt] = p.in[8][512 + c]; mu_v[nt] = p.in[8][1024 + c];
            w0c[nt] = p.in[9][c]; a0c[nt] = p.in[11][c]; kkc[nt] = p.in[14][c]; kac[nt] = p.in[15][c]; rkc[nt] = p.in[16][c]; }
        bf16_t sa_c[5], sa_p[5];
        const unsigned char* zsrc = p.ws + WS_CTL + 128 * 1024;
#define P2_FETCH(cidx_, RAWn_) { const int m0_ = (cidx_) * 16; const bool sq_ = (m0_ & (SEQ - 1)) == 0; \
            _Pragma("unroll") for (int i_ = 0; i_ < 5; ++i_) { const int id_ = tid + 512 * i_, t_ = id_ / 160, j_ = id_ % 160; const bf16_t* ur_ = U + (size_t)(m0_ + t_) * LDU0 + 3584 + j_; sa_c[i_] = ur_[0]; sa_p[i_] = ur_[-LDU0]; } \
            _Pragma("unroll") for (int i_ = 0; i_ < 7; ++i_) { const int q_ = hd + 8 * i_; if (q_ < 51) { const int row_ = q_ / 3, th_ = q_ % 3; \
                const unsigned char* g_ = (row_ == 0 && sq_) ? zsrc + th_ * 1024 + lane * 16 : (const unsigned char*)(U + ((size_t)m0_ + row_) * LDU0 - LDU0 + 2048 + th_ * 512 + lane * 8); \
                __builtin_amdgcn_global_load_lds((const unsigned*)g_, (LAS unsigned*)((RAWn_) + row_ * 3088 + th_ * 1024), 16, 0, 0); } } }
        P2_FETCH(bid, lds + 12288);
        int it = 0;
        for (int cidx = bid; cidx < M / 16; cidx += G, ++it) {
            const int m0 = cidx * 16; const bool seq0 = (m0 & (SEQ - 1)) == 0;
            LAS unsigned char* SL = lds + (it & 1) * (16 * SLS);
            LAS unsigned char* RAW = lds + 12288 + (it & 1) * 52496;
#pragma unroll
            for (int i = 0; i < 5; ++i) { const int id = tid + 512 * i, t = id / 160, j = id % 160;
                const float cur = bf2f(sa_c[i]); const float prev = (t == 0 && seq0) ? 0.f : bf2f(sa_p[i]); const float v = cur + (prev - cur) * p.in[8][1536 + j];
                *(LAS bf16_t*)(SL + t * SLS + j * 2) = f2bf((j < 32) ? tanhf_(v) : (j < 64 ? v : sigmoidf_(v))); }
            asm volatile("s_waitcnt vmcnt(0)" ::: "memory");
            __syncthreads();
            f32x4 dw[4], da[4], dg[4];
            { bf16x8 sf[5];
#pragma unroll
              for (int kk = 0; kk < 5; ++kk) sf[kk] = *(const LAS bf16x8*)(SL + fr * SLS + (kk * 32 + 8 * fq) * 2);
              const f32x4 z4 = {0.f, 0.f, 0.f, 0.f};
#pragma unroll
              for (int nt = 0; nt < 4; ++nt) { const bf16_t* lr = LT + (size_t)(hd * 64 + 4 * fr + nt) * 160 + 8 * fq;
                  const bf16x8 wf = *(const bf16x8*)lr, af = *(const bf16x8*)(lr + 32), g0 = *(const bf16x8*)(lr + 64), g1 = *(const bf16x8*)(lr + 96), g2 = *(const bf16x8*)(lr + 128);
                  dw[nt] = __builtin_amdgcn_mfma_f32_16x16x32_bf16(sf[0], wf, z4, 0, 0, 0); da[nt] = __builtin_amdgcn_mfma_f32_16x16x32_bf16(sf[1], af, z4, 0, 0, 0);
                  f32x4 g = __builtin_amdgcn_mfma_f32_16x16x32_bf16(sf[2], g0, z4, 0, 0, 0); g = __builtin_amdgcn_mfma_f32_16x16x32_bf16(sf[3], g1, g, 0, 0, 0); dg[nt] = __builtin_amdgcn_mfma_f32_16x16x32_bf16(sf[4], g2, g, 0, 0, 0); } }
            { const int cn = (cidx + G < M / 16) ? cidx + G : cidx; P2_FETCH(cn, lds + 12288 + ((it + 1) & 1) * 52496); }
            float as_[4][4], wd_[4][4];
            float ssq[4] = {0.f, 0.f, 0.f, 0.f}, bon[4] = {0.f, 0.f, 0.f, 0.f};
#pragma unroll
            for (int nt = 0; nt < 4; ++nt)
#pragma unroll
                for (int r = 0; r < 4; ++r) { const LAS bf16_t* rw = (const LAS bf16_t*)(RAW + (4 * fq + r) * 3088) + hd * 64 + 4 * fr + nt;
                    const float c0 = bf2f(rw[1544]), c1 = bf2f(rw[1544 + 512]);
                    const float p0 = bf2f(rw[0]), p1 = bf2f(rw[512]);
                    const float rv = c0 + (p0 - c0) * mu_r[nt], kv = c1 + (p1 - c1) * mu_k[nt];
                    const float wlog = -softplusf_(-(w0c[nt] + dw[nt][r])) - 0.5f;
                    wd_[nt][r] = __expf(-__expf(wlog));
                    const float a = sigmoidf_(a0c[nt] + da[nt][r]); as_[nt][r] = a;
                    const float kkv = kv * kkc[nt]; ssq[r] = fmaf(kkv, kkv, ssq[r]);
                    bon[r] = fmaf(rv * kv * (1.f + (a - 1.f) * kac[nt]), rkc[nt], bon[r]); }
#pragma unroll
            for (int r = 0; r < 4; ++r) { ssq[r] = 1.0f / fmaxf(sqrtf(row_sum16(ssq[r])), 1e-12f); bon[r] = row_sum16(bon[r]); }
            float gam[4][5];
#pragma unroll
            for (int nt = 0; nt < 4; ++nt) {
                const float q1 = wd_[nt][0], q2 = q1 * wd_[nt][1], q3 = q2 * wd_[nt][2], q4 = q3 * wd_[nt][3];
                const float t0 = __shfl(q4, fr), t1 = __shfl(q4, fr + 16), t2 = __shfl(q4, fr + 32);
                const float pre = (fq == 0) ? 1.f : (fq == 1) ? t0 : (fq == 2) ? t0 * t1 : t0 * t1 * t2;
                gam[nt][0] = pre; gam[nt][1] = pre * q1; gam[nt][2] = pre * q2; gam[nt][3] = pre * q3; gam[nt][4] = pre * q4; }
#pragma unroll
            for (int r = 0; r < 4; ++r) { const size_t o = (size_t)(m0 + 4 * fq + r) * 512 + hd * 64 + 4 * fr; const LAS bf16_t* rw = (const LAS bf16_t*)(RAW + (4 * fq + r) * 3088) + hd * 64 + 4 * fr;
                float oa[4], orr[4], ob[4], okk[4], ov[4], og[4], obv[4];
#pragma unroll
                for (int nt = 0; nt < 4; ++nt) {
                    const float c0 = bf2f(rw[1544 + nt]), c1 = bf2f(rw[1544 + 512 + nt]), c2 = bf2f(rw[1544 + 1024 + nt]);
                    const float p0 = bf2f(rw[nt]), p1 = bf2f(rw[512 + nt]), p2 = bf2f(rw[1024 + nt]);
                    const float rv = c0 + (p0 - c0) * mu_r[nt], kv = c1 + (p1 - c1) * mu_k[nt], vv = c2 + (p2 - c2) * mu_v[nt];
                    const float a = as_[nt][r], kk = kv * kkc[nt] * ssq[r], kp = kv * (1.f + (a - 1.f) * kac[nt]), ig = __builtin_amdgcn_rcpf(gam[nt][r + 1]), g = dg[nt][r];
                    oa[nt] = -kk * gam[nt][r]; orr[nt] = rv * gam[nt][r + 1]; ob[nt] = kk * a * ig; okk[nt] = kp * ig; ov[nt] = vv; og[nt] = g; obv[nt] = bon[r] * vv * g; }
                u32x2 w;
                w.x = pk2(oa[0], oa[1]); w.y = pk2(oa[2], oa[3]); *(u32x2*)(At + o) = w;
                w.x = pk2(orr[0], orr[1]); w.y = pk2(orr[2], orr[3]); *(u32x2*)(Rt + o) = w;
                w.x = pk2(ob[0], ob[1]); w.y = pk2(ob[2], ob[3]); *(u32x2*)(Bh + o) = w;
                w.x = pk2(okk[0], okk[1]); w.y = pk2(okk[2], okk[3]); *(u32x2*)(Kh + o) = w;
                w.x = pk2(ov[0], ov[1]); w.y = pk2(ov[2], ov[3]); *(u32x2*)(Vv + o) = w;
                w.x = pk2(og[0], og[1]); w.y = pk2(og[2], og[3]); *(u32x2*)(Gg + o) = w;
                w.x = pk2(obv[0], obv[1]); w.y = pk2(obv[2], obv[3]); *(u32x2*)(BVG + o) = w; }
            if (fq == 3) *(f32x4*)(GLc + (size_t)cidx * 512 + hd * 64 + 4 * fr) = (f32x4){gam[0][4], gam[1][4], gam[2][4], gam[3][4]};
        }
#undef P2_FETCH
        STAMP2(20, 0);
        {
            constexpr int HS = 272;
            LAS unsigned char* LQ = lds; LAS unsigned char* LF = lds + 64 * HS; LAS unsigned char* LP = lds + 2 * 64 * HS;
            int prow[2], pc8[2];
#pragma unroll
            for (int i = 0; i < 2; ++i) { const int pp = tid + 512 * i; prow[i] = pp >> 4; pc8[i] = (pp & 15) * 8; }
            u32x4 rq[2], rf[2]; f32x4 lbn[2][2];
#define HP_FETCH(t_) { const int ch_ = (t_) >> 2, hh_ = (t_) & 3; _Pragma("unroll") for (int i_ = 0; i_ < 2; ++i_) { const bf16_t* r_ = U + ((size_t)ch_ * 64 + prow[i_]) * LDU0 + hh_ * 128 + pc8[i_]; rq[i_] = *(const u32x4*)r_; rf[i_] = *(const u32x4*)(r_ + 512); \
                const float* l_ = LBT + hh_ * 128 + (wave + 8 * i_) * 8; lbn[i_][0] = *(const f32x4*)l_; lbn[i_][1] = *(const f32x4*)(l_ + 4); } }
            asm volatile("s_waitcnt vmcnt(0)" ::: "memory");
            __syncthreads();
            for (int i = tid; i < 64 * 144 / 4; i += 512) ((LAS unsigned*)LP)[i] = 0u;
            HP_FETCH(bid);
            for (int tl = bid; tl < (M / 64) * 4; tl += G) {
                const int ch = tl >> 2, hh = tl & 3;
#pragma unroll
                for (int i = 0; i < 2; ++i) { *(LAS u32x4*)(LQ + prow[i] * HS + pc8[i] * 2) = rq[i]; *(LAS u32x4*)(LF + prow[i] * HS + pc8[i] * 2) = rf[i]; }
                const float lbv[2][8] = {{lbn[0][0][0], lbn[0][0][1], lbn[0][0][2], lbn[0][0][3], lbn[0][1][0], lbn[0][1][1], lbn[0][1][2], lbn[0][1][3]}, {lbn[1][0][0], lbn[1][0][1], lbn[1][0][2], lbn[1][0][3], lbn[1][1][0], lbn[1][1][1], lbn[1][1][2], lbn[1][1][3]}};
                __syncthreads();
                { const int tn = (tl + G < (M / 64) * 4) ? tl + G : tl; HP_FETCH(tn); }
#pragma unroll
                for (int gi = 0; gi < 2; ++gi) { const int cg = wave + 8 * gi, c0 = hh * 128 + cg * 8;
                    LAS u32x4* lq = (LAS u32x4*)(LQ + lane * HS + cg * 16); LAS u32x4* lf = (LAS u32x4*)(LF + lane * HS + cg * 16);
                    const u32x4 wq = *lq, wf = *lf;
                    const unsigned wqa[4] = {wq.x, wq.y, wq.z, wq.w}, wfa[4] = {wf.x, wf.y, wf.z, wf.w};
                    unsigned oq[4], ok[4];
#pragma unroll
                    for (int j = 0; j < 8; ++j) { const float aq = (j & 1) ? bfhi(wqa[j >> 1]) : bflo(wqa[j >> 1]), af = (j & 1) ? bfhi(wfa[j >> 1]) : bflo(wfa[j >> 1]);
                        const float kv = (1.f - lbv[gi][j]) * sigmoidf_(-af);
                        float bs = __logf(1.f - kv);
                        bs += __int_as_float(__builtin_amdgcn_update_dpp(0, __float_as_int(bs), 0x111, 0xf, 0xf, true)); bs += __int_as_float(__builtin_amdgcn_update_dpp(0, __float_as_int(bs), 0x112, 0xf, 0xf, true));
                        bs += __int_as_float(__builtin_amdgcn_update_dpp(0, __float_as_int(bs), 0x114, 0xf, 0xf, true)); bs += __int_as_float(__builtin_amdgcn_update_dpp(0, __float_as_int(bs), 0x118, 0xf, 0xf, true));
                        bs += __int_as_float(__builtin_amdgcn_update_dpp(0, __float_as_int(bs), 0x142, 0xa, 0xf, false)); bs += __int_as_float(__builtin_amdgcn_update_dpp(0, __float_as_int(bs), 0x143, 0xc, 0xf, false));
                        const float bm = __int_as_float(__builtin_amdgcn_readlane(__float_as_int(bs), 31)), bL = __int_as_float(__builtin_amdgcn_readlane(__float_as_int(bs), 63));
                        const float qt = siluf_(aq) * __expf(bs - bm), kt = kv * __expf(bm - bs);
                        if (j & 1) { oq[j >> 1] = pk2(__uint_as_float(oq[j >> 1]), qt); ok[j >> 1] = pk2(__uint_as_float(ok[j >> 1]), kt); } else { oq[j >> 1] = __float_as_uint(qt); ok[j >> 1] = __float_as_uint(kt); }
                        if (lane == 0) { const size_t vo = (size_t)ch * 512 + c0 + j; HEM[vo] = __expf(bm); HEL[vo] = __expf(bL); HELM[vo] = __expf(bL - bm); } }
                    u32x4 w; w.x = oq[0]; w.y = oq[1]; w.z = oq[2]; w.w = oq[3]; *lq = w;
                    w.x = ok[0]; w.y = ok[1]; w.z = ok[2]; w.w = ok[3]; *lf = w; }
                LBAR();
#pragma unroll
                for (int i = 0; i < 2; ++i) { bf16_t* r = U + ((size_t)ch * 64 + prow[i]) * LDU0 + hh * 128 + pc8[i];
                    *(u32x4*)r = *(const LAS u32x4*)(LQ + prow[i] * HS + pc8[i] * 2); *(u32x4*)(r + 512) = *(const LAS u32x4*)(LF + prow[i] * HS + pc8[i] * 2); }
                { const int fr = lane & 15, fq = lane >> 4, sb = wave >> 1, tb0 = (wave & 1) * 2;
#define HP_FRAG(T_, row_, kk_) (*(const LAS bf16x8*)((T_) + ((row_) + fr) * HS + ((kk_) * 32 + 8 * fq) * 2))
                  if (sb <= tb0 + 1) { const bool two = sb <= tb0;
                      bf16x8 kf[4], q0f[4], q1f[4];
#pragma unroll
                      for (int kk = 0; kk < 4; ++kk) { kf[kk] = HP_FRAG(LF, sb * 16, kk); q1f[kk] = HP_FRAG(LQ, tb0 * 16 + 16, kk); }
                      if (two) {
#pragma unroll
                          for (int kk = 0; kk < 4; ++kk) q0f[kk] = HP_FRAG(LQ, tb0 * 16, kk); }
                      f32x4 a0 = {0.f, 0.f, 0.f, 0.f}, a1 = {0.f, 0.f, 0.f, 0.f};
                      if (two) {
#pragma unroll
                          for (int kk = 0; kk < 4; ++kk) { a0 = __builtin_amdgcn_mfma_f32_16x16x32_bf16(kf[kk], q0f[kk], a0, 0, 0, 0); a1 = __builtin_amdgcn_mfma_f32_16x16x32_bf16(kf[kk], q1f[kk], a1, 0, 0, 0); }
                      } else {
#pragma unroll
                          for (int kk = 0; kk < 4; ++kk) a1 = __builtin_amdgcn_mfma_f32_16x16x32_bf16(kf[kk], q1f[kk], a1, 0, 0, 0);
                      }
                      const int s0 = sb * 16 + 4 * fq;
#pragma unroll
                      for (int j = 0; j < 2; ++j) { if (j == 1 || two) { const int t = (tb0 + j) * 16 + fr; const f32x4 a = j ? a1 : a0;
                          u32x2 pw; pw.x = pk2((s0 <= t) ? a[0] : 0.f, (s0 + 1 <= t) ? a[1] : 0.f); pw.y = pk2((s0 + 2 <= t) ? a[2] : 0.f, (s0 + 3 <= t) ? a[3] : 0.f);
                          *(LAS u32x2*)(LP + t * 144 + s0 * 2) = pw; } } }
#undef HP_FRAG
                }
                LBAR();
                *(u32x4*)(Pg2 + (size_t)tl * 4096 + tid * 8) = *(const LAS u32x4*)(LP + (tid >> 3) * 144 + (tid & 7) * 16);
            }
#undef HP_FETCH
        }
    }
    GSYNC();
    STAMP(3);

    const bool rwkv_side = ((bid >> 3) & 1) != 0; const int sidx = ((bid >> 4) << 3) | (bid & 7);
    if (rwkv_side) {
        PHASE_IDS
        const int w = __builtin_amdgcn_readfirstlane(tid >> 6), fr = lane & 15, fq = lane >> 4;
        const int grp_ = (sidx & 7) * 8 + (sidx >> 4), vp = (sidx >> 3) & 1, h = grp_ & 7, b = grp_ >> 3;
        constexpr int BUF = 22272, oRt = 0, oAt = 2304, oBh = 4608, oKh = 6912, oBT = 9216, oKT = 14336, oVT = 19456, oGL = 22016;
        constexpr int oMS = 4 * BUF, MSET = 3840, oAf = oMS + 3 * MSET, oTT = oAf + 2 * 1024, oWT = oTT + 2 * 1280, oUT = oWT + 1280, oST = oUT + 1280, LTOT = oST + 2304;
        constexpr int NCH = SEQ / 16;
        LAS unsigned char* L = lds;
        __syncthreads();
        for (int i = tid; i < LTOT / 4; i += 512) ((LAS unsigned*)L)[i] = 0u;
        __syncthreads();
        const size_t tok0 = (size_t)b * SEQ; const size_t colb = (size_t)h * 64;
#define RC_F144(B_, off_, kk_) (*(const LAS bf16x8*)((B_) + (off_) + fr * 144 + ((kk_) * 32 + 8 * fq) * 2))
#define RC_F80(base_, row0_) (*(const LAS bf16x8*)((base_) + ((row0_) + fr) * 80 + (8 * fq) * 2))
        if (w >= 4) {
            const int lt = tid - 256;
            const bf16_t* arr[4] = {Rt, At, Bh, Kh};
            const int q0 = lt, q1 = lt + 256;
            const int kind2 = (lt < 64) ? 1 : (lt < 80) ? 2 : 3;
            const int g1 = q1 & 7; const bool dr0 = (g1 >> 1) & 1, dr1 = (g1 >> 2) & 1; const unsigned sh1 = (g1 & 1) * 16;
            int rof[8];
#pragma unroll
            for (int j = 0; j < 8; ++j) rof[j] = ((j + g1) & 7) * 40;
            const char* gp0 = (const char*)(arr[q0 >> 7] + (tok0 + ((q0 >> 3) & 15)) * 512 + colb + (q0 & 7) * 8);
            const char* gp1 = (const char*)(arr[q1 >> 7] + (tok0 + ((q1 >> 3) & 15)) * 512 + colb + (q1 & 7) * 8);
            const char* gp2 = kind2 == 1 ? (const char*)(Vv + (tok0 + (lt >> 2)) * 512 + colb + vp * 32 + (lt & 3) * 8)
                            : kind2 == 2 ? (const char*)(GLc + ((size_t)b * NCH) * 512 + colb + (lt - 64) * 4) : gp0;
            const size_t st2 = (kind2 == 2) ? (size_t)512 * 4 : (size_t)16 * 512 * 2;
            u32x4 e0[3], e1[3], e2[3], e3[3], e4[3], e5[3], e6[3], e7[3];
#define RP_H(w_, j_) ((bf16_t)(((j_) & 1) ? ((w_) >> 16) : ((w_) & 0xffffu)))
#define RP_FETCH(D_, c_) { const size_t cc_ = (size_t)((c_) < NCH ? (c_) : NCH - 1); D_[0] = *(const u32x4*)(gp0 + cc_ * (size_t)(16 * 512 * 2)); D_[1] = *(const u32x4*)(gp1 + cc_ * (size_t)(16 * 512 * 2)); D_[2] = *(const u32x4*)(gp2 + cc_ * st2); }
#define RP_TILE(B_, q_, D_, TR_) { const int tl_ = (q_) >> 7, t_ = ((q_) >> 3) & 15, k_ = ((q_) & 7) * 8; *(LAS u32x4*)((B_) + tl_ * 2304 + t_ * 144 + k_ * 2) = D_; \
                if (TR_) { LAS bf16_t* x_ = (LAS bf16_t*)((B_) + (tl_ == 2 ? oBT : oKT) + k_ * 80 + t_ * 2);        \
                    const unsigned u0_ = dr0 ? D_.y : D_.x, u1_ = dr0 ? D_.z : D_.y, u2_ = dr0 ? D_.w : D_.z, u3_ = dr0 ? D_.x : D_.w;                 \
                    const unsigned t0_ = dr1 ? u2_ : u0_, t1_ = dr1 ? u3_ : u1_, t2_ = dr1 ? u0_ : u2_, t3_ = dr1 ? u1_ : u3_;                         \
                    const unsigned r0_ = __builtin_amdgcn_alignbit(t1_, t0_, sh1), r1_ = __builtin_amdgcn_alignbit(t2_, t1_, sh1), r2_ = __builtin_amdgcn_alignbit(t3_, t2_, sh1), r3_ = __builtin_amdgcn_alignbit(t0_, t3_, sh1); \
                    x_[rof[0]] = (bf16_t)r0_; x_[rof[1]] = (bf16_t)(r0_ >> 16); x_[rof[2]] = (bf16_t)r1_; x_[rof[3]] = (bf16_t)(r1_ >> 16); x_[rof[4]] = (bf16_t)r2_; x_[rof[5]] = (bf16_t)(r2_ >> 16); x_[rof[6]] = (bf16_t)r3_; x_[rof[7]] = (bf16_t)(r3_ >> 16); } }
#define RP_STORE(D_, buf_) { LAS unsigned char* B_ = L + (buf_) * BUF; RP_TILE(B_, q0, D_[0], false); RP_TILE(B_, q1, D_[1], false);        \
                if (kind2 == 1) { const unsigned w4_[4] = {D_[2].x, D_[2].y, D_[2].z, D_[2].w}; LAS bf16_t* x_ = (LAS bf16_t*)(B_ + oVT + ((lt & 3) * 8) * 80 + (lt >> 2) * 2); _Pragma("unroll") for (int j_ = 0; j_ < 8; ++j_) x_[j_ * 40] = RP_H(w4_[j_ >> 1], j_); } \
                else if (kind2 == 2) *(LAS u32x4*)(B_ + oGL + (lt - 64) * 16) = D_[2]; }
            RP_FETCH(e0, 0); RP_STORE(e0, 0); RP_FETCH(e0, 1); RP_STORE(e0, 1); RP_FETCH(e0, 2); RP_STORE(e0, 2);
            RP_FETCH(e3, 3); RP_FETCH(e4, 4); RP_FETCH(e5, 5); RP_FETCH(e6, 6); RP_FETCH(e7, 7); RP_FETCH(e0, 8); RP_FETCH(e1, 9); RP_FETCH(e2, 10);
            LBAR(); LBAR(); LBAR();
#define RP_TICK(E_, k_) { if (i + 3 + (k_) < NCH) RP_STORE(E_, (i + 3 + (k_)) & 3); RP_FETCH(E_, i + 11 + (k_)); LBAR(); }
            for (int i = 0; i < NCH; i += 8) {
                RP_TICK(e3, 0); RP_TICK(e4, 1); RP_TICK(e5, 2); RP_TICK(e6, 3); RP_TICK(e7, 4); RP_TICK(e0, 5); RP_TICK(e1, 6); RP_TICK(e2, 7);
            }
#undef RP_TICK
#undef RP_TILE
#undef RP_FETCH
#undef RP_H
#undef RP_STORE
        } else if (w == 1) {
            auto amats = [&](int cc) {
                const LAS unsigned char* B_ = L + (cc & 3) * BUF; LAS unsigned char* Ms = L + oMS + (cc % 3) * MSET; LAS unsigned char* Af = L + oAf + (cc & 1) * 1024;
                const bf16x8 a0 = RC_F144(B_, oAt, 0), a1 = RC_F144(B_, oAt, 1), r0 = RC_F144(B_, oRt, 0), r1 = RC_F144(B_, oRt, 1), b0 = RC_F144(B_, oBh, 0), b1 = RC_F144(B_, oBh, 1), k0 = RC_F144(B_, oKh, 0), k1 = RC_F144(B_, oKh, 1);
                const f32x4 z4 = {0.f, 0.f, 0.f, 0.f};
                f32x4 dab = __builtin_amdgcn_mfma_f32_16x16x32_bf16(b0, a0, z4, 0, 0, 0); dab = __builtin_amdgcn_mfma_f32_16x16x32_bf16(b1, a1, dab, 0, 0, 0);
                f32x4 dak = __builtin_amdgcn_mfma_f32_16x16x32_bf16(k0, a0, z4, 0, 0, 0); dak = __builtin_amdgcn_mfma_f32_16x16x32_bf16(k1, a1, dak, 0, 0, 0);
                f32x4 drb = __builtin_amdgcn_mfma_f32_16x16x32_bf16(b0, r0, z4, 0, 0, 0); drb = __builtin_amdgcn_mfma_f32_16x16x32_bf16(b1, r1, drb, 0, 0, 0);
                f32x4 drk = __builtin_amdgcn_mfma_f32_16x16x32_bf16(k0, r0, z4, 0, 0, 0); drk = __builtin_amdgcn_mfma_f32_16x16x32_bf16(k1, r1, drk, 0, 0, 0);
                const int t = fr, s0 = 4 * fq;
#pragma unroll
                for (int r = 0; r < 4; ++r) { const bool st = s0 + r < t, le = s0 + r <= t; dab[r] = st ? dab[r] : 0.f; dak[r] = st ? dak[r] : 0.f; drb[r] = le ? drb[r] : 0.f; drk[r] = le ? drk[r] : 0.f; }
                *(LAS f32x4*)(Af + t * 64 + s0 * 4) = dab;
                { u32x2 w2; w2.x = pk2(dak[0], dak[1]); w2.y = pk2(dak[2], dak[3]); *(LAS u32x2*)(Ms + t * 80 + s0 * 2) = w2; }
                { u32x2 w2; w2.x = pk2(drb[0], drb[1]); w2.y = pk2(drb[2], drb[3]); *(LAS u32x2*)(Ms + 1280 + t * 80 + s0 * 2) = w2; }
                { u32x2 w2; w2.x = pk2(drk[0], drk[1]); w2.y = pk2(drk[2], drk[3]); *(LAS u32x2*)(Ms + 2560 + t * 80 + s0 * 2) = w2; } };
            LBAR();
            amats(0);
            LBAR();
            amats(1);
            LBAR();
            for (int i = 0; i < NCH; ++i) { if (i + 2 < NCH) amats(i + 2); LBAR(); }
        } else if (w == 2) {
            auto tinv = [&](int cc) {
                const LAS unsigned char* Af = L + oAf + (cc & 1) * 1024; LAS unsigned char* Tt = L + oTT + (cc & 1) * 1280;
                const f32x4 y1 = *(const LAS f32x4*)(Af + fr * 64 + (4 * fq) * 4);
                f32x4 x1;
#pragma unroll
                for (int r = 0; r < 4; ++r) x1[r] = *(const LAS float*)(Af + (4 * fq + r) * 64 + fr * 4);
                asm volatile("s_waitcnt lgkmcnt(0)" ::: "memory");
#define TI_PK4(v_) __builtin_bit_cast(s16x4, (u32x2){pk2((v_)[0], (v_)[1]), pk2((v_)[2], (v_)[3])})
                const f32x4 z4 = {0.f, 0.f, 0.f, 0.f};
                const s16x4 X1 = TI_PK4(x1), Y1 = TI_PK4(y1);
                const f32x4 x2 = __builtin_amdgcn_mfma_f32_16x16x16bf16_1k(Y1, X1, z4, 0, 0, 0), y2 = __builtin_amdgcn_mfma_f32_16x16x16bf16_1k(X1, Y1, z4, 0, 0, 0);
                const s16x4 X2 = TI_PK4(x2), Y2 = TI_PK4(y2);
                const f32x4 x4 = __builtin_amdgcn_mfma_f32_16x16x16bf16_1k(Y2, X2, z4, 0, 0, 0), y4 = __builtin_amdgcn_mfma_f32_16x16x16bf16_1k(X2, Y2, z4, 0, 0, 0);
                const s16x4 X4 = TI_PK4(x4), Y4 = TI_PK4(y4);
                const f32x4 x8 = __builtin_amdgcn_mfma_f32_16x16x16bf16_1k(Y4, X4, z4, 0, 0, 0);
                const s16x4 X8 = TI_PK4(x8);
                f32x4 q0;
#pragma unroll
                for (int r = 0; r < 4; ++r) q0[r] = y1[r] + ((4 * fq + r == fr) ? 1.f : 0.f);
                const f32x4 q1 = __builtin_amdgcn_mfma_f32_16x16x16bf16_1k(X2, TI_PK4(q0), q0, 0, 0, 0);
                const f32x4 q2 = __builtin_amdgcn_mfma_f32_16x16x16bf16_1k(X4, TI_PK4(q1), q1, 0, 0, 0);
                const f32x4 tt = __builtin_amdgcn_mfma_f32_16x16x16bf16_1k(X8, TI_PK4(q2), q2, 0, 0, 0);
                { u32x2 tw; tw.x = pk2(tt[0], tt[1]); tw.y = pk2(tt[2], tt[3]); *(LAS u32x2*)(Tt + fr * 80 + (4 * fq) * 2) = tw; }
#undef TI_PK4
            };
            LBAR(); LBAR();
            tinv(0);
            LBAR();
            for (int i = 0; i < NCH; ++i) { if (i + 1 < NCH) tinv(i + 1); LBAR(); }
        } else {
            const int vi = (w == 3) ? 1 : 0;
#define RC_R8(p_) (*(const LAS s16x4*)(p_))
#define RC_CAT(x_, y_) __builtin_shufflevector((x_), (y_), 0, 1, 2, 3, 4, 5, 6, 7)
#define RC_PK4(v_) __builtin_bit_cast(s16x4, (u32x2){pk2((v_)[0], (v_)[1]), pk2((v_)[2], (v_)[3])})
            f32x4 Sacc[4]; s16x4 sp[4];
#pragma unroll
            for (int kt = 0; kt < 4; ++kt) { Sacc[kt] = (f32x4){0.f, 0.f, 0.f, 0.f}; sp[kt] = (s16x4){0, 0, 0, 0}; }
            bf16_t* yg = Vv + tok0 * 512 + colb + vp * 32 + vi * 16;
            LBAR(); LBAR(); LBAR();
            for (int i = 0; i < NCH; ++i) {
                const LAS unsigned char* B_ = L + (i & 3) * BUF; const LAS unsigned char* Ms = L + oMS + (i % 3) * MSET; const LAS unsigned char* Tt = L + oTT + (i & 1) * 1280;
                const LAS unsigned char* ap = B_ + oAt + fr * 144 + (4 * fq) * 2; const LAS unsigned char* rp = B_ + oRt + fr * 144 + (4 * fq) * 2;
                const bf16x8 a0 = RC_CAT(RC_R8(ap), RC_R8(ap + 32)), a1 = RC_CAT(RC_R8(ap + 64), RC_R8(ap + 96)), r0 = RC_CAT(RC_R8(rp), RC_R8(rp + 32)), r1 = RC_CAT(RC_R8(rp + 64), RC_R8(rp + 96));
                const bf16x8 vtf = RC_F80(B_ + oVT, vi * 16), makf = RC_F80(Ms, 0), mrkf = RC_F80(Ms + 2560, 0);
                const s16x4 tt4 = RC_R8(Tt + fr * 80 + (4 * fq) * 2), mrb4 = RC_R8(Ms + 1280 + fr * 80 + (4 * fq) * 2);
                s16x4 kt4[4], bt4[4]; f32x4 glv[4];
                const s16x4 v4 = RC_R8(B_ + oVT + (vi * 16 + fr) * 80 + (4 * fq) * 2);
                const LAS unsigned char* trp = B_ + ((lane >> 4) * 4 + ((lane >> 2) & 3)) * 144 + ((lane & 3) * 4) * 2;
#pragma unroll
                for (int kt = 0; kt < 4; ++kt) { bt4[kt] = __builtin_amdgcn_ds_read_tr16_b64_v4i16((LAS s16x4*)(trp + oBh + kt * 32)); kt4[kt] = __builtin_amdgcn_ds_read_tr16_b64_v4i16((LAS s16x4*)(trp + oKh + kt * 32)); glv[kt] = *(const LAS f32x4*)(B_ + oGL + (kt * 16 + 4 * fq) * 4); }
                asm volatile("s_waitcnt lgkmcnt(0)" ::: "memory");
                const f32x4 z4 = {0.f, 0.f, 0.f, 0.f};
                const bf16x8 sb0 = RC_CAT(sp[0], sp[1]), sb1 = RC_CAT(sp[2], sp[3]);
                f32x4 dw = __builtin_amdgcn_mfma_f32_16x16x32_bf16(a0, sb0, z4, 0, 0, 0); dw = __builtin_amdgcn_mfma_f32_16x16x32_bf16(a1, sb1, dw, 0, 0, 0);
                dw = __builtin_amdgcn_mfma_f32_16x16x32_bf16(makf, vtf, dw, 0, 0, 0);
                f32x4 dy = __builtin_amdgcn_mfma_f32_16x16x32_bf16(sb0, r0, z4, 0, 0, 0); dy = __builtin_amdgcn_mfma_f32_16x16x32_bf16(sb1, r1, dy, 0, 0, 0);
                dy = __builtin_amdgcn_mfma_f32_16x16x32_bf16(vtf, mrkf, dy, 0, 0, 0);
                f32x4 sk[4];
#pragma unroll
                for (int kt = 0; kt < 4; ++kt) sk[kt] = __builtin_amdgcn_mfma_f32_16x16x16bf16_1k(kt4[kt], v4, Sacc[kt], 0, 0, 0);
                const f32x4 du = __builtin_amdgcn_mfma_f32_16x16x16bf16_1k(tt4, RC_PK4(dw), z4, 0, 0, 0);
                const s16x4 u4 = RC_PK4(du);
                dy = __builtin_amdgcn_mfma_f32_16x16x16bf16_1k(u4, mrb4, dy, 0, 0, 0);
#pragma unroll
                for (int kt = 0; kt < 4; ++kt) {
                    f32x4 sa = __builtin_amdgcn_mfma_f32_16x16x16bf16_1k(bt4[kt], u4, sk[kt], 0, 0, 0);
                    sa = sa * glv[kt]; Sacc[kt] = sa; sp[kt] = RC_PK4(sa); }
                { u32x2 yw; yw.x = pk2(dy[0], dy[1]); yw.y = pk2(dy[2], dy[3]); *(u32x2*)(yg + (size_t)(i * 16 + fr) * 512 + 4 * fq) = yw; }
                LBAR();
            }
#undef RC_R8
#undef RC_CAT
#undef RC_PK4
        }
#undef RC_F144
#undef RC_F80
    }
    STAMP(17);
    if (!rwkv_side) {
        PHASE_IDS
        const int w = __builtin_amdgcn_readfirstlane(tid >> 6), fr = lane & 15, fq = lane >> 4;
        const int grp_ = (sidx & 7) * 4 + (sidx >> 5), vs = (sidx >> 3) & 3, h = grp_ & 3, b = grp_ >> 2;
        constexpr int QS = 272, TS = 144;
        constexpr int BUFB = 50176, oQ = 0, oK = 17408, oVT = 34816, oV = 39424, oP = 40960, oCT = 2 * BUFB, CTB = 8704;
        LAS unsigned char* L = lds;
        const size_t tok0 = (size_t)b * SEQ;
        int prow[2], pc8[2];
#pragma unroll
        for (int i = 0; i < 2; ++i) { const int pp = tid + 512 * i; prow[i] = pp >> 4; pc8[i] = (pp & 15) * 8; }
        const int vrow = tid & 63, vpart = (tid >> 6) & 3;
        u32x4 qaA[2], kaA[2], vaA = {0u, 0u, 0u, 0u}, pqA = {0u, 0u, 0u, 0u}; float vemA = 0.f, velA = 0.f, velmA = 0.f;
        u32x4 qaB[2], kaB[2], vaB = {0u, 0u, 0u, 0u}, pqB = {0u, 0u, 0u, 0u}; float vemB = 0.f, velB = 0.f, velmB = 0.f;
#define HM_FETCH(S_, c_) { const size_t tb_ = tok0 + (size_t)(c_) * 64; _Pragma("unroll") for (int i_ = 0; i_ < 2; ++i_) { const bf16_t* r_ = U + (tb_ + prow[i_]) * LDU0 + h * 128 + pc8[i_]; qa##S_[i_] = *(const u32x4*)r_; ka##S_[i_] = *(const u32x4*)(r_ + 512); } \
            { va##S_ = *(const u32x4*)(U + (tb_ + vrow) * LDU0 + 1024 + h * 128 + vs * 32 + vpart * 8); const size_t vo_ = ((size_t)b * (SEQ / 64) + (c_)) * 512 + h * 128 + (tid & 127); vem##S_ = HEM[vo_]; vel##S_ = HEL[vo_]; velm##S_ = HELM[vo_]; pq##S_ = *(const u32x4*)(Pg2 + ((size_t)(b * (SEQ / 64) + (c_)) * 4 + h) * 4096 + tid * 8); } }
#define HM_H(w_, j_) ((bf16_t)(((j_) & 1) ? ((w_) >> 16) : ((w_) & 0xffffu)))
#define HM_STORE(S_, bo_) { *(LAS u32x4*)(L + (bo_) + oP + (tid >> 3) * TS + (tid & 7) * 16) = pq##S_; _Pragma("unroll") for (int i_ = 0; i_ < 2; ++i_) { *(LAS u32x4*)(L + (bo_) + oQ + prow[i_] * QS + pc8[i_] * 2) = qa##S_[i_]; *(LAS u32x4*)(L + (bo_) + oK + prow[i_] * QS + pc8[i_] * 2) = ka##S_[i_]; } \
            if (tid < 256) { LAS bf16_t* vt_ = (LAS bf16_t*)(L + (bo_) + oVT + (vpart * 8) * TS + vrow * 2); const unsigned vw4_[4] = {va##S_.x, va##S_.y, va##S_.z, va##S_.w}; \
                _Pragma("unroll") for (int j_ = 0; j_ < 8; ++j_) vt_[j_ * (TS / 2)] = HM_H(vw4_[j_ >> 1], j_); } \
            if (tid < 128) { ((LAS float*)(L + (bo_) + oV))[tid] = vem##S_; ((LAS float*)(L + (bo_) + oV))[128 + tid] = vel##S_; ((LAS float*)(L + (bo_) + oV))[256 + tid] = velm##S_; } }
#define HM_FRAG(off_, row_, stride_, kk_) (*(const LAS bf16x8*)(L + (off_) + ((row_) + fr) * (stride_) + ((kk_) * 32 + 8 * fq) * 2))
#define HM_TR4(p_) __builtin_amdgcn_ds_read_tr16_b64_v4i16((LAS s16x4*)(p_))
        __syncthreads();
        for (int i = tid; i < 2 * CTB / 4; i += 512) ((LAS unsigned*)(L + oCT))[i] = 0u;
        HM_FETCH(A, 0); HM_STORE(A, 0); HM_FETCH(B, 1); HM_FETCH(A, 2);
        LBAR();
        f32x4 Cacc[2] = {{0.f, 0.f, 0.f, 0.f}, {0.f, 0.f, 0.f, 0.f}};
        const int rtb = w & 3, rvt = w >> 2;
        const int ktoff = oK + ((lane >> 4) * 8 + ((lane >> 2) & 3)) * QS + (w * 16 + (lane & 3) * 4) * 2;
        for (int c2 = 0; c2 < SEQ / 64; c2 += 2) {
          { const int c = c2;
            const int bo = (c & 1) * BUFB, bn = BUFB - bo;
            const f32x4 emn = *(const f32x4*)(HEM + ((size_t)b * (SEQ / 64) + ((c + 1 < SEQ / 64) ? c + 1 : c)) * 512 + h * 128 + w * 16 + 4 * fq);
            if (c + 1 < SEQ / 64) HM_STORE(B, bn);
            HM_FETCH(B, (c + 3 < SEQ / 64) ? c + 3 : c);
            { f32x4 d = {0.f, 0.f, 0.f, 0.f};
#pragma unroll
                for (int kk = 0; kk < 2; ++kk) d = __builtin_amdgcn_mfma_f32_16x16x32_bf16(HM_FRAG(bo + oVT, rvt * 16, TS, kk), HM_FRAG(bo + oP, rtb * 16, TS, kk), d, 0, 0, 0);
#pragma unroll
                for (int kk = 0; kk < 4; ++kk) d = __builtin_amdgcn_mfma_f32_16x16x32_bf16(HM_FRAG(oCT + (c & 1) * CTB, rvt * 16, QS, kk), HM_FRAG(bo + oQ, rtb * 16, QS, kk), d, 0, 0, 0);
                u32x2 ow; ow.x = pk2(d[0], d[1]); ow.y = pk2(d[2], d[3]);
                *(u32x2*)(U + (tok0 + (size_t)c * 64 + rtb * 16 + fr) * LDU0 + 1024 + h * 128 + vs * 32 + rvt * 16 + 4 * fq) = ow; }
            { f32x4 tmp0 = {0.f, 0.f, 0.f, 0.f}, tmp1 = {0.f, 0.f, 0.f, 0.f};
              const LAS unsigned char* kt = L + bo + ktoff;
#pragma unroll
              for (int kk = 0; kk < 2; ++kk) { const bf16x8 ktf = __builtin_shufflevector(HM_TR4(kt + kk * 32 * QS), HM_TR4(kt + kk * 32 * QS + 4 * QS), 0, 1, 2, 3, 4, 5, 6, 7);
                  tmp0 = __builtin_amdgcn_mfma_f32_16x16x32_bf16(ktf, HM_FRAG(bo + oVT, 0, TS, kk), tmp0, 0, 0, 0); tmp1 = __builtin_amdgcn_mfma_f32_16x16x32_bf16(ktf, HM_FRAG(bo + oVT, 16, TS, kk), tmp1, 0, 0, 0); }
              const int k0 = w * 16 + 4 * fq; const LAS float* vEL = (const LAS float*)(L + bo + oV) + 128; const LAS float* vELM = vEL + 128;
#pragma unroll
              for (int r = 0; r < 4; ++r) { Cacc[0][r] = Cacc[0][r] * vEL[k0 + r] + tmp0[r] * vELM[k0 + r]; Cacc[1][r] = Cacc[1][r] * vEL[k0 + r] + tmp1[r] * vELM[k0 + r]; }
#pragma unroll
              for (int j = 0; j < 2; ++j) { u32x2 cw; cw.x = pk2(Cacc[j][0] * emn[0], Cacc[j][1] * emn[1]); cw.y = pk2(Cacc[j][2] * emn[2], Cacc[j][3] * emn[3]);
                  *(LAS u32x2*)(L + oCT + ((c + 1) & 1) * CTB + (j * 16 + fr) * QS + k0 * 2) = cw; } }
            LBAR();
          }
          { const int c = c2 + 1;
            const int bo = (c & 1) * BUFB, bn = BUFB - bo;
            const f32x4 emn = *(const f32x4*)(HEM + ((size_t)b * (SEQ / 64) + ((c + 1 < SEQ / 64) ? c + 1 : c)) * 512 + h * 128 + w * 16 + 4 * fq);
            if (c + 1 < SEQ / 64) HM_STORE(A, bn);
            HM_FETCH(A, (c + 3 < SEQ / 64) ? c + 3 : c);
            { f32x4 d = {0.f, 0.f, 0.f, 0.f};
#pragma unroll
                for (int kk = 0; kk < 2; ++kk) d = __builtin_amdgcn_mfma_f32_16x16x32_bf16(HM_FRAG(bo + oVT, rvt * 16, TS, kk), HM_FRAG(bo + oP, rtb * 16, TS, kk), d, 0, 0, 0);
#pragma unroll
                for (int kk = 0; kk < 4; ++kk) d = __builtin_amdgcn_mfma_f32_16x16x32_bf16(HM_FRAG(oCT + (c & 1) * CTB, rvt * 16, QS, kk), HM_FRAG(bo + oQ, rtb * 16, QS, kk), d, 0, 0, 0);
                u32x2 ow; ow.x = pk2(d[0], d[1]); ow.y = pk2(d[2], d[3]);
                *(u32x2*)(U + (tok0 + (size_t)c * 64 + rtb * 16 + fr) * LDU0 + 1024 + h * 128 + vs * 32 + rvt * 16 + 4 * fq) = ow; }
            { f32x4 tmp0 = {0.f, 0.f, 0.f, 0.f}, tmp1 = {0.f, 0.f, 0.f, 0.f};
              const LAS unsigned char* kt = L + bo + ktoff;
#pragma unroll
              for (int kk = 0; kk < 2; ++kk) { const bf16x8 ktf = __builtin_shufflevector(HM_TR4(kt + kk * 32 * QS), HM_TR4(kt + kk * 32 * QS + 4 * QS), 0, 1, 2, 3, 4, 5, 6, 7);
                  tmp0 = __builtin_amdgcn_mfma_f32_16x16x32_bf16(ktf, HM_FRAG(bo + oVT, 0, TS, kk), tmp0, 0, 0, 0); tmp1 = __builtin_amdgcn_mfma_f32_16x16x32_bf16(ktf, HM_FRAG(bo + oVT, 16, TS, kk), tmp1, 0, 0, 0); }
              const int k0 = w * 16 + 4 * fq; const LAS float* vEL = (const LAS float*)(L + bo + oV) + 128; const LAS float* vELM = vEL + 128;
#pragma unroll
              for (int r = 0; r < 4; ++r) { Cacc[0][r] = Cacc[0][r] * vEL[k0 + r] + tmp0[r] * vELM[k0 + r]; Cacc[1][r] = Cacc[1][r] * vEL[k0 + r] + tmp1[r] * vELM[k0 + r]; }
#pragma unroll
              for (int j = 0; j < 2; ++j) { u32x2 cw; cw.x = pk2(Cacc[j][0] * emn[0], Cacc[j][1] * emn[1]); cw.y = pk2(Cacc[j][2] * emn[2], Cacc[j][3] * emn[3]);
                  *(LAS u32x2*)(L + oCT + ((c + 1) & 1) * CTB + (j * 16 + fr) * QS + k0 * 2) = cw; } }
            LBAR();
          }
        }
#undef HM_TR4
#undef HM_FETCH
#undef HM_STORE
#undef HM_FRAG
#undef HM_H
    }
    if (!rwkv_side) {
        PHASE_IDS
        int it = NT0 + sidx;
        if (it < NT) {
            TrTile cur, nxt; f32x4 tv[8]; float tg[8];
            P0_DECODE(cur, it); tr_load(cur, tid, tv, tg);
            for (; it < NT; it += 128) {
                const int itn = (it + 128 < NT) ? it + 128 : it; P0_DECODE(nxt, itn);
                __syncthreads();
                tr_to_lds(cur, tid, tv, tg, lds);
                tr_load(nxt, tid, tv, tg);
                __syncthreads();
                tr_store(cur, tid, lds);
                cur = nxt;
            }
        }
    }
#undef P0_DECODE
    GSYNC();
    STAMP(4);

    {
        PHASE_IDS
        const int gw = bid * 8 + wave, NWH = G * 4;
        const int c8 = lane * 8;
        if ((gw & 1) == 0) {
            const f32x4 an0 = *(const f32x4*)(p.in[7] + c8), an1 = *(const f32x4*)(p.in[7] + c8 + 4);
            for (int m0 = gw >> 1; m0 < M; m0 += NWH * 4) {
                u32x4 xo[4], xg[4];
#pragma unroll
                for (int u = 0; u < 4; ++u) { const int m = m0 + u * NWH; const bf16_t* ur = U + (size_t)m * LDU0 + c8; xo[u] = *(const u32x4*)(ur + 1024); xg[u] = *(const u32x4*)(ur + 1536); }
#pragma unroll
                for (int u = 0; u < 4; ++u) { const int m = m0 + u * NWH; {
                    const float o[8] = {bflo(xo[u].x), bfhi(xo[u].x), bflo(xo[u].y), bfhi(xo[u].y), bflo(xo[u].z), bfhi(xo[u].z), bflo(xo[u].w), bfhi(xo[u].w)};
                    const float g[8] = {bflo(xg[u].x), bfhi(xg[u].x), bflo(xg[u].y), bfhi(xg[u].y), bflo(xg[u].z), bfhi(xg[u].z), bflo(xg[u].w), bfhi(xg[u].w)};
                    float ss = 0.f;
#pragma unroll
                    for (int e = 0; e < 8; ++e) ss = fmaf(o[e], o[e], ss);
                    const float rs = 1.0f / sqrtf(row_sum16(ss) * (1.f / 128.f) + RMS_EPS);
                    u32x4 w; w.x = pk2(o[0] * rs * an0[0] * siluf_(g[0]), o[1] * rs * an0[1] * siluf_(g[1])); w.y = pk2(o[2] * rs * an0[2] * siluf_(g[2]), o[3] * rs * an0[3] * siluf_(g[3]));
                    w.z = pk2(o[4] * rs * an1[0] * siluf_(g[4]), o[5] * rs * an1[1] * siluf_(g[5])); w.w = pk2(o[6] * rs * an1[2] * siluf_(g[6]), o[7] * rs * an1[3] * siluf_(g[7]));
                    *(u32x4*)(YC + (size_t)m * DM + c8) = w; } }
            }
        } else {
            const f32x4 lw0 = *(const f32x4*)(p.in[17] + c8), lw1 = *(const f32x4*)(p.in[17] + c8 + 4), lb0 = *(const f32x4*)(p.in[18] + c8), lb1 = *(const f32x4*)(p.in[18] + c8 + 4);
            for (int m0 = gw >> 1; m0 < M; m0 += NWH * 4) {
                u32x4 xy[4], xg[4], xb[4];
#pragma unroll
                for (int u = 0; u < 4; ++u) { const int m = m0 + u * NWH; const size_t i = (size_t)m * 512 + c8; xy[u] = *(const u32x4*)(Vv + i); xg[u] = *(const u32x4*)(Gg + i); xb[u] = *(const u32x4*)(BVG + i); }
#pragma unroll
                for (int u = 0; u < 4; ++u) { const int m = m0 + u * NWH; {
                    const float y[8] = {bflo(xy[u].x), bfhi(xy[u].x), bflo(xy[u].y), bfhi(xy[u].y), bflo(xy[u].z), bfhi(xy[u].z), bflo(xy[u].w), bfhi(xy[u].w)};
                    const float g[8] = {bflo(xg[u].x), bfhi(xg[u].x), bflo(xg[u].y), bfhi(xg[u].y), bflo(xg[u].z), bfhi(xg[u].z), bflo(xg[u].w), bfhi(xg[u].w)};
                    const float bv[8] = {bflo(xb[u].x), bfhi(xb[u].x), bflo(xb[u].y), bfhi(xb[u].y), bflo(xb[u].z), bfhi(xb[u].z), bflo(xb[u].w), bfhi(xb[u].w)};
                    float s1 = 0.f;
#pragma unroll
                    for (int e = 0; e < 8; ++e) s1 += y[e];
                    s1 += dpp_mov<0xB1>(s1); s1 += dpp_mov<0x4E>(s1); s1 += dpp_mov<0x141>(s1);
                    const float mean = s1 * (1.f / 64.f); float s2 = 0.f;
#pragma unroll
                    for (int e = 0; e < 8; ++e) { const float d = y[e] - mean; s2 = fmaf(d, d, s2); }
                    s2 += dpp_mov<0xB1>(s2); s2 += dpp_mov<0x4E>(s2); s2 += dpp_mov<0x141>(s2);
                    const float rs = 1.0f / sqrtf(s2 * (1.f / 64.f) + 64e-5f);
                    float r8[8];
#pragma unroll
                    for (int e = 0; e < 8; ++e) { const float lw = e < 4 ? lw0[e] : lw1[e - 4], lb = e < 4 ? lb0[e] : lb1[e - 4]; r8[e] = ((y[e] - mean) * rs * lw + lb) * g[e] + bv[e]; }
                    u32x4 w; w.x = pk2(r8[0], r8[1]); w.y = pk2(r8[2], r8[3]); w.z = pk2(r8[4], r8[5]); w.w = pk2(r8[6], r8[7]);
                    *(u32x4*)(YC + (size_t)m * DM + 512 + c8) = w; } }
            }
        }
    }
    GSYNC();
    STAMP(5);

    { pg8::Gemm g{YC, (const bf16_t*)(p.ws + WS_OUT0), DM, DM, M, DM, DM}; pg8::StaticOrder S; S.init(M, DM, G, bid);
      pg8::EpiResidual<true, true> E{p.in[0], nullptr, XB, SS1}; pg8::gemm_phase<pg8::EpiResidual<true, true>, pg8::StaticOrder, true, true>(lds, g, S, E); }
    GSYNC();
    STAMP(6);
#define HID U
    { pg8::Gemm g{XB, (const bf16_t*)(p.ws + WS_GU0), DM, DM, M, 2 * FFN, DM}; pg8::StaticOrder S; S.init(M, 2 * FFN, G, bid);
      pg8::EpiSwiGlu E{HID, FFN, SS1}; pg8::gemm_phase<pg8::EpiSwiGlu, pg8::StaticOrder, true, true>(lds, g, S, E); }
    GSYNC();
    STAMP(7);
    { pg8::Gemm g{HID, (const bf16_t*)(p.ws + WS_D0), FFN, FFN, M, DM, FFN}; pg8::StaticOrder S; S.init(M, DM, G, bid);
      pg8::EpiResidual<false, true> E{nullptr, XB, XB, SS2}; pg8::gemm_phase<pg8::EpiResidual<false, true>, pg8::StaticOrder, true, true>(lds, g, S, E); }
    GSYNC();
    STAMP(8);
    { pg8::Gemm g{XB, (const bf16_t*)(p.ws + WS_IN1), DM, DM, M, NP1, DM}; pg8::StaticOrder S; S.init(M, NP1, G, bid);
      pg8::EpiScaleBf16 E{U, LDU1, SS2}; pg8::gemm_phase<pg8::EpiScaleBf16, pg8::StaticOrder, true, true>(lds, g, S, E); }
    GSYNC();
    STAMP(9);

#define Qc ((bf16_t*)(p.ws + WS_YC))
#define Kc ((bf16_t*)(p.ws + WS_MS))
#define gSI ((float*)(p.ws + WS_MS + 48 * MiB))
#define gBI (gSI + (size_t)M * 4)
#define gBT (gSI + (size_t)M * 8)
#define gWL (gSI + (size_t)M * 12)
#define gDP ((float*)(p.ws + WS_MS + 50 * MiB))
#define gDEN ((float*)(p.ws + WS_MS + 51 * MiB))
#define Pg ((bf16_t*)(p.ws + WS_MS + 52 * MiB))
    {
        PHASE_IDS
        const float* cq = p.in[31]; const float* ck = p.in[32];
        const int gw = bid * 8 + wave, NW = G * 8;
#define CV_DECODE(S, item_) const int run##S = (item_) / 3, m0##S = run##S * 16, c##S = ((item_) % 3) * 512 + lane * 8; const bool s0##S = (m0##S & (SEQ - 1)) == 0; \
            const bool isk##S = c##S >= 768; const int cc##S = isk##S ? c##S - 768 : c##S; const float* cw##S = (isk##S ? ck : cq) + cc##S; const float sc##S = isk##S ? 0.07216878364870322f : 1.f;
#define CV_LOAD(S, X, W0, W1) { _Pragma("unroll") for (int i = 0; i < 19; ++i) { const int mm = (i < 3 && s0##S) ? m0##S : m0##S - 3 + i; X[i] = *(const u32x4*)(U + (size_t)mm * LDU1 + 256 + c##S); } \
            _Pragma("unroll") for (int j = 0; j < 4; ++j) { W0[j] = *(const f32x4*)(cw##S + j * 768); W1[j] = *(const f32x4*)(cw##S + j * 768 + 4); } }
#define CV_COMPUTE(S, X, W0, W1) { if (s0##S) { const u32x4 z = {0u, 0u, 0u, 0u}; X[0] = z; X[1] = z; X[2] = z; } \
            bf16_t* dst = (isk##S ? Kc : Qc) + (size_t)m0##S * 768 + cc##S; const float sc = sc##S; \
            _Pragma("unroll") for (int tk = 0; tk < 16; ++tk) { float acc[8]; \
                _Pragma("unroll") for (int e = 0; e < 8; ++e) acc[e] = 0.f; \
                _Pragma("unroll") for (int j = 0; j < 4; ++j) { const u32x4 xv = X[tk + j]; \
                    acc[0] = fmaf(W0[j][0], bflo(xv.x), acc[0]); acc[1] = fmaf(W0[j][1], bfhi(xv.x), acc[1]); acc[2] = fmaf(W0[j][2], bflo(xv.y), acc[2]); acc[3] = fmaf(W0[j][3], bfhi(xv.y), acc[3]); \
                    acc[4] = fmaf(W1[j][0], bflo(xv.z), acc[4]); acc[5] = fmaf(W1[j][1], bfhi(xv.z), acc[5]); acc[6] = fmaf(W1[j][2], bflo(xv.w), acc[6]); acc[7] = fmaf(W1[j][3], bfhi(xv.w), acc[7]); } \
                u32x4 o; o.x = pk2(siluf_(acc[0]) * sc, siluf_(acc[1]) * sc); o.y = pk2(siluf_(acc[2]) * sc, siluf_(acc[3]) * sc); o.z = pk2(siluf_(acc[4]) * sc, siluf_(acc[5]) * sc); o.w = pk2(siluf_(acc[6]) * sc, siluf_(acc[7]) * sc); \
                *(u32x4*)(dst + (size_t)tk * 768) = o; } }
        {
            u32x4 xa[19], xb[19]; f32x4 wa0[4], wa1[4], wb0[4], wb1[4];
            CV_DECODE(A, gw) CV_DECODE(B, gw + NW) CV_DECODE(C, gw + 2 * NW)
            CV_LOAD(A, xa, wa0, wa1)
            CV_LOAD(B, xb, wb0, wb1)
            CV_COMPUTE(A, xa, wa0, wa1)
            CV_LOAD(C, xa, wa0, wa1)
            CV_COMPUTE(B, xb, wb0, wb1)
            CV_COMPUTE(C, xa, wa0, wa1)
        }
#undef CV_DECODE
#undef CV_LOAD
#undef CV_COMPUTE
        for (int it = gw; it < (M / 64) * 4; it += NW) {
            const int ch = it >> 2, hh = it & 3; const size_t m = (size_t)ch * 64 + lane; const bf16_t* ur = U + m * LDU1;
            const float lf = -softplusf_(-(bf2f(ur[3332 + hh]) + p.in[34][hh]));
            const float li = bf2f(ur[3328 + hh]) + p.in[33][hh];
            float bs = lf;
#pragma unroll
            for (int o = 1; o < 64; o <<= 1) { const float t = __shfl_up(bs, o); if (lane >= o) bs += t; }
            const float bL = __shfl(bs, 63);
            gSI[m * 4 + hh] = __expf(bs); gBI[m * 4 + hh] = li - bs; gBT[m * 4 + hh] = bs; gWL[m * 4 + hh] = __expf(bL - bs + li);
            if (lane == 0) gDP[ch * 4 + hh] = __expf(bL);
        }
    }
    GSYNC();
    STAMP(10);

    {
        PHASE_IDS
        const int w = __builtin_amdgcn_readfirstlane(tid >> 6), fr = lane & 15, fq = lane >> 4;
        constexpr int QS = 400, TS = 144, oQ = 0, oK = 25600, oP = 51200, oG = 60416;
        LAS unsigned char* L = lds;
        int prow[3], pc8[3];
#pragma unroll
        for (int i = 0; i < 3; ++i) { const int pp = tid + 512 * i; prow[i] = pp / 24; pc8[i] = (pp % 24) * 8; }
        u32x4 qa[3], ka[3]; float gbi = 0.f, gbt = 0.f;
#define PP_FETCH(it_) { const int bh_ = (it_) >> 6, c_ = (it_) & 63; const size_t tb_ = (size_t)(bh_ >> 2) * SEQ + (size_t)c_ * 64; const int h_ = bh_ & 3; \
            _Pragma("unroll") for (int i_ = 0; i_ < 3; ++i_) { const size_t o_ = (tb_ + prow[i_]) * 768 + h_ * 192 + pc8[i_]; qa[i_] = *(const u32x4*)(Qc + o_); ka[i_] = *(const u32x4*)(Kc + o_); } \
            { const size_t g_ = (tb_ + (tid & 63)) * 4 + h_; gbi = gBI[g_]; gbt = gBT[g_]; } }
#define MM_FRAG(off_, row_, stride_, kk_) (*(const LAS bf16x8*)(L + (off_) + ((row_) + fr) * (stride_) + ((kk_) * 32 + 8 * fq) * 2))
        const LAS float* gBIl = (const LAS float*)(L + oG); const LAS float* gBTl = gBIl + 64;
        __syncthreads();
        for (int i = tid; i < 64 * TS / 4; i += 512) ((LAS unsigned*)(L + oP))[i] = 0u;
        PP_FETCH(bid);
        for (int it = bid; it < (M / 64) * 4; it += G) {
            LBAR();
#pragma unroll
            for (int i = 0; i < 3; ++i) { *(LAS u32x4*)(L + oQ + prow[i] * QS + pc8[i] * 2) = qa[i]; *(LAS u32x4*)(L + oK + prow[i] * QS + pc8[i] * 2) = ka[i]; }
            if (tid < 64) { ((LAS float*)(L + oG))[tid] = gbi; ((LAS float*)(L + oG))[64 + tid] = gbt; }
            { const int itn = (it + G < (M / 64) * 4) ? it + G : it; PP_FETCH(itn); }
            LBAR();
            { const int sb = w >> 1, tb0 = (w & 1) * 2;
              if (sb <= tb0 + 1) {
              const bool two = sb <= tb0;
              bf16x8 kf[6], q0f[6], q1f[6];
#pragma unroll
              for (int kk = 0; kk < 6; ++kk) { kf[kk] = MM_FRAG(oK, sb * 16, QS, kk); q1f[kk] = MM_FRAG(oQ, tb0 * 16 + 16, QS, kk); }
              if (two) {
#pragma unroll
                  for (int kk = 0; kk < 6; ++kk) q0f[kk] = MM_FRAG(oQ, tb0 * 16, QS, kk); }
              const int s0 = sb * 16 + 4 * fq;
              const float bi0 = gBIl[s0], bi1 = gBIl[s0 + 1], bi2 = gBIl[s0 + 2], bi3 = gBIl[s0 + 3];
              const float bt0 = gBTl[tb0 * 16 + fr], bt1 = gBTl[tb0 * 16 + 16 + fr];
              asm volatile("s_waitcnt lgkmcnt(0)" ::: "memory");
              f32x4 a0 = {0.f, 0.f, 0.f, 0.f}, a1 = {0.f, 0.f, 0.f, 0.f};
              if (two) {
#pragma unroll
                  for (int kk = 0; kk < 6; ++kk) { a0 = __builtin_amdgcn_mfma_f32_16x16x32_bf16(kf[kk], q0f[kk], a0, 0, 0, 0); a1 = __builtin_amdgcn_mfma_f32_16x16x32_bf16(kf[kk], q1f[kk], a1, 0, 0, 0); }
              } else {
#pragma unroll
                  for (int kk = 0; kk < 6; ++kk) a1 = __builtin_amdgcn_mfma_f32_16x16x32_bf16(kf[kk], q1f[kk], a1, 0, 0, 0);
              }
#pragma unroll
              for (int j = 0; j < 2; ++j) { if (j == 1 || two) { const int t = (tb0 + j) * 16 + fr; const float bt = j ? bt1 : bt0; const f32x4 a = j ? a1 : a0;
                  const float p0 = (s0 <= t) ? a[0] * __expf(bt + bi0) : 0.f, p1 = (s0 + 1 <= t) ? a[1] * __expf(bt + bi1) : 0.f, p2 = (s0 + 2 <= t) ? a[2] * __expf(bt + bi2) : 0.f, p3 = (s0 + 3 <= t) ? a[3] * __expf(bt + bi3) : 0.f;
                  u32x2 pw; pw.x = pk2(p0, p1); pw.y = pk2(p2, p3); *(LAS u32x2*)(L + oP + t * TS + s0 * 2) = pw; } } } }
            LBAR();
            *(u32x4*)(Pg + (size_t)it * 4096 + tid * 8) = *(const LAS u32x4*)(L + oP + (tid >> 3) * TS + (tid & 7) * 16);
        }
#undef PP_FETCH
#undef MM_FRAG
    }
    GSYNC();

    if (bid < 192) {
        PHASE_IDS
        const int w = __builtin_amdgcn_readfirstlane(tid >> 6);
        const int grp_ = (bid & 7) * 4 + (bid >> 3) / 6;
        const int vs = (bid >> 3) % 6, h = grp_ & 3, b = grp_ >> 2;
        constexpr int QS = 400, TS = 144;
        constexpr int oQ = 0, oK = 25600, oKT = 51200, oVT = 78848, oVW = 85760, oP = 92672, oCT = 101888, oG = 121088;
        LAS unsigned char* L = lds;
        for (int i = tid; i < 19200 / 4; i += 512) ((LAS unsigned*)(L + oCT))[i] = 0u;
        for (int i = tid; i < 16 * TS / 4; i += 512) { ((LAS unsigned*)(L + oVT + 32 * TS))[i] = (i < TS / 4) ? 0x3F803F80u : 0u; ((LAS unsigned*)(L + oVW + 32 * TS))[i] = 0u; }
        const size_t tok0 = (size_t)b * SEQ;
        const int fr = lane & 15, fq = lane >> 4;
        u32x4 qa[3], ka[3], va = {0u, 0u, 0u, 0u}, pq = {0u, 0u, 0u, 0u}; float gsi = 0.f, gwl = 0.f, wlr = 0.f;
        int prow[3], pc8[3];
#pragma unroll
        for (int i = 0; i < 3; ++i) { const int pp = tid + 512 * i; prow[i] = pp / 24; pc8[i] = (pp % 24) * 8; }
        const int vrow = tid & 63, vpart = tid >> 6;
#define MM_FETCH(c_) { const size_t tb_ = tok0 + (size_t)(c_) * 64; _Pragma("unroll") for (int i_ = 0; i_ < 3; ++i_) { const size_t o_ = (tb_ + prow[i_]) * 768 + h * 192 + pc8[i_]; qa[i_] = *(const u32x4*)(Qc + o_); ka[i_] = *(const u32x4*)(Kc + o_); } \
            { va = *(const u32x4*)(U + (tb_ + vrow) * LDU1 + 1792 + h * 192 + vs * 32 + (vpart & 3) * 8); wlr = gWL[(tb_ + vrow) * 4 + h]; } \
            { const size_t g_ = (tb_ + (tid & 63)) * 4 + h; gsi = gSI[g_]; gwl = gWL[g_]; pq = *(const u32x4*)(Pg + ((size_t)((b * 4 + h) * (SEQ / 64) + (c_))) * 4096 + tid * 8); } }
#define MM_H(w_, j_) ((bf16_t)(((j_) & 1) ? ((w_) >> 16) : ((w_) & 0xffffu)))
#define MM_STORE() { _Pragma("unroll") for (int i_ = 0; i_ < 3; ++i_) { *(LAS u32x4*)(L + oQ + prow[i_] * QS + pc8[i_] * 2) = qa[i_]; *(LAS u32x4*)(L + oK + prow[i_] * QS + pc8[i_] * 2) = ka[i_]; \
            } \
            if (tid < 256) { LAS bf16_t* vt_ = (LAS bf16_t*)(L + oVT + (vpart * 8) * TS + vrow * 2); LAS bf16_t* vw_ = (LAS bf16_t*)(L + oVW + (vpart * 8) * TS + vrow * 2); const unsigned vw4_[4] = {va.x, va.y, va.z, va.w}; \
                _Pragma("unroll") for (int j_ = 0; j_ < 8; ++j_) { const bf16_t e_ = MM_H(vw4_[j_ >> 1], j_); vt_[j_ * (TS / 2)] = e_; vw_[j_ * (TS / 2)] = f2bf(bf2f(e_) * wlr); } } \
            *(LAS u32x4*)(L + oP + (tid >> 3) * TS + (tid & 7) * 16) = pq; \
            if (tid < 64) { ((LAS bf16_t*)(L + oVW + 32 * TS))[tid] = f2bf(gwl); ((LAS float*)(L + oG))[tid] = gsi; } }
#define MM_TR4(off_) __builtin_amdgcn_ds_read_tr16_b64_v4i16((LAS s16x4*)(ktb + (off_)))
#define MM_TRF(off_) __builtin_shufflevector(MM_TR4(off_), MM_TR4((off_) + 4 * QS), 0, 1, 2, 3, 4, 5, 6, 7)
#define MM_FRAG(off_, row_, stride_, kk_) (*(const LAS bf16x8*)(L + (off_) + ((row_) + fr) * (stride_) + ((kk_) * 32 + 8 * fq) * 2))
        __syncthreads();
        MM_FETCH(0); MM_STORE();
        LBAR();
        f32x4 Cacc[3][2];
#pragma unroll
        for (int i = 0; i < 3; ++i) { Cacc[i][0] = (f32x4){0.f, 0.f, 0.f, 0.f}; Cacc[i][1] = (f32x4){0.f, 0.f, 0.f, 0.f}; }
        const int nvt = (w < 4) ? 1 : 2, vt0 = (w < 4) ? 0 : 1, db0 = 3 * (w & 3);
        const LAS unsigned char* ktb = L + oK + ((lane >> 4) * 8 + ((lane >> 2) & 3)) * QS + (db0 * 16 + (lane & 3) * 4) * 2;
        const LAS float* gSIl = (const LAS float*)(L + oG);
        for (int c = 0; c < SEQ / 64; ++c) {
            int fr_o = lane & 15, fq_o = lane >> 4; asm volatile("" : "+v"(fr_o), "+v"(fq_o));
            const int fr = fr_o, fq = fq_o;
            const float dp = gDP[(b * (SEQ / 64) + c) * 4 + h];
            MM_FETCH((c + 1 < SEQ / 64) ? c + 1 : c);
            { const int tb = w & 3;
              const int n2 = (w < 4) ? 2 : 1;
              bf16x8 qf[6], pf[2], vtf[2][2], ctf[2][6];
#pragma unroll
              for (int kk = 0; kk < 6; ++kk) qf[kk] = MM_FRAG(oQ, tb * 16, QS, kk);
#pragma unroll
              for (int kk = 0; kk < 2; ++kk) pf[kk] = MM_FRAG(oP, tb * 16, TS, kk);
#pragma unroll
              for (int j = 0; j < 2; ++j) { if (j < n2) { const int vt = (w < 4) ? j : 2;
#pragma unroll
                  for (int kk = 0; kk < 2; ++kk) vtf[j][kk] = MM_FRAG(oVT, vt * 16, TS, kk);
#pragma unroll
                  for (int kk = 0; kk < 6; ++kk) ctf[j][kk] = MM_FRAG(oCT, vt * 16, QS, kk); } }
              const float sit = gSIl[tb * 16 + fr];
              asm volatile("s_waitcnt lgkmcnt(0)" ::: "memory");
              bf16x8 ktf[3][2], vwf[2][2];
#pragma unroll
              for (int i = 0; i < 3; ++i) { ktf[i][0] = MM_TRF(i * 32); ktf[i][1] = MM_TRF(32 * QS + i * 32); }
#pragma unroll
              for (int j = 0; j < 2; ++j) { if (j < nvt) { vwf[j][0] = MM_FRAG(oVW, (vt0 + j) * 16, TS, 0); vwf[j][1] = MM_FRAG(oVW, (vt0 + j) * 16, TS, 1); } }
#pragma unroll
              for (int j = 0; j < 2; ++j) { if (j < n2) { const int vt = (w < 4) ? j : 2;
                  f32x4 d2 = {0.f, 0.f, 0.f, 0.f}, d3 = {0.f, 0.f, 0.f, 0.f};
#pragma unroll
                  for (int kk = 0; kk < 2; ++kk) d2 = __builtin_amdgcn_mfma_f32_16x16x32_bf16(vtf[j][kk], pf[kk], d2, 0, 0, 0);
#pragma unroll
                  for (int kk = 0; kk < 6; ++kk) d3 = __builtin_amdgcn_mfma_f32_16x16x32_bf16(ctf[j][kk], qf[kk], d3, 0, 0, 0);
                  const float o0 = sit * d3[0] + d2[0], o1 = sit * d3[1] + d2[1], o2 = sit * d3[2] + d2[2], o3 = sit * d3[3] + d2[3];
                  const size_t tg = tok0 + (size_t)c * 64 + tb * 16 + fr;
                  if (w < 4) { u32x2 ow; ow.x = pk2(o0, o1); ow.y = pk2(o2, o3); *(u32x2*)(U + tg * LDU1 + 1792 + h * 192 + vs * 32 + vt * 16 + 4 * fq) = ow; }
                  else if (fq == 0 && vs == 0) gDEN[tg * 4 + h] = o0; } }
              asm volatile("s_waitcnt lgkmcnt(0)" ::: "memory");
#pragma unroll
              for (int i = 0; i < 3; ++i)
#pragma unroll
                  for (int j = 0; j < 2; ++j) { if (j < nvt) { f32x4 ca = Cacc[i][j] * dp;
                      ca = __builtin_amdgcn_mfma_f32_16x16x32_bf16(ktf[i][0], vwf[j][0], ca, 0, 0, 0);
                      ca = __builtin_amdgcn_mfma_f32_16x16x32_bf16(ktf[i][1], vwf[j][1], ca, 0, 0, 0); Cacc[i][j] = ca; } } }
            LBAR();
#pragma unroll
            for (int i = 0; i < 3; ++i)
#pragma unroll
                for (int j = 0; j < 2; ++j) { if (j < nvt) { const f32x4 ca = Cacc[i][j]; u32x2 cw; cw.x = pk2(ca[0], ca[1]); cw.y = pk2(ca[2], ca[3]);
                    *(LAS u32x2*)(L + oCT + ((vt0 + j) * 16 + fr) * QS + ((db0 + i) * 16 + 4 * fq) * 2) = cw; } }
            if (c + 1 < SEQ / 64) MM_STORE();
            LBAR();
        }
        STAMP2(18, 0);
#undef MM_FETCH
#undef MM_STORE
#undef MM_FRAG
#undef MM_TR4
#undef MM_TRF
#undef MM_H
    } else {
        PHASE_IDS
        const int w = __builtin_amdgcn_readfirstlane(tid >> 6), myc = w >> 2, wq = myc ? 3 - (w & 3) : (w & 3);
        const int fr = lane & 15, fq = lane >> 4;
        constexpr int US = 80, XS = 272, NB = SEQ / 32;
        constexpr int oU = 0, oW1 = 10240, oX = 20480, oH = 37888, oW2 = 55296, oZ = 59648, CH = 61696;
        LAS unsigned char* Lc = lds + myc * CH;
        __syncthreads();
        for (int i = tid; i < 2 * CH / 4; i += 512) ((LAS unsigned*)lds)[i] = 0u;
        __syncthreads();
        for (int i = tid; i < 2 * 128 * 16; i += 512) { const int cc = i >> 11, n = (i >> 4) & 127, k = i & 15; const int g_ = ((bid - 192) * 2 + cc) & 15;
            const float v = (n < 64) ? BBR[(g_ * 64 + n) * 16 + k] : BBI[(g_ * 64 + n - 64) * 16 + k];
            ((LAS bf16_t*)(lds + cc * CH + oW1 + n * US))[k] = f2bf(v); }
        for (int i = tid; i < 2 * 16 * 128; i += 512) { const int cc = i >> 11, hh = (i >> 7) & 15, k = i & 127; const int g_ = ((bid - 192) * 2 + cc) & 15;
            const float v = (k < 64) ? p.in[26][(g_ * 16 + hh) * 64 + k] : -p.in[27][(g_ * 16 + hh) * 64 + k - 64];
            ((LAS bf16_t*)(lds + cc * CH + oW2 + hh * XS))[k] = f2bf(v); }
        const int chain = (bid - 192) * 2 + myc, g = chain & 15, b = chain >> 4;
        bf16_t* gU = U + ((size_t)b * SEQ + (lane >> 1)) * LDU1 + g * 16 + (lane & 1) * 8;
        __syncthreads();
        if (wq == 3) {
            u32x4 sA, sB;
            const int lo = (lane >> 1) * US + (lane & 1) * 16, zo = (lane >> 1) * 32 + (lane & 1) * 16;
#define S5_LD(i_) (*(const u32x4*)(gU + (size_t)(((i_) < NB ? (i_) : NB - 1) * 32) * LDU1))
            sA = S5_LD(0); *(LAS u32x4*)(Lc + oU + 0 * 2560 + lo) = sA; sB = S5_LD(1); *(LAS u32x4*)(Lc + oU + 1 * 2560 + lo) = sB;
            sA = S5_LD(2); sB = S5_LD(3);
            LBAR(); LBAR();
            for (int it = 0; it < NB + 2; it += 2) {
                if (it + 2 < NB) *(LAS u32x4*)(Lc + oU + ((it + 2) & 3) * 2560 + lo) = sA;
                if (it >= 2) *(u32x4*)(gU + (size_t)((it - 2) * 32) * LDU1) = *(const LAS u32x4*)(Lc + oZ + (it & 1) * 1024 + zo);
                sA = S5_LD(it + 4);
                LBAR();
                if (it + 3 < NB) *(LAS u32x4*)(Lc + oU + ((it + 3) & 3) * 2560 + lo) = sB;
                if (it >= 1 && it - 1 < NB) *(u32x4*)(gU + (size_t)((it - 1) * 32) * LDU1) = *(const LAS u32x4*)(Lc + oZ + ((it + 1) & 1) * 1024 + zo);
                sB = S5_LD(it + 5);
                LBAR();
            }
#undef S5_LD
        } else if (wq == 1) {
            bf16x8 w1f[8];
#pragma unroll
            for (int j = 0; j < 8; ++j) w1f[j] = *(const LAS bf16x8*)(Lc + oW1 + (j * 16 + fr) * US + (8 * fq) * 2);
            auto xblk = [&](int blk) {
                const LAS unsigned char* Ut = Lc + oU + (blk & 3) * 2560; LAS unsigned char* Xt = Lc + oX + (blk & 1) * 8704;
                const bf16x8 u0 = *(const LAS bf16x8*)(Ut + fr * US + (8 * fq) * 2), u1 = *(const LAS bf16x8*)(Ut + (16 + fr) * US + (8 * fq) * 2);
                const f32x4 z4 = {0.f, 0.f, 0.f, 0.f};
#pragma unroll
                for (int j = 0; j < 8; ++j) { const f32x4 d0 = __builtin_amdgcn_mfma_f32_16x16x32_bf16(u0, w1f[j], z4, 0, 0, 0), d1 = __builtin_amdgcn_mfma_f32_16x16x32_bf16(u1, w1f[j], z4, 0, 0, 0);
                    LAS bf16_t* xp = (LAS bf16_t*)(Xt + (4 * fq) * XS) + j * 16 + fr;
#pragma unroll
                    for (int r = 0; r < 4; ++r) { xp[r * (XS / 2)] = f2bf(d0[r]); xp[(16 + r) * (XS / 2)] = f2bf(d1[r]); } } };
            LBAR();
            xblk(0);
            LBAR();
            for (int it = 0; it < NB + 2; ++it) { if (it + 1 < NB) xblk(it + 1); LBAR(); }
        } else if (wq == 0) {
            const float ar = LBR[g * 64 + lane], ai = LBI[g * 64 + lane];
            float hr = 0.f, hi = 0.f;
            LBAR(); LBAR();
            for (int it = 0; it < NB + 2; ++it) {
                if (it < NB) { const LAS bf16_t* xp = (const LAS bf16_t*)(Lc + oX + (it & 1) * 8704) + lane; LAS bf16_t* hp = (LAS bf16_t*)(Lc + oH + (it & 1) * 8704) + lane;
                    for (int t8 = 0; t8 < 32; t8 += 8) {
                        bf16_t xr[8], xi[8], or_[8], oi_[8];
#pragma unroll
                        for (int u = 0; u < 8; ++u) { xr[u] = xp[(t8 + u) * (XS / 2)]; xi[u] = xp[(t8 + u) * (XS / 2) + 64]; }
#pragma unroll
                        for (int u = 0; u < 8; ++u) { const float nr = fmaf(ar, hr, fmaf(-ai, hi, bf2f(xr[u]))), ni = fmaf(ar, hi, fmaf(ai, hr, bf2f(xi[u]))); hr = nr; hi = ni; or_[u] = f2bf(hr); oi_[u] = f2bf(hi); }
#pragma unroll
                        for (int u = 0; u < 8; ++u) { hp[(t8 + u) * (XS / 2)] = or_[u]; hp[(t8 + u) * (XS / 2) + 64] = oi_[u]; } } }
                LBAR();
            }
        } else {
            bf16x8 w2f[4];
#pragma unroll
            for (int kk = 0; kk < 4; ++kk) w2f[kk] = *(const LAS bf16x8*)(Lc + oW2 + fr * XS + (kk * 32 + 8 * fq) * 2);
            const float dsk = p.in[28][g * 16 + fr];
            LBAR(); LBAR();
            for (int it = 0; it < NB + 2; ++it) {
                if (it >= 1 && it - 1 < NB) { const int blk = it - 1; const LAS unsigned char* Ht = Lc + oH + (blk & 1) * 8704; const LAS unsigned char* Ut = Lc + oU + (blk & 3) * 2560; LAS unsigned char* Zt = Lc + oZ + (blk & 1) * 1024;
#pragma unroll
                    for (int tb = 0; tb < 2; ++tb) { f32x4 d = {0.f, 0.f, 0.f, 0.f};
#pragma unroll
                        for (int kk = 0; kk < 4; ++kk) d = __builtin_amdgcn_mfma_f32_16x16x32_bf16(*(const LAS bf16x8*)(Ht + (tb * 16 + fr) * XS + (kk * 32 + 8 * fq) * 2), w2f[kk], d, 0, 0, 0);
#pragma unroll
                        for (int r = 0; r < 4; ++r) { const int t = tb * 16 + 4 * fq + r;
                            const float y = d[r] + dsk * bf2f(*(const LAS bf16_t*)(Ut + t * US + fr * 2));
                            const float z = 0.5f * y * (1.f + tanhf_(0.7978845608028654f * (y + 0.044715f * y * y * y)));
                            *(LAS bf16_t*)(Zt + t * 32 + fr * 2) = f2bf(z); } } }
                LBAR();
            }
        }
        STAMP2(19, 192);
    }
    GSYNC();
    STAMP(11);

    {
        PHASE_IDS
        const int w = __builtin_amdgcn_readfirstlane(tid >> 6), fr = lane & 15, fq = lane >> 4;
        constexpr int ZS = 528;
        const bf16_t* WT = (const bf16_t*)(p.ws + WS_GLU);
        bf16x8 wf[2][8];
#pragma unroll
        for (int nt = 0; nt < 2; ++nt)
#pragma unroll
            for (int kk = 0; kk < 8; ++kk) wf[nt][kk] = *(const bf16x8*)(WT + (size_t)(w * 32 + nt * 16 + fr) * 256 + kk * 32 + 8 * fq);
        f32x4 bias4[2];
#pragma unroll
        for (int nt = 0; nt < 2; ++nt) bias4[nt] = *(const f32x4*)(p.in[30] + w * 32 + nt * 16 + 4 * fq);
        u32x4 zr[4];
#define GL_FETCH(m_) { _Pragma("unroll") for (int i = 0; i < 4; ++i) { const int pp = tid + 512 * i, row = pp >> 5, c8 = (pp & 31) * 8; zr[i] = *(const u32x4*)(U + (size_t)((m_) + row) * LDU1 + c8); } }
        GL_FETCH(bid * 64)
        for (int m0 = bid * 64; m0 < M; m0 += G * 64) {
            LBAR();
#pragma unroll
            for (int i = 0; i < 4; ++i) { const int pp = tid + 512 * i, row = pp >> 5, c8 = (pp & 31) * 8; *(LAS u32x4*)(lds + row * ZS + c8 * 2) = zr[i]; }
            { const int mn = (m0 + G * 64 < M) ? m0 + G * 64 : m0; GL_FETCH(mn) }
            LBAR();
#pragma unroll
            for (int tb = 0; tb < 4; ++tb) { f32x4 d0 = {0.f, 0.f, 0.f, 0.f}, d1 = {0.f, 0.f, 0.f, 0.f};
#pragma unroll
                for (int kk = 0; kk < 8; ++kk) { const bf16x8 zf = *(const LAS bf16x8*)(lds + (tb * 16 + fr) * ZS + (kk * 32 + 8 * fq) * 2);
                    d0 = __builtin_amdgcn_mfma_f32_16x16x32_bf16(wf[0][kk], zf, d0, 0, 0, 0); d1 = __builtin_amdgcn_mfma_f32_16x16x32_bf16(wf[1][kk], zf, d1, 0, 0, 0); }
                const int t = tb * 16 + fr;
#pragma unroll
                for (int nt = 0; nt < 2; ++nt) { const f32x4 a = (nt ? d1 : d0) + bias4[nt]; const int n0 = w * 32 + nt * 16 + 4 * fq;
                    const u32x2 zz = *(const LAS u32x2*)(lds + t * ZS + n0 * 2);
                    u32x2 o; o.x = pk2(bflo(zz.x) * sigmoidf_(a[0]), bfhi(zz.x) * sigmoidf_(a[1])); o.y = pk2(bflo(zz.y) * sigmoidf_(a[2]), bfhi(zz.y) * sigmoidf_(a[3]));
                    *(u32x2*)(YC + (size_t)(m0 + t) * DM + n0) = o; } }
        }
    }
#undef GL_FETCH
    {
        PHASE_IDS
        const int gw = bid * 8 + wave, NW = G * 8, hh = lane >> 4, c12 = lane * 12;
        f32x4 nw[3];
#pragma unroll
        for (int j = 0; j < 3; ++j) nw[j] = *(const f32x4*)(p.in[35] + c12 + 4 * j);
        for (int m0 = gw; m0 < M; m0 += NW * 4) {
            u32x2 xn[4][3], xo[4][3]; float dn[4];
#pragma unroll
            for (int u = 0; u < 4; ++u) { const int m = m0 + u * NW; const bf16_t* ur = U + (size_t)m * LDU1 + c12; dn[u] = gDEN[(size_t)m * 4 + hh];
#pragma unroll
                for (int j = 0; j < 3; ++j) { xn[u][j] = *(const u32x2*)(ur + 1792 + 4 * j); xo[u][j] = *(const u32x2*)(ur + 2560 + 4 * j); } }
#pragma unroll
            for (int u = 0; u < 4; ++u) { const int m = m0 + u * NW; const float inv = 1.0f / fmaxf(fabsf(dn[u]), 1.0f);
                float hv[12], og[12]; float ss = 0.f;
#pragma unroll
                for (int j = 0; j < 3; ++j) { hv[4 * j] = bflo(xn[u][j].x) * inv; hv[4 * j + 1] = bfhi(xn[u][j].x) * inv; hv[4 * j + 2] = bflo(xn[u][j].y) * inv; hv[4 * j + 3] = bfhi(xn[u][j].y) * inv;
                    og[4 * j] = bflo(xo[u][j].x); og[4 * j + 1] = bfhi(xo[u][j].x); og[4 * j + 2] = bflo(xo[u][j].y); og[4 * j + 3] = bfhi(xo[u][j].y); }
#pragma unroll
                for (int e = 0; e < 12; ++e) ss = fmaf(hv[e], hv[e], ss);
                const float rs = 1.0f / sqrtf(row_sum16(ss) * (1.f / 192.f) + RMS_EPS);
                bf16_t* yo = YC + (size_t)m * DM + 256 + c12;
#pragma unroll
                for (int j = 0; j < 3; ++j) { u32x2 w; w.x = pk2(hv[4 * j] * rs * nw[j][0] * sigmoidf_(og[4 * j]), hv[4 * j + 1] * rs * nw[j][1] * sigmoidf_(og[4 * j + 1]));
                    w.y = pk2(hv[4 * j + 2] * rs * nw[j][2] * sigmoidf_(og[4 * j + 2]), hv[4 * j + 3] * rs * nw[j][3] * sigmoidf_(og[4 * j + 3])); *(u32x2*)(yo + 4 * j) = w; } }
        }
    }
    GSYNC();
    STAMP(12);

    { pg8::Gemm g{YC, (const bf16_t*)(p.ws + WS_OUT1), DM, DM, M, DM, DM}; pg8::StaticOrder S; S.init(M, DM, G, bid);
      pg8::EpiResidual<false, true> E{nullptr, XB, XB, SS3}; pg8::gemm_phase<pg8::EpiResidual<false, true>, pg8::StaticOrder, true, true>(lds, g, S, E); }
    GSYNC();
    STAMP(13);
    { pg8::Gemm g{XB, (const bf16_t*)(p.ws + WS_GU1), DM, DM, M, 2 * FFN, DM}; pg8::StaticOrder S; S.init(M, 2 * FFN, G, bid);
      pg8::EpiSwiGlu E{HID, FFN, SS3}; pg8::gemm_phase<pg8::EpiSwiGlu, pg8::StaticOrder, true, true>(lds, g, S, E); }
    GSYNC();
    STAMP(14);
    { pg8::Gemm g{HID, (const bf16_t*)(p.ws + WS_D1), FFN, FFN, M, DM, FFN}; pg8::StaticOrder S; S.init(M, DM, G, bid);
      pg8::EpiResidual<false, false> E{nullptr, XB, XB, nullptr}; pg8::gemm_phase<pg8::EpiResidual<false, false>, pg8::StaticOrder, true, true>(lds, g, S, E); }
    GSYNC();
    STAMP(15);

    {
        PHASE_IDS
        const f32x4* gg = (const f32x4*)p.in[3] + lane;
        f32x4 gv[4];
#pragma unroll
        for (int j = 0; j < 4; ++j) gv[j] = gg[64 * j];
        for (int row = bid * 8 + wave; row < M; row += G * 32) {
            u32x2 w[4][4];
#pragma unroll
            for (int r = 0; r < 4; ++r)
#pragma unroll
                for (int j = 0; j < 4; ++j) w[r][j] = ((const u32x2*)(XB + (size_t)(row + r * G * 8) * DM))[64 * j + lane];
#pragma unroll
            for (int r = 0; r < 4; ++r) { f32x4 v[4]; float s = 0.f;
#pragma unroll
                for (int j = 0; j < 4; ++j) { v[j] = (f32x4){bflo(w[r][j].x), bfhi(w[r][j].x), bflo(w[r][j].y), bfhi(w[r][j].y)}; s += (v[j][0] * v[j][0] + v[j][1] * v[j][1]) + (v[j][2] * v[j][2] + v[j][3] * v[j][3]); }
                const float rs = 1.0f / sqrtf(wave_sum(s) * (1.f / DM) + RMS_EPS);
                f32x4* xr = (f32x4*)(p.out + (size_t)(row + r * G * 8) * DM) + lane;
#pragma unroll
                for (int j = 0; j < 4; ++j) __builtin_nontemporal_store(v[j] * rs * gv[j], xr + 64 * j); }
        }
    }
    STAMP(16);
#if PROBE
    if (bid == 0 && threadIdx.x == 0) {
        const unsigned long long* ts = (const unsigned long long*)(p.ws + CTL_TS);
        const int order[18] = {0, 1, 2, 3, 17, 4, 5, 6, 7, 8, 9, 10, 11, 12, 13, 14, 15, 16};
        unsigned long long extra = 0;
        for (int j = 0; j < 17; ++j) if ((PROBE_MASK >> j) & 1) extra += __hip_atomic_load(ts + order[j + 1], __ATOMIC_RELAXED, __HIP_MEMORY_SCOPE_AGENT) - __hip_atomic_load(ts + order[j], __ATOMIC_RELAXED, __HIP_MEMORY_SCOPE_AGENT);
#ifdef PROBE_A
        extra += __hip_atomic_load(ts + PROBE_B, __ATOMIC_RELAXED, __HIP_MEMORY_SCOPE_AGENT) - __hip_atomic_load(ts + PROBE_A, __ATOMIC_RELAXED, __HIP_MEMORY_SCOPE_AGENT);
#endif
        const unsigned long long t0 = __builtin_amdgcn_s_memrealtime();
        while (__builtin_amdgcn_s_memrealtime() - t0 < extra) __builtin_amdgcn_s_sleep(8);
    }
#endif
}

extern "C" void kernel_launch(void* const* d_in, const int* in_sizes, int n_in, void* d_out, int out_size, void* d_ws, size_t ws_size, hipStream_t stream) {
    static int ready = 0;
    if (!ready) {
        if (n_in != 39 || out_size != M * DM || ws_size < WS_END) { fprintf(stderr, "kernel_launch: unexpected problem shape (n_in %d out %d ws %zu)\n", n_in, out_size, ws_size); ready = -1; return; }
        if (hipFuncSetAttribute((const void*)mega, hipFuncAttributeMaxDynamicSharedMemorySize, LDS_BYTES) != hipSuccess) { fprintf(stderr, "kernel_launch: hipFuncSetAttribute failed\n"); ready = -1; return; }
        int per_cu = 0; (void)hipOccupancyMaxActiveBlocksPerMultiprocessor(&per_cu, (const void*)mega, 512, LDS_BYTES);
        if (per_cu < 1) fprintf(stderr, "kernel_launch: occupancy query says %d blocks per CU\n", per_cu);
        (void)hipGetLastError();
        ready = 1;
    }
    if (ready < 0) return;
    (void)hipMemsetAsync((char*)d_ws + WS_CTL, 0, CTL_BYTES, stream);
    Params p{};
    for (int i = 0; i < 39; ++i) p.in[i] = (const float*)d_in[i];
    p.out = (float*)d_out; p.ws = (unsigned char*)d_ws;
    void* args[] = {&p};
    hipError_t e = hipLaunchCooperativeKernel((const void*)mega, dim3(256), dim3(512), args, LDS_BYTES, stream);
    if (e != hipSuccess) fprintf(stderr, "kernel_launch: cooperative launch failed: %s\n", hipGetErrorString(e));
}
```
